# Optimizing an MI355X kernel written in HIP

```python
import jax, jax.numpy as jnp
from jax import lax
import numpy as np

D_MODEL = 1024
BATCH = 8
SEQ = 2048
DEPTH = 1
DEC_BATCH = 128
DEC_SEQ = 1
PAST_LEN = 8192
PAGE_SIZE = 128

D_MIX = D_MODEL
D_REC = D_MIX // 2
N_REC_BLOCKS = 8
REC_BLOCK = D_REC // N_REC_BLOCKS
CONV_W = 4
LRU_C = 8.0
N_HEADS = 8
HEAD_DIM = 64
N_KV_HEADS = 2
GQA_GROUP = N_HEADS // N_KV_HEADS
D_ATTN = N_HEADS * HEAD_DIM
D_KV = N_KV_HEADS * HEAD_DIM
WINDOW = 128
ATTN_BLOCK = 128
D_FF = -(-8 * D_MODEL // (3 * 256)) * 256
D_IN = 2 * D_REC + D_ATTN + 2 * D_KV
IN_SPLITS = (D_REC, 2 * D_REC, 2 * D_REC + D_ATTN, 2 * D_REC + D_ATTN + D_KV)
EPS = 1e-6

kernel_name = 'hymba_style_rglru_swa_sink_decoder_step'


def _rmsnorm(x, g):
    xf = x.astype(jnp.float32)
    y = xf * lax.rsqrt(jnp.mean(xf * xf, axis=-1, keepdims=True) + EPS) * g.astype(jnp.float32)
    return y.astype(x.dtype)


def _causal_conv(x, buf, w, b):
    xp = jnp.concatenate([buf.astype(x.dtype), x], axis=1)
    T = x.shape[1]
    y = b + xp[:, 0:T] * w[0]
    for j in range(1, CONV_W):
        y = y + xp[:, j:j + T] * w[j]
    return y, xp[:, xp.shape[1] - (CONV_W - 1):]


def _block_diag(x, w, b):
    xb = x.reshape(x.shape[:-1] + (N_REC_BLOCKS, REC_BLOCK))
    y = jnp.einsum('btni,nij->btnj', xb, w.astype(jnp.float32))
    return y.reshape(x.shape) + b.astype(jnp.float32)


def _rglru(x, h0, gate_a_w, gate_a_b, gate_x_w, gate_x_b, lru_lambda):
    xf = x.astype(jnp.float32)
    r = jax.nn.sigmoid(_block_diag(xf, gate_a_w, gate_a_b))
    i = jax.nn.sigmoid(_block_diag(xf, gate_x_w, gate_x_b))
    log_a = -LRU_C * r * jax.nn.softplus(-lru_lambda.astype(jnp.float32))
    a = jnp.exp(log_a)
    u = jnp.sqrt(-jnp.expm1(2.0 * log_a)) * (i * xf)

    def step(h, au):
        a_t, u_t = au
        h = a_t * h + u_t
        return h, h

    h_last, hs = lax.scan(step, h0.astype(jnp.float32),
                          (jnp.swapaxes(a, 0, 1), jnp.swapaxes(u, 0, 1)))
    return jnp.swapaxes(hs, 0, 1), h_last


def _sink_attention(q, k, v, mask, sinks):
    s = jnp.einsum('bnqkgd,bnskd->bnkgqs', q.astype(jnp.float32), k.astype(jnp.float32)) * (HEAD_DIM ** -0.5)
    s = jnp.where(mask[None, :, None, None], s, -jnp.inf)
    sink = sinks.astype(jnp.float32).reshape(1, 1, N_KV_HEADS, GQA_GROUP, 1, 1)
    sink = jnp.broadcast_to(sink, s.shape[:-1] + (1,))
    p = jax.nn.softmax(jnp.concatenate([s, sink], axis=-1), axis=-1)[..., :-1]
    o = jnp.einsum('bnkgqs,bnskd->bnqkgd', p, v.astype(jnp.float32))
    return o.astype(q.dtype)


def _prompt_attention(q, k, v, sinks):
    B, T = q.shape[:2]
    nb = T // ATTN_BLOCK
    qb = q.reshape(B, nb, ATTN_BLOCK, N_KV_HEADS, GQA_GROUP, HEAD_DIM)
    kb = k.reshape(B, nb, ATTN_BLOCK, N_KV_HEADS, HEAD_DIM)
    vb = v.reshape(B, nb, ATTN_BLOCK, N_KV_HEADS, HEAD_DIM)

    def band(xb):
        prev = jnp.concatenate([jnp.zeros_like(xb[:, :1]), xb[:, :-1]], axis=1)
        return jnp.concatenate([prev, xb], axis=2)

    blk = jnp.arange(nb)[:, None, None] * ATTN_BLOCK
    qpos = blk + jnp.arange(ATTN_BLOCK)[None, :, None]
    kpos = blk - ATTN_BLOCK + jnp.arange(2 * ATTN_BLOCK)[None, None, :]
    mask = (kpos >= 0) & (kpos <= qpos) & (kpos >= qpos - WINDOW)
    o = _sink_attention(qb, band(kb), band(vb), mask, sinks)
    return o.reshape(B, T, D_ATTN)


def _sample_attention(q, k, v, k_buf, v_buf, sinks):
    B, T = q.shape[:2]
    Wb = k_buf.shape[1]
    k_all = jnp.concatenate([k_buf.astype(k.dtype), k], axis=1)
    v_all = jnp.concatenate([v_buf.astype(v.dtype), v], axis=1)
    qpos = Wb + jnp.arange(T)[:, None]
    kpos = jnp.arange(Wb + T)[None, :]
    mask = ((kpos <= qpos) & (kpos >= qpos - WINDOW))[None]
    o = _sink_attention(q[:, None], k_all[:, None], v_all[:, None], mask, sinks)
    return o.reshape(B, T, D_ATTN), k_all[:, T:], v_all[:, T:]


def _layer(x, conv_buf, h0, k_buf, v_buf, norm1_g, w_in, conv_w, conv_b, gate_a_w, gate_a_b,
           gate_x_w, gate_x_b, lru_lambda, attn_sinks, rec_norm_g, attn_norm_g, w_out,
           norm2_g, w_gate, w_up, w_down):
    B, T, _ = x.shape
    xn = _rmsnorm(x, norm1_g)
    z = jnp.einsum('btd,de->bte', xn, w_in)
    xr, gr, q, k, v = jnp.split(z, IN_SPLITS, axis=-1)
    if conv_buf is None:
        conv_buf = jnp.zeros((B, CONV_W - 1, D_REC), x.dtype)
        h0 = jnp.zeros((B, D_REC), jnp.float32)
    xc, new_conv = _causal_conv(xr, conv_buf, conv_w, conv_b)
    hs, h_last = _rglru(xc, h0, gate_a_w, gate_a_b, gate_x_w, gate_x_b, lru_lambda)
    rec = (hs * jax.nn.gelu(gr.astype(jnp.float32))).astype(x.dtype)
    q = q.reshape(B, T, N_KV_HEADS, GQA_GROUP, HEAD_DIM)
    k = k.reshape(B, T, N_KV_HEADS, HEAD_DIM)
    v = v.reshape(B, T, N_KV_HEADS, HEAD_DIM)
    if k_buf is None:
        att = _prompt_attention(q, k, v, attn_sinks)
        keep = min(WINDOW, T)
        new_k, new_v = k[:, T - keep:], v[:, T - keep:]
    else:
        att, new_k, new_v = _sample_attention(q, k, v, k_buf, v_buf, attn_sinks)
    mix = jnp.concatenate([_rmsnorm(rec, rec_norm_g), _rmsnorm(att, attn_norm_g)], axis=-1)
    h = x + jnp.einsum('bte,ed->btd', mix, w_out)
    hn = _rmsnorm(h, norm2_g)
    ff = jax.nn.silu(jnp.einsum('btd,df->btf', hn, w_gate)) * jnp.einsum('btd,df->btf', hn, w_up)
    y = h + jnp.einsum('btf,fd->btd', ff, w_down)
    return y, new_k, new_v, new_conv, h_last.astype(x.dtype)


def setup_inputs(seed: int = 0) -> dict:
    key = jax.random.key(seed)
    ks = jax.random.split(key, 24)
    f32 = jnp.float32
    w_buf = min(WINDOW, PAST_LEN)

    def nrm(k, shape, scale):
        return jax.random.normal(k, shape, f32) * scale

    def gain(k, shape):
        return 1.0 + 0.05 * jax.random.normal(k, shape, f32)

    a0 = jax.random.uniform(ks[14], (DEPTH, D_REC), f32, 0.9, 0.999)
    s = a0 ** (1.0 / LRU_C)
    lru_lambda = jnp.log(s) - jnp.log1p(-s)
    return {
        'x_prompt': nrm(ks[0], (BATCH, SEQ, D_MODEL), 1.0),
        'x_sample': nrm(ks[1], (DEC_BATCH, DEC_SEQ, D_MODEL), 1.0),
        'cache_k_win': nrm(ks[2], (DEPTH, DEC_BATCH, w_buf, N_KV_HEADS, HEAD_DIM), 1.0),
        'cache_v_win': nrm(ks[3], (DEPTH, DEC_BATCH, w_buf, N_KV_HEADS, HEAD_DIM), 1.0),
        'state_conv': nrm(ks[4], (DEPTH, DEC_BATCH, CONV_W - 1, D_REC), 1.0),
        'state_h': nrm(ks[5], (DEPTH, DEC_BATCH, D_REC), 0.5),
        'norm1_g': gain(ks[6], (DEPTH, D_MODEL)),
        'w_in': nrm(ks[7], (DEPTH, D_MODEL, D_IN), D_MODEL ** -0.5),
        'conv_w': nrm(ks[8], (DEPTH, CONV_W, D_REC), CONV_W ** -0.5),
        'conv_b': nrm(ks[9], (DEPTH, D_REC), 0.02),
        'gate_a_w': nrm(ks[10], (DEPTH, N_REC_BLOCKS, REC_BLOCK, REC_BLOCK), REC_BLOCK ** -0.5),
        'gate_a_b': nrm(ks[11], (DEPTH, D_REC), 0.02),
        'gate_x_w': nrm(ks[12], (DEPTH, N_REC_BLOCKS, REC_BLOCK, REC_BLOCK), REC_BLOCK ** -0.5),
        'gate_x_b': nrm(ks[13], (DEPTH, D_REC), 0.02),
        'lru_lambda': lru_lambda,
        'attn_sinks': nrm(ks[15], (DEPTH, N_HEADS), 0.5),
        'rec_norm_g': gain(ks[16], (DEPTH, D_REC)),
        'attn_norm_g': gain(ks[17], (DEPTH, D_ATTN)),
        'w_out': nrm(ks[18], (DEPTH, D_MIX, D_MODEL), D_MIX ** -0.5),
        'norm2_g': gain(ks[19], (DEPTH, D_MODEL)),
        'w_gate': nrm(ks[20], (DEPTH, D_MODEL, D_FF), D_MODEL ** -0.5),
        'w_up': nrm(ks[21], (DEPTH, D_MODEL, D_FF), D_MODEL ** -0.5),
        'w_down': nrm(ks[22], (DEPTH, D_FF, D_MODEL), D_FF ** -0.5),
        'final_norm_g': gain(ks[23], (D_MODEL,)),
    }


def reference(x_prompt, x_sample, cache_k_win, cache_v_win, state_conv, state_h,
              norm1_g, w_in, conv_w, conv_b, gate_a_w, gate_a_b, gate_x_w, gate_x_b,
              lru_lambda, attn_sinks, rec_norm_g, attn_norm_g, w_out, norm2_g,
              w_gate, w_up, w_down, final_norm_g):
    params = (norm1_g, w_in, conv_w, conv_b, gate_a_w, gate_a_b, gate_x_w, gate_x_b,
              lru_lambda, attn_sinks, rec_norm_g, attn_norm_g, w_out, norm2_g,
              w_gate, w_up, w_down)
    yp, ys = x_prompt, x_sample
    pk, pv, pc, ph = [], [], [], []
    sk, sv, sc, sh = [], [], [], []
    for l in range(DEPTH):
        p = [t[l] for t in params]
        yp, k1, v1, c1, h1 = _layer(yp, None, None, None, None, *p)
        ys, k2, v2, c2, h2 = _layer(ys, state_conv[l], state_h[l], cache_k_win[l], cache_v_win[l], *p)
        pk.append(k1); pv.append(v1); pc.append(c1); ph.append(h1)
        sk.append(k2); sv.append(v2); sc.append(c2); sh.append(h2)
    y_prompt = _rmsnorm(yp, final_norm_g)
    y_sample = _rmsnorm(ys, final_norm_g)
    return (y_prompt, y_sample, jnp.stack(pk), jnp.stack(pv), jnp.stack(pc), jnp.stack(ph),
            jnp.stack(sk), jnp.stack(sv), jnp.stack(sc), jnp.stack(sh))
```

```cpp
#include <hip/hip_runtime.h>
#include <hip/hip_cooperative_groups.h>
#include <cstdio>
#include <cstdint>
namespace cg = cooperative_groups;
namespace pg8 {
#define PG8_LAS __attribute__((address_space(3)))
typedef unsigned short bf16_t;
typedef short bf16x8 __attribute__((ext_vector_type(8)));
typedef float f32x4 __attribute__((ext_vector_type(4)));
typedef unsigned u32x4 __attribute__((ext_vector_type(4)));
constexpr int BM = 256, BK = 64, HALF = 128, HTB = HALF * BK * 2  , STAGE_BYTES = 8 * HTB, NXCD = 8, WGM = 8;

__host__ __device__ __forceinline__ int lds_byte(int r, int c) { const int st = (r >> 4) * 2 + (c >> 5), rr = r & 15, cc = c & 31, ob = rr * 64 + cc * 2; return st * 1024 + (ob ^ (((ob >> 9) & 1) << 5)); }
__host__ __device__ __forceinline__ void stage_rc(int b, int& R, int& C) { const int st = b / 1024, sb = b % 1024, swz = sb ^ (((sb >> 9) & 1) << 5); R = (st >> 1) * 16 + swz / 64; C = (st & 1) * 32 + (swz % 64) / 2; }
__host__ __device__ __forceinline__ int perm32(int rho) { const int n = rho >> 4, i = rho & 15; return 8 * (i >> 2) + 4 * n + (i & 3); }

struct Unit { int pm, pn; };
struct Gemm { const bf16_t* A; const bf16_t* Bt; int M, N, K; };

struct StaticOrder {
    int nM, nN, nwg, G, c;
    __host__ __device__ void init(int M, int N, int G_, int c_) { nM = M / BM; nN = N / BM; nwg = nM * nN; G = G_; c = c_; }
    __host__ __device__ bool next(int i, Unit& u) const {
        const long L = (long)i * G + c; if (L >= nwg) return false;
        int wgid = (int)L; { const int q = nwg / NXCD, r = nwg % NXCD, xcd = wgid % NXCD, off = wgid / NXCD; wgid = (xcd < r ? xcd * (q + 1) : r * (q + 1) + (xcd - r) * q) + off; }
        const int nig = WGM * nN, gid = wgid / nig, fm = gid * WGM, gsz = (nM - fm) < WGM ? (nM - fm) : WGM;
        u.pm = fm + ((wgid % nig) % gsz); u.pn = (wgid % nig) / gsz; return true;
    }
    __device__ __forceinline__ void a_ready(const Unit&) const {}
    __device__ __forceinline__ void done(const Unit&) const {}
};

template <class Epi, class Sched, bool ALIGN_EPI = false, bool SP2 = false>
__device__ __forceinline__ void gemm_phase(PG8_LAS unsigned char* lds, const Gemm g, const Sched& S, const Epi& E) {
    int tid_ = threadIdx.x; asm volatile("" : "+v"(tid_));
    const int tid = tid_, wid = __builtin_amdgcn_readfirstlane(tid >> 6), lane = tid & 63, wr = wid >> 2, wc = wid & 3, fr = lane & 15, fq = lane >> 4;
    const int K = g.K, nt = K / BK;
    unsigned voffA[2], voffB[2];
#pragma unroll
    for (int i = 0; i < 2; ++i) { int R, C; stage_rc(tid * 16 + i * 8192, R, C); const int Rb = Epi::PERM ? ((R & ~31) + perm32(R & 31)) : R;
        voffA[i] = (unsigned)(R * K + C) * 2u; voffB[i] = (unsigned)(Rb * K + C) * 2u; }
    const size_t kstep = (size_t)(BK * 2);
    const size_t hstep = (size_t)HALF * K * 2;
    const size_t tstep = 2 * hstep;
    const unsigned ldsw = (unsigned)wid * 1024u;
    const int aoff = lds_byte(wr * 64 + fr, fq * 8), boff = lds_byte(wc * 32 + fr, fq * 8);
#define PG8_SA(b, h) (((b) * 2 + (h)) * HTB)
#define PG8_SB(b, h) ((4 + (b) * 2 + (h)) * HTB)
#define PG8_STAGE(bufoff, gbase, voff) do { _Pragma("unroll") for (int _i = 0; _i < 2; ++_i) \
        __builtin_amdgcn_global_load_lds((const unsigned*)((const char*)(gbase) + (voff)[_i]), (PG8_LAS unsigned*)(lds + (bufoff) + ldsw + _i * 8192), 16, 0, 0); } while (0)
#define PG8_LDA(dst, b, h) do { _Pragma("unroll") for (int m = 0; m < 4; ++m) _Pragma("unroll") for (int k = 0; k < 2; ++k) dst[m][k] = *(const PG8_LAS bf16x8*)(lds + PG8_SA(b, h) + aoff + m * 2048 + k * 1024); } while (0)
#define PG8_LDB(dst, b, h) do { _Pragma("unroll") for (int n = 0; n < 2; ++n) _Pragma("unroll") for (int k = 0; k < 2; ++k) dst[n][k] = *(const PG8_LAS bf16x8*)(lds + PG8_SB(b, h) + boff + n * 2048 + k * 1024); } while (0)
#define PG8_MMA(ai, bj, At, Bt) do { __builtin_amdgcn_s_setprio(1); _Pragma("unroll") for (int m = 0; m < 4; ++m) _Pragma("unroll") for (int n = 0; n < 2; ++n) _Pragma("unroll") for (int k = 0; k < 2; ++k) \
        acc[ai][bj][m][n] = __builtin_amdgcn_mfma_f32_16x16x32_bf16(Bt[n][k], At[m][k], acc[ai][bj][m][n], 0, 0, 0); __builtin_amdgcn_s_setprio(0); } while (0)
#define PG8_WAIT_V(n) asm volatile("s_waitcnt vmcnt(" #n ")" ::: "memory")
#define PG8_WAIT_L(n) asm volatile("s_waitcnt lgkmcnt(" #n ")" ::: "memory")
#define PG8_BAR __builtin_amdgcn_s_barrier()
#define PG8_SCHED __builtin_amdgcn_sched_barrier(0)
    Unit cur, nxt; int ui = 0;
    if (!S.next(0, cur)) return;
    f32x4 acc[2][2][4][2];
#pragma unroll
    for (int a = 0; a < 2; ++a)
#pragma unroll
        for (int b = 0; b < 2; ++b)
#pragma unroll
            for (int m = 0; m < 4; ++m)
#pragma unroll
                for (int n = 0; n < 2; ++n) acc[a][b][m][n] = (f32x4){0.f, 0.f, 0.f, 0.f};
    bf16x8 At[4][2], B0[2][2], B1[2][2];
    const char* cA = (const char*)g.A + (size_t)cur.pm * tstep; const char* cB = (const char*)g.Bt + (size_t)cur.pn * tstep;
    S.a_ready(cur);
    if constexpr (SP2) {
        PG8_STAGE(PG8_SB(0, 0), cB, voffB); PG8_STAGE(PG8_SB(0, 1), cB + hstep, voffB); PG8_STAGE(PG8_SA(0, 0), cA, voffA); PG8_STAGE(PG8_SA(0, 1), cA + hstep, voffA);
        if (wr == 1) PG8_BAR;
        PG8_WAIT_V(2); PG8_BAR;
        PG8_STAGE(PG8_SB(1, 0), cB + kstep, voffB); PG8_STAGE(PG8_SA(1, 0), cA + kstep, voffA); PG8_STAGE(PG8_SB(1, 1), cB + hstep + kstep, voffB);
        PG8_WAIT_V(6); PG8_BAR;
    } else {
        PG8_STAGE(PG8_SB(0, 0), cB, voffB); PG8_STAGE(PG8_SA(0, 0), cA, voffA); PG8_STAGE(PG8_SB(0, 1), cB + hstep, voffB); PG8_STAGE(PG8_SA(0, 1), cA + hstep, voffA);
        if (wr == 1) PG8_BAR;
        PG8_WAIT_V(4); PG8_BAR;
        PG8_STAGE(PG8_SB(1, 0), cB + kstep, voffB); PG8_STAGE(PG8_SA(1, 0), cA + kstep, voffA); PG8_STAGE(PG8_SB(1, 1), cB + hstep + kstep, voffB);
        PG8_WAIT_V(6); PG8_BAR;
    }
    for (;;) {
        const bool has_next = S.next(ui + 1, nxt);
        const char* nA = has_next ? (const char*)g.A + (size_t)nxt.pm * tstep : cA; const char* nB = has_next ? (const char*)g.Bt + (size_t)nxt.pn * tstep : cB;
        for (int t = 0; t < nt; t += 2) {
            const bool last = (t == nt - 2);
            const char* a1 = cA + (size_t)(t + 1) * kstep;
            const char* a2 = last ? nA : cA + (size_t)(t + 2) * kstep; const char* b2 = last ? nB : cB + (size_t)(t + 2) * kstep;
            const char* a3 = a2 + kstep; const char* b3 = b2 + kstep;
            if (last && has_next) S.a_ready(nxt);
            if constexpr (SP2) {
            PG8_LDB(B0, 0, 0); PG8_LDB(B1, 0, 1); PG8_SCHED; PG8_LDA(At, 0, 0); PG8_STAGE(PG8_SA(1, 1), a1 + hstep, voffA);
            PG8_WAIT_V(8); PG8_WAIT_L(0); PG8_BAR; PG8_MMA(0, 0, At, B0); PG8_MMA(0, 1, At, B1); PG8_BAR; PG8_SCHED;
            PG8_LDA(At, 0, 1); PG8_STAGE(PG8_SB(0, 0), b2, voffB); PG8_STAGE(PG8_SB(0, 1), b2 + hstep, voffB); PG8_STAGE(PG8_SA(0, 0), a2, voffA);
            PG8_WAIT_V(8); PG8_WAIT_L(0); PG8_BAR; PG8_MMA(1, 0, At, B0); PG8_MMA(1, 1, At, B1); PG8_BAR; PG8_SCHED;
            PG8_LDB(B0, 1, 0); PG8_LDB(B1, 1, 1); PG8_SCHED; PG8_LDA(At, 1, 0); PG8_STAGE(PG8_SA(0, 1), a2 + hstep, voffA);
            PG8_WAIT_V(8); PG8_WAIT_L(0); PG8_BAR; PG8_MMA(0, 0, At, B0); PG8_MMA(0, 1, At, B1); PG8_BAR; PG8_SCHED;
            PG8_LDA(At, 1, 1); PG8_STAGE(PG8_SB(1, 0), b3, voffB); PG8_STAGE(PG8_SB(1, 1), b3 + hstep, voffB); PG8_STAGE(PG8_SA(1, 0), a3, voffA);
            PG8_WAIT_V(8); PG8_WAIT_L(0); PG8_BAR; PG8_MMA(1, 0, At, B0); PG8_MMA(1, 1, At, B1); PG8_BAR; PG8_SCHED;
            } else {
            PG8_LDB(B0, 0, 0); PG8_SCHED; PG8_LDA(At, 0, 0); PG8_STAGE(PG8_SA(1, 1), a1 + hstep, voffA);
            PG8_WAIT_L(8); PG8_BAR; PG8_WAIT_L(0); PG8_MMA(0, 0, At, B0); PG8_BAR; PG8_SCHED;
            PG8_LDB(B1, 0, 1); PG8_STAGE(PG8_SB(0, 0), b2, voffB);
            PG8_BAR; PG8_WAIT_L(0); PG8_MMA(0, 1, At, B1); PG8_BAR;
            PG8_LDA(At, 0, 1); PG8_STAGE(PG8_SA(0, 0), a2, voffA);
            PG8_BAR; PG8_WAIT_L(0); PG8_MMA(1, 0, At, B0); PG8_BAR; PG8_SCHED;
            PG8_STAGE(PG8_SB(0, 1), b2 + hstep, voffB);
            PG8_WAIT_V(6); PG8_BAR; PG8_MMA(1, 1, At, B1); PG8_BAR;
            PG8_LDB(B0, 1, 0); PG8_SCHED; PG8_LDA(At, 1, 0); PG8_STAGE(PG8_SA(0, 1), a2 + hstep, voffA);
            PG8_WAIT_L(8); PG8_BAR; PG8_WAIT_L(0); PG8_MMA(0, 0, At, B0); PG8_BAR; PG8_SCHED;
            PG8_LDB(B1, 1, 1); PG8_STAGE(PG8_SB(1, 0), b3, voffB);
            PG8_BAR; PG8_WAIT_L(0); PG8_MMA(0, 1, At, B1); PG8_BAR;
            PG8_LDA(At, 1, 1); PG8_STAGE(PG8_SA(1, 0), a3, voffA);
            PG8_BAR; PG8_WAIT_L(0); PG8_MMA(1, 0, At, B0); PG8_BAR; PG8_SCHED;
            PG8_STAGE(PG8_SB(1, 1), b3 + hstep, voffB);
            PG8_WAIT_V(6); PG8_BAR; PG8_MMA(1, 1, At, B1); PG8_BAR;
            }
        }
        if constexpr (ALIGN_EPI) { if (wr == 0) PG8_BAR; }
        if constexpr (!Epi::AFTER_DRAIN) { E(acc, cur, wr, wc, fr, fq); S.done(cur); }
        if (!has_next) break;
#pragma unroll
        for (int a = 0; a < 2; ++a)
#pragma unroll
            for (int b = 0; b < 2; ++b)
#pragma unroll
                for (int m = 0; m < 4; ++m)
#pragma unroll
                    for (int n = 0; n < 2; ++n) acc[a][b][m][n] = (f32x4){0.f, 0.f, 0.f, 0.f};
        cur = nxt; cA = nA; cB = nB; ++ui;
        if constexpr (ALIGN_EPI) { if (wr == 1) PG8_BAR; }
    }
    PG8_WAIT_V(0);
    if constexpr (!ALIGN_EPI) { if (wr == 0) PG8_BAR; }
    PG8_BAR;
    if constexpr (Epi::AFTER_DRAIN) { E.fused(acc, cur, wr, wc, fr, fq, lds, wid, lane); S.done(cur); }
#undef PG8_SA
#undef PG8_SB
#undef PG8_STAGE
#undef PG8_LDA
#undef PG8_LDB
#undef PG8_MMA
#undef PG8_WAIT_V
#undef PG8_WAIT_L
#undef PG8_BAR
#undef PG8_SCHED
}
}

#define LAS __attribute__((address_space(3)))
typedef unsigned short bf16;
typedef short bf16x8 __attribute__((ext_vector_type(8)));
typedef float f32x4 __attribute__((ext_vector_type(4)));
typedef float f32x16 __attribute__((ext_vector_type(16)));
typedef unsigned u32x4 __attribute__((ext_vector_type(4)));
typedef unsigned u32x2 __attribute__((ext_vector_type(2)));
typedef float f32x2_t __attribute__((ext_vector_type(2)));
typedef __bf16 bf16x2_t __attribute__((ext_vector_type(2)));

constexpr int DM = 1024, TSEQ = 2048, NB = 8, MP = NB * TSEQ  , NS = 128  , MR = MP + NS  , MPAD = 16640  ;
constexpr int DREC = 512, DATT = 512, DKV = 128, DFF = 2816, DIN = 1792;
constexpr float EPS = 1e-6f;
constexpr int NWAVES = 8, NTHR = 512;
constexpr size_t OFF_Y = 0, OFF_PK = (size_t)MR * DM, OFF_PV = OFF_PK + 131072, OFF_PCONV = OFF_PV + 131072, OFF_PH = OFF_PCONV + 12288,
                 OFF_SK = OFF_PH + 4096, OFF_SV = OFF_SK + 2097152, OFF_SCONV = OFF_SV + 2097152, OFF_SH = OFF_SCONV + 196608, OUT_END = OFF_SH + 65536;
constexpr size_t MiB = 1u << 20;
constexpr size_t WS_RSQH = 0, WS_SUMA = 1 * MiB, WS_SUMH = 1 * MiB + 512 * 1024;
constexpr size_t WS_WIN = 2 * MiB, WS_WOUT = 6 * MiB, WS_WGU = 8 * MiB, WS_WD = 19 * MiB, WS_GWT = 25 * MiB;
constexpr size_t WS_MIX = 26 * MiB, WS_HB = 59 * MiB, WS_FF = 92 * MiB;
constexpr size_t WS_XN = 92 * MiB, WS_XR = 125 * MiB, WS_GR = 142 * MiB, WS_Q = 159 * MiB, WS_KB = 176 * MiB, WS_VT = 181 * MiB, WS_END = 186 * MiB;
static_assert(WS_MIX + (size_t)MPAD * DM * 2 <= WS_HB && WS_HB + (size_t)MPAD * DM * 2 <= WS_FF && WS_FF + (size_t)MPAD * DFF * 2 <= WS_END, "ws map");
static_assert(WS_GR - WS_XR == WS_Q - WS_GR, "xr/gr/q equally spaced");
static_assert(WS_XN + (size_t)MPAD * DM * 2 <= WS_XR && WS_XR + (size_t)MPAD * 512 * 2 <= WS_GR && WS_GR + (size_t)MPAD * 512 * 2 <= WS_Q && WS_Q + (size_t)MPAD * 512 * 2 <= WS_KB && WS_KB + (size_t)MPAD * 128 * 2 <= WS_VT, "ws map 2");
constexpr int LDS_BYTES = 132096;

struct Params {
    const float* in[24];
    float* out; unsigned char* ws;
};
typedef const __attribute__((address_space(4))) Params* KP;
__device__ __forceinline__ KP kargs() { KP q = (KP)__builtin_amdgcn_kernarg_segment_ptr(); asm volatile("" : "+s"(q)); return q; }
enum { I_XP = 0, I_XS, I_CK, I_CV, I_SCONV, I_SH, I_N1G, I_WIN, I_CONVW, I_CONVB, I_GAW, I_GAB, I_GXW, I_GXB, I_LAM, I_SINK, I_RNG, I_ANG, I_WOUT, I_N2G, I_WG, I_WU, I_WD, I_FNG };

__device__ __forceinline__ unsigned pk2(float lo, float hi) { f32x2_t v = {lo, hi}; bf16x2_t b = __builtin_convertvector(v, bf16x2_t); return __builtin_bit_cast(unsigned, b); }
__device__ __forceinline__ float bflo(unsigned w) { return __uint_as_float(w << 16); }
__device__ __forceinline__ float bfhi(unsigned w) { return __uint_as_float(w & 0xffff0000u); }
__device__ __forceinline__ float bf1(bf16 u) { return __uint_as_float((unsigned)u << 16); }
__device__ __forceinline__ float wave_sum(float v) {
#pragma unroll
    for (int o = 1; o < 64; o <<= 1) v += __shfl_xor(v, o);
    return v;
}
__device__ __forceinline__ float wave_max(float v) {
#pragma unroll
    for (int o = 1; o < 64; o <<= 1) v = fmaxf(v, __shfl_xor(v, o));
    return v;
}
__device__ __forceinline__ float sigmoidf_(float x) { return 1.0f / (1.0f + __expf(-x)); }
__device__ __forceinline__ float gelu_tanh(float x) { const float z = 0.7978845608028654f * (x + 0.044715f * x * x * x); const float e = __expf(2.0f * z); const float th = 1.0f - 2.0f / (e + 1.0f); return 0.5f * x * (1.0f + th); }

using pg8::Unit;
struct EpiIn {
    static constexpr bool PERM = true, AFTER_DRAIN = false;
    unsigned char* ws; float* out;
    __device__ __forceinline__ void operator()(const f32x4 (&acc)[2][2][4][2], const Unit& u, int wr, int wc, int fr, int fq) const {
        const int pn = u.pn;
        bf16* const KB = (bf16*)(ws + WS_KB); bf16* const VT = (bf16*)(ws + WS_VT);
#pragma unroll
        for (int ai = 0; ai < 2; ++ai)
#pragma unroll
            for (int m = 0; m < 4; ++m) {
                const int row = u.pm * 256 + ai * 128 + wr * 64 + m * 16 + fr;
                const bool isp = row < MP, iss = (row >= MP) && (row < MR);
                const int b = isp ? (row >> 11) : (row - MP), t = row & (TSEQ - 1);
#pragma unroll
                for (int bj = 0; bj < 2; ++bj) {
                    const int c = bj * 128 + wc * 32 + 8 * fq;
                    f32x4 v0 = acc[ai][bj][m][0], v1 = acc[ai][bj][m][1];
                    if (pn < 6) {
                        bf16* dst = (bf16*)(ws + WS_XR + (size_t)(pn >> 1) * (WS_GR - WS_XR));
                        const int col = (pn & 1) * 256 + c;
                        if (pn >= 4) { v0 = v0 * 0.125f; v1 = v1 * 0.125f; }
                        u32x4 w; w.x = pk2(v0[0], v0[1]); w.y = pk2(v0[2], v0[3]); w.z = pk2(v1[0], v1[1]); w.w = pk2(v1[2], v1[3]);
                        *(u32x4*)(dst + (size_t)row * 512 + col) = w;
                        if (pn < 2) {
                            float* o = nullptr;
                            if (isp && t >= TSEQ - 3) o = out + OFF_PCONV + (size_t)(b * 3 + (t - (TSEQ - 3))) * 512 + col;
                            if (iss) o = out + OFF_SCONV + (size_t)(b * 3 + 2) * 512 + col;
                            if (o) { *(f32x4*)o = v0; *(f32x4*)(o + 4) = v1; }
                        }
                    } else {
                        const int cc = wc * 32 + 8 * fq;
                        if (bj == 0) {
                            u32x4 w; w.x = pk2(v0[0], v0[1]); w.y = pk2(v0[2], v0[3]); w.z = pk2(v1[0], v1[1]); w.w = pk2(v1[2], v1[3]);
                            *(u32x4*)(KB + (size_t)row * 128 + cc) = w;
                        } else if (isp) {
                            const int kvh = cc >> 6, d0 = cc & 63;
                            bf16* vt = VT + ((size_t)(b * 2 + kvh) * 64 + d0) * TSEQ + t;
                            const unsigned w0 = pk2(v0[0], v0[1]), w1 = pk2(v0[2], v0[3]), w2 = pk2(v1[0], v1[1]), w3 = pk2(v1[2], v1[3]);
                            vt[0 * TSEQ] = (bf16)(w0 & 0xffff); vt[1 * TSEQ] = (bf16)(w0 >> 16); vt[2 * TSEQ] = (bf16)(w1 & 0xffff); vt[3 * TSEQ] = (bf16)(w1 >> 16);
                            vt[4 * TSEQ] = (bf16)(w2 & 0xffff); vt[5 * TSEQ] = (bf16)(w2 >> 16); vt[6 * TSEQ] = (bf16)(w3 & 0xffff); vt[7 * TSEQ] = (bf16)(w3 >> 16);
                        }
                        float* o = nullptr;
                        if (isp && t >= TSEQ - 128) o = out + (bj == 0 ? OFF_PK : OFF_PV) + (size_t)(b * 128 + (t - (TSEQ - 128))) * 128 + cc;
                        if (iss) o = out + (bj == 0 ? OFF_SK : OFF_SV) + (size_t)(b * 128 + 127) * 128 + cc;
                        if (o) { *(f32x4*)o = v0; *(f32x4*)(o + 4) = v1; }
                    }
                }
            }
    }
};
struct EpiOut {
    static constexpr bool PERM = false, AFTER_DRAIN = false;
    const float *xp, *xs; float* H; unsigned char* ws;
    __device__ __forceinline__ void operator()(const f32x4 (&acc)[2][2][4][2], const Unit& u, int wr, int wc, int fr, int fq) const {
        const int col0 = u.pn * 256 + wc * 32 + 4 * fq;
        bf16* const HB = (bf16*)(ws + WS_HB); float* const rsq = (float*)(ws + WS_RSQH);
#pragma unroll
        for (int ai = 0; ai < 2; ++ai)
#pragma unroll
            for (int m = 0; m < 4; ++m) {
                const int row = u.pm * 256 + ai * 128 + wr * 64 + m * 16 + fr;
                const bool real = row < MR;
                const float* xrow = row < MP ? xp + (size_t)row * DM : xs + (size_t)(row - MP) * DM;
                float s = 0.f;
#pragma unroll
                for (int bj = 0; bj < 2; ++bj)
#pragma unroll
                    for (int n = 0; n < 2; ++n) {
                        const int c = col0 + bj * 128 + n * 16;
                        f32x4 v = acc[ai][bj][m][n];
                        if (real) {
                            v = v + *(const f32x4*)(xrow + c);
                            *(f32x4*)(H + (size_t)row * DM + c) = v;
                        }
                        s += (v[0] * v[0] + v[1] * v[1]) + (v[2] * v[2] + v[3] * v[3]);
                        u32x2 w; w.x = pk2(v[0], v[1]); w.y = pk2(v[2], v[3]);
                        *(u32x2*)(HB + (size_t)row * DM + c) = w;
                    }
                s += __shfl_xor(s, 16); s += __shfl_xor(s, 32);
                if (fq == 0) atomicAdd(rsq + row, s);
            }
    }
};
struct EpiGU {
    static constexpr bool PERM = true, AFTER_DRAIN = false;
    unsigned char* ws;
    __device__ __forceinline__ void operator()(const f32x4 (&acc)[2][2][4][2], const Unit& u, int wr, int wc, int fr, int fq) const {
        const int col = u.pn * 128 + wc * 32 + 8 * fq;
        bf16* const FF = (bf16*)(ws + WS_FF); const float* const rsq = (const float*)(ws + WS_RSQH);
#pragma unroll
        for (int ai = 0; ai < 2; ++ai)
#pragma unroll
            for (int m = 0; m < 4; ++m) {
                const int row = u.pm * 256 + ai * 128 + wr * 64 + m * 16 + fr;
                const float r = rsqrtf(rsq[row] * (1.0f / DM) + EPS);
                float o[8];
#pragma unroll
                for (int n = 0; n < 2; ++n)
#pragma unroll
                    for (int e = 0; e < 4; ++e) { const float g = acc[ai][0][m][n][e] * r, uu = acc[ai][1][m][n][e] * r; o[4 * n + e] = g * sigmoidf_(g) * uu; }
                u32x4 w; w.x = pk2(o[0], o[1]); w.y = pk2(o[2], o[3]); w.z = pk2(o[4], o[5]); w.w = pk2(o[6], o[7]);
                *(u32x4*)(FF + (size_t)row * DFF + col) = w;
            }
    }
};
struct EpiDown {
    static constexpr bool PERM = false, AFTER_DRAIN = false;
    float* H;
    __device__ __forceinline__ void operator()(const f32x4 (&acc)[2][2][4][2], const Unit& u, int wr, int wc, int fr, int fq) const {
        const int col0 = u.pn * 256 + wc * 32 + 4 * fq;
#pragma unroll
        for (int ai = 0; ai < 2; ++ai)
#pragma unroll
            for (int m = 0; m < 4; ++m) {
                const int row = u.pm * 256 + ai * 128 + wr * 64 + m * 16 + fr;
                if (row < MR) {
#pragma unroll
                    for (int bj = 0; bj < 2; ++bj)
#pragma unroll
                        for (int n = 0; n < 2; ++n) {
                            float* pp = H + (size_t)row * DM + col0 + bj * 128 + n * 16;
                            *(f32x4*)pp = *(const f32x4*)pp + acc[ai][bj][m][n];
                        }
                }
            }
    }
};

__device__ __forceinline__ void tr_item(const float* __restrict__ W, int N, bf16* WT, int ldt, int k0, int n0, int drow0, const float* __restrict__ kscale, LAS float* scr, int lane) {
#pragma unroll 8
    for (int i = 0; i < 32; ++i) { const int kk = 2 * i + (lane >> 5); float v = W[(size_t)(k0 + kk) * N + n0 + (lane & 31)]; if (kscale) v *= kscale[k0 + kk]; scr[kk * 33 + (lane & 31)] = v; }
    asm volatile("s_waitcnt lgkmcnt(0)" ::: "memory");
    const int c = lane & 7;
#pragma unroll
    for (int j = 0; j < 4; ++j) { const int n = (lane >> 3) + 8 * j; const LAS float* s = scr + (8 * c) * 33 + n;
        u32x4 o; o.x = pk2(s[0 * 33], s[1 * 33]); o.y = pk2(s[2 * 33], s[3 * 33]); o.z = pk2(s[4 * 33], s[5 * 33]); o.w = pk2(s[6 * 33], s[7 * 33]);
        *(u32x4*)(WT + (size_t)(drow0 + n) * ldt + k0 + 8 * c) = o; }
    asm volatile("s_waitcnt lgkmcnt(0)" ::: "memory");
}
__device__ __forceinline__ void p0_prologue(KP p, LAS unsigned char* lds, int gw, int NGW, int wave, int lane) {
    unsigned char* ws = p->ws;
    LAS float* scr = (LAS float*)(lds + wave * 16384);
    constexpr int I0 = 16 * 56, I1 = 16 * 32, I2 = 16 * 88, I3 = 16 * 88, I4 = 44 * 32, I5 = 16, I6 = 16, NIT = I0 + I1 + I2 + I3 + I4 + I5 + I6;
    for (int it = gw; it < NIT; it += NGW) {
        int r = it;
        if (r < I0) { const int kb = r / 56, nb = r % 56; tr_item(p->in[I_WIN], DIN, (bf16*)(ws + WS_WIN), DM, 64 * kb, 32 * nb, 32 * nb, nullptr, scr, lane); continue; } r -= I0;
        if (r < I1) { const int kb = r / 32, nb = r % 32; tr_item(p->in[I_WOUT], DM, (bf16*)(ws + WS_WOUT), DM, 64 * kb, 32 * nb, 32 * nb, nullptr, scr, lane); continue; } r -= I1;
        if (r < I2) { const int kb = r / 88, nb = r % 88, n0 = 32 * nb; tr_item(p->in[I_WG], DFF, (bf16*)(ws + WS_WGU), DM, 64 * kb, n0, 256 * (n0 >> 7) + (n0 & 127), p->in[I_N2G], scr, lane); continue; } r -= I2;
        if (r < I3) { const int kb = r / 88, nb = r % 88, n0 = 32 * nb; tr_item(p->in[I_WU], DFF, (bf16*)(ws + WS_WGU), DM, 64 * kb, n0, 256 * (n0 >> 7) + 128 + (n0 & 127), p->in[I_N2G], scr, lane); continue; } r -= I3;
        if (r < I4) { const int kb = r / 32, nb = r % 32; tr_item(p->in[I_WD], DM, (bf16*)(ws + WS_WD), DFF, 64 * kb, 32 * nb, 32 * nb, nullptr, scr, lane); continue; } r -= I4;
        if (r < I5) { const int n = r >> 1, nb = r & 1; tr_item(p->in[I_GAW] + n * 4096, 64, (bf16*)(ws + WS_GWT) + n * 4096, 64, 0, 32 * nb, 32 * nb, nullptr, scr, lane); continue; } r -= I5;
        { const int n = r >> 1, nb = r & 1; tr_item(p->in[I_GXW] + n * 4096, 64, (bf16*)(ws + WS_GWT) + 8 * 4096 + n * 4096, 64, 0, 32 * nb, 32 * nb, nullptr, scr, lane); }
    }
    {
        const f32x4* g4 = (const f32x4*)p->in[I_N1G] + lane;
        f32x4 g[4];
#pragma unroll
        for (int j = 0; j < 4; ++j) g[j] = g4[64 * j];
        for (int m = gw; m < MR; m += NGW) {
            const float* xrow = m < MP ? p->in[I_XP] + (size_t)m * DM : p->in[I_XS] + (size_t)(m - MP) * DM;
            const f32x4* xr = (const f32x4*)xrow + lane;
            f32x4 v[4]; float s = 0.f;
#pragma unroll
            for (int j = 0; j < 4; ++j) { v[j] = xr[64 * j]; s += (v[j].x * v[j].x + v[j].y * v[j].y) + (v[j].z * v[j].z + v[j].w * v[j].w); }
            const float rs = rsqrtf(wave_sum(s) * (1.f / DM) + EPS);
            u32x2* o8 = (u32x2*)((bf16*)(ws + WS_XN) + (size_t)m * DM) + lane;
#pragma unroll
            for (int j = 0; j < 4; ++j) { u32x2 w; w.x = pk2(v[j].x * rs * g[j].x, v[j].y * rs * g[j].y); w.y = pk2(v[j].z * rs * g[j].z, v[j].w * rs * g[j].w); o8[64 * j] = w; }
        }
    }
    const int gt = gw * 64 + lane, NGT = NGW * 64;
    for (int i = gt; i < MPAD; i += NGT) ((float*)(ws + WS_RSQH))[i] = 0.f;
    for (int i = gt; i < NS * 4064; i += NGT) { const int b = i / 4064, o = i % 4064;
        ((f32x4*)(p->out + OFF_SK + (size_t)b * 16384))[o] = ((const f32x4*)(p->in[I_CK] + (size_t)b * 16384 + 128))[o];
        ((f32x4*)(p->out + OFF_SV + (size_t)b * 16384))[o] = ((const f32x4*)(p->in[I_CV] + (size_t)b * 16384 + 128))[o]; }
    for (int i = gt; i < NS * 256; i += NGT) { const int b = i >> 8, o = i & 255;
        ((f32x4*)(p->out + OFF_SCONV + (size_t)b * 1536))[o] = ((const f32x4*)(p->in[I_SCONV] + (size_t)b * 1536 + 512))[o]; }
}

constexpr int HS_OFF = 16384, HS_LD = 1032;
#define MFMA16(a, b, c) __builtin_amdgcn_mfma_f32_16x16x32_bf16((a), (b), (c), 0, 0, 0)
#define MFMA32(a, b, c) __builtin_amdgcn_mfma_f32_32x32x16_bf16((a), (b), (c), 0, 0, 0)
template <bool FINAL>
__device__ __forceinline__ void scan_unit(KP p, int b, int chunk, LAS unsigned char* lds, int wave, int lane) {
    unsigned char* ws = p->ws;
    const bf16* XR = (const bf16*)(ws + WS_XR);
    const bf16* GWT = (const bf16*)(ws + WS_GWT);
    float* SA = (float*)(ws + WS_SUMA); float* SH = (float*)(ws + WS_SUMH);
    const LAS float* cw = (const LAS float*)lds;
    const int n = wave, j = lane & 15, q = lane >> 4;
    bf16x8 wf[2][4][2];
#pragma unroll
    for (int g = 0; g < 2; ++g)
#pragma unroll
        for (int nt = 0; nt < 4; ++nt)
#pragma unroll
            for (int s = 0; s < 2; ++s) wf[g][nt][s] = *(const bf16x8*)(GWT + ((size_t)(g * 8 + n) * 64 + 16 * nt + j) * 64 + 32 * s + 8 * q);
    bf16x8 idf[2];
#pragma unroll
    for (int e = 0; e < 2; ++e)
#pragma unroll
        for (int jj = 0; jj < 8; ++jj) idf[e][jj] = (16 * e + j - 8 * q == jj) ? (short)0x3F80 : (short)0;
    float ba[4], bx[4], sp[4], hprev[4], acum[4];
#pragma unroll
    for (int nt = 0; nt < 4; ++nt) { const int ch = 64 * n + 16 * nt + j; ba[nt] = p->in[I_GAB][ch]; bx[nt] = p->in[I_GXB][ch]; sp[nt] = 8.0f * log1pf(__expf(-p->in[I_LAM][ch])); hprev[nt] = 0.f; acum[nt] = 1.f; }
    if (FINAL) {
        for (int c = 0; c < chunk; ++c) {
#pragma unroll
            for (int nt = 0; nt < 4; ++nt) { const int ch = 64 * n + 16 * nt + j; const size_t o = (size_t)(b * 32 + c) * 512 + ch; hprev[nt] = SA[o] * hprev[nt] + SH[o]; }
        }
    }
    for (int sc = 0; sc < 4; ++sc) {
        const int t0 = chunk * 64 + sc * 16, tok = t0 + j;
        bf16x8 af[2];
#pragma unroll
        for (int s = 0; s < 2; ++s) {
            const int ch0 = 64 * n + 32 * s + 8 * q;
            float a8[8];
            { const f32x4 c0 = *(const LAS f32x4*)(cw + 2048 + ch0), c1 = *(const LAS f32x4*)(cw + 2048 + ch0 + 4);
              a8[0] = c0[0]; a8[1] = c0[1]; a8[2] = c0[2]; a8[3] = c0[3]; a8[4] = c1[0]; a8[5] = c1[1]; a8[6] = c1[2]; a8[7] = c1[3]; }
#pragma unroll
            for (int w = 0; w < 4; ++w) {
                const int tt = tok - 3 + w;
                u32x4 x = {0u, 0u, 0u, 0u};
                if (tt >= 0) x = *(const u32x4*)(XR + (size_t)(b * TSEQ + tt) * 512 + ch0);
                const f32x4 w0 = *(const LAS f32x4*)(cw + w * 512 + ch0), w1 = *(const LAS f32x4*)(cw + w * 512 + ch0 + 4);
                a8[0] += w0[0] * bflo(x.x); a8[1] += w0[1] * bfhi(x.x); a8[2] += w0[2] * bflo(x.y); a8[3] += w0[3] * bfhi(x.y);
                a8[4] += w1[0] * bflo(x.z); a8[5] += w1[1] * bfhi(x.z); a8[6] += w1[2] * bflo(x.w); a8[7] += w1[3] * bfhi(x.w);
            }
            u32x4 pk; pk.x = pk2(a8[0], a8[1]); pk.y = pk2(a8[2], a8[3]); pk.z = pk2(a8[4], a8[5]); pk.w = pk2(a8[6], a8[7]);
            af[s] = __builtin_bit_cast(bf16x8, pk);
        }
#pragma unroll
        for (int nt = 0; nt < 4; ++nt) {
            f32x4 da = {0.f, 0.f, 0.f, 0.f}, dx = {0.f, 0.f, 0.f, 0.f}, xc = {0.f, 0.f, 0.f, 0.f};
            da = MFMA16(af[0], wf[0][nt][0], da); da = MFMA16(af[1], wf[0][nt][1], da);
            dx = MFMA16(af[0], wf[1][nt][0], dx); dx = MFMA16(af[1], wf[1][nt][1], dx);
            xc = MFMA16(af[nt >> 1], idf[nt & 1], xc);
            float a4[4], u4[4];
#pragma unroll
            for (int r = 0; r < 4; ++r) {
                const float ra = sigmoidf_(da[r] + ba[nt]), ix = sigmoidf_(dx[r] + bx[nt]);
                const float a = __expf(-ra * sp[nt]);
                a4[r] = a; u4[r] = sqrtf(fmaxf(1.0f - a * a, 0.f)) * ix * xc[r];
            }
            const float A4 = (a4[0] * a4[1]) * (a4[2] * a4[3]);
            const float H4 = ((u4[0] * a4[1] + u4[1]) * a4[2] + u4[2]) * a4[3] + u4[3];
            float c = hprev[nt], cin = 0.f, ap = 1.f;
#pragma unroll
            for (int pq = 0; pq < 4; ++pq) {
                const float Ap = __shfl(A4, j + 16 * pq), Hp = __shfl(H4, j + 16 * pq);
                if (pq == q) cin = c;
                c = Ap * c + Hp; ap *= Ap;
            }
            hprev[nt] = c; acum[nt] *= ap;
            if (FINAL) {
                LAS bf16* hs = (LAS bf16*)(lds + HS_OFF + (sc * 16 + 4 * q) * HS_LD) + (64 * n + 16 * nt + j);
                float h = cin;
#pragma unroll
                for (int r = 0; r < 4; ++r) { h = a4[r] * h + u4[r]; hs[r * (HS_LD / 2)] = (bf16)(pk2(h, 0.f) & 0xffff); }
            }
        }
    }
    if (!FINAL) {
        if (q == 0) {
#pragma unroll
            for (int nt = 0; nt < 4; ++nt) { const int ch = 64 * n + 16 * nt + j; const size_t o = (size_t)(b * 32 + chunk) * 512 + ch; SA[o] = acum[nt]; SH[o] = hprev[nt]; }
        }
    } else {
        if (chunk == 31 && q == 0) {
#pragma unroll
            for (int nt = 0; nt < 4; ++nt) p->out[OFF_PH + (size_t)b * 512 + 64 * n + 16 * nt + j] = hprev[nt];
        }
        __syncthreads();
        const bf16* GR = (const bf16*)(ws + WS_GR);
        bf16* MIX = (bf16*)(ws + WS_MIX);
        const f32x4 g0 = *(const f32x4*)(p->in[I_RNG] + 8 * lane), g1 = *(const f32x4*)(p->in[I_RNG] + 8 * lane + 4);
#pragma unroll 2
        for (int tt = 0; tt < 8; ++tt) {
            const int tl = wave * 8 + tt;
            const size_t row = (size_t)b * TSEQ + chunk * 64 + tl;
            const LAS u32x2* hp = (const LAS u32x2*)(lds + HS_OFF + tl * HS_LD + 16 * lane);
            const u32x2 h0 = hp[0], h1 = hp[1];
            const u32x4 gr = *(const u32x4*)(GR + row * 512 + 8 * lane);
            float rc[8];
            rc[0] = bflo(h0.x) * gelu_tanh(bflo(gr.x)); rc[1] = bfhi(h0.x) * gelu_tanh(bfhi(gr.x)); rc[2] = bflo(h0.y) * gelu_tanh(bflo(gr.y)); rc[3] = bfhi(h0.y) * gelu_tanh(bfhi(gr.y));
            rc[4] = bflo(h1.x) * gelu_tanh(bflo(gr.z)); rc[5] = bfhi(h1.x) * gelu_tanh(bfhi(gr.z)); rc[6] = bflo(h1.y) * gelu_tanh(bflo(gr.w)); rc[7] = bfhi(h1.y) * gelu_tanh(bfhi(gr.w));
            float ss = 0.f;
#pragma unroll
            for (int e = 0; e < 8; ++e) ss += rc[e] * rc[e];
            const float rn = rsqrtf(wave_sum(ss) * (1.0f / DREC) + EPS);
            u32x4 w; w.x = pk2(rc[0] * rn * g0[0], rc[1] * rn * g0[1]); w.y = pk2(rc[2] * rn * g0[2], rc[3] * rn * g0[3]);
            w.z = pk2(rc[4] * rn * g1[0], rc[5] * rn * g1[1]); w.w = pk2(rc[6] * rn * g1[2], rc[7] * rn * g1[3]);
            *(u32x4*)(MIX + row * DM + 8 * lane) = w;
        }
        __syncthreads();
    }
}

__device__ __forceinline__ void attn_unit(KP p, int b, int qt, LAS unsigned char* lds, int wave, int lane) {
    unsigned char* ws = p->ws;
    const bf16* Q = (const bf16*)(ws + WS_Q); const bf16* KB = (const bf16*)(ws + WS_KB); const bf16* VT = (const bf16*)(ws + WS_VT);
    bf16* MIX = (bf16*)(ws + WS_MIX);
    LAS float* red = (LAS float*)lds;
    const int r = lane & 31, h = lane >> 5, kvh = wave >> 2, q0 = qt * 32;
    const size_t rowq = (size_t)b * TSEQ + q0 + r;
    bf16x8 qf[4];
#pragma unroll
    for (int s = 0; s < 4; ++s) qf[s] = *(const bf16x8*)(Q + rowq * 512 + wave * 64 + 16 * s + 8 * h);
    const int pr = (r & ~12) | ((r & 4) << 1) | ((r & 8) >> 1);
    f32x16 S[5];
#pragma unroll
    for (int kt = 0; kt < 5; ++kt) {
        const int kbase = q0 - 128 + 32 * kt;
#pragma unroll
        for (int i = 0; i < 16; ++i) S[kt][i] = 0.f;
        if (kbase >= 0) {
#pragma unroll
            for (int s = 0; s < 4; ++s) {
                const bf16x8 kf = *(const bf16x8*)(KB + ((size_t)b * TSEQ + kbase + pr) * 128 + kvh * 64 + 16 * s + 8 * h);
                S[kt] = MFMA32(kf, qf[s], S[kt]);
            }
        }
    }
    const float sink = p->in[I_SINK][wave];
    float m = sink;
#pragma unroll
    for (int kt = 0; kt < 5; ++kt) {
        const int kbase = q0 - 128 + 32 * kt;
#pragma unroll
        for (int i = 0; i < 16; ++i) {
            const int kl = 16 * (i >> 3) + 8 * h + (i & 7);
            bool valid = kbase >= 0;
            if (kt == 0) valid = valid && (kl >= r);
            if (kt == 4) valid = valid && (kl <= r);
            const float sv = valid ? S[kt][i] : -INFINITY;
            S[kt][i] = sv; m = fmaxf(m, sv);
        }
    }
    m = fmaxf(m, __shfl_xor(m, 32));
    float l = 0.f;
#pragma unroll
    for (int kt = 0; kt < 5; ++kt)
#pragma unroll
        for (int i = 0; i < 16; ++i) { const float pv = __expf(S[kt][i] - m); S[kt][i] = pv; l += pv; }
    l += __shfl_xor(l, 32);
    const float inv = 1.0f / (l + __expf(sink - m));
    f32x16 O[2];
#pragma unroll
    for (int dt = 0; dt < 2; ++dt)
#pragma unroll
        for (int i = 0; i < 16; ++i) O[dt][i] = 0.f;
#pragma unroll
    for (int kt = 0; kt < 5; ++kt) {
        const int kbase = q0 - 128 + 32 * kt;
        if (kbase >= 0) {
#pragma unroll
            for (int s2 = 0; s2 < 2; ++s2) {
                u32x4 pk; pk.x = pk2(S[kt][8 * s2 + 0], S[kt][8 * s2 + 1]); pk.y = pk2(S[kt][8 * s2 + 2], S[kt][8 * s2 + 3]);
                pk.z = pk2(S[kt][8 * s2 + 4], S[kt][8 * s2 + 5]); pk.w = pk2(S[kt][8 * s2 + 6], S[kt][8 * s2 + 7]);
                const bf16x8 pb = __builtin_bit_cast(bf16x8, pk);
#pragma unroll
                for (int dt = 0; dt < 2; ++dt) {
                    const bf16x8 vf = *(const bf16x8*)(VT + ((size_t)(b * 2 + kvh) * 64 + 32 * dt + r) * TSEQ + kbase + 16 * s2 + 8 * h);
                    O[dt] = MFMA32(vf, pb, O[dt]);
                }
            }
        }
    }
    float ss = 0.f;
#pragma unroll
    for (int dt = 0; dt < 2; ++dt)
#pragma unroll
        for (int i = 0; i < 16; ++i) { O[dt][i] *= inv; ss += O[dt][i] * O[dt][i]; }
    ss += __shfl_xor(ss, 32);
    if (h == 0) red[wave * 32 + r] = ss;
    __syncthreads();
    float tot = 0.f;
#pragma unroll
    for (int w = 0; w < 8; ++w) tot += red[w * 32 + r];
    const float rn = rsqrtf(tot * (1.0f / DATT) + EPS);
#pragma unroll
    for (int dt = 0; dt < 2; ++dt)
#pragma unroll
        for (int g4 = 0; g4 < 4; ++g4) {
            const int d = 32 * dt + 8 * g4 + 4 * h;
            const f32x4 gg = *(const f32x4*)(p->in[I_ANG] + wave * 64 + d);
            u32x2 w; w.x = pk2(O[dt][4 * g4 + 0] * rn * gg[0], O[dt][4 * g4 + 1] * rn * gg[1]); w.y = pk2(O[dt][4 * g4 + 2] * rn * gg[2], O[dt][4 * g4 + 3] * rn * gg[3]);
            *(u32x2*)(MIX + rowq * DM + 512 + wave * 64 + d) = w;
        }
    __syncthreads();
}

__device__ __forceinline__ void sample_unit(KP p, int b, LAS unsigned char* lds, int tid, int wave, int lane) {
    unsigned char* ws = p->ws;
    const size_t row = (size_t)MP + b;
    bf16* MIX = (bf16*)(ws + WS_MIX);
    LAS float* xs = (LAS float*)(lds + 12288);
    LAS float* redw = (LAS float*)(lds + 12288 + 2048);
    LAS float* qs = (LAS float*)(lds + 12288 + 4096);
    LAS float* ps = (LAS float*)(lds + 12288 + 8192);
    __syncthreads();
    {
        const int c = tid;
        const float* sc = p->in[I_SCONV] + (size_t)b * 1536;
        const float* cwg = p->in[I_CONVW];
        const float xr = p->out[OFF_SCONV + (size_t)(b * 3 + 2) * 512 + c];
        const float xc = p->in[I_CONVB][c] + sc[c] * cwg[c] + sc[512 + c] * cwg[512 + c] + sc[1024 + c] * cwg[1024 + c] + xr * cwg[1536 + c];
        xs[c] = xc;
        __syncthreads();
        const int n = c >> 6, jj = c & 63;
        const float* wa = p->in[I_GAW] + n * 4096 + jj; const float* wx = p->in[I_GXW] + n * 4096 + jj;
        float ya = p->in[I_GAB][c], yx = p->in[I_GXB][c];
#pragma unroll 8
        for (int i = 0; i < 64; ++i) { const float xv = xs[64 * n + i]; ya += xv * wa[i * 64]; yx += xv * wx[i * 64]; }
        const float ra = sigmoidf_(ya), ix = sigmoidf_(yx);
        const float la = -8.0f * ra * log1pf(__expf(-p->in[I_LAM][c]));
        const float a = __expf(la);
        const float u = sqrtf(fmaxf(1.0f - a * a, 0.f)) * ix * xc;
        const float hn = a * p->in[I_SH][(size_t)b * 512 + c] + u;
        p->out[OFF_SH + (size_t)b * 512 + c] = hn;
        const float gr = bf1(((const bf16*)(ws + WS_GR))[row * 512 + c]);
        const float rec = hn * gelu_tanh(gr);
        const float ssw = wave_sum(rec * rec);
        if (lane == 0) redw[wave] = ssw;
        __syncthreads();
        float tot = 0.f;
#pragma unroll
        for (int w = 0; w < 8; ++w) tot += redw[w];
        const float rn = rsqrtf(tot * (1.0f / DREC) + EPS);
        MIX[row * DM + c] = (bf16)(pk2(rec * rn * p->in[I_RNG][c], 0.f) & 0xffff);
    }
    {
        const int kvh = wave >> 2;
        const float qd = bf1(((const bf16*)(ws + WS_Q))[row * 512 + wave * 64 + lane]);
        qs[wave * 64 + lane] = qd;
        const float* kself = p->out + OFF_SK + (size_t)(b * 128 + 127) * 128 + kvh * 64;
        const float* vself = p->out + OFF_SV + (size_t)(b * 128 + 127) * 128 + kvh * 64;
        const float sself = wave_sum(qd * kself[lane]);
        asm volatile("s_waitcnt lgkmcnt(0)" ::: "memory");
        const float* kc = p->in[I_CK] + (size_t)b * 16384 + kvh * 64;
        float s0 = 0.f, s1 = 0.f;
        const f32x4* k0 = (const f32x4*)(kc + (size_t)lane * 128);
        const f32x4* k1 = (const f32x4*)(kc + (size_t)(lane + 64) * 128);
        const LAS f32x4* q4 = (const LAS f32x4*)(qs + wave * 64);
#pragma unroll 4
        for (int i = 0; i < 16; ++i) { const f32x4 qq = q4[i], a0 = k0[i], a1 = k1[i];
            s0 += (qq[0] * a0[0] + qq[1] * a0[1]) + (qq[2] * a0[2] + qq[3] * a0[3]);
            s1 += (qq[0] * a1[0] + qq[1] * a1[1]) + (qq[2] * a1[2] + qq[3] * a1[3]); }
        const float sink = p->in[I_SINK][wave];
        const float m = fmaxf(fmaxf(wave_max(fmaxf(s0, s1)), sself), sink);
        const float p0 = __expf(s0 - m), p1 = __expf(s1 - m), pself = __expf(sself - m);
        const float den = wave_sum(p0 + p1) + pself + __expf(sink - m);
        ps[wave * 128 + lane] = p0; ps[wave * 128 + 64 + lane] = p1;
        asm volatile("s_waitcnt lgkmcnt(0)" ::: "memory");
        const float* vc = p->in[I_CV] + (size_t)b * 16384 + kvh * 64 + lane;
        float o = pself * vself[lane];
#pragma unroll 8
        for (int k = 0; k < 128; ++k) o += ps[wave * 128 + k] * vc[(size_t)k * 128];
        o *= 1.0f / den;
        const float ssw = wave_sum(o * o);
        if (lane == 0) redw[8 + wave] = ssw;
        __syncthreads();
        float tot = 0.f;
#pragma unroll
        for (int w = 0; w < 8; ++w) tot += redw[8 + w];
        const float rn = rsqrtf(tot * (1.0f / DATT) + EPS);
        MIX[row * DM + 512 + wave * 64 + lane] = (bf16)(pk2(o * rn * p->in[I_ANG][wave * 64 + lane], 0.f) & 0xffff);
    }
    __syncthreads();
}

__global__ void __launch_bounds__(NTHR, 2) fwd_megakernel(Params p_unused) {
    extern __shared__ __attribute__((aligned(16))) unsigned char lds_[];
    cg::grid_group grid = cg::this_grid();
    LAS unsigned char* lds = (LAS unsigned char*)lds_;
    const int G = gridDim.x, bx = blockIdx.x;
#define PHASE_IDS int tid_ = threadIdx.x; asm volatile("" : "+v"(tid_)); const int tid = tid_, lane = tid & 63, wave = __builtin_amdgcn_readfirstlane(tid >> 6); (void)tid; (void)lane; (void)wave;

    { PHASE_IDS KP p = kargs(); p0_prologue(p, lds, bx * NWAVES + wave, G * NWAVES, wave, lane); }
    grid.sync();

    {
        KP p = kargs(); unsigned char* ws = p->ws;
        pg8::Gemm g{(const bf16*)(ws + WS_XN), (const bf16*)(ws + WS_WIN), MPAD, DIN, DM}; pg8::StaticOrder S; S.init(MPAD, DIN, G, bx);
        EpiIn E{ws, p->out};
        pg8::gemm_phase<EpiIn, pg8::StaticOrder, true, true>(lds, g, S, E);
    }
    grid.sync();

    {
        PHASE_IDS KP p = kargs();
        for (int i = tid; i < 2560; i += NTHR) ((LAS float*)lds)[i] = i < 2048 ? p->in[I_CONVW][i] : p->in[I_CONVB][i - 2048];
        __syncthreads();
        for (int u = bx; u < 640; u += G) {
            int tl_ = threadIdx.x; asm volatile("" : "+v"(tl_)); const int tid = tl_, lane = tl_ & 63;
            if (u < 256) scan_unit<false>(p, u >> 5, u & 31, lds, wave, lane);
            else if (u < 384) sample_unit(p, u - 256, lds, tid, wave, lane);
            else { const int a = u - 384; attn_unit(p, a >> 6, a & 63, lds + 12288, wave, lane); }
        }
    }
    grid.sync();

    {
        PHASE_IDS KP p = kargs();
        for (int u = bx; u < 512; u += G) {
            int tl_ = threadIdx.x; asm volatile("" : "+v"(tl_)); const int lane = tl_ & 63;
            if (u < 256) scan_unit<true>(p, u >> 5, u & 31, lds, wave, lane);
            else { const int a = u; attn_unit(p, a >> 6, a & 63, lds + 12288, wave, lane); }
        }
    }
    grid.sync();

    {
        KP p = kargs(); unsigned char* ws = p->ws;
        pg8::Gemm g{(const bf16*)(ws + WS_MIX), (const bf16*)(ws + WS_WOUT), MPAD, DM, DM}; pg8::StaticOrder S; S.init(MPAD, DM, G, bx);
        EpiOut E{p->in[I_XP], p->in[I_XS], p->out, ws};
        pg8::gemm_phase<EpiOut, pg8::StaticOrder, true, true>(lds, g, S, E);
    }
    grid.sync();

    {
        KP p = kargs(); unsigned char* ws = p->ws;
        pg8::Gemm g{(const bf16*)(ws + WS_HB), (const bf16*)(ws + WS_WGU), MPAD, 2 * DFF, DM}; pg8::StaticOrder S; S.init(MPAD, 2 * DFF, G, bx);
        EpiGU E{ws};
        pg8::gemm_phase<EpiGU, pg8::StaticOrder, true, true>(lds, g, S, E);
    }
    grid.sync();

    {
        KP p = kargs(); unsigned char* ws = p->ws;
        pg8::Gemm g{(const bf16*)(ws + WS_FF), (const bf16*)(ws + WS_WD), MPAD, DM, DFF}; pg8::StaticOrder S; S.init(MPAD, DM, G, bx);
        EpiDown E{p->out};
        pg8::gemm_phase<EpiDown, pg8::StaticOrder, true, true>(lds, g, S, E);
    }
    grid.sync();

    {
        PHASE_IDS KP p = kargs();
        const int gw = bx * NWAVES + wave, NGW = G * NWAVES;
        const f32x4* g4 = (const f32x4*)p->in[I_FNG] + lane;
        f32x4 gg[4];
#pragma unroll
        for (int j = 0; j < 4; ++j) gg[j] = g4[64 * j];
        for (int m = gw; m < MR; m += NGW) {
            f32x4* yr = (f32x4*)(p->out + (size_t)m * DM) + lane;
            f32x4 v[4]; float s = 0.f;
#pragma unroll
            for (int j = 0; j < 4; ++j) { v[j] = yr[64 * j]; s += (v[j].x * v[j].x + v[j].y * v[j].y) + (v[j].z * v[j].z + v[j].w * v[j].w); }
            const float rs = rsqrtf(wave_sum(s) * (1.f / DM) + EPS);
#pragma unroll
            for (int j = 0; j < 4; ++j) yr[64 * j] = v[j] * rs * gg[j];
        }
    }
}

extern "C" void kernel_launch(void* const* d_in, const int* in_sizes, int n_in, void* d_out, int out_size, void* d_ws, size_t ws_size, hipStream_t stream) {
    static int grid = 0;
    if (grid == 0) {
        int dev = 0, cus = 0, per_cu = 0;
        hipGetDevice(&dev);
        hipDeviceGetAttribute(&cus, hipDeviceAttributeMultiprocessorCount, dev);
        hipFuncSetAttribute((const void*)fwd_megakernel, hipFuncAttributeMaxDynamicSharedMemorySize, LDS_BYTES);
        hipOccupancyMaxActiveBlocksPerMultiprocessor(&per_cu, (const void*)fwd_megakernel, NTHR, LDS_BYTES);
        if (per_cu < 1) { fprintf(stderr, "kernel_launch: occupancy query says %d blocks/CU\n", per_cu); per_cu = 1; }
        (void)hipGetLastError();
        grid = cus;
        if (n_in != 24 || ws_size < WS_END || (size_t)out_size != OUT_END) fprintf(stderr, "kernel_launch: unexpected sizes n_in %d ws %zu out %d\n", n_in, ws_size, out_size);
    }
    Params p{};
    for (int i = 0; i < 24; ++i) p.in[i] = (const float*)d_in[i];
    p.out = (float*)d_out; p.ws = (unsigned char*)d_ws;
    void* args[] = {&p};
    hipError_t e = hipLaunchCooperativeKernel((const void*)fwd_megakernel, dim3(grid), dim3(NTHR), args, LDS_BYTES, stream);
    if (e != hipSuccess) fprintf(stderr, "cooperative launch failed: %s (grid %d)\n", hipGetErrorString(e), grid);
}
```

```cpp
#include <hip/hip_runtime.h>
#include <hip/hip_cooperative_groups.h>
#include <cstdio>
#include <cstdint>
namespace cg = cooperative_groups;
namespace pg8 {
#define PG8_LAS __attribute__((address_space(3)))
typedef unsigned short bf16_t;
typedef short bf16x8 __attribute__((ext_vector_type(8)));
typedef float f32x4 __attribute__((ext_vector_type(4)));
typedef unsigned u32x4 __attribute__((ext_vector_type(4)));
constexpr int BM = 256, BK = 64, HALF = 128, HTB = HALF * BK * 2  , STAGE_BYTES = 8 * HTB, NXCD = 8, WGM = 8;

__host__ __device__ __forceinline__ int lds_byte(int r, int c) { const int st = (r >> 4) * 2 + (c >> 5), rr = r & 15, cc = c & 31, ob = rr * 64 + cc * 2; return st * 1024 + (ob ^ (((ob >> 9) & 1) << 5)); }
__host__ __device__ __forceinline__ void stage_rc(int b, int& R, int& C) { const int st = b / 1024, sb = b % 1024, swz = sb ^ (((sb >> 9) & 1) << 5); R = (st >> 1) * 16 + swz / 64; C = (st & 1) * 32 + (swz % 64) / 2; }
__host__ __device__ __forceinline__ int perm32(int rho) { const int n = rho >> 4, i = rho & 15; return 8 * (i >> 2) + 4 * n + (i & 3); }

struct Unit { int pm, pn; };
struct Gemm { const bf16_t* A; const bf16_t* Bt; int M, N, K; };

struct StaticOrder {
    int nM, nN, nwg, G, c;
    __host__ __device__ void init(int M, int N, int G_, int c_) { nM = M / BM; nN = N / BM; nwg = nM * nN; G = G_; c = c_; }
    __host__ __device__ bool next(int i, Unit& u) const {
        const long L = (long)i * G + c; if (L >= nwg) return false;
        int wgid = (int)L; { const int q = nwg / NXCD, r = nwg % NXCD, xcd = wgid % NXCD, off = wgid / NXCD; wgid = (xcd < r ? xcd * (q + 1) : r * (q + 1) + (xcd - r) * q) + off; }
        const int nig = WGM * nN, gid = wgid / nig, fm = gid * WGM, gsz = (nM - fm) < WGM ? (nM - fm) : WGM;
        u.pm = fm + ((wgid % nig) % gsz); u.pn = (wgid % nig) / gsz; return true;
    }
    __device__ __forceinline__ void a_ready(const Unit&) const {}
    __device__ __forceinline__ void done(const Unit&) const {}
};

template <class Epi, class Sched, bool ALIGN_EPI = false, bool SP2 = false>
__device__ __forceinline__ void gemm_phase(PG8_LAS unsigned char* lds, const Gemm g, const Sched& S, const Epi& E) {
    int tid_ = threadIdx.x; asm volatile("" : "+v"(tid_));
    const int tid = tid_, wid = __builtin_amdgcn_readfirstlane(tid >> 6), lane = tid & 63, wr = wid >> 2, wc = wid & 3, fr = lane & 15, fq = lane >> 4;
    const int K = g.K, nt = K / BK;
    unsigned voffA[2], voffB[2];
#pragma unroll
    for (int i = 0; i < 2; ++i) { int R, C; stage_rc(tid * 16 + i * 8192, R, C); const int Rb = Epi::PERM ? ((R & ~31) + perm32(R & 31)) : R;
        voffA[i] = (unsigned)(R * K + C) * 2u; voffB[i] = (unsigned)(Rb * K + C) * 2u; }
    const size_t kstep = (size_t)(BK * 2);
    const size_t hstep = (size_t)HALF * K * 2;
    const size_t tstep = 2 * hstep;
    const unsigned ldsw = (unsigned)wid * 1024u;
    const int aoff = lds_byte(wr * 64 + fr, fq * 8), boff = lds_byte(wc * 32 + fr, fq * 8);
#define PG8_SA(b, h) (((b) * 2 + (h)) * HTB)
#define PG8_SB(b, h) ((4 + (b) * 2 + (h)) * HTB)
#define PG8_STAGE(bufoff, gbase, voff) do { _Pragma("unroll") for (int _i = 0; _i < 2; ++_i) \
        __builtin_amdgcn_global_load_lds((const unsigned*)((const char*)(gbase) + (voff)[_i]), (PG8_LAS unsigned*)(lds + (bufoff) + ldsw + _i * 8192), 16, 0, 0); } while (0)
#define PG8_LDA(dst, b, h) do { _Pragma("unroll") for (int m = 0; m < 4; ++m) _Pragma("unroll") for (int k = 0; k < 2; ++k) dst[m][k] = *(const PG8_LAS bf16x8*)(lds + PG8_SA(b, h) + aoff + m * 2048 + k * 1024); } while (0)
#define PG8_LDB(dst, b, h) do { _Pragma("unroll") for (int n = 0; n < 2; ++n) _Pragma("unroll") for (int k = 0; k < 2; ++k) dst[n][k] = *(const PG8_LAS bf16x8*)(lds + PG8_SB(b, h) + boff + n * 2048 + k * 1024); } while (0)
#define PG8_MMA(ai, bj, At, Bt) do { __builtin_amdgcn_s_setprio(1); _Pragma("unroll") for (int m = 0; m < 4; ++m) _Pragma("unroll") for (int n = 0; n < 2; ++n) _Pragma("unroll") for (int k = 0; k < 2; ++k) \
        acc[ai][bj][m][n] = __builtin_amdgcn_mfma_f32_16x16x32_bf16(Bt[n][k], At[m][k], acc[ai][bj][m][n], 0, 0, 0); __builtin_amdgcn_s_setprio(0); } while (0)
#define PG8_WAIT_V(n) asm volatile("s_waitcnt vmcnt(" #n ")" ::: "memory")
#define PG8_WAIT_L(n) asm volatile("s_waitcnt lgkmcnt(" #n ")" ::: "memory")
#define PG8_BAR __builtin_amdgcn_s_barrier()
#define PG8_SCHED __builtin_amdgcn_sched_barrier(0)
    Unit cur, nxt; int ui = 0;
    if (!S.next(0, cur)) return;
    f32x4 acc[2][2][4][2];
#pragma unroll
    for (int a = 0; a < 2; ++a)
#pragma unroll
        for (int b = 0; b < 2; ++b)
#pragma unroll
            for (int m = 0; m < 4; ++m)
#pragma unroll
                for (int n = 0; n < 2; ++n) acc[a][b][m][n] = (f32x4){0.f, 0.f, 0.f, 0.f};
    bf16x8 At[4][2], B0[2][2], B1[2][2];
    const char* cA = (const char*)g.A + (size_t)cur.pm * tstep; const char* cB = (const char*)g.Bt + (size_t)cur.pn * tstep;
    S.a_ready(cur);
    if constexpr (SP2) {
        PG8_STAGE(PG8_SB(0, 0), cB, voffB); PG8_STAGE(PG8_SB(0, 1), cB + hstep, voffB); PG8_STAGE(PG8_SA(0, 0), cA, voffA); PG8_STAGE(PG8_SA(0, 1), cA + hstep, voffA);
        if (wr == 1) PG8_BAR;
        PG8_WAIT_V(2); PG8_BAR;
        PG8_STAGE(PG8_SB(1, 0), cB + kstep, voffB); PG8_STAGE(PG8_SA(1, 0), cA + kstep, voffA); PG8_STAGE(PG8_SB(1, 1), cB + hstep + kstep, voffB);
        PG8_WAIT_V(6); PG8_BAR;
    } else {
        PG8_STAGE(PG8_SB(0, 0), cB, voffB); PG8_STAGE(PG8_SA(0, 0), cA, voffA); PG8_STAGE(PG8_SB(0, 1), cB + hstep, voffB); PG8_STAGE(PG8_SA(0, 1), cA + hstep, voffA);
        if (wr == 1) PG8_BAR;
        PG8_WAIT_V(4); PG8_BAR;
        PG8_STAGE(PG8_SB(1, 0), cB + kstep, voffB); PG8_STAGE(PG8_SA(1, 0), cA + kstep, voffA); PG8_STAGE(PG8_SB(1, 1), cB + hstep + kstep, voffB);
        PG8_WAIT_V(6); PG8_BAR;
    }
    for (;;) {
        const bool has_next = S.next(ui + 1, nxt);
        const char* nA = has_next ? (const char*)g.A + (size_t)nxt.pm * tstep : cA; const char* nB = has_next ? (const char*)g.Bt + (size_t)nxt.pn * tstep : cB;
        for (int t = 0; t < nt; t += 2) {
            const bool last = (t == nt - 2);
            const char* a1 = cA + (size_t)(t + 1) * kstep;
            const char* a2 = last ? nA : cA + (size_t)(t + 2) * kstep; const char* b2 = last ? nB : cB + (size_t)(t + 2) * kstep;
            const char* a3 = a2 + kstep; const char* b3 = b2 + kstep;
            if (last && has_next) S.a_ready(nxt);
            if constexpr (SP2) {
            PG8_LDB(B0, 0, 0); PG8_LDB(B1, 0, 1); PG8_SCHED; PG8_LDA(At, 0, 0); PG8_STAGE(PG8_SA(1, 1), a1 + hstep, voffA);
            PG8_WAIT_V(8); PG8_WAIT_L(0); PG8_BAR; PG8_MMA(0, 0, At, B0); PG8_MMA(0, 1, At, B1); PG8_BAR; PG8_SCHED;
            PG8_LDA(At, 0, 1); PG8_STAGE(PG8_SB(0, 0), b2, voffB); PG8_STAGE(PG8_SB(0, 1), b2 + hstep, voffB); PG8_STAGE(PG8_SA(0, 0), a2, voffA);
            PG8_WAIT_V(8); PG8_WAIT_L(0); PG8_BAR; PG8_MMA(1, 0, At, B0); PG8_MMA(1, 1, At, B1); PG8_BAR; PG8_SCHED;
            PG8_LDB(B0, 1, 0); PG8_LDB(B1, 1, 1); PG8_SCHED; PG8_LDA(At, 1, 0); PG8_STAGE(PG8_SA(0, 1), a2 + hstep, voffA);
            PG8_WAIT_V(8); PG8_WAIT_L(0); PG8_BAR; PG8_MMA(0, 0, At, B0); PG8_MMA(0, 1, At, B1); PG8_BAR; PG8_SCHED;
            PG8_LDA(At, 1, 1); PG8_STAGE(PG8_SB(1, 0), b3, voffB); PG8_STAGE(PG8_SB(1, 1), b3 + hstep, voffB); PG8_STAGE(PG8_SA(1, 0), a3, voffA);
            PG8_WAIT_V(8); PG8_WAIT_L(0); PG8_BAR; PG8_MMA(1, 0, At, B0); PG8_MMA(1, 1, At, B1); PG8_BAR; PG8_SCHED;
            } else {
            PG8_LDB(B0, 0, 0); PG8_SCHED; PG8_LDA(At, 0, 0); PG8_STAGE(PG8_SA(1, 1), a1 + hstep, voffA);
            PG8_WAIT_L(8); PG8_BAR; PG8_WAIT_L(0); PG8_MMA(0, 0, At, B0); PG8_BAR; PG8_SCHED;
            PG8_LDB(B1, 0, 1); PG8_STAGE(PG8_SB(0, 0), b2, voffB);
            PG8_BAR; PG8_WAIT_L(0); PG8_MMA(0, 1, At, B1); PG8_BAR;
            PG8_LDA(At, 0, 1); PG8_STAGE(PG8_SA(0, 0), a2, voffA);
            PG8_BAR; PG8_WAIT_L(0); PG8_MMA(1, 0, At, B0); PG8_BAR; PG8_SCHED;
            PG8_STAGE(PG8_SB(0, 1), b2 + hstep, voffB);
            PG8_WAIT_V(6); PG8_BAR; PG8_MMA(1, 1, At, B1); PG8_BAR;
            PG8_LDB(B0, 1, 0); PG8_SCHED; PG8_LDA(At, 1, 0); PG8_STAGE(PG8_SA(0, 1), a2 + hstep, voffA);
            PG8_WAIT_L(8); PG8_BAR; PG8_WAIT_L(0); PG8_MMA(0, 0, At, B0); PG8_BAR; PG8_SCHED;
            PG8_LDB(B1, 1, 1); PG8_STAGE(PG8_SB(1, 0), b3, voffB);
            PG8_BAR; PG8_WAIT_L(0); PG8_MMA(0, 1, At, B1); PG8_BAR;
            PG8_LDA(At, 1, 1); PG8_STAGE(PG8_SA(1, 0), a3, voffA);
            PG8_BAR; PG8_WAIT_L(0); PG8_MMA(1, 0, At, B0); PG8_BAR; PG8_SCHED;
            PG8_STAGE(PG8_SB(1, 1), b3 + hstep, voffB);
            PG8_WAIT_V(6); PG8_BAR; PG8_MMA(1, 1, At, B1); PG8_BAR;
            }
        }
        if constexpr (ALIGN_EPI) { if (wr == 0) PG8_BAR; }
        if constexpr (!Epi::AFTER_DRAIN) { E(acc, cur, wr, wc, fr, fq); S.done(cur); }
        if (!has_next) break;
#pragma unroll
        for (int a = 0; a < 2; ++a)
#pragma unroll
            for (int b = 0; b < 2; ++b)
#pragma unroll
                for (int m = 0; m < 4; ++m)
#pragma unroll
                    for (int n = 0; n < 2; ++n) acc[a][b][m][n] = (f32x4){0.f, 0.f, 0.f, 0.f};
        cur = nxt; cA = nA; cB = nB; ++ui;
        if constexpr (ALIGN_EPI) { if (wr == 1) PG8_BAR; }
    }
    PG8_WAIT_V(0);
    if constexpr (!ALIGN_EPI) { if (wr == 0) PG8_BAR; }
    PG8_BAR;
    if constexpr (Epi::AFTER_DRAIN) { E.fused(acc, cur, wr, wc, fr, fq, lds, wid, lane); S.done(cur); }
#undef PG8_SA
#undef PG8_SB
#undef PG8_STAGE
#undef PG8_LDA
#undef PG8_LDB
#undef PG8_MMA
#undef PG8_WAIT_V
#undef PG8_WAIT_L
#undef PG8_BAR
#undef PG8_SCHED
}
}

#define LAS __attribute__((address_space(3)))
typedef unsigned short bf16;
typedef short bf16x8 __attribute__((ext_vector_type(8)));
typedef float f32x4 __attribute__((ext_vector_type(4)));
typedef float f32x16 __attribute__((ext_vector_type(16)));
typedef unsigned u32x4 __attribute__((ext_vector_type(4)));
typedef unsigned u32x2 __attribute__((ext_vector_type(2)));
typedef float f32x2_t __attribute__((ext_vector_type(2)));
typedef __bf16 bf16x2_t __attribute__((ext_vector_type(2)));

constexpr int DM = 1024, TSEQ = 2048, NB = 8, MP = NB * TSEQ  , NS = 128  , MR = MP + NS  , MPAD = 16640  ;
constexpr int DREC = 512, DATT = 512, DKV = 128, DFF = 2816, DIN = 1792;
constexpr float EPS = 1e-6f;
constexpr int NWAVES = 8, NTHR = 512;
constexpr size_t OFF_Y = 0, OFF_PK = (size_t)MR * DM, OFF_PV = OFF_PK + 131072, OFF_PCONV = OFF_PV + 131072, OFF_PH = OFF_PCONV + 12288,
                 OFF_SK = OFF_PH + 4096, OFF_SV = OFF_SK + 2097152, OFF_SCONV = OFF_SV + 2097152, OFF_SH = OFF_SCONV + 196608, OUT_END = OFF_SH + 65536;
constexpr size_t MiB = 1u << 20;
constexpr size_t WS_BAR = 512 * 1024, BAR_BYTES = 16384;
constexpr size_t WS_RSQH = 0, WS_SUMA = 1 * MiB, WS_SUMH = 1 * MiB + 512 * 1024;
constexpr size_t WS_WIN = 2 * MiB, WS_WOUT = 6 * MiB, WS_WGU = 8 * MiB, WS_WD = 19 * MiB, WS_GWT = 25 * MiB;
constexpr size_t WS_MIX = 26 * MiB, WS_HB = 59 * MiB, WS_FF = 92 * MiB;
constexpr size_t WS_XN = 92 * MiB, WS_XR = 125 * MiB, WS_GR = 142 * MiB, WS_Q = 159 * MiB, WS_KB = 176 * MiB, WS_VT = 181 * MiB, WS_END = 186 * MiB;
static_assert(WS_MIX + (size_t)MPAD * DM * 2 <= WS_HB && WS_HB + (size_t)MPAD * DM * 2 <= WS_FF && WS_FF + (size_t)MPAD * DFF * 2 <= WS_END, "ws map");
static_assert(WS_GR - WS_XR == WS_Q - WS_GR, "xr/gr/q equally spaced");
static_assert(WS_XN + (size_t)MPAD * DM * 2 <= WS_XR && WS_XR + (size_t)MPAD * 512 * 2 <= WS_GR && WS_GR + (size_t)MPAD * 512 * 2 <= WS_Q && WS_Q + (size_t)MPAD * 512 * 2 <= WS_KB && WS_KB + (size_t)MPAD * 128 * 2 <= WS_VT, "ws map 2");
constexpr int LDS_BYTES = 132096;

struct Params {
    const float* in[24];
    float* out; unsigned char* ws;
};
typedef const __attribute__((address_space(4))) Params* KP;
__device__ __forceinline__ KP kargs() { KP q = (KP)__builtin_amdgcn_kernarg_segment_ptr(); asm volatile("" : "+s"(q)); return q; }
enum { I_XP = 0, I_XS, I_CK, I_CV, I_SCONV, I_SH, I_N1G, I_WIN, I_CONVW, I_CONVB, I_GAW, I_GAB, I_GXW, I_GXB, I_LAM, I_SINK, I_RNG, I_ANG, I_WOUT, I_N2G, I_WG, I_WU, I_WD, I_FNG };

__device__ __forceinline__ unsigned pk2(float lo, float hi) { f32x2_t v = {lo, hi}; bf16x2_t b = __builtin_convertvector(v, bf16x2_t); return __builtin_bit_cast(unsigned, b); }
__device__ __forceinline__ float bflo(unsigned w) { return __uint_as_float(w << 16); }
__device__ __forceinline__ float bfhi(unsigned w) { return __uint_as_float(w & 0xffff0000u); }
__device__ __forceinline__ float bf1(bf16 u) { return __uint_as_float((unsigned)u << 16); }
__device__ __forceinline__ float wave_sum(float v) {
#pragma unroll
    for (int o = 1; o < 64; o <<= 1) v += __shfl_xor(v, o);
    return v;
}
__device__ __forceinline__ float wave_max(float v) {
#pragma unroll
    for (int o = 1; o < 64; o <<= 1) v = fmaxf(v, __shfl_xor(v, o));
    return v;
}
__device__ __forceinline__ float sigmoidf_(float x) { return 1.0f / (1.0f + __expf(-x)); }
__device__ __forceinline__ float gelu_tanh(float x) { const float z = 0.7978845608028654f * (x + 0.044715f * x * x * x); const float e = __expf(2.0f * z); const float th = 1.0f - 2.0f / (e + 1.0f); return 0.5f * x * (1.0f + th); }

using pg8::Unit;
struct EpiIn {
    static constexpr bool PERM = true, AFTER_DRAIN = false;
    unsigned char* ws; float* out;
    __device__ __forceinline__ void operator()(const f32x4 (&acc)[2][2][4][2], const Unit& u, int wr, int wc, int fr, int fq) const {
        const int pn = u.pn;
        bf16* const KB = (bf16*)(ws + WS_KB); bf16* const VT = (bf16*)(ws + WS_VT);
#pragma unroll
        for (int ai = 0; ai < 2; ++ai)
#pragma unroll
            for (int m = 0; m < 4; ++m) {
                const int row = u.pm * 256 + ai * 128 + wr * 64 + m * 16 + fr;
                const bool isp = row < MP, iss = (row >= MP) && (row < MR);
                const int b = isp ? (row >> 11) : (row - MP), t = row & (TSEQ - 1);
#pragma unroll
                for (int bj = 0; bj < 2; ++bj) {
                    const int c = bj * 128 + wc * 32 + 8 * fq;
                    f32x4 v0 = acc[ai][bj][m][0], v1 = acc[ai][bj][m][1];
                    if (pn < 6) {
                        bf16* dst = (bf16*)(ws + WS_XR + (size_t)(pn >> 1) * (WS_GR - WS_XR));
                        const int col = (pn & 1) * 256 + c;
                        if (pn >= 4) { v0 = v0 * 0.125f; v1 = v1 * 0.125f; }
                        u32x4 w; w.x = pk2(v0[0], v0[1]); w.y = pk2(v0[2], v0[3]); w.z = pk2(v1[0], v1[1]); w.w = pk2(v1[2], v1[3]);
                        *(u32x4*)(dst + (size_t)row * 512 + col) = w;
                        if (pn < 2) {
                            float* o = nullptr;
                            if (isp && t >= TSEQ - 3) o = out + OFF_PCONV + (size_t)(b * 3 + (t - (TSEQ - 3))) * 512 + col;
                            if (iss) o = out + OFF_SCONV + (size_t)(b * 3 + 2) * 512 + col;
                            if (o) { *(f32x4*)o = v0; *(f32x4*)(o + 4) = v1; }
                        }
                    } else {
                        const int cc = wc * 32 + 8 * fq;
                        if (bj == 0) {
                            u32x4 w; w.x = pk2(v0[0], v0[1]); w.y = pk2(v0[2], v0[3]); w.z = pk2(v1[0], v1[1]); w.w = pk2(v1[2], v1[3]);
                            *(u32x4*)(KB + (size_t)row * 128 + cc) = w;
                        } else if (isp) {
                            const int kvh = cc >> 6, d0 = cc & 63;
                            bf16* vt = VT + ((size_t)(b * 2 + kvh) * 64 + d0) * TSEQ + t;
                            const unsigned w0 = pk2(v0[0], v0[1]), w1 = pk2(v0[2], v0[3]), w2 = pk2(v1[0], v1[1]), w3 = pk2(v1[2], v1[3]);
                            vt[0 * TSEQ] = (bf16)(w0 & 0xffff); vt[1 * TSEQ] = (bf16)(w0 >> 16); vt[2 * TSEQ] = (bf16)(w1 & 0xffff); vt[3 * TSEQ] = (bf16)(w1 >> 16);
                            vt[4 * TSEQ] = (bf16)(w2 & 0xffff); vt[5 * TSEQ] = (bf16)(w2 >> 16); vt[6 * TSEQ] = (bf16)(w3 & 0xffff); vt[7 * TSEQ] = (bf16)(w3 >> 16);
                        }
                        float* o = nullptr;
                        if (isp && t >= TSEQ - 128) o = out + (bj == 0 ? OFF_PK : OFF_PV) + (size_t)(b * 128 + (t - (TSEQ - 128))) * 128 + cc;
                        if (iss) o = out + (bj == 0 ? OFF_SK : OFF_SV) + (size_t)(b * 128 + 127) * 128 + cc;
                        if (o) { *(f32x4*)o = v0; *(f32x4*)(o + 4) = v1; }
                    }
                }
            }
    }
};
struct EpiOut {
    static constexpr bool PERM = false, AFTER_DRAIN = false;
    const float *xp, *xs; float* H; unsigned char* ws;
    __device__ __forceinline__ void operator()(const f32x4 (&acc)[2][2][4][2], const Unit& u, int wr, int wc, int fr, int fq) const {
        const int col0 = u.pn * 256 + wc * 32 + 4 * fq;
        bf16* const HB = (bf16*)(ws + WS_HB); float* const rsq = (float*)(ws + WS_RSQH);
#pragma unroll
        for (int ai = 0; ai < 2; ++ai)
#pragma unroll
            for (int m = 0; m < 4; ++m) {
                const int row = u.pm * 256 + ai * 128 + wr * 64 + m * 16 + fr;
                const bool real = row < MR;
                const float* xrow = row < MP ? xp + (size_t)row * DM : xs + (size_t)(row - MP) * DM;
                float s = 0.f;
#pragma unroll
                for (int bj = 0; bj < 2; ++bj)
#pragma unroll
                    for (int n = 0; n < 2; ++n) {
                        const int c = col0 + bj * 128 + n * 16;
                        f32x4 v = acc[ai][bj][m][n];
                        if (real) {
                            v = v + *(const f32x4*)(xrow + c);
                            *(f32x4*)(H + (size_t)row * DM + c) = v;
                        }
                        s += (v[0] * v[0] + v[1] * v[1]) + (v[2] * v[2] + v[3] * v[3]);
                        u32x2 w; w.x = pk2(v[0], v[1]); w.y = pk2(v[2], v[3]);
                        *(u32x2*)(HB + (size_t)row * DM + c) = w;
                    }
                s += __shfl_xor(s, 16); s += __shfl_xor(s, 32);
                if (fq == 0) atomicAdd(rsq + row, s);
            }
    }
};
struct EpiGU {
    static constexpr bool PERM = true, AFTER_DRAIN = false;
    unsigned char* ws;
    __device__ __forceinline__ void operator()(const f32x4 (&acc)[2][2][4][2], const Unit& u, int wr, int wc, int fr, int fq) const {
        const int col = u.pn * 128 + wc * 32 + 8 * fq;
        bf16* const FF = (bf16*)(ws + WS_FF); const float* const rsq = (const float*)(ws + WS_RSQH);
#pragma unroll
        for (int ai = 0; ai < 2; ++ai)
#pragma unroll
            for (int m = 0; m < 4; ++m) {
                const int row = u.pm * 256 + ai * 128 + wr * 64 + m * 16 + fr;
                const float r = rsqrtf(rsq[row] * (1.0f / DM) + EPS);
                float o[8];
#pragma unroll
                for (int n = 0; n < 2; ++n)
#pragma unroll
                    for (int e = 0; e < 4; ++e) { const float g = acc[ai][0][m][n][e] * r, uu = acc[ai][1][m][n][e] * r; o[4 * n + e] = g * sigmoidf_(g) * uu; }
                u32x4 w; w.x = pk2(o[0], o[1]); w.y = pk2(o[2], o[3]); w.z = pk2(o[4], o[5]); w.w = pk2(o[6], o[7]);
                *(u32x4*)(FF + (size_t)row * DFF + col) = w;
            }
    }
};
struct EpiDown {
    static constexpr bool PERM = false, AFTER_DRAIN = false;
    float* H;
    __device__ __forceinline__ void operator()(const f32x4 (&acc)[2][2][4][2], const Unit& u, int wr, int wc, int fr, int fq) const {
        const int col0 = u.pn * 256 + wc * 32 + 4 * fq;
#pragma unroll
        for (int ai = 0; ai < 2; ++ai)
#pragma unroll
            for (int m = 0; m < 4; ++m) {
                const int row = u.pm * 256 + ai * 128 + wr * 64 + m * 16 + fr;
                if (row < MR) {
#pragma unroll
                    for (int bj = 0; bj < 2; ++bj)
#pragma unroll
                        for (int n = 0; n < 2; ++n) {
                            float* pp = H + (size_t)row * DM + col0 + bj * 128 + n * 16;
                            *(f32x4*)pp = *(const f32x4*)pp + acc[ai][bj][m][n];
                        }
                }
            }
    }
};

__device__ __forceinline__ void tr_item(const float* __restrict__ W, int N, bf16* WT, int ldt, int k0, int n0, int drow0, const float* __restrict__ kscale, LAS float* scr, int lane) {
#pragma unroll 8
    for (int i = 0; i < 32; ++i) { const int kk = 2 * i + (lane >> 5); float v = W[(size_t)(k0 + kk) * N + n0 + (lane & 31)]; if (kscale) v *= kscale[k0 + kk]; scr[kk * 33 + (lane & 31)] = v; }
    asm volatile("s_waitcnt lgkmcnt(0)" ::: "memory");
    const int c = lane & 7;
#pragma unroll
    for (int j = 0; j < 4; ++j) { const int n = (lane >> 3) + 8 * j; const LAS float* s = scr + (8 * c) * 33 + n;
        u32x4 o; o.x = pk2(s[0 * 33], s[1 * 33]); o.y = pk2(s[2 * 33], s[3 * 33]); o.z = pk2(s[4 * 33], s[5 * 33]); o.w = pk2(s[6 * 33], s[7 * 33]);
        *(u32x4*)(WT + (size_t)(drow0 + n) * ldt + k0 + 8 * c) = o; }
    asm volatile("s_waitcnt lgkmcnt(0)" ::: "memory");
}
__device__ __forceinline__ void p0_prologue(KP p, LAS unsigned char* lds, int gw, int NGW, int wave, int lane) {
    unsigned char* ws = p->ws;
    LAS float* scr = (LAS float*)(lds + wave * 16384);
    constexpr int I0 = 16 * 56, I1 = 16 * 32, I2 = 16 * 88, I3 = 16 * 88, I4 = 44 * 32, I5 = 16, I6 = 16, NIT = I0 + I1 + I2 + I3 + I4 + I5 + I6;
    for (int it = gw; it < NIT; it += NGW) {
        int r = it;
        if (r < I0) { const int kb = r / 56, nb = r % 56; tr_item(p->in[I_WIN], DIN, (bf16*)(ws + WS_WIN), DM, 64 * kb, 32 * nb, 32 * nb, nullptr, scr, lane); continue; } r -= I0;
        if (r < I1) { const int kb = r / 32, nb = r % 32; tr_item(p->in[I_WOUT], DM, (bf16*)(ws + WS_WOUT), DM, 64 * kb, 32 * nb, 32 * nb, nullptr, scr, lane); continue; } r -= I1;
        if (r < I2) { const int kb = r / 88, nb = r % 88, n0 = 32 * nb; tr_item(p->in[I_WG], DFF, (bf16*)(ws + WS_WGU), DM, 64 * kb, n0, 256 * (n0 >> 7) + (n0 & 127), p->in[I_N2G], scr, lane); continue; } r -= I2;
        if (r < I3) { const int kb = r / 88, nb = r % 88, n0 = 32 * nb; tr_item(p->in[I_WU], DFF, (bf16*)(ws + WS_WGU), DM, 64 * kb, n0, 256 * (n0 >> 7) + 128 + (n0 & 127), p->in[I_N2G], scr, lane); continue; } r -= I3;
        if (r < I4) { const int kb = r / 32, nb = r % 32; tr_item(p->in[I_WD], DM, (bf16*)(ws + WS_WD), DFF, 64 * kb, 32 * nb, 32 * nb, nullptr, scr, lane); continue; } r -= I4;
        if (r < I5) { const int n = r >> 1, nb = r & 1; tr_item(p->in[I_GAW] + n * 4096, 64, (bf16*)(ws + WS_GWT) + n * 4096, 64, 0, 32 * nb, 32 * nb, nullptr, scr, lane); continue; } r -= I5;
        { const int n = r >> 1, nb = r & 1; tr_item(p->in[I_GXW] + n * 4096, 64, (bf16*)(ws + WS_GWT) + 8 * 4096 + n * 4096, 64, 0, 32 * nb, 32 * nb, nullptr, scr, lane); }
    }
    {
        const f32x4* g4 = (const f32x4*)p->in[I_N1G] + lane;
        f32x4 g[4];
#pragma unroll
        for (int j = 0; j < 4; ++j) g[j] = g4[64 * j];
        for (int m = gw; m < MR; m += NGW) {
            const float* xrow = m < MP ? p->in[I_XP] + (size_t)m * DM : p->in[I_XS] + (size_t)(m - MP) * DM;
            const f32x4* xr = (const f32x4*)xrow + lane;
            f32x4 v[4]; float s = 0.f;
#pragma unroll
            for (int j = 0; j < 4; ++j) { v[j] = xr[64 * j]; s += (v[j].x * v[j].x + v[j].y * v[j].y) + (v[j].z * v[j].z + v[j].w * v[j].w); }
            const float rs = rsqrtf(wave_sum(s) * (1.f / DM) + EPS);
            u32x2* o8 = (u32x2*)((bf16*)(ws + WS_XN) + (size_t)m * DM) + lane;
#pragma unroll
            for (int j = 0; j < 4; ++j) { u32x2 w; w.x = pk2(v[j].x * rs * g[j].x, v[j].y * rs * g[j].y); w.y = pk2(v[j].z * rs * g[j].z, v[j].w * rs * g[j].w); o8[64 * j] = w; }
        }
    }
    const int gt = gw * 64 + lane, NGT = NGW * 64;
    for (int i = gt; i < MPAD; i += NGT) ((float*)(ws + WS_RSQH))[i] = 0.f;
    for (int i = gt; i < NS * 4064; i += NGT) { const int b = i / 4064, o = i % 4064;
        ((f32x4*)(p->out + OFF_SK + (size_t)b * 16384))[o] = ((const f32x4*)(p->in[I_CK] + (size_t)b * 16384 + 128))[o];
        ((f32x4*)(p->out + OFF_SV + (size_t)b * 16384))[o] = ((const f32x4*)(p->in[I_CV] + (size_t)b * 16384 + 128))[o]; }
    for (int i = gt; i < NS * 256; i += NGT) { const int b = i >> 8, o = i & 255;
        ((f32x4*)(p->out + OFF_SCONV + (size_t)b * 1536))[o] = ((const f32x4*)(p->in[I_SCONV] + (size_t)b * 1536 + 512))[o]; }
}

constexpr int HS_OFF = 16384, HS_LD = 1032;
#define MFMA16(a, b, c) __builtin_amdgcn_mfma_f32_16x16x32_bf16((a), (b), (c), 0, 0, 0)
#define MFMA32(a, b, c) __builtin_amdgcn_mfma_f32_32x32x16_bf16((a), (b), (c), 0, 0, 0)
template <bool FINAL>
__device__ __forceinline__ void scan_unit(KP p, int b, int chunk, LAS unsigned char* lds, int wave, int lane) {
    unsigned char* ws = p->ws;
    const bf16* XR = (const bf16*)(ws + WS_XR);
    const bf16* GWT = (const bf16*)(ws + WS_GWT);
    float* SA = (float*)(ws + WS_SUMA); float* SH = (float*)(ws + WS_SUMH);
    const LAS float* cw = (const LAS float*)lds;
    const int n = wave, j = lane & 15, q = lane >> 4;
    bf16x8 wf[2][4][2];
#pragma unroll
    for (int g = 0; g < 2; ++g)
#pragma unroll
        for (int nt = 0; nt < 4; ++nt)
#pragma unroll
            for (int s = 0; s < 2; ++s) wf[g][nt][s] = *(const bf16x8*)(GWT + ((size_t)(g * 8 + n) * 64 + 16 * nt + j) * 64 + 32 * s + 8 * q);
    bf16x8 idf[2];
#pragma unroll
    for (int e = 0; e < 2; ++e)
#pragma unroll
        for (int jj = 0; jj < 8; ++jj) idf[e][jj] = (16 * e + j - 8 * q == jj) ? (short)0x3F80 : (short)0;
    float ba[4], bx[4], sp[4], hprev[4], acum[4];
#pragma unroll
    for (int nt = 0; nt < 4; ++nt) { const int ch = 64 * n + 16 * nt + j; ba[nt] = p->in[I_GAB][ch]; bx[nt] = p->in[I_GXB][ch]; sp[nt] = 8.0f * log1pf(__expf(-p->in[I_LAM][ch])); hprev[nt] = 0.f; acum[nt] = 1.f; }
    if (FINAL) {
        for (int c = 0; c < chunk; ++c) {
#pragma unroll
            for (int nt = 0; nt < 4; ++nt) { const int ch = 64 * n + 16 * nt + j; const size_t o = (size_t)(b * 32 + c) * 512 + ch; hprev[nt] = SA[o] * hprev[nt] + SH[o]; }
        }
    }
    for (int sc = 0; sc < 4; ++sc) {
        const int t0 = chunk * 64 + sc * 16, tok = t0 + j;
        bf16x8 af[2];
#pragma unroll
        for (int s = 0; s < 2; ++s) {
            const int ch0 = 64 * n + 32 * s + 8 * q;
            float a8[8];
            { const f32x4 c0 = *(const LAS f32x4*)(cw + 2048 + ch0), c1 = *(const LAS f32x4*)(cw + 2048 + ch0 + 4);
              a8[0] = c0[0]; a8[1] = c0[1]; a8[2] = c0[2]; a8[3] = c0[3]; a8[4] = c1[0]; a8[5] = c1[1]; a8[6] = c1[2]; a8[7] = c1[3]; }
#pragma unroll
            for (int w = 0; w < 4; ++w) {
                const int tt = tok - 3 + w;
                u32x4 x = {0u, 0u, 0u, 0u};
                if (tt >= 0) x = *(const u32x4*)(XR + (size_t)(b * TSEQ + tt) * 512 + ch0);
                const f32x4 w0 = *(const LAS f32x4*)(cw + w * 512 + ch0), w1 = *(const LAS f32x4*)(cw + w * 512 + ch0 + 4);
                a8[0] += w0[0] * bflo(x.x); a8[1] += w0[1] * bfhi(x.x); a8[2] += w0[2] * bflo(x.y); a8[3] += w0[3] * bfhi(x.y);
                a8[4] += w1[0] * bflo(x.z); a8[5] += w1[1] * bfhi(x.z); a8[6] += w1[2] * bflo(x.w); a8[7] += w1[3] * bfhi(x.w);
            }
            u32x4 pk; pk.x = pk2(a8[0], a8[1]); pk.y = pk2(a8[2], a8[3]); pk.z = pk2(a8[4], a8[5]); pk.w = pk2(a8[6], a8[7]);
            af[s] = __builtin_bit_cast(bf16x8, pk);
        }
#pragma unroll
        for (int nt = 0; nt < 4; ++nt) {
            f32x4 da = {0.f, 0.f, 0.f, 0.f}, dx = {0.f, 0.f, 0.f, 0.f}, xc = {0.f, 0.f, 0.f, 0.f};
            da = MFMA16(af[0], wf[0][nt][0], da); da = MFMA16(af[1], wf[0][nt][1], da);
            dx = MFMA16(af[0], wf[1][nt][0], dx); dx = MFMA16(af[1], wf[1][nt][1], dx);
            xc = MFMA16(af[nt >> 1], idf[nt & 1], xc);
            float a4[4], u4[4];
#pragma unroll
            for (int r = 0; r < 4; ++r) {
                const float ra = sigmoidf_(da[r] + ba[nt]), ix = sigmoidf_(dx[r] + bx[nt]);
                const float a = __expf(-ra * sp[nt]);
                a4[r] = a; u4[r] = sqrtf(fmaxf(1.0f - a * a, 0.f)) * ix * xc[r];
            }
            const float A4 = (a4[0] * a4[1]) * (a4[2] * a4[3]);
            const float H4 = ((u4[0] * a4[1] + u4[1]) * a4[2] + u4[2]) * a4[3] + u4[3];
            float c = hprev[nt], cin = 0.f, ap = 1.f;
#pragma unroll
            for (int pq = 0; pq < 4; ++pq) {
                const float Ap = __shfl(A4, j + 16 * pq), Hp = __shfl(H4, j + 16 * pq);
                if (pq == q) cin = c;
                c = Ap * c + Hp; ap *= Ap;
            }
            hprev[nt] = c; acum[nt] *= ap;
            if (FINAL) {
                LAS bf16* hs = (LAS bf16*)(lds + HS_OFF + (sc * 16 + 4 * q) * HS_LD) + (64 * n + 16 * nt + j);
                float h = cin;
#pragma unroll
                for (int r = 0; r < 4; ++r) { h = a4[r] * h + u4[r]; hs[r * (HS_LD / 2)] = (bf16)(pk2(h, 0.f) & 0xffff); }
            }
        }
    }
    if (!FINAL) {
        if (q == 0) {
#pragma unroll
            for (int nt = 0; nt < 4; ++nt) { const int ch = 64 * n + 16 * nt + j; const size_t o = (size_t)(b * 32 + chunk) * 512 + ch; SA[o] = acum[nt]; SH[o] = hprev[nt]; }
        }
    } else {
        if (chunk == 31 && q == 0) {
#pragma unroll
            for (int nt = 0; nt < 4; ++nt) p->out[OFF_PH + (size_t)b * 512 + 64 * n + 16 * nt + j] = hprev[nt];
        }
        __syncthreads();
        const bf16* GR = (const bf16*)(ws + WS_GR);
        bf16* MIX = (bf16*)(ws + WS_MIX);
        const f32x4 g0 = *(const f32x4*)(p->in[I_RNG] + 8 * lane), g1 = *(const f32x4*)(p->in[I_RNG] + 8 * lane + 4);
#pragma unroll 2
        for (int tt = 0; tt < 8; ++tt) {
            const int tl = wave * 8 + tt;
            const size_t row = (size_t)b * TSEQ + chunk * 64 + tl;
            const LAS u32x2* hp = (const LAS u32x2*)(lds + HS_OFF + tl * HS_LD + 16 * lane);
            const u32x2 h0 = hp[0], h1 = hp[1];
            const u32x4 gr = *(const u32x4*)(GR + row * 512 + 8 * lane);
            float rc[8];
            rc[0] = bflo(h0.x) * gelu_tanh(bflo(gr.x)); rc[1] = bfhi(h0.x) * gelu_tanh(bfhi(gr.x)); rc[2] = bflo(h0.y) * gelu_tanh(bflo(gr.y)); rc[3] = bfhi(h0.y) * gelu_tanh(bfhi(gr.y));
            rc[4] = bflo(h1.x) * gelu_tanh(bflo(gr.z)); rc[5] = bfhi(h1.x) * gelu_tanh(bfhi(gr.z)); rc[6] = bflo(h1.y) * gelu_tanh(bflo(gr.w)); rc[7] = bfhi(h1.y) * gelu_tanh(bfhi(gr.w));
            float ss = 0.f;
#pragma unroll
            for (int e = 0; e < 8; ++e) ss += rc[e] * rc[e];
            const float rn = rsqrtf(wave_sum(ss) * (1.0f / DREC) + EPS);
            u32x4 w; w.x = pk2(rc[0] * rn * g0[0], rc[1] * rn * g0[1]); w.y = pk2(rc[2] * rn * g0[2], rc[3] * rn * g0[3]);
            w.z = pk2(rc[4] * rn * g1[0], rc[5] * rn * g1[1]); w.w = pk2(rc[6] * rn * g1[2], rc[7] * rn * g1[3]);
            *(u32x4*)(MIX + row * DM + 8 * lane) = w;
        }
        __syncthreads();
    }
}

__device__ __forceinline__ void attn_unit(KP p, int b, int qt, LAS unsigned char* lds, int wave, int lane) {
    unsigned char* ws = p->ws;
    const bf16* Q = (const bf16*)(ws + WS_Q); const bf16* KB = (const bf16*)(ws + WS_KB); const bf16* VT = (const bf16*)(ws + WS_VT);
    bf16* MIX = (bf16*)(ws + WS_MIX);
    LAS float* red = (LAS float*)lds;
    const int r = lane & 31, h = lane >> 5, kvh = wave >> 2, q0 = qt * 32;
    const size_t rowq = (size_t)b * TSEQ + q0 + r;
    bf16x8 qf[4];
#pragma unroll
    for (int s = 0; s < 4; ++s) qf[s] = *(const bf16x8*)(Q + rowq * 512 + wave * 64 + 16 * s + 8 * h);
    const int pr = (r & ~12) | ((r & 4) << 1) | ((r & 8) >> 1);
    f32x16 S[5];
#pragma unroll
    for (int kt = 0; kt < 5; ++kt) {
        const int kbase = q0 - 128 + 32 * kt;
#pragma unroll
        for (int i = 0; i < 16; ++i) S[kt][i] = 0.f;
        if (kbase >= 0) {
#pragma unroll
            for (int s = 0; s < 4; ++s) {
                const bf16x8 kf = *(const bf16x8*)(KB + ((size_t)b * TSEQ + kbase + pr) * 128 + kvh * 64 + 16 * s + 8 * h);
                S[kt] = MFMA32(kf, qf[s], S[kt]);
            }
        }
    }
    const float sink = p->in[I_SINK][wave];
    float m = sink;
#pragma unroll
    for (int kt = 0; kt < 5; ++kt) {
        const int kbase = q0 - 128 + 32 * kt;
#pragma unroll
        for (int i = 0; i < 16; ++i) {
            const int kl = 16 * (i >> 3) + 8 * h + (i & 7);
            bool valid = kbase >= 0;
            if (kt == 0) valid = valid && (kl >= r);
            if (kt == 4) valid = valid && (kl <= r);
            const float sv = valid ? S[kt][i] : -INFINITY;
            S[kt][i] = sv; m = fmaxf(m, sv);
        }
    }
    m = fmaxf(m, __shfl_xor(m, 32));
    float l = 0.f;
#pragma unroll
    for (int kt = 0; kt < 5; ++kt)
#pragma unroll
        for (int i = 0; i < 16; ++i) { const float pv = __expf(S[kt][i] - m); S[kt][i] = pv; l += pv; }
    l += __shfl_xor(l, 32);
    const float inv = 1.0f / (l + __expf(sink - m));
    f32x16 O[2];
#pragma unroll
    for (int dt = 0; dt < 2; ++dt)
#pragma unroll
        for (int i = 0; i < 16; ++i) O[dt][i] = 0.f;
#pragma unroll
    for (int kt = 0; kt < 5; ++kt) {
        const int kbase = q0 - 128 + 32 * kt;
        if (kbase >= 0) {
#pragma unroll
            for (int s2 = 0; s2 < 2; ++s2) {
                u32x4 pk; pk.x = pk2(S[kt][8 * s2 + 0], S[kt][8 * s2 + 1]); pk.y = pk2(S[kt][8 * s2 + 2], S[kt][8 * s2 + 3]);
                pk.z = pk2(S[kt][8 * s2 + 4], S[kt][8 * s2 + 5]); pk.w = pk2(S[kt][8 * s2 + 6], S[kt][8 * s2 + 7]);
                const bf16x8 pb = __builtin_bit_cast(bf16x8, pk);
#pragma unroll
                for (int dt = 0; dt < 2; ++dt) {
                    const bf16x8 vf = *(const bf16x8*)(VT + ((size_t)(b * 2 + kvh) * 64 + 32 * dt + r) * TSEQ + kbase + 16 * s2 + 8 * h);
                    O[dt] = MFMA32(vf, pb, O[dt]);
                }
            }
        }
    }
    float ss = 0.f;
#pragma unroll
    for (int dt = 0; dt < 2; ++dt)
#pragma unroll
        for (int i = 0; i < 16; ++i) { O[dt][i] *= inv; ss += O[dt][i] * O[dt][i]; }
    ss += __shfl_xor(ss, 32);
    if (h == 0) red[wave * 32 + r] = ss;
    __syncthreads();
    float tot = 0.f;
#pragma unroll
    for (int w = 0; w < 8; ++w) tot += red[w * 32 + r];
    const float rn = rsqrtf(tot * (1.0f / DATT) + EPS);
#pragma unroll
    for (int dt = 0; dt < 2; ++dt)
#pragma unroll
        for (int g4 = 0; g4 < 4; ++g4) {
            const int d = 32 * dt + 8 * g4 + 4 * h;
            const f32x4 gg = *(const f32x4*)(p->in[I_ANG] + wave * 64 + d);
            u32x2 w; w.x = pk2(O[dt][4 * g4 + 0] * rn * gg[0], O[dt][4 * g4 + 1] * rn * gg[1]); w.y = pk2(O[dt][4 * g4 + 2] * rn * gg[2], O[dt][4 * g4 + 3] * rn * gg[3]);
            *(u32x2*)(MIX + rowq * DM + 512 + wave * 64 + d) = w;
        }
    __syncthreads();
}

__device__ __forceinline__ void sample_unit(KP p, int b, LAS unsigned char* lds, int tid, int wave, int lane) {
    unsigned char* ws = p->ws;
    const size_t row = (size_t)MP + b;
    bf16* MIX = (bf16*)(ws + WS_MIX);
    LAS float* xs = (LAS float*)(lds + 12288);
    LAS float* redw = (LAS float*)(lds + 12288 + 2048);
    LAS float* qs = (LAS float*)(lds + 12288 + 4096);
    LAS float* ps = (LAS float*)(lds + 12288 + 8192);
    __syncthreads();
    {
        const int c = tid;
        const float* sc = p->in[I_SCONV] + (size_t)b * 1536;
        const float* cwg = p->in[I_CONVW];
        const float xr = p->out[OFF_SCONV + (size_t)(b * 3 + 2) * 512 + c];
        const float xc = p->in[I_CONVB][c] + sc[c] * cwg[c] + sc[512 + c] * cwg[512 + c] + sc[1024 + c] * cwg[1024 + c] + xr * cwg[1536 + c];
        xs[c] = xc;
        __syncthreads();
        const int n = c >> 6, jj = c & 63;
        const float* wa = p->in[I_GAW] + n * 4096 + jj; const float* wx = p->in[I_GXW] + n * 4096 + jj;
        float ya = p->in[I_GAB][c], yx = p->in[I_GXB][c];
#pragma unroll 8
        for (int i = 0; i < 64; ++i) { const float xv = xs[64 * n + i]; ya += xv * wa[i * 64]; yx += xv * wx[i * 64]; }
        const float ra = sigmoidf_(ya), ix = sigmoidf_(yx);
        const float la = -8.0f * ra * log1pf(__expf(-p->in[I_LAM][c]));
        const float a = __expf(la);
        const float u = sqrtf(fmaxf(1.0f - a * a, 0.f)) * ix * xc;
        const float hn = a * p->in[I_SH][(size_t)b * 512 + c] + u;
        p->out[OFF_SH + (size_t)b * 512 + c] = hn;
        const float gr = bf1(((const bf16*)(ws + WS_GR))[row * 512 + c]);
        const float rec = hn * gelu_tanh(gr);
        const float ssw = wave_sum(rec * rec);
        if (lane == 0) redw[wave] = ssw;
        __syncthreads();
        float tot = 0.f;
#pragma unroll
        for (int w = 0; w < 8; ++w) tot += redw[w];
        const float rn = rsqrtf(tot * (1.0f / DREC) + EPS);
        MIX[row * DM + c] = (bf16)(pk2(rec * rn * p->in[I_RNG][c], 0.f) & 0xffff);
    }
    {
        const int kvh = wave >> 2;
        const float qd = bf1(((const bf16*)(ws + WS_Q))[row * 512 + wave * 64 + lane]);
        qs[wave * 64 + lane] = qd;
        const float* kself = p->out + OFF_SK + (size_t)(b * 128 + 127) * 128 + kvh * 64;
        const float* vself = p->out + OFF_SV + (size_t)(b * 128 + 127) * 128 + kvh * 64;
        const float sself = wave_sum(qd * kself[lane]);
        asm volatile("s_waitcnt lgkmcnt(0)" ::: "memory");
        const float* kc = p->in[I_CK] + (size_t)b * 16384 + kvh * 64;
        float s0 = 0.f, s1 = 0.f;
        const f32x4* k0 = (const f32x4*)(kc + (size_t)lane * 128);
        const f32x4* k1 = (const f32x4*)(kc + (size_t)(lane + 64) * 128);
        const LAS f32x4* q4 = (const LAS f32x4*)(qs + wave * 64);
#pragma unroll 4
        for (int i = 0; i < 16; ++i) { const f32x4 qq = q4[i], a0 = k0[i], a1 = k1[i];
            s0 += (qq[0] * a0[0] + qq[1] * a0[1]) + (qq[2] * a0[2] + qq[3] * a0[3]);
            s1 += (qq[0] * a1[0] + qq[1] * a1[1]) + (qq[2] * a1[2] + qq[3] * a1[3]); }
        const float sink = p->in[I_SINK][wave];
        const float m = fmaxf(fmaxf(wave_max(fmaxf(s0, s1)), sself), sink);
        const float p0 = __expf(s0 - m), p1 = __expf(s1 - m), pself = __expf(sself - m);
        const float den = wave_sum(p0 + p1) + pself + __expf(sink - m);
        ps[wave * 128 + lane] = p0; ps[wave * 128 + 64 + lane] = p1;
        asm volatile("s_waitcnt lgkmcnt(0)" ::: "memory");
        const float* vc = p->in[I_CV] + (size_t)b * 16384 + kvh * 64 + lane;
        float o = pself * vself[lane];
#pragma unroll 8
        for (int k = 0; k < 128; ++k) o += ps[wave * 128 + k] * vc[(size_t)k * 128];
        o *= 1.0f / den;
        const float ssw = wave_sum(o * o);
        if (lane == 0) redw[8 + wave] = ssw;
        __syncthreads();
        float tot = 0.f;
#pragma unroll
        for (int w = 0; w < 8; ++w) tot += redw[8 + w];
        const float rn = rsqrtf(tot * (1.0f / DATT) + EPS);
        MIX[row * DM + 512 + wave * 64 + lane] = (bf16)(pk2(o * rn * p->in[I_ANG][wave * 64 + lane], 0.f) & 0xffff);
    }
    __syncthreads();
}

#define XB_TMO      128
#define XB_XCNT(j)  (256  + 64 * (j))
#define XB_XSUB(j)  (1280 + 64 * (j))
#define XB_XGEN(j)  (2304 + 64 * (j))
#define XB_TOP      3328
#define XB_TOPGEN   3392
#define XCD_BAR_WORDS 3456
#define XB_SPIN_CAP (1u << 18)

__device__ __forceinline__ unsigned xb_ld(unsigned* p)              { return __hip_atomic_load(p, __ATOMIC_RELAXED, __HIP_MEMORY_SCOPE_AGENT); }
__device__ __forceinline__ unsigned xb_add(unsigned* p, unsigned v) { return __hip_atomic_fetch_add(p, v, __ATOMIC_RELAXED, __HIP_MEMORY_SCOPE_AGENT); }
__device__ __forceinline__ unsigned xb_xcc_id() { return (unsigned)__builtin_amdgcn_s_getreg((3 << 11) | 20) & 0xFu; }
#define XB_SPIN(cond, bar) do { unsigned _sp = 0; while (cond) { __builtin_amdgcn_s_sleep(1); \
    if ((++_sp & 255u) == 0u) { if (xb_ld(&(bar)[XB_TMO])) break; if (_sp > XB_SPIN_CAP) { atomicAdd(&(bar)[XB_TMO], 1u); break; } } } } while (0)

struct XcdBarrier {
    unsigned* bar; unsigned x;
    volatile LAS unsigned* st;
};

__device__ __forceinline__ XcdBarrier xcd_barrier_post(unsigned* bar, volatile LAS unsigned* st) {
    XcdBarrier b; b.bar = bar; b.x = xb_xcc_id(); b.st = st;
    if (threadIdx.x == 0) (void)xb_add(&bar[XB_XCNT(b.x)], 1u);
    return b;
}
__device__ __forceinline__ void xcd_barrier_complete(unsigned* bar, unsigned x, unsigned& nloc, unsigned& nx) {
    const unsigned G = gridDim.x * gridDim.y * gridDim.z;
    unsigned sum, cnt, mine, sp = 0u;
    for (;;) {
        sum = 0u; cnt = 0u; mine = 0u;
#pragma unroll
        for (unsigned j = 0; j < 16; ++j) { const unsigned c = xb_ld(&bar[XB_XCNT(j)]); sum += c; cnt += (c > 0u) ? 1u : 0u; mine = (j == x) ? c : mine; }
        if (sum == G) break;
        __builtin_amdgcn_s_sleep(1);
        if ((++sp & 255u) == 0u) { if (xb_ld(&bar[XB_TMO])) break; if (sp > XB_SPIN_CAP) { atomicAdd(&bar[XB_TMO], 1u); break; } }
    }
    nloc = mine > 0u ? mine : 1u; nx = cnt > 0u ? cnt : 1u;
}

__device__ __forceinline__ void xcd_barrier(const XcdBarrier& b) {
    asm volatile("s_waitcnt vmcnt(0)" ::: "memory");
    __syncthreads();
    if (threadIdx.x == 0) {
        unsigned* bar = b.bar;
        __builtin_amdgcn_s_waitcnt(0);
        unsigned nloc = b.st[0], nx = b.st[1];
        if (nloc == 0u) { xcd_barrier_complete(bar, b.x, nloc, nx); b.st[0] = nloc; b.st[1] = nx; }
        const unsigned old = xb_add(&bar[XB_XSUB(b.x)], 1u);
        const unsigned gen = old / nloc;
        if (old + 1u == (gen + 1u) * nloc) {
            __builtin_amdgcn_fence(__ATOMIC_RELEASE, "agent");
            asm volatile("s_waitcnt vmcnt(0)" ::: "memory");
            const unsigned og = xb_add(&bar[XB_TOP], 1u);
            const unsigned tg = og / nx;
            if (og + 1u == (tg + 1u) * nx) xb_add(&bar[XB_TOPGEN], 1u);
            else XB_SPIN(xb_ld(&bar[XB_TOPGEN]) == tg, bar);
            __builtin_amdgcn_fence(__ATOMIC_ACQUIRE, "agent");
            xb_add(&bar[XB_XGEN(b.x)], 1u);
            asm volatile("s_waitcnt vmcnt(0)" ::: "memory");
        } else {
            XB_SPIN(xb_ld(&bar[XB_XGEN(b.x)]) == gen, bar);
            __builtin_amdgcn_fence(__ATOMIC_ACQUIRE, "agent");
            asm volatile("s_waitcnt vmcnt(0)" ::: "memory");
        }
    }
    __syncthreads();
}

#ifndef REP_P0
#define REP_P0 1
#endif
#ifndef REP_P1
#define REP_P1 1
#endif
#ifndef REP_P4
#define REP_P4 1
#endif
#ifndef REP_SYNC
#define REP_SYNC 0
#endif
#ifndef REP_P2
#define REP_P2 1
#endif
#ifndef REP_P2B
#define REP_P2B 1
#endif
__global__ void __launch_bounds__(NTHR, 2) fwd_megakernel(Params p_unused) {
    extern __shared__ __attribute__((aligned(16))) unsigned char lds_[];
    cg::grid_group grid = cg::this_grid();
    LAS unsigned char* lds = (LAS unsigned char*)lds_;
    const int G = gridDim.x, bx = blockIdx.x;
    if (threadIdx.x < 2) ((LAS unsigned*)(lds + 131072))[threadIdx.x] = 0u;
    __syncthreads();
    XcdBarrier bar;
    { KP p = kargs(); unsigned char* ws = p->ws;
      if (ws == nullptr) grid.sync();
      bar = xcd_barrier_post((unsigned*)(ws + WS_BAR), (volatile LAS unsigned*)(lds + 131072)); }
#define GRID_SYNC() xcd_barrier(bar)
#define PHASE_IDS int tid_ = threadIdx.x; asm volatile("" : "+v"(tid_)); const int tid = tid_, lane = tid & 63, wave = __builtin_amdgcn_readfirstlane(tid >> 6); (void)tid; (void)lane; (void)wave;

    for (int rep = 0; rep < REP_P0; ++rep) { PHASE_IDS KP p = kargs(); p0_prologue(p, lds, bx * NWAVES + wave, G * NWAVES, wave, lane); }
    GRID_SYNC();

    for (int rep = 0; rep < REP_SYNC; ++rep) GRID_SYNC();
    for (int rep = 0; rep < REP_P1; ++rep) {
        KP p = kargs(); unsigned char* ws = p->ws;
        pg8::Gemm g{(const bf16*)(ws + WS_XN), (const bf16*)(ws + WS_WIN), MPAD, DIN, DM}; pg8::StaticOrder S; S.init(MPAD, DIN, G, bx);
        EpiIn E{ws, p->out};
        pg8::gemm_phase<EpiIn, pg8::StaticOrder, true, true>(lds, g, S, E);
    }
    GRID_SYNC();

    {
        PHASE_IDS KP p = kargs();
        for (int i = tid; i < 2560; i += NTHR) ((LAS float*)lds)[i] = i < 2048 ? p->in[I_CONVW][i] : p->in[I_CONVB][i - 2048];
        __syncthreads();
        for (int rep = 0; rep < REP_P2; ++rep)
        for (int u = bx; u < 640; u += G) {
            int tl_ = threadIdx.x; asm volatile("" : "+v"(tl_)); const int tid = tl_, lane = tl_ & 63;
            if (u < 256) scan_unit<false>(p, u >> 5, u & 31, lds, wave, lane);
            else if (u < 384) sample_unit(p, u - 256, lds, tid, wave, lane);
            else { const int a = u - 384; attn_unit(p, a >> 6, a & 63, lds + 12288, wave, lane); }
        }
    }
    GRID_SYNC();

    {
        PHASE_IDS KP p = kargs();
        for (int rep = 0; rep < REP_P2B; ++rep)
        for (int u = bx; u < 512; u += G) {
            int tl_ = threadIdx.x; asm volatile("" : "+v"(tl_)); const int lane = tl_ & 63;
            if (u < 256) scan_unit<true>(p, u >> 5, u & 31, lds, wave, lane);
            else { const int a = u; attn_unit(p, a >> 6, a & 63, lds + 12288, wave, lane); }
        }
    }
    GRID_SYNC();

    {
        KP p = kargs(); unsigned char* ws = p->ws;
        pg8::Gemm g{(const bf16*)(ws + WS_MIX), (const bf16*)(ws + WS_WOUT), MPAD, DM, DM}; pg8::StaticOrder S; S.init(MPAD, DM, G, bx);
        EpiOut E{p->in[I_XP], p->in[I_XS], p->out, ws};
        pg8::gemm_phase<EpiOut, pg8::StaticOrder, true, true>(lds, g, S, E);
    }
    GRID_SYNC();

    for (int rep = 0; rep < REP_P4; ++rep) {
        KP p = kargs(); unsigned char* ws = p->ws;
        pg8::Gemm g{(const bf16*)(ws + WS_HB), (const bf16*)(ws + WS_WGU), MPAD, 2 * DFF, DM}; pg8::StaticOrder S; S.init(MPAD, 2 * DFF, G, bx);
        EpiGU E{ws};
        pg8::gemm_phase<EpiGU, pg8::StaticOrder, true, true>(lds, g, S, E);
    }
    GRID_SYNC();

    {
        KP p = kargs(); unsigned char* ws = p->ws;
        pg8::Gemm g{(const bf16*)(ws + WS_FF), (const bf16*)(ws + WS_WD), MPAD, DM, DFF}; pg8::StaticOrder S; S.init(MPAD, DM, G, bx);
        EpiDown E{p->out};
        pg8::gemm_phase<EpiDown, pg8::StaticOrder, true, true>(lds, g, S, E);
    }
    GRID_SYNC();

    {
        PHASE_IDS KP p = kargs();
        const int gw = bx * NWAVES + wave, NGW = G * NWAVES;
        const f32x4* g4 = (const f32x4*)p->in[I_FNG] + lane;
        f32x4 gg[4];
#pragma unroll
        for (int j = 0; j < 4; ++j) gg[j] = g4[64 * j];
        for (int m = gw; m < MR; m += NGW) {
            f32x4* yr = (f32x4*)(p->out + (size_t)m * DM) + lane;
            f32x4 v[4]; float s = 0.f;
#pragma unroll
            for (int j = 0; j < 4; ++j) { v[j] = yr[64 * j]; s += (v[j].x * v[j].x + v[j].y * v[j].y) + (v[j].z * v[j].z + v[j].w * v[j].w); }
            const float rs = rsqrtf(wave_sum(s) * (1.f / DM) + EPS);
#pragma unroll
            for (int j = 0; j < 4; ++j) yr[64 * j] = v[j] * rs * gg[j];
        }
    }
}

extern "C" void kernel_launch(void* const* d_in, const int* in_sizes, int n_in, void* d_out, int out_size, void* d_ws, size_t ws_size, hipStream_t stream) {
    static int grid = 0;
    if (grid == 0) {
        int dev = 0, cus = 0, per_cu = 0;
        hipGetDevice(&dev);
        hipDeviceGetAttribute(&cus, hipDeviceAttributeMultiprocessorCount, dev);
        hipFuncSetAttribute((const void*)fwd_megakernel, hipFuncAttributeMaxDynamicSharedMemorySize, LDS_BYTES);
        hipOccupancyMaxActiveBlocksPerMultiprocessor(&per_cu, (const void*)fwd_megakernel, NTHR, LDS_BYTES);
        if (per_cu < 1) { fprintf(stderr, "kernel_launch: occupancy query says %d blocks/CU\n", per_cu); per_cu = 1; }
        (void)hipGetLastError();
        grid = cus;
        if (n_in != 24 || ws_size < WS_END || (size_t)out_size != OUT_END) fprintf(stderr, "kernel_launch: unexpected sizes n_in %d ws %zu out %d\n", n_in, ws_size, out_size);
    }
    hipMemsetAsync((unsigned char*)d_ws + WS_BAR, 0, BAR_BYTES, stream);
    Params p{};
    for (int i = 0; i < 24; ++i) p.in[i] = (const float*)d_in[i];
    p.out = (float*)d_out; p.ws = (unsigned char*)d_ws;
    void* args[] = {&p};
    hipError_t e = hipLaunchCooperativeKernel((const void*)fwd_megakernel, dim3(grid), dim3(NTHR), args, LDS_BYTES, stream);
    if (e != hipSuccess) fprintf(stderr, "cooperative launch failed: %s (grid %d)\n", hipGetErrorString(e), grid);
}
```

```cpp
#include <hip/hip_runtime.h>
#include <hip/hip_cooperative_groups.h>
#include <cstdio>
#include <cstdint>
namespace cg = cooperative_groups;
namespace pg8 {
#define PG8_LAS __attribute__((address_space(3)))
typedef unsigned short bf16_t;
typedef short bf16x8 __attribute__((ext_vector_type(8)));
typedef float f32x4 __attribute__((ext_vector_type(4)));
typedef unsigned u32x4 __attribute__((ext_vector_type(4)));
constexpr int BM = 256, BK = 64, HALF = 128, HTB = HALF * BK * 2  , STAGE_BYTES = 8 * HTB, NXCD = 8, WGM = 8;

__host__ __device__ __forceinline__ int lds_byte(int r, int c) { const int st = (r >> 4) * 2 + (c >> 5), rr = r & 15, cc = c & 31, ob = rr * 64 + cc * 2; return st * 1024 + (ob ^ (((ob >> 9) & 1) << 5)); }
__host__ __device__ __forceinline__ void stage_rc(int b, int& R, int& C) { const int st = b / 1024, sb = b % 1024, swz = sb ^ (((sb >> 9) & 1) << 5); R = (st >> 1) * 16 + swz / 64; C = (st & 1) * 32 + (swz % 64) / 2; }
__host__ __device__ __forceinline__ int perm32(int rho) { const int n = rho >> 4, i = rho & 15; return 8 * (i >> 2) + 4 * n + (i & 3); }

struct Unit { int pm, pn; };
struct Gemm { const bf16_t* A; const bf16_t* Bt; int M, N, K; };

struct StaticOrder {
    int nM, nN, nwg, G, c;
    int nfirst, first_pm, sig_pm; unsigned* cnt;
    __host__ __device__ void init(int M, int N, int G_, int c_) { nM = M / BM; nN = N / BM; nwg = nM * nN; G = G_; c = c_; nfirst = 0; first_pm = 0; sig_pm = -1; cnt = nullptr; }
    __host__ __device__ bool next(int i, Unit& u) const {
        long L = (long)i * G + c; if (L < nfirst) { u.pm = first_pm; u.pn = (int)L; return true; } L -= nfirst; if (L >= nwg) return false;
        int wgid = (int)L; { const int q = nwg / NXCD, r = nwg % NXCD, xcd = wgid % NXCD, off = wgid / NXCD; wgid = (xcd < r ? xcd * (q + 1) : r * (q + 1) + (xcd - r) * q) + off; }
        const int nig = WGM * nN, gid = wgid / nig, fm = gid * WGM, gsz = (nM - fm) < WGM ? (nM - fm) : WGM;
        u.pm = fm + ((wgid % nig) % gsz); u.pn = (wgid % nig) / gsz; return true;
    }
    __device__ __forceinline__ void a_ready(const Unit&) const {}
    __device__ __forceinline__ void done(const Unit& u) const { if (u.pm == sig_pm) { asm volatile("s_waitcnt vmcnt(0)" ::: "memory"); if ((threadIdx.x & 63) == 0) atomicAdd(cnt, 1u); } }
};

template <class Epi, class Sched, bool ALIGN_EPI = false, bool SP2 = false>
__device__ __forceinline__ void gemm_phase(PG8_LAS unsigned char* lds, const Gemm g, const Sched& S, const Epi& E) {
    int tid_ = threadIdx.x; asm volatile("" : "+v"(tid_));
    const int tid = tid_, wid = __builtin_amdgcn_readfirstlane(tid >> 6), lane = tid & 63, wr = wid >> 2, wc = wid & 3, fr = lane & 15, fq = lane >> 4;
    const int K = g.K, nt = K / BK;
    unsigned voffA[2], voffB[2];
#pragma unroll
    for (int i = 0; i < 2; ++i) { int R, C; stage_rc(tid * 16 + i * 8192, R, C); const int Rb = Epi::PERM ? ((R & ~31) + perm32(R & 31)) : R;
        voffA[i] = (unsigned)(R * K + C) * 2u; voffB[i] = (unsigned)(Rb * K + C) * 2u; }
    const size_t kstep = (size_t)(BK * 2);
    const size_t hstep = (size_t)HALF * K * 2;
    const size_t tstep = 2 * hstep;
    const unsigned ldsw = (unsigned)wid * 1024u;
    const int aoff = lds_byte(wr * 64 + fr, fq * 8), boff = lds_byte(wc * 32 + fr, fq * 8);
#define PG8_SA(b, h) (((b) * 2 + (h)) * HTB)
#define PG8_SB(b, h) ((4 + (b) * 2 + (h)) * HTB)
#define PG8_STAGE(bufoff, gbase, voff) do { _Pragma("unroll") for (int _i = 0; _i < 2; ++_i) \
        __builtin_amdgcn_global_load_lds((const unsigned*)((const char*)(gbase) + (voff)[_i]), (PG8_LAS unsigned*)(lds + (bufoff) + ldsw + _i * 8192), 16, 0, 0); } while (0)
#define PG8_LDA(dst, b, h) do { _Pragma("unroll") for (int m = 0; m < 4; ++m) _Pragma("unroll") for (int k = 0; k < 2; ++k) dst[m][k] = *(const PG8_LAS bf16x8*)(lds + PG8_SA(b, h) + aoff + m * 2048 + k * 1024); } while (0)
#define PG8_LDB(dst, b, h) do { _Pragma("unroll") for (int n = 0; n < 2; ++n) _Pragma("unroll") for (int k = 0; k < 2; ++k) dst[n][k] = *(const PG8_LAS bf16x8*)(lds + PG8_SB(b, h) + boff + n * 2048 + k * 1024); } while (0)
#define PG8_MMA(ai, bj, At, Bt) do { __builtin_amdgcn_s_setprio(1); _Pragma("unroll") for (int m = 0; m < 4; ++m) _Pragma("unroll") for (int n = 0; n < 2; ++n) _Pragma("unroll") for (int k = 0; k < 2; ++k) \
        acc[ai][bj][m][n] = __builtin_amdgcn_mfma_f32_16x16x32_bf16(Bt[n][k], At[m][k], acc[ai][bj][m][n], 0, 0, 0); __builtin_amdgcn_s_setprio(0); } while (0)
#define PG8_WAIT_V(n) asm volatile("s_waitcnt vmcnt(" #n ")" ::: "memory")
#define PG8_WAIT_L(n) asm volatile("s_waitcnt lgkmcnt(" #n ")" ::: "memory")
#define PG8_BAR __builtin_amdgcn_s_barrier()
#define PG8_SCHED __builtin_amdgcn_sched_barrier(0)
    Unit cur, nxt; int ui = 0;
    if (!S.next(0, cur)) return;
    f32x4 acc[2][2][4][2];
#pragma unroll
    for (int a = 0; a < 2; ++a)
#pragma unroll
        for (int b = 0; b < 2; ++b)
#pragma unroll
            for (int m = 0; m < 4; ++m)
#pragma unroll
                for (int n = 0; n < 2; ++n) acc[a][b][m][n] = (f32x4){0.f, 0.f, 0.f, 0.f};
    bf16x8 At[4][2], B0[2][2], B1[2][2];
    const char* cA = (const char*)g.A + (size_t)cur.pm * tstep; const char* cB = (const char*)g.Bt + (size_t)cur.pn * tstep;
    S.a_ready(cur);
    if constexpr (SP2) {
        PG8_STAGE(PG8_SB(0, 0), cB, voffB); PG8_STAGE(PG8_SB(0, 1), cB + hstep, voffB); PG8_STAGE(PG8_SA(0, 0), cA, voffA); PG8_STAGE(PG8_SA(0, 1), cA + hstep, voffA);
        if (wr == 1) PG8_BAR;
        PG8_WAIT_V(2); PG8_BAR;
        PG8_STAGE(PG8_SB(1, 0), cB + kstep, voffB); PG8_STAGE(PG8_SA(1, 0), cA + kstep, voffA); PG8_STAGE(PG8_SB(1, 1), cB + hstep + kstep, voffB);
        PG8_WAIT_V(6); PG8_BAR;
    } else {
        PG8_STAGE(PG8_SB(0, 0), cB, voffB); PG8_STAGE(PG8_SA(0, 0), cA, voffA); PG8_STAGE(PG8_SB(0, 1), cB + hstep, voffB); PG8_STAGE(PG8_SA(0, 1), cA + hstep, voffA);
        if (wr == 1) PG8_BAR;
        PG8_WAIT_V(4); PG8_BAR;
        PG8_STAGE(PG8_SB(1, 0), cB + kstep, voffB); PG8_STAGE(PG8_SA(1, 0), cA + kstep, voffA); PG8_STAGE(PG8_SB(1, 1), cB + hstep + kstep, voffB);
        PG8_WAIT_V(6); PG8_BAR;
    }
    for (;;) {
        const bool has_next = S.next(ui + 1, nxt);
        const char* nA = has_next ? (const char*)g.A + (size_t)nxt.pm * tstep : cA; const char* nB = has_next ? (const char*)g.Bt + (size_t)nxt.pn * tstep : cB;
        for (int t = 0; t < nt; t += 2) {
            const bool last = (t == nt - 2);
            const char* a1 = cA + (size_t)(t + 1) * kstep;
            const char* a2 = last ? nA : cA + (size_t)(t + 2) * kstep; const char* b2 = last ? nB : cB + (size_t)(t + 2) * kstep;
            const char* a3 = a2 + kstep; const char* b3 = b2 + kstep;
            if (last && has_next) S.a_ready(nxt);
            if constexpr (SP2) {
            PG8_LDB(B0, 0, 0); PG8_LDB(B1, 0, 1); PG8_SCHED; PG8_LDA(At, 0, 0); PG8_STAGE(PG8_SA(1, 1), a1 + hstep, voffA);
            PG8_WAIT_V(8); PG8_WAIT_L(0); PG8_BAR; PG8_MMA(0, 0, At, B0); PG8_MMA(0, 1, At, B1); PG8_BAR; PG8_SCHED;
            PG8_LDA(At, 0, 1); PG8_STAGE(PG8_SB(0, 0), b2, voffB); PG8_STAGE(PG8_SB(0, 1), b2 + hstep, voffB); PG8_STAGE(PG8_SA(0, 0), a2, voffA);
            PG8_WAIT_V(8); PG8_WAIT_L(0); PG8_BAR; PG8_MMA(1, 0, At, B0); PG8_MMA(1, 1, At, B1); PG8_BAR; PG8_SCHED;
            PG8_LDB(B0, 1, 0); PG8_LDB(B1, 1, 1); PG8_SCHED; PG8_LDA(At, 1, 0); PG8_STAGE(PG8_SA(0, 1), a2 + hstep, voffA);
            PG8_WAIT_V(8); PG8_WAIT_L(0); PG8_BAR; PG8_MMA(0, 0, At, B0); PG8_MMA(0, 1, At, B1); PG8_BAR; PG8_SCHED;
            PG8_LDA(At, 1, 1); PG8_STAGE(PG8_SB(1, 0), b3, voffB); PG8_STAGE(PG8_SB(1, 1), b3 + hstep, voffB); PG8_STAGE(PG8_SA(1, 0), a3, voffA);
            PG8_WAIT_V(8); PG8_WAIT_L(0); PG8_BAR; PG8_MMA(1, 0, At, B0); PG8_MMA(1, 1, At, B1); PG8_BAR; PG8_SCHED;
            } else {
            PG8_LDB(B0, 0, 0); PG8_SCHED; PG8_LDA(At, 0, 0); PG8_STAGE(PG8_SA(1, 1), a1 + hstep, voffA);
            PG8_WAIT_L(8); PG8_BAR; PG8_WAIT_L(0); PG8_MMA(0, 0, At, B0); PG8_BAR; PG8_SCHED;
            PG8_LDB(B1, 0, 1); PG8_STAGE(PG8_SB(0, 0), b2, voffB);
            PG8_BAR; PG8_WAIT_L(0); PG8_MMA(0, 1, At, B1); PG8_BAR;
            PG8_LDA(At, 0, 1); PG8_STAGE(PG8_SA(0, 0), a2, voffA);
            PG8_BAR; PG8_WAIT_L(0); PG8_MMA(1, 0, At, B0); PG8_BAR; PG8_SCHED;
            PG8_STAGE(PG8_SB(0, 1), b2 + hstep, voffB);
            PG8_WAIT_V(6); PG8_BAR; PG8_MMA(1, 1, At, B1); PG8_BAR;
            PG8_LDB(B0, 1, 0); PG8_SCHED; PG8_LDA(At, 1, 0); PG8_STAGE(PG8_SA(0, 1), a2 + hstep, voffA);
            PG8_WAIT_L(8); PG8_BAR; PG8_WAIT_L(0); PG8_MMA(0, 0, At, B0); PG8_BAR; PG8_SCHED;
            PG8_LDB(B1, 1, 1); PG8_STAGE(PG8_SB(1, 0), b3, voffB);
            PG8_BAR; PG8_WAIT_L(0); PG8_MMA(0, 1, At, B1); PG8_BAR;
            PG8_LDA(At, 1, 1); PG8_STAGE(PG8_SA(1, 0), a3, voffA);
            PG8_BAR; PG8_WAIT_L(0); PG8_MMA(1, 0, At, B0); PG8_BAR; PG8_SCHED;
            PG8_STAGE(PG8_SB(1, 1), b3 + hstep, voffB);
            PG8_WAIT_V(6); PG8_BAR; PG8_MMA(1, 1, At, B1); PG8_BAR;
            }
        }
        if constexpr (ALIGN_EPI) { if (wr == 0) PG8_BAR; }
        if constexpr (!Epi::AFTER_DRAIN) { E(acc, cur, wr, wc, fr, fq); S.done(cur); }
        if (!has_next) break;
#pragma unroll
        for (int a = 0; a < 2; ++a)
#pragma unroll
            for (int b = 0; b < 2; ++b)
#pragma unroll
                for (int m = 0; m < 4; ++m)
#pragma unroll
                    for (int n = 0; n < 2; ++n) acc[a][b][m][n] = (f32x4){0.f, 0.f, 0.f, 0.f};
        cur = nxt; cA = nA; cB = nB; ++ui;
        if constexpr (ALIGN_EPI) { if (wr == 1) PG8_BAR; }
    }
    PG8_WAIT_V(0);
    if constexpr (!ALIGN_EPI) { if (wr == 0) PG8_BAR; }
    PG8_BAR;
    if constexpr (Epi::AFTER_DRAIN) { E.fused(acc, cur, wr, wc, fr, fq, lds, wid, lane); S.done(cur); }
#undef PG8_SA
#undef PG8_SB
#undef PG8_STAGE
#undef PG8_LDA
#undef PG8_LDB
#undef PG8_MMA
#undef PG8_WAIT_V
#undef PG8_WAIT_L
#undef PG8_BAR
#undef PG8_SCHED
}
}

#define LAS __attribute__((address_space(3)))
typedef unsigned short bf16;
typedef short bf16x8 __attribute__((ext_vector_type(8)));
typedef float f32x4 __attribute__((ext_vector_type(4)));
typedef float f32x16 __attribute__((ext_vector_type(16)));
typedef unsigned u32x4 __attribute__((ext_vector_type(4)));
typedef unsigned u32x2 __attribute__((ext_vector_type(2)));
typedef float f32x2_t __attribute__((ext_vector_type(2)));
typedef __bf16 bf16x2_t __attribute__((ext_vector_type(2)));

constexpr int DM = 1024, TSEQ = 2048, NB = 8, MP = NB * TSEQ  , NS = 128  , MR = MP + NS  , MPAD = 16640  ;
constexpr int DREC = 512, DATT = 512, DKV = 128, DFF = 2816, DIN = 1792;
constexpr float EPS = 1e-6f;
constexpr int NWAVES = 8, NTHR = 512;
constexpr size_t OFF_Y = 0, OFF_PK = (size_t)MR * DM, OFF_PV = OFF_PK + 131072, OFF_PCONV = OFF_PV + 131072, OFF_PH = OFF_PCONV + 12288,
                 OFF_SK = OFF_PH + 4096, OFF_SV = OFF_SK + 2097152, OFF_SCONV = OFF_SV + 2097152, OFF_SH = OFF_SCONV + 196608, OUT_END = OFF_SH + 65536;
constexpr size_t MiB = 1u << 20;
constexpr size_t WS_BAR = 512 * 1024, BAR_BYTES = 40960;
constexpr size_t WS_RSQH = 0, WS_SUMA = 1 * MiB, WS_SUMH = 1 * MiB + 512 * 1024;
constexpr size_t WS_WIN = 2 * MiB, WS_WOUT = 6 * MiB, WS_WGU = 8 * MiB, WS_WD = 19 * MiB, WS_GWT = 25 * MiB;
constexpr size_t WS_MIX = 26 * MiB, WS_HB = 59 * MiB, WS_FF = 92 * MiB;
constexpr size_t WS_XN = 92 * MiB, WS_XR = 125 * MiB, WS_GR = 142 * MiB, WS_Q = 159 * MiB, WS_KB = 176 * MiB, WS_VT = 181 * MiB, WS_END = 250 * MiB;
static_assert(WS_MIX + (size_t)MPAD * DM * 2 <= WS_HB && WS_HB + (size_t)MPAD * DM * 2 <= WS_FF && WS_FF + (size_t)MPAD * DFF * 2 <= WS_END, "ws map");
static_assert(WS_GR - WS_XR == WS_Q - WS_GR, "xr/gr/q equally spaced");
static_assert(WS_XN + (size_t)MPAD * DM * 2 <= WS_XR && WS_XR + (size_t)MPAD * 512 * 2 <= WS_GR && WS_GR + (size_t)MPAD * 512 * 2 <= WS_Q && WS_Q + (size_t)MPAD * 512 * 2 <= WS_KB && WS_KB + (size_t)MPAD * 128 * 2 <= WS_VT, "ws map 2");
constexpr int LDS_BYTES = 132096;

struct Params {
    const float* in[24];
    float* out; unsigned char* ws;
};
typedef const __attribute__((address_space(4))) Params* KP;
__device__ __forceinline__ KP kargs() { KP q = (KP)__builtin_amdgcn_kernarg_segment_ptr(); asm volatile("" : "+s"(q)); return q; }
enum { I_XP = 0, I_XS, I_CK, I_CV, I_SCONV, I_SH, I_N1G, I_WIN, I_CONVW, I_CONVB, I_GAW, I_GAB, I_GXW, I_GXB, I_LAM, I_SINK, I_RNG, I_ANG, I_WOUT, I_N2G, I_WG, I_WU, I_WD, I_FNG };

__device__ __forceinline__ unsigned pk2(float lo, float hi) { f32x2_t v = {lo, hi}; bf16x2_t b = __builtin_convertvector(v, bf16x2_t); return __builtin_bit_cast(unsigned, b); }
__device__ __forceinline__ float bflo(unsigned w) { return __uint_as_float(w << 16); }
__device__ __forceinline__ float bfhi(unsigned w) { return __uint_as_float(w & 0xffff0000u); }
__device__ __forceinline__ float bf1(bf16 u) { return __uint_as_float((unsigned)u << 16); }
__device__ __forceinline__ float shx(float v, int o, int lane) { return __int_as_float(__builtin_amdgcn_ds_bpermute((lane ^ o) << 2, __float_as_int(v))); }
__device__ __forceinline__ float shl(float v, int src) { return __int_as_float(__builtin_amdgcn_ds_bpermute(src << 2, __float_as_int(v))); }
__device__ __forceinline__ float wave_sum(float v, int lane) {
#pragma unroll
    for (int o = 1; o < 64; o <<= 1) v += shx(v, o, lane);
    return v;
}
__device__ __forceinline__ float wave_max(float v, int lane) {
#pragma unroll
    for (int o = 1; o < 64; o <<= 1) v = fmaxf(v, shx(v, o, lane));
    return v;
}
__device__ __forceinline__ float frcp(float x) { return __builtin_amdgcn_rcpf(x); }
__device__ __forceinline__ float fsqrt(float x) { return __builtin_amdgcn_sqrtf(x); }
__device__ __forceinline__ float frsq(float x) { return __builtin_amdgcn_rsqf(x); }
__device__ __forceinline__ float fexp(float x) { return __builtin_amdgcn_exp2f(x * 1.4426950408889634f); }
__device__ __forceinline__ float sigmoidf_(float x) { return frcp(1.0f + fexp(-x)); }
__device__ __forceinline__ float gelu_tanh(float x) { const float z = 0.7978845608028654f * (x + 0.044715f * x * x * x); const float e = fexp(2.0f * z); return x * (1.0f - frcp(e + 1.0f)); }

__device__ __forceinline__ void wt4f(float* p, float v) { __hip_atomic_store(p, v, __ATOMIC_RELAXED, __HIP_MEMORY_SCOPE_AGENT); }

using pg8::Unit;
struct EpiIn {
    static constexpr bool PERM = true, AFTER_DRAIN = false;
    unsigned char* ws; float* out;
    __device__ __forceinline__ void operator()(const f32x4 (&acc)[2][2][4][2], const Unit& u, int wr, int wc, int fr, int fq) const {
        const int pn = u.pn;
        bf16* const KB = (bf16*)(ws + WS_KB); bf16* const VT = (bf16*)(ws + WS_VT);
#pragma unroll
        for (int ai = 0; ai < 2; ++ai)
#pragma unroll
            for (int m = 0; m < 4; ++m) {
                const int row = u.pm * 256 + ai * 128 + wr * 64 + m * 16 + fr;
                const bool isp = row < MP, iss = (row >= MP) && (row < MR);
                const int b = isp ? (row >> 11) : (row - MP), t = row & (TSEQ - 1);
#pragma unroll
                for (int bj = 0; bj < 2; ++bj) {
                    const int c = bj * 128 + wc * 32 + 8 * fq;
                    f32x4 v0 = acc[ai][bj][m][0], v1 = acc[ai][bj][m][1];
                    if (pn < 6) {
                        bf16* dst = (bf16*)(ws + WS_XR + (size_t)(pn >> 1) * (WS_GR - WS_XR));
                        const int col = (pn & 1) * 256 + c;
                        if (pn >= 4) { v0 = v0 * 0.125f; v1 = v1 * 0.125f; }
                        u32x4 w; w.x = pk2(v0[0], v0[1]); w.y = pk2(v0[2], v0[3]); w.z = pk2(v1[0], v1[1]); w.w = pk2(v1[2], v1[3]);
                        *(u32x4*)(dst + (size_t)row * 512 + col) = w;
                        if (pn < 2) {
                            float* o = nullptr;
                            if (isp && t >= TSEQ - 3) o = out + OFF_PCONV + (size_t)(b * 3 + (t - (TSEQ - 3))) * 512 + col;
                            if (iss) o = out + OFF_SCONV + (size_t)(b * 3 + 2) * 512 + col;
                            if (o) { *(f32x4*)o = v0; *(f32x4*)(o + 4) = v1; }
                        }
                    } else {
                        const int cc = wc * 32 + 8 * fq;
                        if (bj == 0) {
                            u32x4 w; w.x = pk2(v0[0], v0[1]); w.y = pk2(v0[2], v0[3]); w.z = pk2(v1[0], v1[1]); w.w = pk2(v1[2], v1[3]);
                            *(u32x4*)(KB + (size_t)row * 128 + cc) = w;
                        } else if (isp) {
                            const int kvh = cc >> 6, d0 = cc & 63;
                            bf16* vt = VT + ((size_t)(b * 2 + kvh) * 64 + d0) * TSEQ + t;
                            const unsigned w0 = pk2(v0[0], v0[1]), w1 = pk2(v0[2], v0[3]), w2 = pk2(v1[0], v1[1]), w3 = pk2(v1[2], v1[3]);
                            vt[0 * TSEQ] = (bf16)(w0 & 0xffff); vt[1 * TSEQ] = (bf16)(w0 >> 16); vt[2 * TSEQ] = (bf16)(w1 & 0xffff); vt[3 * TSEQ] = (bf16)(w1 >> 16);
                            vt[4 * TSEQ] = (bf16)(w2 & 0xffff); vt[5 * TSEQ] = (bf16)(w2 >> 16); vt[6 * TSEQ] = (bf16)(w3 & 0xffff); vt[7 * TSEQ] = (bf16)(w3 >> 16);
                        }
                        float* o = nullptr;
                        if (isp && t >= TSEQ - 128) o = out + (bj == 0 ? OFF_PK : OFF_PV) + (size_t)(b * 128 + (t - (TSEQ - 128))) * 128 + cc;
                        if (iss) o = out + (bj == 0 ? OFF_SK : OFF_SV) + (size_t)(b * 128 + 127) * 128 + cc;
                        if (o) { *(f32x4*)o = v0; *(f32x4*)(o + 4) = v1; }
                    }
                }
            }
    }
};
struct EpiOut {
    static constexpr bool PERM = false, AFTER_DRAIN = false;
    const float *xp, *xs; float* H; unsigned char* ws;
    __device__ __forceinline__ void operator()(const f32x4 (&acc)[2][2][4][2], const Unit& u, int wr, int wc, int fr, int fq) const {
        const int col0 = u.pn * 256 + wc * 32 + 4 * fq, lane = fr + 16 * fq;
        bf16* const HB = (bf16*)(ws + WS_HB); float* const rsq = (float*)(ws + WS_RSQH);
#pragma unroll
        for (int ai = 0; ai < 2; ++ai)
#pragma unroll
            for (int m = 0; m < 4; ++m) {
                const int row = u.pm * 256 + ai * 128 + wr * 64 + m * 16 + fr;
                const bool real = row < MR;
                const float* xrow = row < MP ? xp + (size_t)row * DM : xs + (size_t)(row - MP) * DM;
                float s = 0.f;
#pragma unroll
                for (int bj = 0; bj < 2; ++bj)
#pragma unroll
                    for (int n = 0; n < 2; ++n) {
                        const int c = col0 + bj * 128 + n * 16;
                        f32x4 v = acc[ai][bj][m][n];
                        if (real) v = v + *(const f32x4*)(xrow + c);
                        s += (v[0] * v[0] + v[1] * v[1]) + (v[2] * v[2] + v[3] * v[3]);
                        u32x2 w; w.x = pk2(v[0], v[1]); w.y = pk2(v[2], v[3]);
                        *(u32x2*)(HB + (size_t)row * DM + c) = w;
                    }
                s += shx(s, 16, lane); s += shx(s, 32, lane);
                if (fq == 0) atomicAdd(rsq + row, s);
            }
    }
};
struct EpiGU {
    static constexpr bool PERM = true, AFTER_DRAIN = false;
    unsigned char* ws;
    __device__ __forceinline__ void operator()(const f32x4 (&acc)[2][2][4][2], const Unit& u, int wr, int wc, int fr, int fq) const {
        const int col = u.pn * 128 + wc * 32 + 8 * fq;
        bf16* const FF = (bf16*)(ws + WS_FF); const float* const rsq = (const float*)(ws + WS_RSQH);
#pragma unroll
        for (int ai = 0; ai < 2; ++ai)
#pragma unroll
            for (int m = 0; m < 4; ++m) {
                const int row = u.pm * 256 + ai * 128 + wr * 64 + m * 16 + fr;
                const float r = frsq(rsq[row] * (1.0f / DM) + EPS);
                float o[8];
#pragma unroll
                for (int n = 0; n < 2; ++n)
#pragma unroll
                    for (int e = 0; e < 4; ++e) { const float g = acc[ai][0][m][n][e] * r, uu = acc[ai][1][m][n][e] * r; o[4 * n + e] = g * sigmoidf_(g) * uu; }
                u32x4 w; w.x = pk2(o[0], o[1]); w.y = pk2(o[2], o[3]); w.z = pk2(o[4], o[5]); w.w = pk2(o[6], o[7]);
                if (u.pm == MP / 256) { unsigned long long* q8 = (unsigned long long*)(FF + (size_t)row * DFF + col);
                    __hip_atomic_store(q8, ((unsigned long long)w.y << 32) | w.x, __ATOMIC_RELAXED, __HIP_MEMORY_SCOPE_AGENT); __hip_atomic_store(q8 + 1, ((unsigned long long)w.w << 32) | w.z, __ATOMIC_RELAXED, __HIP_MEMORY_SCOPE_AGENT); }
                else *(u32x4*)(FF + (size_t)row * DFF + col) = w;
            }
    }
};
struct EpiDown {
    static constexpr bool PERM = false, AFTER_DRAIN = false;
    float* H;
    __device__ __forceinline__ void operator()(const f32x4 (&acc)[2][2][4][2], const Unit& u, int wr, int wc, int fr, int fq) const {
        const int col0 = u.pn * 256 + wc * 32 + 4 * fq;
#pragma unroll
        for (int ai = 0; ai < 2; ++ai)
#pragma unroll
            for (int m = 0; m < 4; ++m) {
                const int row = u.pm * 256 + ai * 128 + wr * 64 + m * 16 + fr;
                if (row < MR) {
#pragma unroll
                    for (int bj = 0; bj < 2; ++bj)
#pragma unroll
                        for (int n = 0; n < 2; ++n) {
                            float* pp = H + (size_t)row * DM + col0 + bj * 128 + n * 16;
                            *(f32x4*)pp = *(const f32x4*)pp + acc[ai][bj][m][n];
                        }
                }
            }
    }
};

constexpr size_t WS_XBUF = 768 * 1024;
constexpr int CW_PANEL = 4096, CW_SAMPLE = 8192, CW_S1 = 8192 + 64, CW_SCAN = 8192 + 128, CW_S2 = 8192 + 768;
struct EpiDownFused {
    static constexpr bool PERM = false, AFTER_DRAIN = true;
    unsigned char* ws; float* out; const float* gf;
    __device__ __forceinline__ void operator()(const f32x4 (&)[2][2][4][2], const Unit&, int, int, int, int) const {}
    __device__ __forceinline__ void fused(f32x4 (&acc)[2][2][4][2], const Unit& u, int wr, int wc, int fr, int fq, PG8_LAS unsigned char* lds, int wid, int lane) const {
        LAS float* P = (LAS float*)lds;
        LAS float* Sr = (LAS float*)(lds + 4096);
        const bf16* HB = (const bf16*)(ws + WS_HB);
        float* xbuf = (float*)(ws + WS_XBUF);
        unsigned* cnt = (unsigned*)(ws + WS_BAR) + CW_PANEL + 64 * u.pm;
        const int col0 = u.pn * 256 + wc * 32 + 4 * fq;
#pragma unroll
        for (int ai = 0; ai < 2; ++ai)
#pragma unroll
            for (int m = 0; m < 4; ++m) {
                const int rl = ai * 128 + wr * 64 + m * 16 + fr; const size_t row = (size_t)u.pm * 256 + rl;
                float s = 0.f;
#pragma unroll
                for (int bj = 0; bj < 2; ++bj)
#pragma unroll
                    for (int n = 0; n < 2; ++n) {
                        const u32x2 hb = *(const u32x2*)(HB + row * DM + col0 + bj * 128 + n * 16);
                        f32x4 v = acc[ai][bj][m][n];
                        v[0] += bflo(hb.x); v[1] += bfhi(hb.x); v[2] += bflo(hb.y); v[3] += bfhi(hb.y);
                        acc[ai][bj][m][n] = v;
                        s += (v[0] * v[0] + v[1] * v[1]) + (v[2] * v[2] + v[3] * v[3]);
                    }
                s += shx(s, 16, lane); s += shx(s, 32, lane);
                if (fq == 0) P[rl * 4 + wc] = s;
            }
        asm volatile("s_waitcnt lgkmcnt(0)" ::: "memory"); __builtin_amdgcn_s_barrier(); asm volatile("" ::: "memory");
        const int rr = wid * 32 + (lane & 31);
        if (lane < 32) {
            const float tot = (P[rr * 4 + 0] + P[rr * 4 + 1]) + (P[rr * 4 + 2] + P[rr * 4 + 3]);
            __hip_atomic_store(xbuf + ((size_t)u.pm * 256 + rr) * 4 + u.pn, tot, __ATOMIC_RELAXED, __HIP_MEMORY_SCOPE_AGENT);
        }
        asm volatile("s_waitcnt vmcnt(0)" ::: "memory");
        if (lane == 0) __hip_atomic_fetch_add(cnt, 1u, __ATOMIC_RELAXED, __HIP_MEMORY_SCOPE_AGENT);
        if (wid == 0) {
            unsigned sp = 0;
            while ((unsigned)__builtin_amdgcn_readfirstlane(__hip_atomic_load(cnt, __ATOMIC_RELAXED, __HIP_MEMORY_SCOPE_AGENT)) < 32u) { __builtin_amdgcn_s_sleep(2); if (++sp > (1u << 22)) break; }
            __builtin_amdgcn_fence(__ATOMIC_ACQUIRE, "agent");
        }
        asm volatile("s_waitcnt vmcnt(0) lgkmcnt(0)" ::: "memory"); __builtin_amdgcn_s_barrier(); asm volatile("" ::: "memory");
        if (lane < 32) {
            const float* sl = xbuf + ((size_t)u.pm * 256 + rr) * 4; float t = 0.f;
#pragma unroll
            for (int k = 0; k < 4; ++k) t += __hip_atomic_load(sl + k, __ATOMIC_RELAXED, __HIP_MEMORY_SCOPE_AGENT);
            Sr[rr] = frsq(t * (1.0f / DM) + EPS);
        }
        asm volatile("s_waitcnt vmcnt(0) lgkmcnt(0)" ::: "memory"); __builtin_amdgcn_s_barrier(); asm volatile("" ::: "memory");
        f32x4 gv[2][2];
#pragma unroll
        for (int bj = 0; bj < 2; ++bj)
#pragma unroll
            for (int n = 0; n < 2; ++n) gv[bj][n] = *(const f32x4*)(gf + col0 + bj * 128 + n * 16);
#pragma unroll
        for (int ai = 0; ai < 2; ++ai)
#pragma unroll
            for (int m = 0; m < 4; ++m) {
                const int rl = ai * 128 + wr * 64 + m * 16 + fr; const size_t row = (size_t)u.pm * 256 + rl;
                const float sc = Sr[rl];
#pragma unroll
                for (int bj = 0; bj < 2; ++bj)
#pragma unroll
                    for (int n = 0; n < 2; ++n) *(f32x4*)(out + row * DM + col0 + bj * 128 + n * 16) = acc[ai][bj][m][n] * sc * gv[bj][n];
            }
    }
};

__device__ __forceinline__ void tr_item(const float* __restrict__ W, int N, bf16* WT, int ldt, int k0, int n0, int drow0, const float* __restrict__ kscale, LAS float* scr, int lane) {
    float wv[32];
#pragma unroll
    for (int i = 0; i < 32; ++i) wv[i] = W[(size_t)(k0 + 2 * i + (lane >> 5)) * N + n0 + (lane & 31)];
#pragma unroll
    for (int i = 0; i < 32; ++i) { const int kk = 2 * i + (lane >> 5); float v = wv[i]; if (kscale) v *= kscale[k0 + kk]; scr[kk * 33 + (lane & 31)] = v; }
    asm volatile("s_waitcnt lgkmcnt(0)" ::: "memory");
    const int c = lane & 7;
#pragma unroll
    for (int j = 0; j < 4; ++j) { const int n = (lane >> 3) + 8 * j; const LAS float* s = scr + (8 * c) * 33 + n;
        u32x4 o; o.x = pk2(s[0 * 33], s[1 * 33]); o.y = pk2(s[2 * 33], s[3 * 33]); o.z = pk2(s[4 * 33], s[5 * 33]); o.w = pk2(s[6 * 33], s[7 * 33]);
        *(u32x4*)(WT + (size_t)(drow0 + n) * ldt + k0 + 8 * c) = o; }
    asm volatile("s_waitcnt lgkmcnt(0)" ::: "memory");
}
constexpr int CI_WIN = 16 * 56, CI_G = CI_WIN + 32, CI_WOUT = CI_G + 16 * 32, CI_WU = CI_WOUT + 2 * 16 * 88, CI_WD = CI_WU + 44 * 32;
__device__ __forceinline__ void convert_items(KP p, LAS unsigned char* lds, int lo, int hi, int gw, int NGW, int wave, int lane) {
    unsigned char* ws = p->ws;
    LAS float* scr = (LAS float*)(lds + wave * 16384);
    for (int it = lo + gw; it < hi; it += NGW) {
        const float* W; const float* ks = nullptr; bf16* WT; int N, ldt, k0, n0, drow0; int r = it;
        if (r < CI_WIN) { const int kb = r / 56, nb = r % 56; W = p->in[I_WIN]; N = DIN; WT = (bf16*)(ws + WS_WIN); ldt = DM; k0 = 64 * kb; n0 = 32 * nb; drow0 = n0; }
        else if (r < CI_G) { r -= CI_WIN; const int gx = r >> 4, n = (r & 15) >> 1, nb = r & 1; W = p->in[gx ? I_GXW : I_GAW] + n * 4096; N = 64; WT = (bf16*)(ws + WS_GWT) + gx * 8 * 4096 + n * 4096; ldt = 64; k0 = 0; n0 = 32 * nb; drow0 = n0; }
        else if (r < CI_WOUT) { r -= CI_G; const int kb = r / 32, nb = r % 32; W = p->in[I_WOUT]; N = DM; WT = (bf16*)(ws + WS_WOUT); ldt = DM; k0 = 64 * kb; n0 = 32 * nb; drow0 = n0; }
        else if (r < CI_WU) { r -= CI_WOUT; const int up = r >= 16 * 88 ? 1 : 0; if (up) r -= 16 * 88; const int kb = r / 88, nb = r % 88; W = p->in[up ? I_WU : I_WG]; N = DFF; WT = (bf16*)(ws + WS_WGU); ldt = DM; k0 = 64 * kb; n0 = 32 * nb;
            drow0 = 256 * (n0 >> 7) + 128 * up + (n0 & 127); ks = p->in[I_N2G]; }
        else { r -= CI_WU; const int kb = r / 32, nb = r % 32; W = p->in[I_WD]; N = DM; WT = (bf16*)(ws + WS_WD); ldt = DFF; k0 = 64 * kb; n0 = 32 * nb; drow0 = n0; }
        tr_item(W, N, WT, ldt, k0, n0, drow0, ks, scr, lane);
    }
}
__device__ __forceinline__ void copy_windows(KP p, int gt, int NGT) {
    for (int i = gt; i < NS * 4064; i += NGT) { const int b = i / 4064, o = i % 4064;
        ((f32x4*)(p->out + OFF_SK + (size_t)b * 16384))[o] = ((const f32x4*)(p->in[I_CK] + (size_t)b * 16384 + 128))[o];
        ((f32x4*)(p->out + OFF_SV + (size_t)b * 16384))[o] = ((const f32x4*)(p->in[I_CV] + (size_t)b * 16384 + 128))[o]; }
    for (int i = gt; i < NS * 256; i += NGT) { const int b = i >> 8, o = i & 255;
        ((f32x4*)(p->out + OFF_SCONV + (size_t)b * 1536))[o] = ((const f32x4*)(p->in[I_SCONV] + (size_t)b * 1536 + 512))[o]; }
}
__device__ __forceinline__ void slack_slot(int nwg, int G, int bx, int& slot, int& nslots) {
    const int mx = (nwg + G - 1) / G, first = nwg - (mx - 1) * G;
    if (first >= G) { slot = bx; nslots = G; } else { slot = bx - first; nslots = G - first; }
}
__device__ __forceinline__ void p0_prologue(KP p, LAS unsigned char* lds, int gw, int NGW, int wave, int lane) {
    unsigned char* ws = p->ws;
    convert_items(p, lds, 0, CI_G, gw, NGW, wave, lane);
    convert_items(p, lds, CI_WU, CI_WD, gw, NGW, wave, lane);
    {
        const f32x4* g4 = (const f32x4*)p->in[I_N1G] + lane;
        f32x4 g[4];
#pragma unroll
        for (int j = 0; j < 4; ++j) g[j] = g4[64 * j];
        for (int m0 = gw; m0 < MR; m0 += 2 * NGW) {
            f32x4 v[2][4];
#pragma unroll
            for (int rr = 0; rr < 2; ++rr) { const int m = m0 + rr * NGW, mc = m < MR ? m : m0;
                const float* xrow = mc < MP ? p->in[I_XP] + (size_t)mc * DM : p->in[I_XS] + (size_t)(mc - MP) * DM;
                const f32x4* xr = (const f32x4*)xrow + lane;
#pragma unroll
                for (int j = 0; j < 4; ++j) v[rr][j] = xr[64 * j]; }
#pragma unroll
            for (int rr = 0; rr < 2; ++rr) { const int m = m0 + rr * NGW;
                float s = 0.f;
#pragma unroll
                for (int j = 0; j < 4; ++j) s += (v[rr][j].x * v[rr][j].x + v[rr][j].y * v[rr][j].y) + (v[rr][j].z * v[rr][j].z + v[rr][j].w * v[rr][j].w);
                const float rs = frsq(wave_sum(s, lane) * (1.f / DM) + EPS);
                if (m < MR) { u32x2* o8 = (u32x2*)((bf16*)(ws + WS_XN) + (size_t)m * DM) + lane;
#pragma unroll
                    for (int j = 0; j < 4; ++j) { u32x2 w; w.x = pk2(v[rr][j].x * rs * g[j].x, v[rr][j].y * rs * g[j].y); w.y = pk2(v[rr][j].z * rs * g[j].z, v[rr][j].w * rs * g[j].w); o8[64 * j] = w; } }
            }
        }
    }
    const int gt = gw * 64 + lane, NGT = NGW * 64;
    for (int i = gt; i < MPAD; i += NGT) ((float*)(ws + WS_RSQH))[i] = 0.f;
}

constexpr int HS_OFF = 16384, HS_LD = 1032;
#define MFMA16(a, b, c) __builtin_amdgcn_mfma_f32_16x16x32_bf16((a), (b), (c), 0, 0, 0)
#define MFMA32(a, b, c) __builtin_amdgcn_mfma_f32_32x32x16_bf16((a), (b), (c), 0, 0, 0)
typedef float f32x2v __attribute__((ext_vector_type(2)));
constexpr size_t WS_AU = 186 * MiB;
template <bool FINAL>
__device__ __forceinline__ void scan_unit(KP p, int b, int chunk, LAS unsigned char* lds, int wave, int lane) {
    unsigned char* ws = p->ws;
    const bf16* XR = (const bf16*)(ws + WS_XR);
    const bf16* GWT = (const bf16*)(ws + WS_GWT);
    float* SA = (float*)(ws + WS_SUMA); float* SH = (float*)(ws + WS_SUMH);
    f32x2v* AU = (f32x2v*)(ws + WS_AU);
    const LAS float* cw = (const LAS float*)lds;
    const int n = wave, j = lane & 15, q = lane >> 4;
    float hprev[4] = {0.f, 0.f, 0.f, 0.f}, acum[4] = {1.f, 1.f, 1.f, 1.f};
    const size_t au0 = ((size_t)b * TSEQ + chunk * 64 + 4 * q) * 512 + 64 * n + j;
    if constexpr (FINAL) {
        unsigned pfg; { const int t_ = wave * 64 + lane; pfg = *(const unsigned*)((const bf16*)(ws + WS_GR) + ((size_t)b * TSEQ + chunk * 64 + (t_ >> 3)) * 512 + (t_ & 7) * 64); }
        f32x2v au[4][4], aun[4][4];
#define SCAN_LOADAU(dst, sc_) do { _Pragma("unroll") for (int nt = 0; nt < 4; ++nt) _Pragma("unroll") for (int r = 0; r < 4; ++r) dst[nt][r] = AU[au0 + (size_t)((sc_) * 16 + r) * 512 + 16 * nt]; } while (0)
        SCAN_LOADAU(au, 0);
        {
            float As[4] = {1.f, 1.f, 1.f, 1.f}, Hs[4] = {0.f, 0.f, 0.f, 0.f};
            float la[8][4], lh[8][4];
#pragma unroll
            for (int cc = 0; cc < 8; ++cc) { const int c = 8 * q + cc, ce = c < chunk ? c : 0;
#pragma unroll
                for (int nt = 0; nt < 4; ++nt) { const size_t o = (size_t)(b * 32 + ce) * 512 + 64 * n + 16 * nt + j; la[cc][nt] = __hip_atomic_load(SA + o, __ATOMIC_RELAXED, __HIP_MEMORY_SCOPE_AGENT); lh[cc][nt] = __hip_atomic_load(SH + o, __ATOMIC_RELAXED, __HIP_MEMORY_SCOPE_AGENT); } }
#pragma unroll
            for (int cc = 0; cc < 8; ++cc) { const bool ok = (8 * q + cc) < chunk;
#pragma unroll
                for (int nt = 0; nt < 4; ++nt) { const float a = ok ? la[cc][nt] : 1.f, hh = ok ? lh[cc][nt] : 0.f; Hs[nt] = a * Hs[nt] + hh; As[nt] *= a; } }
#pragma unroll
            for (int nt = 0; nt < 4; ++nt) { float hv = 0.f;
#pragma unroll
                for (int pq = 0; pq < 4; ++pq) { const float Ap = shl(As[nt], j + 16 * pq), Hp = shl(Hs[nt], j + 16 * pq); hv = Ap * hv + Hp; }
                hprev[nt] = hv; }
        }
#pragma unroll
        for (int sc = 0; sc < 4; ++sc) {
            if (sc < 3) SCAN_LOADAU(aun, sc + 1);
#pragma unroll
            for (int nt = 0; nt < 4; ++nt) {
                float a4[4], u4[4];
#pragma unroll
                for (int r = 0; r < 4; ++r) { a4[r] = au[nt][r].x; u4[r] = au[nt][r].y; }
                const float A4 = (a4[0] * a4[1]) * (a4[2] * a4[3]);
                const float H4 = ((u4[0] * a4[1] + u4[1]) * a4[2] + u4[2]) * a4[3] + u4[3];
                float c = hprev[nt], cin = 0.f;
#pragma unroll
                for (int pq = 0; pq < 4; ++pq) {
                    const float Ap = shl(A4, j + 16 * pq), Hp = shl(H4, j + 16 * pq);
                    if (pq == q) cin = c;
                    c = Ap * c + Hp;
                }
                hprev[nt] = c;
                LAS bf16* hs = (LAS bf16*)(lds + HS_OFF + (sc * 16 + 4 * q) * HS_LD) + (64 * n + 16 * nt + j);
                float h = cin;
#pragma unroll
                for (int r = 0; r < 4; ++r) { h = a4[r] * h + u4[r]; hs[r * (HS_LD / 2)] = (bf16)(pk2(h, 0.f) & 0xffff); }
            }
#pragma unroll
            for (int nt = 0; nt < 4; ++nt)
#pragma unroll
                for (int r = 0; r < 4; ++r) au[nt][r] = aun[nt][r];
        }
#undef SCAN_LOADAU
        asm volatile("" :: "v"(pfg));
    } else {
    bf16x8 wf[2][4][2];
#pragma unroll
    for (int g = 0; g < 2; ++g)
#pragma unroll
        for (int nt = 0; nt < 4; ++nt)
#pragma unroll
            for (int s = 0; s < 2; ++s) wf[g][nt][s] = *(const bf16x8*)(GWT + ((size_t)(g * 8 + n) * 64 + 16 * nt + j) * 64 + 32 * s + 8 * q);
    bf16x8 idf[2];
#pragma unroll
    for (int e = 0; e < 2; ++e)
#pragma unroll
        for (int jj = 0; jj < 8; ++jj) idf[e][jj] = (16 * e + j - 8 * q == jj) ? (short)0x3F80 : (short)0;
    float ba[4], bx[4], sp[4];
#pragma unroll
    for (int nt = 0; nt < 4; ++nt) { const int ch = 64 * n + 16 * nt + j; ba[nt] = p->in[I_GAB][ch]; bx[nt] = p->in[I_GXB][ch]; sp[nt] = 8.0f * log1pf(__expf(-p->in[I_LAM][ch])) * 1.4426950408889634f; }
#define SCAN_LOADX(dst, sc_) do { const int tok_ = chunk * 64 + (sc_) * 16 + j; \
        _Pragma("unroll") for (int s = 0; s < 2; ++s) _Pragma("unroll") for (int w = 0; w < 4; ++w) { \
            const int tt = tok_ - 3 + w, ttc = tt < 0 ? 0 : tt; \
            u32x4 x = *(const u32x4*)(XR + (size_t)(b * TSEQ + ttc) * 512 + 64 * n + 32 * s + 8 * q); \
            if (tt < 0) x = (u32x4){0u, 0u, 0u, 0u}; dst[s][w] = x; } } while (0)
    u32x4 xcur[2][4], xnext[2][4];
    SCAN_LOADX(xcur, 0);
#pragma unroll
    for (int sc = 0; sc < 4; ++sc) {
        if (sc < 3) SCAN_LOADX(xnext, sc + 1);
        bf16x8 af[2];
#pragma unroll
        for (int s = 0; s < 2; ++s) {
            const int ch0 = 64 * n + 32 * s + 8 * q;
            float a8[8];
            { const f32x4 c0 = *(const LAS f32x4*)(cw + 2048 + ch0), c1 = *(const LAS f32x4*)(cw + 2048 + ch0 + 4);
              a8[0] = c0[0]; a8[1] = c0[1]; a8[2] = c0[2]; a8[3] = c0[3]; a8[4] = c1[0]; a8[5] = c1[1]; a8[6] = c1[2]; a8[7] = c1[3]; }
#pragma unroll
            for (int w = 0; w < 4; ++w) {
                const u32x4 x = xcur[s][w];
                const f32x4 w0 = *(const LAS f32x4*)(cw + w * 512 + ch0), w1 = *(const LAS f32x4*)(cw + w * 512 + ch0 + 4);
                a8[0] += w0[0] * bflo(x.x); a8[1] += w0[1] * bfhi(x.x); a8[2] += w0[2] * bflo(x.y); a8[3] += w0[3] * bfhi(x.y);
                a8[4] += w1[0] * bflo(x.z); a8[5] += w1[1] * bfhi(x.z); a8[6] += w1[2] * bflo(x.w); a8[7] += w1[3] * bfhi(x.w);
            }
            u32x4 pk; pk.x = pk2(a8[0], a8[1]); pk.y = pk2(a8[2], a8[3]); pk.z = pk2(a8[4], a8[5]); pk.w = pk2(a8[6], a8[7]);
            af[s] = __builtin_bit_cast(bf16x8, pk);
        }
#pragma unroll
        for (int nt = 0; nt < 4; ++nt) {
            f32x4 da = {0.f, 0.f, 0.f, 0.f}, dx = {0.f, 0.f, 0.f, 0.f}, xc = {0.f, 0.f, 0.f, 0.f};
            da = MFMA16(af[0], wf[0][nt][0], da); da = MFMA16(af[1], wf[0][nt][1], da);
            dx = MFMA16(af[0], wf[1][nt][0], dx); dx = MFMA16(af[1], wf[1][nt][1], dx);
            xc = MFMA16(af[nt >> 1], idf[nt & 1], xc);
            float a4[4], u4[4];
#pragma unroll
            for (int r = 0; r < 4; ++r) {
                const float ra = sigmoidf_(da[r] + ba[nt]), ix = sigmoidf_(dx[r] + bx[nt]);
                const float a = __builtin_amdgcn_exp2f(-ra * sp[nt]);
                a4[r] = a; u4[r] = fsqrt(fmaxf(1.0f - a * a, 0.f)) * ix * xc[r];
                AU[au0 + (size_t)(sc * 16 + r) * 512 + 16 * nt] = (f32x2v){a4[r], u4[r]};
            }
            const float A4 = (a4[0] * a4[1]) * (a4[2] * a4[3]);
            const float H4 = ((u4[0] * a4[1] + u4[1]) * a4[2] + u4[2]) * a4[3] + u4[3];
            float c = hprev[nt], ap = 1.f;
#pragma unroll
            for (int pq = 0; pq < 4; ++pq) {
                const float Ap = shl(A4, j + 16 * pq), Hp = shl(H4, j + 16 * pq);
                c = Ap * c + Hp; ap *= Ap;
            }
            hprev[nt] = c; acum[nt] *= ap;
            asm volatile("" : "+v"(hprev[nt]), "+v"(acum[nt]));
            __builtin_amdgcn_sched_barrier(0);
        }
#pragma unroll
        for (int s = 0; s < 2; ++s)
#pragma unroll
            for (int w = 0; w < 4; ++w) xcur[s][w] = xnext[s][w];
    }
#undef SCAN_LOADX
    }
    if (!FINAL) {
        if (q == 0) {
#pragma unroll
            for (int nt = 0; nt < 4; ++nt) { const int ch = 64 * n + 16 * nt + j; const size_t o = (size_t)(b * 32 + chunk) * 512 + ch;
                __hip_atomic_store(SA + o, acum[nt], __ATOMIC_RELAXED, __HIP_MEMORY_SCOPE_AGENT); __hip_atomic_store(SH + o, hprev[nt], __ATOMIC_RELAXED, __HIP_MEMORY_SCOPE_AGENT); }
        }
    } else {
        if (chunk == 31 && q == 0) {
#pragma unroll
            for (int nt = 0; nt < 4; ++nt) p->out[OFF_PH + (size_t)b * 512 + 64 * n + 16 * nt + j] = hprev[nt];
        }
        __syncthreads();
        const bf16* GR = (const bf16*)(ws + WS_GR);
        bf16* MIX = (bf16*)(ws + WS_MIX);
        const f32x4 g0 = *(const f32x4*)(p->in[I_RNG] + 8 * lane), g1 = *(const f32x4*)(p->in[I_RNG] + 8 * lane + 4);
        u32x4 grv[8];
#pragma unroll
        for (int tt = 0; tt < 8; ++tt) grv[tt] = *(const u32x4*)(GR + ((size_t)b * TSEQ + chunk * 64 + wave * 8 + tt) * 512 + 8 * lane);
#pragma unroll
        for (int tt = 0; tt < 8; ++tt) {
            const int tl = wave * 8 + tt;
            const size_t row = (size_t)b * TSEQ + chunk * 64 + tl;
            const LAS u32x2* hp = (const LAS u32x2*)(lds + HS_OFF + tl * HS_LD + 16 * lane);
            const u32x2 h0 = hp[0], h1 = hp[1];
            const u32x4 gr = grv[tt];
            float rc[8];
            rc[0] = bflo(h0.x) * gelu_tanh(bflo(gr.x)); rc[1] = bfhi(h0.x) * gelu_tanh(bfhi(gr.x)); rc[2] = bflo(h0.y) * gelu_tanh(bflo(gr.y)); rc[3] = bfhi(h0.y) * gelu_tanh(bfhi(gr.y));
            rc[4] = bflo(h1.x) * gelu_tanh(bflo(gr.z)); rc[5] = bfhi(h1.x) * gelu_tanh(bfhi(gr.z)); rc[6] = bflo(h1.y) * gelu_tanh(bflo(gr.w)); rc[7] = bfhi(h1.y) * gelu_tanh(bfhi(gr.w));
            float ss = 0.f;
#pragma unroll
            for (int e = 0; e < 8; ++e) ss += rc[e] * rc[e];
            const float rn = frsq(wave_sum(ss, lane) * (1.0f / DREC) + EPS);
            u32x4 w; w.x = pk2(rc[0] * rn * g0[0], rc[1] * rn * g0[1]); w.y = pk2(rc[2] * rn * g0[2], rc[3] * rn * g0[3]);
            w.z = pk2(rc[4] * rn * g1[0], rc[5] * rn * g1[1]); w.w = pk2(rc[6] * rn * g1[2], rc[7] * rn * g1[3]);
            *(u32x4*)(MIX + row * DM + 8 * lane) = w;
        }
        __syncthreads();
    }
}

constexpr int AT_KLD = 272, AT_VLD = 336, AT_OLD = 1040;
constexpr int AT_K = 0, AT_V = AT_K + 160 * AT_KLD, AT_RED = AT_V + 128 * AT_VLD, AT_END = AT_RED + 1024;
static_assert(32 * AT_OLD <= AT_V && 12288 + AT_END <= 131072, "attention LDS map");
__device__ __forceinline__ void attn_unit(KP p, int b, int qt, LAS unsigned char* lds, int wave, int lane) {
    unsigned char* ws = p->ws;
    const bf16* Q = (const bf16*)(ws + WS_Q); const bf16* KB = (const bf16*)(ws + WS_KB); const bf16* VT = (const bf16*)(ws + WS_VT);
    bf16* MIX = (bf16*)(ws + WS_MIX);
    LAS float* red = (LAS float*)(lds + AT_RED);
    const int r = lane & 31, h = lane >> 5, kvh = wave >> 2, q0 = qt * 32, tid = wave * 64 + lane;
    const size_t rowq = (size_t)b * TSEQ + q0 + r;
    __syncthreads();
    bf16x8 qf[4];
#pragma unroll
    for (int s = 0; s < 4; ++s) qf[s] = *(const bf16x8*)(Q + rowq * 512 + wave * 64 + 16 * s + 8 * h);
    {
        u32x4 kv[5], vv[5];
#pragma unroll
        for (int i = 0; i < 5; ++i) { const int id = tid + 512 * i, row = id >> 4, c16 = id & 15; int g = q0 - 128 + row; g = g < 0 ? 0 : g;
            kv[i] = *(const u32x4*)(KB + ((size_t)b * TSEQ + g) * 128 + c16 * 8); }
#pragma unroll
        for (int i = 0; i < 5; ++i) { const int id = tid + 512 * i, row = id / 20, cc = id % 20; int k0 = q0 - 128 + 8 * cc; k0 = k0 < 0 ? 0 : k0;
            vv[i] = *(const u32x4*)(VT + ((size_t)b * 128 + row) * TSEQ + k0); }
#pragma unroll
        for (int i = 0; i < 5; ++i) { const int id = tid + 512 * i, row = id >> 4, c16 = id & 15; *(LAS u32x4*)(lds + AT_K + row * AT_KLD + c16 * 16) = kv[i]; }
#pragma unroll
        for (int i = 0; i < 5; ++i) { const int id = tid + 512 * i, row = id / 20, cc = id % 20; *(LAS u32x4*)(lds + AT_V + row * AT_VLD + cc * 16) = vv[i]; }
    }
    __syncthreads();
    const int pr = (r & ~12) | ((r & 4) << 1) | ((r & 8) >> 1);
    f32x16 S[5];
#pragma unroll
    for (int kt = 0; kt < 5; ++kt) {
#pragma unroll
        for (int i = 0; i < 16; ++i) S[kt][i] = 0.f;
#pragma unroll
        for (int s = 0; s < 4; ++s) {
            const bf16x8 kf = *(const LAS bf16x8*)(lds + AT_K + (32 * kt + pr) * AT_KLD + kvh * 128 + (16 * s + 8 * h) * 2);
            S[kt] = MFMA32(kf, qf[s], S[kt]);
        }
    }
    const float sink = p->in[I_SINK][wave];
    float m = sink;
#pragma unroll
    for (int kt = 0; kt < 5; ++kt) {
        const int kbase = q0 - 128 + 32 * kt;
#pragma unroll
        for (int i = 0; i < 16; ++i) {
            const int kl = 16 * (i >> 3) + 8 * h + (i & 7);
            bool valid = kbase >= 0;
            if (kt == 0) valid = valid && (kl >= r);
            if (kt == 4) valid = valid && (kl <= r);
            const float sv = valid ? S[kt][i] : -INFINITY;
            S[kt][i] = sv; m = fmaxf(m, sv);
        }
    }
    m = fmaxf(m, shx(m, 32, lane));
    float l = 0.f;
#pragma unroll
    for (int kt = 0; kt < 5; ++kt)
#pragma unroll
        for (int i = 0; i < 16; ++i) { const float pv = fexp(S[kt][i] - m); S[kt][i] = pv; l += pv; }
    l += shx(l, 32, lane);
    const float inv = frcp(l + fexp(sink - m));
    f32x16 O[2];
#pragma unroll
    for (int dt = 0; dt < 2; ++dt)
#pragma unroll
        for (int i = 0; i < 16; ++i) O[dt][i] = 0.f;
#pragma unroll
    for (int kt = 0; kt < 5; ++kt) {
#pragma unroll
        for (int s2 = 0; s2 < 2; ++s2) {
            u32x4 pk; pk.x = pk2(S[kt][8 * s2 + 0], S[kt][8 * s2 + 1]); pk.y = pk2(S[kt][8 * s2 + 2], S[kt][8 * s2 + 3]);
            pk.z = pk2(S[kt][8 * s2 + 4], S[kt][8 * s2 + 5]); pk.w = pk2(S[kt][8 * s2 + 6], S[kt][8 * s2 + 7]);
            const bf16x8 pb = __builtin_bit_cast(bf16x8, pk);
#pragma unroll
            for (int dt = 0; dt < 2; ++dt) {
                const bf16x8 vf = *(const LAS bf16x8*)(lds + AT_V + (kvh * 64 + 32 * dt + r) * AT_VLD + (32 * kt + 16 * s2 + 8 * h) * 2);
                O[dt] = MFMA32(vf, pb, O[dt]);
            }
        }
    }
    float ss = 0.f;
#pragma unroll
    for (int dt = 0; dt < 2; ++dt)
#pragma unroll
        for (int i = 0; i < 16; ++i) { O[dt][i] *= inv; ss += O[dt][i] * O[dt][i]; }
    ss += shx(ss, 32, lane);
    if (h == 0) red[wave * 32 + r] = ss;
    __syncthreads();
    float tot = 0.f;
#pragma unroll
    for (int w = 0; w < 8; ++w) tot += red[w * 32 + r];
    const float rn = frsq(tot * (1.0f / DATT) + EPS);
#pragma unroll
    for (int dt = 0; dt < 2; ++dt)
#pragma unroll
        for (int g4 = 0; g4 < 4; ++g4) {
            const int d = 32 * dt + 8 * g4 + 4 * h;
            const f32x4 gg = *(const f32x4*)(p->in[I_ANG] + wave * 64 + d);
            u32x2 w; w.x = pk2(O[dt][4 * g4 + 0] * rn * gg[0], O[dt][4 * g4 + 1] * rn * gg[1]); w.y = pk2(O[dt][4 * g4 + 2] * rn * gg[2], O[dt][4 * g4 + 3] * rn * gg[3]);
            *(LAS u32x2*)(lds + AT_K + r * AT_OLD + (wave * 64 + d) * 2) = w;
        }
    __syncthreads();
#pragma unroll
    for (int i = 0; i < 4; ++i) { const int id = tid + 512 * i, row = id >> 6, cc = id & 63;
        *(u32x4*)(MIX + ((size_t)b * TSEQ + q0 + row) * DM + 512 + cc * 8) = *(const LAS u32x4*)(lds + AT_K + row * AT_OLD + cc * 16); }
    __syncthreads();
}

__device__ __forceinline__ void sample_unit(KP p, int b, LAS unsigned char* lds, int tid, int wave, int lane) {
    unsigned char* ws = p->ws;
    const size_t row = (size_t)MP + b;
    bf16* MIX = (bf16*)(ws + WS_MIX);
    LAS float* xs = (LAS float*)(lds + 12288);
    LAS float* redw = (LAS float*)(lds + 12288 + 2048);
    LAS float* qs = (LAS float*)(lds + 12288 + 4096);
    LAS float* ps = (LAS float*)(lds + 12288 + 8192);
    __syncthreads();
    {
        const int c = tid;
        const float* sc = p->in[I_SCONV] + (size_t)b * 1536;
        const float* cwg = p->in[I_CONVW];
        const float xr = p->out[OFF_SCONV + (size_t)(b * 3 + 2) * 512 + c];
        const float xc = p->in[I_CONVB][c] + sc[c] * cwg[c] + sc[512 + c] * cwg[512 + c] + sc[1024 + c] * cwg[1024 + c] + xr * cwg[1536 + c];
        xs[c] = xc;
        __syncthreads();
        const int n = c >> 6, jj = c & 63;
        const float* wa = p->in[I_GAW] + n * 4096 + jj; const float* wx = p->in[I_GXW] + n * 4096 + jj;
        float ya = p->in[I_GAB][c], yx = p->in[I_GXB][c];
#pragma unroll
        for (int hb = 0; hb < 2; ++hb) {
            float wa_[32], wx_[32];
#pragma unroll
            for (int i = 0; i < 32; ++i) { wa_[i] = wa[(hb * 32 + i) * 64]; wx_[i] = wx[(hb * 32 + i) * 64]; }
#pragma unroll
            for (int i = 0; i < 32; ++i) { const float xv = xs[64 * n + hb * 32 + i]; ya += xv * wa_[i]; yx += xv * wx_[i]; }
        }
        const float ra = sigmoidf_(ya), ix = sigmoidf_(yx);
        const float la = -8.0f * ra * log1pf(__expf(-p->in[I_LAM][c]));
        const float a = __expf(la);
        const float u = fsqrt(fmaxf(1.0f - a * a, 0.f)) * ix * xc;
        const float hn = a * p->in[I_SH][(size_t)b * 512 + c] + u;
        p->out[OFF_SH + (size_t)b * 512 + c] = hn;
        const float gr = bf1(((const bf16*)(ws + WS_GR))[row * 512 + c]);
        const float rec = hn * gelu_tanh(gr);
        const float ssw = wave_sum(rec * rec, lane);
        if (lane == 0) redw[wave] = ssw;
        __syncthreads();
        float tot = 0.f;
#pragma unroll
        for (int w = 0; w < 8; ++w) tot += redw[w];
        const float rn = frsq(tot * (1.0f / DREC) + EPS);
        { const float mv = rec * rn * p->in[I_RNG][c], mo = shx(mv, 1, lane);
          if ((lane & 1) == 0) __hip_atomic_store((unsigned*)(MIX + row * DM + c), pk2(mv, mo), __ATOMIC_RELAXED, __HIP_MEMORY_SCOPE_AGENT); }
    }
    {
        const int kvh = wave >> 2;
        const float qd = bf1(((const bf16*)(ws + WS_Q))[row * 512 + wave * 64 + lane]);
        qs[wave * 64 + lane] = qd;
        const float* kself = p->out + OFF_SK + (size_t)(b * 128 + 127) * 128 + kvh * 64;
        const float* vself = p->out + OFF_SV + (size_t)(b * 128 + 127) * 128 + kvh * 64;
        const float sself = wave_sum(qd * kself[lane], lane);
        asm volatile("s_waitcnt lgkmcnt(0)" ::: "memory");
        const float* kc = p->in[I_CK] + (size_t)b * 16384 + kvh * 64;
        float s0 = 0.f, s1 = 0.f;
        const f32x4* k0 = (const f32x4*)(kc + (size_t)lane * 128);
        const f32x4* k1 = (const f32x4*)(kc + (size_t)(lane + 64) * 128);
        const LAS f32x4* q4 = (const LAS f32x4*)(qs + wave * 64);
        {
            f32x4 ka[16], kb2[16];
#pragma unroll
            for (int i = 0; i < 16; ++i) { ka[i] = k0[i]; kb2[i] = k1[i]; }
#pragma unroll
            for (int i = 0; i < 16; ++i) { const f32x4 qq = q4[i], a0 = ka[i], a1 = kb2[i];
                s0 += (qq[0] * a0[0] + qq[1] * a0[1]) + (qq[2] * a0[2] + qq[3] * a0[3]);
                s1 += (qq[0] * a1[0] + qq[1] * a1[1]) + (qq[2] * a1[2] + qq[3] * a1[3]); }
        }
        const float sink = p->in[I_SINK][wave];
        const float m = fmaxf(fmaxf(wave_max(fmaxf(s0, s1), lane), sself), sink);
        const float p0 = __expf(s0 - m), p1 = __expf(s1 - m), pself = __expf(sself - m);
        const float den = wave_sum(p0 + p1, lane) + pself + __expf(sink - m);
        ps[wave * 128 + lane] = p0; ps[wave * 128 + 64 + lane] = p1;
        asm volatile("s_waitcnt lgkmcnt(0)" ::: "memory");
        const int kg = lane >> 4, d4 = lane & 15;
        const float* vc = p->in[I_CV] + (size_t)b * 16384 + kvh * 64 + 4 * d4;
        f32x4 o4 = {0.f, 0.f, 0.f, 0.f};
#pragma unroll
        for (int hb = 0; hb < 2; ++hb) {
            f32x4 vv[16];
#pragma unroll
            for (int i = 0; i < 16; ++i) vv[i] = *(const f32x4*)(vc + (size_t)(kg + 4 * (hb * 16 + i)) * 128);
#pragma unroll
            for (int i = 0; i < 16; ++i) o4 = o4 + vv[i] * ps[wave * 128 + kg + 4 * (hb * 16 + i)];
        }
#pragma unroll
        for (int e = 0; e < 4; ++e) { o4[e] += shx(o4[e], 16, lane); o4[e] += shx(o4[e], 32, lane); }
        o4 = (o4 + *(const f32x4*)(vself + 4 * d4) * pself) * (1.0f / den);
        const float ssw = wave_sum((o4[0] * o4[0] + o4[1] * o4[1]) + (o4[2] * o4[2] + o4[3] * o4[3]), lane) * 0.25f;
        if (lane == 0) redw[8 + wave] = ssw;
        __syncthreads();
        float tot = 0.f;
#pragma unroll
        for (int w = 0; w < 8; ++w) tot += redw[8 + w];
        const float rn = frsq(tot * (1.0f / DATT) + EPS);
        if (kg == 0) { const f32x4 gg = *(const f32x4*)(p->in[I_ANG] + wave * 64 + 4 * d4);
            u32x2 w; w.x = pk2(o4[0] * rn * gg[0], o4[1] * rn * gg[1]); w.y = pk2(o4[2] * rn * gg[2], o4[3] * rn * gg[3]);
            unsigned* mp = (unsigned*)(MIX + row * DM + 512 + wave * 64 + 4 * d4);
            __hip_atomic_store(mp, w.x, __ATOMIC_RELAXED, __HIP_MEMORY_SCOPE_AGENT); __hip_atomic_store(mp + 1, w.y, __ATOMIC_RELAXED, __HIP_MEMORY_SCOPE_AGENT); }
    }
    __syncthreads();
}


template <int MODE>
__device__ __forceinline__ void small_gemm_task(KP p, const bf16* __restrict__ A, const bf16* __restrict__ Bt, int K, int n0, LAS unsigned char* lds, int wave, int lane) {
    const int r = lane & 31, h = lane >> 5, mt = wave & 3, kh = wave >> 2, Kh = K >> 1;
    const bf16* ap = A + (size_t)(32 * mt + r) * K + kh * Kh + 64 * h;
    const bf16* bp = Bt + (size_t)(n0 + r) * K + kh * Kh + 64 * h;
    f32x16 acc;
#pragma unroll
    for (int i = 0; i < 16; ++i) acc[i] = 0.f;
    bf16x8 a[8], b[8], an[8], bn[8];
#pragma unroll
    for (int i = 0; i < 8; ++i) { a[i] = *(const bf16x8*)(ap + 8 * i); b[i] = *(const bf16x8*)(bp + 8 * i); }
    for (int k = 0; k < Kh; k += 128) {
        const int kn = (k + 128 < Kh) ? k + 128 : k;
#pragma unroll
        for (int i = 0; i < 8; ++i) { an[i] = *(const bf16x8*)(ap + kn + 8 * i); bn[i] = *(const bf16x8*)(bp + kn + 8 * i); }
#pragma unroll
        for (int i = 0; i < 8; ++i) acc = MFMA32(a[i], b[i], acc);
#pragma unroll
        for (int i = 0; i < 8; ++i) { a[i] = an[i]; b[i] = bn[i]; }
    }
    LAS float* red = (LAS float*)lds;
    __syncthreads();
    if (kh == 1) {
#pragma unroll
        for (int i = 0; i < 16; ++i) red[(mt * 16 + i) * 64 + lane] = acc[i];
    }
    __syncthreads();
    if (kh == 0) {
        float* H = p->out; const int c = n0 + r;
#pragma unroll
        for (int i = 0; i < 16; ++i) {
            const int rs = 32 * mt + (i & 3) + 8 * (i >> 2) + 4 * h;
            float v = acc[i] + red[(mt * 16 + i) * 64 + lane];
            float* hp = H + (size_t)(MP + rs) * DM + c;
            if (MODE == 0) {
                v += p->in[I_XS][(size_t)rs * DM + c];
                *hp = v;
                ((bf16*)(p->ws + WS_HB))[(size_t)(MP + rs) * DM + c] = (bf16)(pk2(v, 0.f) & 0xffff);
                float s = v * v;
                s += shx(s, 1, lane); s += shx(s, 2, lane); s += shx(s, 4, lane); s += shx(s, 8, lane); s += shx(s, 16, lane);
                if (r == 0) atomicAdd((float*)(p->ws + WS_RSQH) + MP + rs, s);
            } else {
                wt4f(hp, *hp + v);
            }
        }
    }
    __syncthreads();
}

#define XB_TMO      128
#define XB_XCNT(j)  (256  + 64 * (j))
#define XB_XSUB(j)  (1280 + 64 * (j))
#define XB_XGEN(j)  (2304 + 64 * (j))
#define XB_TOP      3328
#define XB_TOPGEN   3392
#define XCD_BAR_WORDS 3456
#define XB_SPIN_CAP (1u << 18)

__device__ __forceinline__ unsigned xb_ld(unsigned* p)              { return __hip_atomic_load(p, __ATOMIC_RELAXED, __HIP_MEMORY_SCOPE_AGENT); }
__device__ __forceinline__ unsigned xb_add(unsigned* p, unsigned v) { return __hip_atomic_fetch_add(p, v, __ATOMIC_RELAXED, __HIP_MEMORY_SCOPE_AGENT); }
__device__ __forceinline__ unsigned xb_xcc_id() { return (unsigned)__builtin_amdgcn_s_getreg((3 << 11) | 20) & 0xFu; }
#define XB_SPIN(cond, bar) do { unsigned _sp = 0; while (cond) { __builtin_amdgcn_s_sleep(1); \
    if ((++_sp & 255u) == 0u) { if (xb_ld(&(bar)[XB_TMO])) break; if (_sp > XB_SPIN_CAP) { atomicAdd(&(bar)[XB_TMO], 1u); break; } } } } while (0)

struct XcdBarrier {
    unsigned* bar; unsigned x;
    volatile LAS unsigned* st;
};

__device__ __forceinline__ XcdBarrier xcd_barrier_post(unsigned* bar, volatile LAS unsigned* st) {
    XcdBarrier b; b.bar = bar; b.x = xb_xcc_id(); b.st = st;
    if (threadIdx.x == 0) (void)xb_add(&bar[XB_XCNT(b.x)], 1u);
    return b;
}
__device__ __forceinline__ void xcd_barrier_complete(unsigned* bar, unsigned x, unsigned& nloc, unsigned& nx) {
    const unsigned G = gridDim.x * gridDim.y * gridDim.z;
    unsigned sum, cnt, mine, sp = 0u;
    for (;;) {
        sum = 0u; cnt = 0u; mine = 0u;
#pragma unroll
        for (unsigned j = 0; j < 16; ++j) { const unsigned c = xb_ld(&bar[XB_XCNT(j)]); sum += c; cnt += (c > 0u) ? 1u : 0u; mine = (j == x) ? c : mine; }
        if (sum == G) break;
        __builtin_amdgcn_s_sleep(1);
        if ((++sp & 255u) == 0u) { if (xb_ld(&bar[XB_TMO])) break; if (sp > XB_SPIN_CAP) { atomicAdd(&bar[XB_TMO], 1u); break; } }
    }
    nloc = mine > 0u ? mine : 1u; nx = cnt > 0u ? cnt : 1u;
}

__device__ __forceinline__ void xcd_barrier(const XcdBarrier& b) {
    asm volatile("s_waitcnt vmcnt(0)" ::: "memory");
    __syncthreads();
    if (threadIdx.x == 0) {
        unsigned* bar = b.bar;
        __builtin_amdgcn_s_waitcnt(0);
        unsigned nloc = b.st[0], nx = b.st[1];
        if (nloc == 0u) { xcd_barrier_complete(bar, b.x, nloc, nx); b.st[0] = nloc; b.st[1] = nx; }
        const unsigned old = xb_add(&bar[XB_XSUB(b.x)], 1u);
        const unsigned gen = old / nloc;
        if (old + 1u == (gen + 1u) * nloc) {
            __builtin_amdgcn_fence(__ATOMIC_RELEASE, "agent");
            asm volatile("s_waitcnt vmcnt(0)" ::: "memory");
            const unsigned og = xb_add(&bar[XB_TOP], 1u);
            const unsigned tg = og / nx;
            if (og + 1u == (tg + 1u) * nx) xb_add(&bar[XB_TOPGEN], 1u);
            else XB_SPIN(xb_ld(&bar[XB_TOPGEN]) == tg, bar);
            __builtin_amdgcn_fence(__ATOMIC_ACQUIRE, "agent");
            xb_add(&bar[XB_XGEN(b.x)], 1u);
            asm volatile("s_waitcnt vmcnt(0)" ::: "memory");
        } else {
            XB_SPIN(xb_ld(&bar[XB_XGEN(b.x)]) == gen, bar);
            __builtin_amdgcn_fence(__ATOMIC_ACQUIRE, "agent");
            asm volatile("s_waitcnt vmcnt(0)" ::: "memory");
        }
    }
    __syncthreads();
}

#ifndef REP_P0
#define REP_P0 1
#endif
#ifndef REP_P1
#define REP_P1 1
#endif
#ifndef REP_P4
#define REP_P4 1
#endif
#ifndef REP_SYNC
#define REP_SYNC 0
#endif
#ifndef PROBE_P3
#define PROBE_P3 0
#endif
#ifndef PROBE_P5
#define PROBE_P5 0
#endif
#ifndef PROBE_P6
#define PROBE_P6 0
#endif
#ifndef STAMP_A
#define STAMP_A -1
#define STAMP_B -1
#endif
#ifndef STAMP_MULT
#define STAMP_MULT 4
#endif
#ifndef REP_ALL
#define REP_ALL 1
#endif
#ifndef REP_P2
#define REP_P2 1
#endif
#ifndef REP_P2B
#define REP_P2B 1
#endif
__device__ __forceinline__ void fwd_body(LAS unsigned char* lds, const XcdBarrier& bar);
__global__ void __launch_bounds__(NTHR, 2) fwd_megakernel(Params p_unused) {
    extern __shared__ __attribute__((aligned(16))) unsigned char lds_[];
    cg::grid_group grid = cg::this_grid();
    LAS unsigned char* lds = (LAS unsigned char*)lds_;
    if (threadIdx.x < 2) ((LAS unsigned*)(lds + 131072))[threadIdx.x] = 0u;
    __syncthreads();
    XcdBarrier bar;
    { KP p = kargs(); unsigned char* ws = p->ws;
      if (ws == nullptr) grid.sync();
      bar = xcd_barrier_post((unsigned*)(ws + WS_BAR), (volatile LAS unsigned*)(lds + 131072)); }
#define GRID_SYNC() xcd_barrier(bar)
    fwd_body(lds, bar);
#if REP_ALL > 1
    GRID_SYNC();
    fwd_body(lds, bar);
#endif
}
__device__ __forceinline__ void fwd_body(LAS unsigned char* lds, const XcdBarrier& bar) {
    const int G = gridDim.x, bx = blockIdx.x;
#define STAMP(i) do { if (STAMP_A >= 0 && blockIdx.x == 0 && threadIdx.x == 0) ((LAS unsigned long long*)(lds + 131072 + 64))[i] = __builtin_amdgcn_s_memrealtime(); } while (0)
    STAMP(0);
#define PHASE_IDS int tid_ = threadIdx.x; asm volatile("" : "+v"(tid_)); const int tid = tid_, lane = tid & 63, wave = __builtin_amdgcn_readfirstlane(tid >> 6); (void)tid; (void)lane; (void)wave;

    for (int rep = 0; rep < REP_P0; ++rep) { PHASE_IDS KP p = kargs(); p0_prologue(p, lds, bx * NWAVES + wave, G * NWAVES, wave, lane); }
    GRID_SYNC();
    STAMP(1);

    for (int rep = 0; rep < REP_SYNC; ++rep) GRID_SYNC();
    for (int rep = 0; rep < REP_P1; ++rep) {
        KP p = kargs(); unsigned char* ws = p->ws;
        pg8::Gemm g{(const bf16*)(ws + WS_XN), (const bf16*)(ws + WS_WIN), MPAD, DIN, DM}; pg8::StaticOrder S; S.init(MPAD, DIN, G, bx);
        EpiIn E{ws, p->out};
        pg8::gemm_phase<EpiIn, pg8::StaticOrder, true, true>(lds, g, S, E);
        { PHASE_IDS int slot, ns; slack_slot((MPAD / 256) * (DIN / 256), G, bx, slot, ns);
          if (slot >= 0) convert_items(p, lds, CI_G, CI_WU, slot * NWAVES + wave, ns * NWAVES, wave, lane); }
    }
    GRID_SYNC();
    STAMP(2);

    {
        PHASE_IDS KP p = kargs();
        for (int i = tid; i < 2560; i += NTHR) ((LAS float*)lds)[i] = i < 2048 ? p->in[I_CONVW][i] : p->in[I_CONVB][i - 2048];
        __syncthreads();
        unsigned* cw = (unsigned*)(p->ws + WS_BAR);
        for (int u = bx; u < 1184; u += G) {
            int tl_ = threadIdx.x; asm volatile("" : "+v"(tl_)); const int tid = tl_, lane = tl_ & 63;
            if (u < 128) { sample_unit(p, u, lds, tid, wave, lane); asm volatile("s_waitcnt vmcnt(0)" ::: "memory"); __syncthreads(); if (tid == 0) atomicAdd(cw + CW_S1, 1u); }
            else if (u < 384) { const int k = u - 128; scan_unit<false>(p, k >> 5, k & 31, lds, wave, lane); asm volatile("s_waitcnt vmcnt(0)" ::: "memory"); __syncthreads(); if (tid == 0) atomicAdd(cw + CW_SCAN + 64 * (k >> 5), 1u); }
            else if (u < 896) { const int a = u - 384; attn_unit(p, a >> 6, a & 63, lds + 12288, wave, lane); }
            else if (u < 1152) { const int k = u - 896;
                if (tid == 0) { unsigned sp = 0; while (__hip_atomic_load(cw + CW_SCAN + 64 * (k >> 5), __ATOMIC_RELAXED, __HIP_MEMORY_SCOPE_AGENT) < 32u) { __builtin_amdgcn_s_sleep(4); if (++sp > (1u << 22)) break; } }
                __syncthreads(); __builtin_amdgcn_fence(__ATOMIC_ACQUIRE, "agent");
                scan_unit<true>(p, k >> 5, k & 31, lds, wave, lane); }
            else {
                if (tid == 0) { unsigned sp = 0; while (__hip_atomic_load(cw + CW_S1, __ATOMIC_RELAXED, __HIP_MEMORY_SCOPE_AGENT) < 128u) { __builtin_amdgcn_s_sleep(4); if (++sp > (1u << 22)) break; } }
                __syncthreads(); __builtin_amdgcn_fence(__ATOMIC_ACQUIRE, "agent");
                small_gemm_task<0>(p, (const bf16*)(p->ws + WS_MIX) + (size_t)MP * DM, (const bf16*)(p->ws + WS_WOUT), DM, 32 * (u - 1152), lds, wave, lane);
            }
        }
    }
    GRID_SYNC();
    STAMP(4);

    {
        KP p = kargs(); unsigned char* ws = p->ws;
        pg8::Gemm g{(const bf16*)(ws + WS_MIX), (const bf16*)(ws + WS_WOUT), MP, DM, DM}; pg8::StaticOrder S; S.init(MP, DM, G, bx);
        if (PROBE_P3) { EpiOut E0{p->in[I_XP], p->in[I_XS], (float*)(ws + 92 * MiB), ws + 128 * MiB}; pg8::gemm_phase<EpiOut, pg8::StaticOrder, true, true>(lds, g, S, E0); }
        EpiOut E{p->in[I_XP], p->in[I_XS], p->out, ws};
        pg8::gemm_phase<EpiOut, pg8::StaticOrder, true, true>(lds, g, S, E);
    }
    GRID_SYNC();
    STAMP(5);

    {
        KP p = kargs(); unsigned char* ws = p->ws;
        unsigned* cnt2 = (unsigned*)(ws + WS_BAR) + CW_S2;
        pg8::Gemm g{(const bf16*)(ws + WS_HB), (const bf16*)(ws + WS_WGU), MPAD, 2 * DFF, DM}; pg8::StaticOrder S; S.init(MP, 2 * DFF, G, bx);
        S.nfirst = 2 * DFF / 256; S.first_pm = MP / 256; S.sig_pm = MP / 256; S.cnt = cnt2;
        EpiGU E{ws};
        pg8::gemm_phase<EpiGU, pg8::StaticOrder, true, true>(lds, g, S, E);
        { PHASE_IDS int slot, ns; slack_slot((MPAD / 256) * (2 * DFF / 256), G, bx, slot, ns);
          if (slot >= 0) {
              const bool split = ns >= 64;
              if (!split || slot >= 32) { const int s2 = split ? slot - 32 : slot, n2 = split ? ns - 32 : ns; copy_windows(p, (s2 * NWAVES + wave) * 64 + lane, n2 * NWAVES * 64); }
              if (!split || slot < 32) {
                  int ndone = 0;
                  if (tid == 0) { unsigned sp = 0; while (__hip_atomic_load(cnt2, __ATOMIC_RELAXED, __HIP_MEMORY_SCOPE_AGENT) < 8u * (2 * DFF / 256)) { __builtin_amdgcn_s_sleep(4); if (++sp > (1u << 22)) break; } }
                  __syncthreads(); __builtin_amdgcn_fence(__ATOMIC_ACQUIRE, "agent");
                  for (int u = slot; u < 32; u += (split ? 32 : ns)) { small_gemm_task<1>(p, (const bf16*)(ws + WS_FF) + (size_t)MP * DFF, (const bf16*)(ws + WS_WD), DFF, 32 * u, lds, wave, lane); ++ndone; }
                  if (ndone) {
                      asm volatile("s_waitcnt vmcnt(0)" ::: "memory"); __syncthreads();
                      LAS unsigned* flag = (LAS unsigned*)(lds + 8192);
                      if (tid == 0) { const unsigned old = atomicAdd((unsigned*)(ws + WS_BAR) + CW_SAMPLE, (unsigned)ndone); *flag = (old + (unsigned)ndone == 32u) ? 1u : 0u; }
                      __syncthreads();
                      if (*flag) {
                          __builtin_amdgcn_fence(__ATOMIC_ACQUIRE, "agent");
                          const f32x4* g4 = (const f32x4*)p->in[I_FNG] + lane;
                          f32x4 gq[4];
#pragma unroll
                          for (int j = 0; j < 4; ++j) gq[j] = g4[64 * j];
                          for (int m0 = MP + wave; m0 < MR; m0 += 4 * NWAVES) {
                              f32x4 v[4][4];
#pragma unroll
                              for (int q = 0; q < 4; ++q) { const f32x4* yr = (const f32x4*)(p->out + (size_t)(m0 + q * NWAVES) * DM) + lane;
#pragma unroll
                                  for (int j = 0; j < 4; ++j) v[q][j] = yr[64 * j]; }
#pragma unroll
                              for (int q = 0; q < 4; ++q) { float s = 0.f;
#pragma unroll
                                  for (int j = 0; j < 4; ++j) s += (v[q][j].x * v[q][j].x + v[q][j].y * v[q][j].y) + (v[q][j].z * v[q][j].z + v[q][j].w * v[q][j].w);
                                  const float rs = frsq(wave_sum(s, lane) * (1.f / DM) + EPS);
                                  f32x4* yw = (f32x4*)(p->out + (size_t)(m0 + q * NWAVES) * DM) + lane;
#pragma unroll
                                  for (int j = 0; j < 4; ++j) yw[64 * j] = v[q][j] * rs * gq[j]; }
                          }
                      }
                  }
              }
          }
        }
    }
    GRID_SYNC();
    STAMP(6);

    {
        KP p = kargs(); unsigned char* ws = p->ws;
        pg8::Gemm g{(const bf16*)(ws + WS_FF), (const bf16*)(ws + WS_WD), MP, DM, DFF}; pg8::StaticOrder S; S.init(MP, DM, G, bx);
        EpiDownFused E{ws, p->out, p->in[I_FNG]};
        pg8::gemm_phase<EpiDownFused, pg8::StaticOrder, false, true>(lds, g, S, E);
    }
    STAMP(7);
    STAMP(8);
    if (STAMP_A >= 0 && blockIdx.x == 0 && threadIdx.x == 0) {
        const LAS unsigned long long* ts = (const LAS unsigned long long*)(lds + 131072 + 64);
        const unsigned long long d = (ts[STAMP_B < 0 ? 0 : STAMP_B] - ts[STAMP_A < 0 ? 0 : STAMP_A]) * STAMP_MULT, t0 = __builtin_amdgcn_s_memrealtime();
        while (__builtin_amdgcn_s_memrealtime() - t0 < d) __builtin_amdgcn_s_sleep(16);
    }
}

extern "C" void kernel_launch(void* const* d_in, const int* in_sizes, int n_in, void* d_out, int out_size, void* d_ws, size_t ws_size, hipStream_t stream) {
    static int grid = 0;
    if (grid == 0) {
        int dev = 0, cus = 0, per_cu = 0;
        hipGetDevice(&dev);
        hipDeviceGetAttribute(&cus, hipDeviceAttributeMultiprocessorCount, dev);
        hipFuncSetAttribute((const void*)fwd_megakernel, hipFuncAttributeMaxDynamicSharedMemorySize, LDS_BYTES);
        hipOccupancyMaxActiveBlocksPerMultiprocessor(&per_cu, (const void*)fwd_megakernel, NTHR, LDS_BYTES);
        if (per_cu < 1) { fprintf(stderr, "kernel_launch: occupancy query says %d blocks/CU\n", per_cu); per_cu = 1; }
        (void)hipGetLastError();
        grid = cus;
        if (n_in != 24 || ws_size < WS_END || (size_t)out_size != OUT_END) fprintf(stderr, "kernel_launch: unexpected sizes n_in %d ws %zu out %d\n", n_in, ws_size, out_size);
    }
    hipMemsetAsync((unsigned char*)d_ws + WS_BAR, 0, BAR_BYTES, stream);
    Params p{};
    for (int i = 0; i < 24; ++i) p.in[i] = (const float*)d_in[i];
    p.out = (float*)d_out; p.ws = (unsigned char*)d_ws;
    void* args[] = {&p};
    hipError_t e = hipLaunchCooperativeKernel((const void*)fwd_megakernel, dim3(grid), dim3(NTHR), args, LDS_BYTES, stream);
    if (e != hipSuccess) fprintf(stderr, "cooperative launch failed: %s (grid %d)\n", hipGetErrorString(e), grid);
}
```

```cpp
#include <hip/hip_runtime.h>
#include <hip/hip_cooperative_groups.h>
#include <cstdio>
#include <cstdint>
namespace cg = cooperative_groups;
namespace pg8 {
#define PG8_LAS __attribute__((address_space(3)))
typedef unsigned short bf16_t;
typedef short bf16x8 __attribute__((ext_vector_type(8)));
typedef float f32x4 __attribute__((ext_vector_type(4)));
typedef unsigned u32x4 __attribute__((ext_vector_type(4)));
constexpr int BM = 256, BK = 64, HALF = 128, HTB = HALF * BK * 2  , STAGE_BYTES = 8 * HTB, NXCD = 8, WGM = 8;

__host__ __device__ __forceinline__ int lds_byte(int r, int c) { const int st = (r >> 4) * 2 + (c >> 5), rr = r & 15, cc = c & 31, ob = rr * 64 + cc * 2; return st * 1024 + (ob ^ (((ob >> 9) & 1) << 5)); }
__host__ __device__ __forceinline__ void stage_rc(int b, int& R, int& C) { const int st = b / 1024, sb = b % 1024, swz = sb ^ (((sb >> 9) & 1) << 5); R = (st >> 1) * 16 + swz / 64; C = (st & 1) * 32 + (swz % 64) / 2; }
__host__ __device__ __forceinline__ int perm32(int rho) { const int n = rho >> 4, i = rho & 15; return 8 * (i >> 2) + 4 * n + (i & 3); }

struct Unit { int pm, pn; };
struct Gemm { const bf16_t* A; const bf16_t* Bt; int M, N, K; };

struct StaticOrder {
    int nM, nN, nwg, G, c;
    __host__ __device__ void init(int M, int N, int G_, int c_) { nM = M / BM; nN = N / BM; nwg = nM * nN; G = G_; c = c_; }
    __host__ __device__ bool next(int i, Unit& u) const {
        const long L = (long)i * G + c; if (L >= nwg) return false;
        int wgid = (int)L; { const int q = nwg / NXCD, r = nwg % NXCD, xcd = wgid % NXCD, off = wgid / NXCD; wgid = (xcd < r ? xcd * (q + 1) : r * (q + 1) + (xcd - r) * q) + off; }
        const int nig = WGM * nN, gid = wgid / nig, fm = gid * WGM, gsz = (nM - fm) < WGM ? (nM - fm) : WGM;
        u.pm = fm + ((wgid % nig) % gsz); u.pn = (wgid % nig) / gsz; return true;
    }
    __device__ __forceinline__ void a_ready(const Unit&) const {}
    __device__ __forceinline__ void done(const Unit&) const {}
};

template <class Epi, class Sched, bool ALIGN_EPI = false, bool SP2 = false>
__device__ __forceinline__ void gemm_phase(PG8_LAS unsigned char* lds, const Gemm g, const Sched& S, const Epi& E) {
    int tid_ = threadIdx.x; asm volatile("" : "+v"(tid_));
    const int tid = tid_, wid = __builtin_amdgcn_readfirstlane(tid >> 6), lane = tid & 63, wr = wid >> 2, wc = wid & 3, fr = lane & 15, fq = lane >> 4;
    const int K = g.K, nt = K / BK;
    unsigned voffA[2], voffB[2];
#pragma unroll
    for (int i = 0; i < 2; ++i) { int R, C; stage_rc(tid * 16 + i * 8192, R, C); const int Rb = Epi::PERM ? ((R & ~31) + perm32(R & 31)) : R;
        voffA[i] = (unsigned)(R * K + C) * 2u; voffB[i] = (unsigned)(Rb * K + C) * 2u; }
    const size_t kstep = (size_t)(BK * 2);
    const size_t hstep = (size_t)HALF * K * 2;
    const size_t tstep = 2 * hstep;
    const unsigned ldsw = (unsigned)wid * 1024u;
    const int aoff = lds_byte(wr * 64 + fr, fq * 8), boff = lds_byte(wc * 32 + fr, fq * 8);
#define PG8_SA(b, h) (((b) * 2 + (h)) * HTB)
#define PG8_SB(b, h) ((4 + (b) * 2 + (h)) * HTB)
#define PG8_STAGE(bufoff, gbase, voff) do { _Pragma("unroll") for (int _i = 0; _i < 2; ++_i) \
        __builtin_amdgcn_global_load_lds((const unsigned*)((const char*)(gbase) + (voff)[_i]), (PG8_LAS unsigned*)(lds + (bufoff) + ldsw + _i * 8192), 16, 0, 0); } while (0)
#define PG8_LDA(dst, b, h) do { _Pragma("unroll") for (int m = 0; m < 4; ++m) _Pragma("unroll") for (int k = 0; k < 2; ++k) dst[m][k] = *(const PG8_LAS bf16x8*)(lds + PG8_SA(b, h) + aoff + m * 2048 + k * 1024); } while (0)
#define PG8_LDB(dst, b, h) do { _Pragma("unroll") for (int n = 0; n < 2; ++n) _Pragma("unroll") for (int k = 0; k < 2; ++k) dst[n][k] = *(const PG8_LAS bf16x8*)(lds + PG8_SB(b, h) + boff + n * 2048 + k * 1024); } while (0)
#define PG8_MMA(ai, bj, At, Bt) do { __builtin_amdgcn_s_setprio(1); _Pragma("unroll") for (int m = 0; m < 4; ++m) _Pragma("unroll") for (int n = 0; n < 2; ++n) _Pragma("unroll") for (int k = 0; k < 2; ++k) \
        acc[ai][bj][m][n] = __builtin_amdgcn_mfma_f32_16x16x32_bf16(Bt[n][k], At[m][k], acc[ai][bj][m][n], 0, 0, 0); __builtin_amdgcn_s_setprio(0); } while (0)
#define PG8_WAIT_V(n) asm volatile("s_waitcnt vmcnt(" #n ")" ::: "memory")
#define PG8_WAIT_L(n) asm volatile("s_waitcnt lgkmcnt(" #n ")" ::: "memory")
#define PG8_BAR __builtin_amdgcn_s_barrier()
#define PG8_SCHED __builtin_amdgcn_sched_barrier(0)
    Unit cur, nxt; int ui = 0;
    if (!S.next(0, cur)) return;
    f32x4 acc[2][2][4][2];
#pragma unroll
    for (int a = 0; a < 2; ++a)
#pragma unroll
        for (int b = 0; b < 2; ++b)
#pragma unroll
            for (int m = 0; m < 4; ++m)
#pragma unroll
                for (int n = 0; n < 2; ++n) acc[a][b][m][n] = (f32x4){0.f, 0.f, 0.f, 0.f};
    bf16x8 At[4][2], B0[2][2], B1[2][2];
    const char* cA = (const char*)g.A + (size_t)cur.pm * tstep; const char* cB = (const char*)g.Bt + (size_t)cur.pn * tstep;
    S.a_ready(cur);
    if constexpr (SP2) {
        PG8_STAGE(PG8_SB(0, 0), cB, voffB); PG8_STAGE(PG8_SB(0, 1), cB + hstep, voffB); PG8_STAGE(PG8_SA(0, 0), cA, voffA); PG8_STAGE(PG8_SA(0, 1), cA + hstep, voffA);
        if (wr == 1) PG8_BAR;
        PG8_WAIT_V(2); PG8_BAR;
        PG8_STAGE(PG8_SB(1, 0), cB + kstep, voffB); PG8_STAGE(PG8_SA(1, 0), cA + kstep, voffA); PG8_STAGE(PG8_SB(1, 1), cB + hstep + kstep, voffB);
        PG8_WAIT_V(6); PG8_BAR;
    } else {
        PG8_STAGE(PG8_SB(0, 0), cB, voffB); PG8_STAGE(PG8_SA(0, 0), cA, voffA); PG8_STAGE(PG8_SB(0, 1), cB + hstep, voffB); PG8_STAGE(PG8_SA(0, 1), cA + hstep, voffA);
        if (wr == 1) PG8_BAR;
        PG8_WAIT_V(4); PG8_BAR;
        PG8_STAGE(PG8_SB(1, 0), cB + kstep, voffB); PG8_STAGE(PG8_SA(1, 0), cA + kstep, voffA); PG8_STAGE(PG8_SB(1, 1), cB + hstep + kstep, voffB);
        PG8_WAIT_V(6); PG8_BAR;
    }
    for (;;) {
        const bool has_next = S.next(ui + 1, nxt);
        const char* nA = has_next ? (const char*)g.A + (size_t)nxt.pm * tstep : cA; const char* nB = has_next ? (const char*)g.Bt + (size_t)nxt.pn * tstep : cB;
        for (int t = 0; t < nt; t += 2) {
            const bool last = (t == nt - 2);
            const char* a1 = cA + (size_t)(t + 1) * kstep;
            const char* a2 = last ? nA : cA + (size_t)(t + 2) * kstep; const char* b2 = last ? nB : cB + (size_t)(t + 2) * kstep;
            const char* a3 = a2 + kstep; const char* b3 = b2 + kstep;
            if (last && has_next) S.a_ready(nxt);
            if constexpr (SP2) {
            PG8_LDB(B0, 0, 0); PG8_LDB(B1, 0, 1); PG8_SCHED; PG8_LDA(At, 0, 0); PG8_STAGE(PG8_SA(1, 1), a1 + hstep, voffA);
            PG8_WAIT_V(8); PG8_WAIT_L(0); PG8_BAR; PG8_MMA(0, 0, At, B0); PG8_MMA(0, 1, At, B1); PG8_BAR; PG8_SCHED;
            PG8_LDA(At, 0, 1); PG8_STAGE(PG8_SB(0, 0), b2, voffB); PG8_STAGE(PG8_SB(0, 1), b2 + hstep, voffB); PG8_STAGE(PG8_SA(0, 0), a2, voffA);
            PG8_WAIT_V(8); PG8_WAIT_L(0); PG8_BAR; PG8_MMA(1, 0, At, B0); PG8_MMA(1, 1, At, B1); PG8_BAR; PG8_SCHED;
            PG8_LDB(B0, 1, 0); PG8_LDB(B1, 1, 1); PG8_SCHED; PG8_LDA(At, 1, 0); PG8_STAGE(PG8_SA(0, 1), a2 + hstep, voffA);
            PG8_WAIT_V(8); PG8_WAIT_L(0); PG8_BAR; PG8_MMA(0, 0, At, B0); PG8_MMA(0, 1, At, B1); PG8_BAR; PG8_SCHED;
            PG8_LDA(At, 1, 1); PG8_STAGE(PG8_SB(1, 0), b3, voffB); PG8_STAGE(PG8_SB(1, 1), b3 + hstep, voffB); PG8_STAGE(PG8_SA(1, 0), a3, voffA);
            PG8_WAIT_V(8); PG8_WAIT_L(0); PG8_BAR; PG8_MMA(1, 0, At, B0); PG8_MMA(1, 1, At, B1); PG8_BAR; PG8_SCHED;
            } else {
            PG8_LDB(B0, 0, 0); PG8_SCHED; PG8_LDA(At, 0, 0); PG8_STAGE(PG8_SA(1, 1), a1 + hstep, voffA);
            PG8_WAIT_L(8); PG8_BAR; PG8_WAIT_L(0); PG8_MMA(0, 0, At, B0); PG8_BAR; PG8_SCHED;
            PG8_LDB(B1, 0, 1); PG8_STAGE(PG8_SB(0, 0), b2, voffB);
            PG8_BAR; PG8_WAIT_L(0); PG8_MMA(0, 1, At, B1); PG8_BAR;
            PG8_LDA(At, 0, 1); PG8_STAGE(PG8_SA(0, 0), a2, voffA);
            PG8_BAR; PG8_WAIT_L(0); PG8_MMA(1, 0, At, B0); PG8_BAR; PG8_SCHED;
            PG8_STAGE(PG8_SB(0, 1), b2 + hstep, voffB);
            PG8_WAIT_V(6); PG8_BAR; PG8_MMA(1, 1, At, B1); PG8_BAR;
            PG8_LDB(B0, 1, 0); PG8_SCHED; PG8_LDA(At, 1, 0); PG8_STAGE(PG8_SA(0, 1), a2 + hstep, voffA);
            PG8_WAIT_L(8); PG8_BAR; PG8_WAIT_L(0); PG8_MMA(0, 0, At, B0); PG8_BAR; PG8_SCHED;
            PG8_LDB(B1, 1, 1); PG8_STAGE(PG8_SB(1, 0), b3, voffB);
            PG8_BAR; PG8_WAIT_L(0); PG8_MMA(0, 1, At, B1); PG8_BAR;
            PG8_LDA(At, 1, 1); PG8_STAGE(PG8_SA(1, 0), a3, voffA);
            PG8_BAR; PG8_WAIT_L(0); PG8_MMA(1, 0, At, B0); PG8_BAR; PG8_SCHED;
            PG8_STAGE(PG8_SB(1, 1), b3 + hstep, voffB);
            PG8_WAIT_V(6); PG8_BAR; PG8_MMA(1, 1, At, B1); PG8_BAR;
            }
        }
        if constexpr (ALIGN_EPI) { if (wr == 0) PG8_BAR; }
        if constexpr (!Epi::AFTER_DRAIN) { E(acc, cur, wr, wc, fr, fq); S.done(cur); }
        if (!has_next) break;
#pragma unroll
        for (int a = 0; a < 2; ++a)
#pragma unroll
            for (int b = 0; b < 2; ++b)
#pragma unroll
                for (int m = 0; m < 4; ++m)
#pragma unroll
                    for (int n = 0; n < 2; ++n) acc[a][b][m][n] = (f32x4){0.f, 0.f, 0.f, 0.f};
        cur = nxt; cA = nA; cB = nB; ++ui;
        if constexpr (ALIGN_EPI) { if (wr == 1) PG8_BAR; }
    }
    PG8_WAIT_V(0);
    if constexpr (!ALIGN_EPI) { if (wr == 0) PG8_BAR; }
    PG8_BAR;
    if constexpr (Epi::AFTER_DRAIN) { E.fused(acc, cur, wr, wc, fr, fq, lds, wid, lane); S.done(cur); }
#undef PG8_SA
#undef PG8_SB
#undef PG8_STAGE
#undef PG8_LDA
#undef PG8_LDB
#undef PG8_MMA
#undef PG8_WAIT_V
#undef PG8_WAIT_L
#undef PG8_BAR
#undef PG8_SCHED
}
}

#define LAS __attribute__((address_space(3)))
typedef unsigned short bf16;
typedef short bf16x8 __attribute__((ext_vector_type(8)));
typedef float f32x4 __attribute__((ext_vector_type(4)));
typedef float f32x16 __attribute__((ext_vector_type(16)));
typedef unsigned u32x4 __attribute__((ext_vector_type(4)));
typedef unsigned u32x2 __attribute__((ext_vector_type(2)));
typedef float f32x2_t __attribute__((ext_vector_type(2)));
typedef __bf16 bf16x2_t __attribute__((ext_vector_type(2)));

constexpr int DM = 1024, TSEQ = 2048, NB = 8, MP = NB * TSEQ  , NS = 128  , MR = MP + NS  , MPAD = 16640  ;
constexpr int DREC = 512, DATT = 512, DKV = 128, DFF = 2816, DIN = 1792;
constexpr float EPS = 1e-6f;
constexpr int NWAVES = 8, NTHR = 512;
constexpr size_t OFF_Y = 0, OFF_PK = (size_t)MR * DM, OFF_PV = OFF_PK + 131072, OFF_PCONV = OFF_PV + 131072, OFF_PH = OFF_PCONV + 12288,
                 OFF_SK = OFF_PH + 4096, OFF_SV = OFF_SK + 2097152, OFF_SCONV = OFF_SV + 2097152, OFF_SH = OFF_SCONV + 196608, OUT_END = OFF_SH + 65536;
constexpr size_t MiB = 1u << 20;
constexpr size_t WS_BAR = 512 * 1024, BAR_BYTES = 40960;
constexpr size_t WS_RSQH = 0, WS_SUMA = 1 * MiB, WS_SUMH = 1 * MiB + 512 * 1024;
constexpr size_t WS_WIN = 2 * MiB, WS_WOUT = 6 * MiB, WS_WGU = 8 * MiB, WS_WD = 19 * MiB, WS_GWT = 25 * MiB;
constexpr size_t WS_MIX = 26 * MiB, WS_HB = 59 * MiB, WS_FF = 92 * MiB;
constexpr size_t WS_XN = 92 * MiB, WS_XR = 125 * MiB, WS_GR = 142 * MiB, WS_Q = 159 * MiB, WS_KB = 176 * MiB, WS_VT = 181 * MiB, WS_END = 250 * MiB;
static_assert(WS_MIX + (size_t)MPAD * DM * 2 <= WS_HB && WS_HB + (size_t)MPAD * DM * 2 <= WS_FF && WS_FF + (size_t)MPAD * DFF * 2 <= WS_END, "ws map");
static_assert(WS_GR - WS_XR == WS_Q - WS_GR, "xr/gr/q equally spaced");
static_assert(WS_XN + (size_t)MPAD * DM * 2 <= WS_XR && WS_XR + (size_t)MPAD * 512 * 2 <= WS_GR && WS_GR + (size_t)MPAD * 512 * 2 <= WS_Q && WS_Q + (size_t)MPAD * 512 * 2 <= WS_KB && WS_KB + (size_t)MPAD * 128 * 2 <= WS_VT, "ws map 2");
constexpr int LDS_BYTES = 132096;

struct Params {
    const float* in[24];
    float* out; unsigned char* ws;
};
typedef const __attribute__((address_space(4))) Params* KP;
__device__ __forceinline__ KP kargs() { KP q = (KP)__builtin_amdgcn_kernarg_segment_ptr(); asm volatile("" : "+s"(q)); return q; }
enum { I_XP = 0, I_XS, I_CK, I_CV, I_SCONV, I_SH, I_N1G, I_WIN, I_CONVW, I_CONVB, I_GAW, I_GAB, I_GXW, I_GXB, I_LAM, I_SINK, I_RNG, I_ANG, I_WOUT, I_N2G, I_WG, I_WU, I_WD, I_FNG };

__device__ __forceinline__ unsigned pk2(float lo, float hi) { f32x2_t v = {lo, hi}; bf16x2_t b = __builtin_convertvector(v, bf16x2_t); return __builtin_bit_cast(unsigned, b); }
__device__ __forceinline__ float bflo(unsigned w) { return __uint_as_float(w << 16); }
__device__ __forceinline__ float bfhi(unsigned w) { return __uint_as_float(w & 0xffff0000u); }
__device__ __forceinline__ float bf1(bf16 u) { return __uint_as_float((unsigned)u << 16); }
__device__ __forceinline__ float shx(float v, int o, int lane) { return __int_as_float(__builtin_amdgcn_ds_bpermute((lane ^ o) << 2, __float_as_int(v))); }
__device__ __forceinline__ float shl(float v, int src) { return __int_as_float(__builtin_amdgcn_ds_bpermute(src << 2, __float_as_int(v))); }
__device__ __forceinline__ float wave_sum(float v, int lane) {
#pragma unroll
    for (int o = 1; o < 64; o <<= 1) v += shx(v, o, lane);
    return v;
}
__device__ __forceinline__ float wave_max(float v, int lane) {
#pragma unroll
    for (int o = 1; o < 64; o <<= 1) v = fmaxf(v, shx(v, o, lane));
    return v;
}
__device__ __forceinline__ float frcp(float x) { return __builtin_amdgcn_rcpf(x); }
__device__ __forceinline__ float fsqrt(float x) { return __builtin_amdgcn_sqrtf(x); }
__device__ __forceinline__ float frsq(float x) { return __builtin_amdgcn_rsqf(x); }
__device__ __forceinline__ float fexp(float x) { return __builtin_amdgcn_exp2f(x * 1.4426950408889634f); }
__device__ __forceinline__ float sigmoidf_(float x) { return frcp(1.0f + fexp(-x)); }
__device__ __forceinline__ float gelu_tanh(float x) { const float z = 0.7978845608028654f * (x + 0.044715f * x * x * x); const float e = fexp(2.0f * z); return x * (1.0f - frcp(e + 1.0f)); }

using pg8::Unit;
struct EpiIn {
    static constexpr bool PERM = true, AFTER_DRAIN = false;
    unsigned char* ws; float* out;
    __device__ __forceinline__ void operator()(const f32x4 (&acc)[2][2][4][2], const Unit& u, int wr, int wc, int fr, int fq) const {
        const int pn = u.pn;
        bf16* const KB = (bf16*)(ws + WS_KB); bf16* const VT = (bf16*)(ws + WS_VT);
#pragma unroll
        for (int ai = 0; ai < 2; ++ai)
#pragma unroll
            for (int m = 0; m < 4; ++m) {
                const int row = u.pm * 256 + ai * 128 + wr * 64 + m * 16 + fr;
                const bool isp = row < MP, iss = (row >= MP) && (row < MR);
                const int b = isp ? (row >> 11) : (row - MP), t = row & (TSEQ - 1);
#pragma unroll
                for (int bj = 0; bj < 2; ++bj) {
                    const int c = bj * 128 + wc * 32 + 8 * fq;
                    f32x4 v0 = acc[ai][bj][m][0], v1 = acc[ai][bj][m][1];
                    if (pn < 6) {
                        bf16* dst = (bf16*)(ws + WS_XR + (size_t)(pn >> 1) * (WS_GR - WS_XR));
                        const int col = (pn & 1) * 256 + c;
                        if (pn >= 4) { v0 = v0 * 0.125f; v1 = v1 * 0.125f; }
                        u32x4 w; w.x = pk2(v0[0], v0[1]); w.y = pk2(v0[2], v0[3]); w.z = pk2(v1[0], v1[1]); w.w = pk2(v1[2], v1[3]);
                        *(u32x4*)(dst + (size_t)row * 512 + col) = w;
                        if (pn < 2) {
                            float* o = nullptr;
                            if (isp && t >= TSEQ - 3) o = out + OFF_PCONV + (size_t)(b * 3 + (t - (TSEQ - 3))) * 512 + col;
                            if (iss) o = out + OFF_SCONV + (size_t)(b * 3 + 2) * 512 + col;
                            if (o) { *(f32x4*)o = v0; *(f32x4*)(o + 4) = v1; }
                        }
                    } else {
                        const int cc = wc * 32 + 8 * fq;
                        if (bj == 0) {
                            u32x4 w; w.x = pk2(v0[0], v0[1]); w.y = pk2(v0[2], v0[3]); w.z = pk2(v1[0], v1[1]); w.w = pk2(v1[2], v1[3]);
                            *(u32x4*)(KB + (size_t)row * 128 + cc) = w;
                        } else if (isp) {
                            const int kvh = cc >> 6, d0 = cc & 63;
                            bf16* vt = VT + ((size_t)(b * 2 + kvh) * 64 + d0) * TSEQ + t;
                            const unsigned w0 = pk2(v0[0], v0[1]), w1 = pk2(v0[2], v0[3]), w2 = pk2(v1[0], v1[1]), w3 = pk2(v1[2], v1[3]);
                            vt[0 * TSEQ] = (bf16)(w0 & 0xffff); vt[1 * TSEQ] = (bf16)(w0 >> 16); vt[2 * TSEQ] = (bf16)(w1 & 0xffff); vt[3 * TSEQ] = (bf16)(w1 >> 16);
                            vt[4 * TSEQ] = (bf16)(w2 & 0xffff); vt[5 * TSEQ] = (bf16)(w2 >> 16); vt[6 * TSEQ] = (bf16)(w3 & 0xffff); vt[7 * TSEQ] = (bf16)(w3 >> 16);
                        }
                        float* o = nullptr;
                        if (isp && t >= TSEQ - 128) o = out + (bj == 0 ? OFF_PK : OFF_PV) + (size_t)(b * 128 + (t - (TSEQ - 128))) * 128 + cc;
                        if (iss) o = out + (bj == 0 ? OFF_SK : OFF_SV) + (size_t)(b * 128 + 127) * 128 + cc;
                        if (o) { *(f32x4*)o = v0; *(f32x4*)(o + 4) = v1; }
                    }
                }
            }
    }
};
struct EpiOut {
    static constexpr bool PERM = false, AFTER_DRAIN = false;
    const float *xp, *xs; float* H; unsigned char* ws;
    __device__ __forceinline__ void operator()(const f32x4 (&acc)[2][2][4][2], const Unit& u, int wr, int wc, int fr, int fq) const {
        const int col0 = u.pn * 256 + wc * 32 + 4 * fq, lane = fr + 16 * fq;
        bf16* const HB = (bf16*)(ws + WS_HB); float* const rsq = (float*)(ws + WS_RSQH);
#pragma unroll
        for (int ai = 0; ai < 2; ++ai)
#pragma unroll
            for (int m = 0; m < 4; ++m) {
                const int row = u.pm * 256 + ai * 128 + wr * 64 + m * 16 + fr;
                const bool real = row < MR;
                const float* xrow = row < MP ? xp + (size_t)row * DM : xs + (size_t)(row - MP) * DM;
                float s = 0.f;
#pragma unroll
                for (int bj = 0; bj < 2; ++bj)
#pragma unroll
                    for (int n = 0; n < 2; ++n) {
                        const int c = col0 + bj * 128 + n * 16;
                        f32x4 v = acc[ai][bj][m][n];
                        if (real) v = v + *(const f32x4*)(xrow + c);
                        s += (v[0] * v[0] + v[1] * v[1]) + (v[2] * v[2] + v[3] * v[3]);
                        u32x2 w; w.x = pk2(v[0], v[1]); w.y = pk2(v[2], v[3]);
                        *(u32x2*)(HB + (size_t)row * DM + c) = w;
                    }
                s += shx(s, 16, lane); s += shx(s, 32, lane);
                if (fq == 0) atomicAdd(rsq + row, s);
            }
    }
};
struct EpiGU {
    static constexpr bool PERM = true, AFTER_DRAIN = false;
    unsigned char* ws;
    __device__ __forceinline__ void operator()(const f32x4 (&acc)[2][2][4][2], const Unit& u, int wr, int wc, int fr, int fq) const {
        const int col = u.pn * 128 + wc * 32 + 8 * fq;
        bf16* const FF = (bf16*)(ws + WS_FF); const float* const rsq = (const float*)(ws + WS_RSQH);
#pragma unroll
        for (int ai = 0; ai < 2; ++ai)
#pragma unroll
            for (int m = 0; m < 4; ++m) {
                const int row = u.pm * 256 + ai * 128 + wr * 64 + m * 16 + fr;
                const float r = frsq(rsq[row] * (1.0f / DM) + EPS);
                float o[8];
#pragma unroll
                for (int n = 0; n < 2; ++n)
#pragma unroll
                    for (int e = 0; e < 4; ++e) { const float g = acc[ai][0][m][n][e] * r, uu = acc[ai][1][m][n][e] * r; o[4 * n + e] = g * sigmoidf_(g) * uu; }
                u32x4 w; w.x = pk2(o[0], o[1]); w.y = pk2(o[2], o[3]); w.z = pk2(o[4], o[5]); w.w = pk2(o[6], o[7]);
                *(u32x4*)(FF + (size_t)row * DFF + col) = w;
            }
    }
};
struct EpiDown {
    static constexpr bool PERM = false, AFTER_DRAIN = false;
    float* H;
    __device__ __forceinline__ void operator()(const f32x4 (&acc)[2][2][4][2], const Unit& u, int wr, int wc, int fr, int fq) const {
        const int col0 = u.pn * 256 + wc * 32 + 4 * fq;
#pragma unroll
        for (int ai = 0; ai < 2; ++ai)
#pragma unroll
            for (int m = 0; m < 4; ++m) {
                const int row = u.pm * 256 + ai * 128 + wr * 64 + m * 16 + fr;
                if (row < MR) {
#pragma unroll
                    for (int bj = 0; bj < 2; ++bj)
#pragma unroll
                        for (int n = 0; n < 2; ++n) {
                            float* pp = H + (size_t)row * DM + col0 + bj * 128 + n * 16;
                            *(f32x4*)pp = *(const f32x4*)pp + acc[ai][bj][m][n];
                        }
                }
            }
    }
};

constexpr size_t WS_XBUF = 768 * 1024;
constexpr int CW_PANEL = 4096, CW_SAMPLE = 8192, CW_S1 = 8192 + 64, CW_SCAN = 8192 + 128;
struct EpiDownFused {
    static constexpr bool PERM = false, AFTER_DRAIN = true;
    unsigned char* ws; float* out; const float* gf;
    __device__ __forceinline__ void operator()(const f32x4 (&)[2][2][4][2], const Unit&, int, int, int, int) const {}
    __device__ __forceinline__ void fused(f32x4 (&acc)[2][2][4][2], const Unit& u, int wr, int wc, int fr, int fq, PG8_LAS unsigned char* lds, int wid, int lane) const {
        LAS float* P = (LAS float*)lds;
        LAS float* Sr = (LAS float*)(lds + 4096);
        const bf16* HB = (const bf16*)(ws + WS_HB);
        float* xbuf = (float*)(ws + WS_XBUF);
        unsigned* cnt = (unsigned*)(ws + WS_BAR) + CW_PANEL + 64 * u.pm;
        const int col0 = u.pn * 256 + wc * 32 + 4 * fq;
#pragma unroll
        for (int ai = 0; ai < 2; ++ai)
#pragma unroll
            for (int m = 0; m < 4; ++m) {
                const int rl = ai * 128 + wr * 64 + m * 16 + fr; const size_t row = (size_t)u.pm * 256 + rl;
                float s = 0.f;
#pragma unroll
                for (int bj = 0; bj < 2; ++bj)
#pragma unroll
                    for (int n = 0; n < 2; ++n) {
                        const u32x2 hb = *(const u32x2*)(HB + row * DM + col0 + bj * 128 + n * 16);
                        f32x4 v = acc[ai][bj][m][n];
                        v[0] += bflo(hb.x); v[1] += bfhi(hb.x); v[2] += bflo(hb.y); v[3] += bfhi(hb.y);
                        acc[ai][bj][m][n] = v;
                        s += (v[0] * v[0] + v[1] * v[1]) + (v[2] * v[2] + v[3] * v[3]);
                    }
                s += shx(s, 16, lane); s += shx(s, 32, lane);
                if (fq == 0) P[rl * 4 + wc] = s;
            }
        asm volatile("s_waitcnt lgkmcnt(0)" ::: "memory"); __builtin_amdgcn_s_barrier(); asm volatile("" ::: "memory");
        const int rr = wid * 32 + (lane & 31);
        if (lane < 32) {
            const float tot = (P[rr * 4 + 0] + P[rr * 4 + 1]) + (P[rr * 4 + 2] + P[rr * 4 + 3]);
            __hip_atomic_store(xbuf + ((size_t)u.pm * 256 + rr) * 4 + u.pn, tot, __ATOMIC_RELAXED, __HIP_MEMORY_SCOPE_AGENT);
        }
        asm volatile("s_waitcnt vmcnt(0)" ::: "memory");
        if (lane == 0) __hip_atomic_fetch_add(cnt, 1u, __ATOMIC_RELAXED, __HIP_MEMORY_SCOPE_AGENT);
        if (wid == 0) {
            unsigned sp = 0;
            while ((unsigned)__builtin_amdgcn_readfirstlane(__hip_atomic_load(cnt, __ATOMIC_RELAXED, __HIP_MEMORY_SCOPE_AGENT)) < 32u) { __builtin_amdgcn_s_sleep(2); if (++sp > (1u << 22)) break; }
            __builtin_amdgcn_fence(__ATOMIC_ACQUIRE, "agent");
        }
        asm volatile("s_waitcnt vmcnt(0) lgkmcnt(0)" ::: "memory"); __builtin_amdgcn_s_barrier(); asm volatile("" ::: "memory");
        if (lane < 32) {
            const float* sl = xbuf + ((size_t)u.pm * 256 + rr) * 4; float t = 0.f;
#pragma unroll
            for (int k = 0; k < 4; ++k) t += __hip_atomic_load(sl + k, __ATOMIC_RELAXED, __HIP_MEMORY_SCOPE_AGENT);
            Sr[rr] = frsq(t * (1.0f / DM) + EPS);
        }
        asm volatile("s_waitcnt vmcnt(0) lgkmcnt(0)" ::: "memory"); __builtin_amdgcn_s_barrier(); asm volatile("" ::: "memory");
        f32x4 gv[2][2];
#pragma unroll
        for (int bj = 0; bj < 2; ++bj)
#pragma unroll
            for (int n = 0; n < 2; ++n) gv[bj][n] = *(const f32x4*)(gf + col0 + bj * 128 + n * 16);
#pragma unroll
        for (int ai = 0; ai < 2; ++ai)
#pragma unroll
            for (int m = 0; m < 4; ++m) {
                const int rl = ai * 128 + wr * 64 + m * 16 + fr; const size_t row = (size_t)u.pm * 256 + rl;
                const float sc = Sr[rl];
#pragma unroll
                for (int bj = 0; bj < 2; ++bj)
#pragma unroll
                    for (int n = 0; n < 2; ++n) *(f32x4*)(out + row * DM + col0 + bj * 128 + n * 16) = acc[ai][bj][m][n] * sc * gv[bj][n];
            }
    }
};

__device__ __forceinline__ void tr_item(const float* __restrict__ W, int N, bf16* WT, int ldt, int k0, int n0, int drow0, const float* __restrict__ kscale, LAS float* scr, int lane) {
    float wv[32];
#pragma unroll
    for (int i = 0; i < 32; ++i) wv[i] = W[(size_t)(k0 + 2 * i + (lane >> 5)) * N + n0 + (lane & 31)];
#pragma unroll
    for (int i = 0; i < 32; ++i) { const int kk = 2 * i + (lane >> 5); float v = wv[i]; if (kscale) v *= kscale[k0 + kk]; scr[kk * 33 + (lane & 31)] = v; }
    asm volatile("s_waitcnt lgkmcnt(0)" ::: "memory");
    const int c = lane & 7;
#pragma unroll
    for (int j = 0; j < 4; ++j) { const int n = (lane >> 3) + 8 * j; const LAS float* s = scr + (8 * c) * 33 + n;
        u32x4 o; o.x = pk2(s[0 * 33], s[1 * 33]); o.y = pk2(s[2 * 33], s[3 * 33]); o.z = pk2(s[4 * 33], s[5 * 33]); o.w = pk2(s[6 * 33], s[7 * 33]);
        *(u32x4*)(WT + (size_t)(drow0 + n) * ldt + k0 + 8 * c) = o; }
    asm volatile("s_waitcnt lgkmcnt(0)" ::: "memory");
}
constexpr int CI_WIN = 16 * 56, CI_G = CI_WIN + 32, CI_WOUT = CI_G + 16 * 32, CI_WU = CI_WOUT + 2 * 16 * 88, CI_WD = CI_WU + 44 * 32;
__device__ __forceinline__ void convert_items(KP p, LAS unsigned char* lds, int lo, int hi, int gw, int NGW, int wave, int lane) {
    unsigned char* ws = p->ws;
    LAS float* scr = (LAS float*)(lds + wave * 16384);
    for (int it = lo + gw; it < hi; it += NGW) {
        const float* W; const float* ks = nullptr; bf16* WT; int N, ldt, k0, n0, drow0; int r = it;
        if (r < CI_WIN) { const int kb = r / 56, nb = r % 56; W = p->in[I_WIN]; N = DIN; WT = (bf16*)(ws + WS_WIN); ldt = DM; k0 = 64 * kb; n0 = 32 * nb; drow0 = n0; }
        else if (r < CI_G) { r -= CI_WIN; const int gx = r >> 4, n = (r & 15) >> 1, nb = r & 1; W = p->in[gx ? I_GXW : I_GAW] + n * 4096; N = 64; WT = (bf16*)(ws + WS_GWT) + gx * 8 * 4096 + n * 4096; ldt = 64; k0 = 0; n0 = 32 * nb; drow0 = n0; }
        else if (r < CI_WOUT) { r -= CI_G; const int kb = r / 32, nb = r % 32; W = p->in[I_WOUT]; N = DM; WT = (bf16*)(ws + WS_WOUT); ldt = DM; k0 = 64 * kb; n0 = 32 * nb; drow0 = n0; }
        else if (r < CI_WU) { r -= CI_WOUT; const int up = r >= 16 * 88 ? 1 : 0; if (up) r -= 16 * 88; const int kb = r / 88, nb = r % 88; W = p->in[up ? I_WU : I_WG]; N = DFF; WT = (bf16*)(ws + WS_WGU); ldt = DM; k0 = 64 * kb; n0 = 32 * nb;
            drow0 = 256 * (n0 >> 7) + 128 * up + (n0 & 127); ks = p->in[I_N2G]; }
        else { r -= CI_WU; const int kb = r / 32, nb = r % 32; W = p->in[I_WD]; N = DM; WT = (bf16*)(ws + WS_WD); ldt = DFF; k0 = 64 * kb; n0 = 32 * nb; drow0 = n0; }
        tr_item(W, N, WT, ldt, k0, n0, drow0, ks, scr, lane);
    }
}
__device__ __forceinline__ void copy_windows(KP p, int gt, int NGT) {
    for (int i = gt; i < NS * 4064; i += NGT) { const int b = i / 4064, o = i % 4064;
        ((f32x4*)(p->out + OFF_SK + (size_t)b * 16384))[o] = ((const f32x4*)(p->in[I_CK] + (size_t)b * 16384 + 128))[o];
        ((f32x4*)(p->out + OFF_SV + (size_t)b * 16384))[o] = ((const f32x4*)(p->in[I_CV] + (size_t)b * 16384 + 128))[o]; }
    for (int i = gt; i < NS * 256; i += NGT) { const int b = i >> 8, o = i & 255;
        ((f32x4*)(p->out + OFF_SCONV + (size_t)b * 1536))[o] = ((const f32x4*)(p->in[I_SCONV] + (size_t)b * 1536 + 512))[o]; }
}
__device__ __forceinline__ void slack_slot(int nwg, int G, int bx, int& slot, int& nslots) {
    const int mx = (nwg + G - 1) / G, first = nwg - (mx - 1) * G;
    if (first >= G) { slot = bx; nslots = G; } else { slot = bx - first; nslots = G - first; }
}
__device__ __forceinline__ void p0_prologue(KP p, LAS unsigned char* lds, int gw, int NGW, int wave, int lane) {
    unsigned char* ws = p->ws;
    convert_items(p, lds, 0, CI_G, gw, NGW, wave, lane);
    {
        const f32x4* g4 = (const f32x4*)p->in[I_N1G] + lane;
        f32x4 g[4];
#pragma unroll
        for (int j = 0; j < 4; ++j) g[j] = g4[64 * j];
        for (int m0 = gw; m0 < MR; m0 += 2 * NGW) {
            f32x4 v[2][4];
#pragma unroll
            for (int rr = 0; rr < 2; ++rr) { const int m = m0 + rr * NGW, mc = m < MR ? m : m0;
                const float* xrow = mc < MP ? p->in[I_XP] + (size_t)mc * DM : p->in[I_XS] + (size_t)(mc - MP) * DM;
                const f32x4* xr = (const f32x4*)xrow + lane;
#pragma unroll
                for (int j = 0; j < 4; ++j) v[rr][j] = xr[64 * j]; }
#pragma unroll
            for (int rr = 0; rr < 2; ++rr) { const int m = m0 + rr * NGW;
                float s = 0.f;
#pragma unroll
                for (int j = 0; j < 4; ++j) s += (v[rr][j].x * v[rr][j].x + v[rr][j].y * v[rr][j].y) + (v[rr][j].z * v[rr][j].z + v[rr][j].w * v[rr][j].w);
                const float rs = frsq(wave_sum(s, lane) * (1.f / DM) + EPS);
                if (m < MR) { u32x2* o8 = (u32x2*)((bf16*)(ws + WS_XN) + (size_t)m * DM) + lane;
#pragma unroll
                    for (int j = 0; j < 4; ++j) { u32x2 w; w.x = pk2(v[rr][j].x * rs * g[j].x, v[rr][j].y * rs * g[j].y); w.y = pk2(v[rr][j].z * rs * g[j].z, v[rr][j].w * rs * g[j].w); o8[64 * j] = w; } }
            }
        }
    }
    const int gt = gw * 64 + lane, NGT = NGW * 64;
    for (int i = gt; i < MPAD; i += NGT) ((float*)(ws + WS_RSQH))[i] = 0.f;
}

__device__ __forceinline__ void row_scan4(float A, float H, float c0, int q, float& cin, float& At, float& Ht) {
    const auto ra = __builtin_amdgcn_permlane16_swap(__float_as_uint(A), __float_as_uint(A), false, false);
    const auto rh = __builtin_amdgcn_permlane16_swap(__float_as_uint(H), __float_as_uint(H), false, false);
    const float Ae = __uint_as_float(ra[0]), Ao = __uint_as_float(ra[1]), He = __uint_as_float(rh[0]), Ho = __uint_as_float(rh[1]);
    const float Ap = Ae * Ao, Hp = Ao * He + Ho;
    const auto pa = __builtin_amdgcn_permlane32_swap(__float_as_uint(Ap), __float_as_uint(Ap), false, false);
    const auto ph = __builtin_amdgcn_permlane32_swap(__float_as_uint(Hp), __float_as_uint(Hp), false, false);
    const float Alo = __uint_as_float(pa[0]), Ahi = __uint_as_float(pa[1]), Hlo = __uint_as_float(ph[0]), Hhi = __uint_as_float(ph[1]);
    const float c2 = Alo * c0 + Hlo, base = (q & 2) ? c2 : c0;
    cin = (q & 1) ? (Ae * base + He) : base;
    At = Alo * Ahi; Ht = Ahi * Hlo + Hhi;
}

constexpr int HS_OFF = 16384, HS_LD = 1032;
#define MFMA16(a, b, c) __builtin_amdgcn_mfma_f32_16x16x32_bf16((a), (b), (c), 0, 0, 0)
#define MFMA32(a, b, c) __builtin_amdgcn_mfma_f32_32x32x16_bf16((a), (b), (c), 0, 0, 0)
typedef float f32x2v __attribute__((ext_vector_type(2)));
constexpr size_t WS_AU = 186 * MiB;
template <bool FINAL>
__device__ __forceinline__ void scan_unit(KP p, int b, int chunk, LAS unsigned char* lds, int wave, int lane) {
    unsigned char* ws = p->ws;
    const bf16* XR = (const bf16*)(ws + WS_XR);
    const bf16* GWT = (const bf16*)(ws + WS_GWT);
    float* SA = (float*)(ws + WS_SUMA); float* SH = (float*)(ws + WS_SUMH);
    f32x2v* AU = (f32x2v*)(ws + WS_AU);
    const LAS float* cw = (const LAS float*)lds;
    const int n = wave, j = lane & 15, q = lane >> 4;
    float hprev[4] = {0.f, 0.f, 0.f, 0.f}, acum[4] = {1.f, 1.f, 1.f, 1.f};
    const size_t au0 = ((size_t)b * TSEQ + chunk * 64 + 4 * q) * 512 + 64 * n + j;
    if constexpr (FINAL) {
        unsigned pfg; { const int t_ = wave * 64 + lane; pfg = *(const unsigned*)((const bf16*)(ws + WS_GR) + ((size_t)b * TSEQ + chunk * 64 + (t_ >> 3)) * 512 + (t_ & 7) * 64); }
        f32x2v au[4][4], aun[4][4];
#define SCAN_LOADAU(dst, sc_) do { _Pragma("unroll") for (int nt = 0; nt < 4; ++nt) _Pragma("unroll") for (int r = 0; r < 4; ++r) dst[nt][r] = AU[au0 + (size_t)((sc_) * 16 + r) * 512 + 16 * nt]; } while (0)
        SCAN_LOADAU(au, 0);
        {
            float As[4] = {1.f, 1.f, 1.f, 1.f}, Hs[4] = {0.f, 0.f, 0.f, 0.f};
            float la[8][4], lh[8][4];
#pragma unroll
            for (int cc = 0; cc < 8; ++cc) { const int c = 8 * q + cc, ce = c < chunk ? c : 0;
#pragma unroll
                for (int nt = 0; nt < 4; ++nt) { const size_t o = (size_t)(b * 32 + ce) * 512 + 64 * n + 16 * nt + j; la[cc][nt] = __hip_atomic_load(SA + o, __ATOMIC_RELAXED, __HIP_MEMORY_SCOPE_AGENT); lh[cc][nt] = __hip_atomic_load(SH + o, __ATOMIC_RELAXED, __HIP_MEMORY_SCOPE_AGENT); } }
#pragma unroll
            for (int cc = 0; cc < 8; ++cc) { const bool ok = (8 * q + cc) < chunk;
#pragma unroll
                for (int nt = 0; nt < 4; ++nt) { const float a = ok ? la[cc][nt] : 1.f, hh = ok ? lh[cc][nt] : 0.f; Hs[nt] = a * Hs[nt] + hh; As[nt] *= a; } }
#pragma unroll
            for (int nt = 0; nt < 4; ++nt) { float cin_, At_, Ht_; row_scan4(As[nt], Hs[nt], 0.f, q, cin_, At_, Ht_); hprev[nt] = Ht_; }
        }
#pragma unroll
        for (int sc = 0; sc < 4; ++sc) {
            if (sc < 3) SCAN_LOADAU(aun, sc + 1);
#pragma unroll
            for (int nt = 0; nt < 4; ++nt) {
                float a4[4], u4[4];
#pragma unroll
                for (int r = 0; r < 4; ++r) { a4[r] = au[nt][r].x; u4[r] = au[nt][r].y; }
                const float A4 = (a4[0] * a4[1]) * (a4[2] * a4[3]);
                const float H4 = ((u4[0] * a4[1] + u4[1]) * a4[2] + u4[2]) * a4[3] + u4[3];
                float cin, At_, Ht_; row_scan4(A4, H4, hprev[nt], q, cin, At_, Ht_);
                hprev[nt] = At_ * hprev[nt] + Ht_;
                LAS bf16* hs = (LAS bf16*)(lds + HS_OFF + (sc * 16 + 4 * q) * HS_LD) + (64 * n + 16 * nt + j);
                float h = cin;
#pragma unroll
                for (int r = 0; r < 4; ++r) { h = a4[r] * h + u4[r]; hs[r * (HS_LD / 2)] = (bf16)(pk2(h, 0.f) & 0xffff); }
            }
#pragma unroll
            for (int nt = 0; nt < 4; ++nt)
#pragma unroll
                for (int r = 0; r < 4; ++r) au[nt][r] = aun[nt][r];
        }
#undef SCAN_LOADAU
        asm volatile("" :: "v"(pfg));
    } else {
    bf16x8 wf[2][4][2];
#pragma unroll
    for (int g = 0; g < 2; ++g)
#pragma unroll
        for (int nt = 0; nt < 4; ++nt)
#pragma unroll
            for (int s = 0; s < 2; ++s) wf[g][nt][s] = *(const bf16x8*)(GWT + ((size_t)(g * 8 + n) * 64 + 16 * nt + j) * 64 + 32 * s + 8 * q);
    bf16x8 idf[2];
#pragma unroll
    for (int e = 0; e < 2; ++e)
#pragma unroll
        for (int jj = 0; jj < 8; ++jj) idf[e][jj] = (16 * e + j - 8 * q == jj) ? (short)0x3F80 : (short)0;
    float ba[4], bx[4], sp[4];
#pragma unroll
    for (int nt = 0; nt < 4; ++nt) { const int ch = 64 * n + 16 * nt + j; ba[nt] = p->in[I_GAB][ch]; bx[nt] = p->in[I_GXB][ch]; sp[nt] = 8.0f * log1pf(__expf(-p->in[I_LAM][ch])) * 1.4426950408889634f; }
#define SCAN_LOADX(dst, sc_) do { const int tok_ = chunk * 64 + (sc_) * 16 + j; \
        _Pragma("unroll") for (int s = 0; s < 2; ++s) _Pragma("unroll") for (int w = 0; w < 4; ++w) { \
            const int tt = tok_ - 3 + w, ttc = tt < 0 ? 0 : tt; \
            u32x4 x = *(const u32x4*)(XR + (size_t)(b * TSEQ + ttc) * 512 + 64 * n + 32 * s + 8 * q); \
            if (tt < 0) x = (u32x4){0u, 0u, 0u, 0u}; dst[s][w] = x; } } while (0)
    u32x4 xcur[2][4], xnext[2][4];
    SCAN_LOADX(xcur, 0);
#pragma unroll
    for (int sc = 0; sc < 4; ++sc) {
        if (sc < 3) SCAN_LOADX(xnext, sc + 1);
        bf16x8 af[2];
#pragma unroll
        for (int s = 0; s < 2; ++s) {
            const int ch0 = 64 * n + 32 * s + 8 * q;
            float a8[8];
            { const f32x4 c0 = *(const LAS f32x4*)(cw + 2048 + ch0), c1 = *(const LAS f32x4*)(cw + 2048 + ch0 + 4);
              a8[0] = c0[0]; a8[1] = c0[1]; a8[2] = c0[2]; a8[3] = c0[3]; a8[4] = c1[0]; a8[5] = c1[1]; a8[6] = c1[2]; a8[7] = c1[3]; }
#pragma unroll
            for (int w = 0; w < 4; ++w) {
                const u32x4 x = xcur[s][w];
                const f32x4 w0 = *(const LAS f32x4*)(cw + w * 512 + ch0), w1 = *(const LAS f32x4*)(cw + w * 512 + ch0 + 4);
                a8[0] += w0[0] * bflo(x.x); a8[1] += w0[1] * bfhi(x.x); a8[2] += w0[2] * bflo(x.y); a8[3] += w0[3] * bfhi(x.y);
                a8[4] += w1[0] * bflo(x.z); a8[5] += w1[1] * bfhi(x.z); a8[6] += w1[2] * bflo(x.w); a8[7] += w1[3] * bfhi(x.w);
            }
            u32x4 pk; pk.x = pk2(a8[0], a8[1]); pk.y = pk2(a8[2], a8[3]); pk.z = pk2(a8[4], a8[5]); pk.w = pk2(a8[6], a8[7]);
            af[s] = __builtin_bit_cast(bf16x8, pk);
        }
#pragma unroll
        for (int nt = 0; nt < 4; ++nt) {
            f32x4 da = {0.f, 0.f, 0.f, 0.f}, dx = {0.f, 0.f, 0.f, 0.f}, xc = {0.f, 0.f, 0.f, 0.f};
            da = MFMA16(af[0], wf[0][nt][0], da); da = MFMA16(af[1], wf[0][nt][1], da);
            dx = MFMA16(af[0], wf[1][nt][0], dx); dx = MFMA16(af[1], wf[1][nt][1], dx);
            xc = MFMA16(af[nt >> 1], idf[nt & 1], xc);
            float a4[4], u4[4];
#pragma unroll
            for (int r = 0; r < 4; ++r) {
                const float ra = sigmoidf_(da[r] + ba[nt]), ix = sigmoidf_(dx[r] + bx[nt]);
                const float a = __builtin_amdgcn_exp2f(-ra * sp[nt]);
                a4[r] = a; u4[r] = fsqrt(fmaxf(1.0f - a * a, 0.f)) * ix * xc[r];
                AU[au0 + (size_t)(sc * 16 + r) * 512 + 16 * nt] = (f32x2v){a4[r], u4[r]};
            }
            const float A4 = (a4[0] * a4[1]) * (a4[2] * a4[3]);
            const float H4 = ((u4[0] * a4[1] + u4[1]) * a4[2] + u4[2]) * a4[3] + u4[3];
            float cin_, At_, Ht_; row_scan4(A4, H4, hprev[nt], q, cin_, At_, Ht_);
            hprev[nt] = At_ * hprev[nt] + Ht_; acum[nt] *= At_;
            asm volatile("" : "+v"(hprev[nt]), "+v"(acum[nt]));
        }
#pragma unroll
        for (int s = 0; s < 2; ++s)
#pragma unroll
            for (int w = 0; w < 4; ++w) xcur[s][w] = xnext[s][w];
    }
#undef SCAN_LOADX
    }
    if (!FINAL) {
        if (q == 0) {
#pragma unroll
            for (int nt = 0; nt < 4; ++nt) { const int ch = 64 * n + 16 * nt + j; const size_t o = (size_t)(b * 32 + chunk) * 512 + ch;
                __hip_atomic_store(SA + o, acum[nt], __ATOMIC_RELAXED, __HIP_MEMORY_SCOPE_AGENT); __hip_atomic_store(SH + o, hprev[nt], __ATOMIC_RELAXED, __HIP_MEMORY_SCOPE_AGENT); }
        }
    } else {
        if (chunk == 31 && q == 0) {
#pragma unroll
            for (int nt = 0; nt < 4; ++nt) p->out[OFF_PH + (size_t)b * 512 + 64 * n + 16 * nt + j] = hprev[nt];
        }
        __syncthreads();
        const bf16* GR = (const bf16*)(ws + WS_GR);
        bf16* MIX = (bf16*)(ws + WS_MIX);
        const f32x4 g0 = *(const f32x4*)(p->in[I_RNG] + 8 * lane), g1 = *(const f32x4*)(p->in[I_RNG] + 8 * lane + 4);
        u32x4 grv[8];
#pragma unroll
        for (int tt = 0; tt < 8; ++tt) grv[tt] = *(const u32x4*)(GR + ((size_t)b * TSEQ + chunk * 64 + wave * 8 + tt) * 512 + 8 * lane);
#pragma unroll
        for (int tt = 0; tt < 8; ++tt) {
            const int tl = wave * 8 + tt;
            const size_t row = (size_t)b * TSEQ + chunk * 64 + tl;
            const LAS u32x2* hp = (const LAS u32x2*)(lds + HS_OFF + tl * HS_LD + 16 * lane);
            const u32x2 h0 = hp[0], h1 = hp[1];
            const u32x4 gr = grv[tt];
            float rc[8];
            rc[0] = bflo(h0.x) * gelu_tanh(bflo(gr.x)); rc[1] = bfhi(h0.x) * gelu_tanh(bfhi(gr.x)); rc[2] = bflo(h0.y) * gelu_tanh(bflo(gr.y)); rc[3] = bfhi(h0.y) * gelu_tanh(bfhi(gr.y));
            rc[4] = bflo(h1.x) * gelu_tanh(bflo(gr.z)); rc[5] = bfhi(h1.x) * gelu_tanh(bfhi(gr.z)); rc[6] = bflo(h1.y) * gelu_tanh(bflo(gr.w)); rc[7] = bfhi(h1.y) * gelu_tanh(bfhi(gr.w));
            float ss = 0.f;
#pragma unroll
            for (int e = 0; e < 8; ++e) ss += rc[e] * rc[e];
            const float rn = frsq(wave_sum(ss, lane) * (1.0f / DREC) + EPS);
            u32x4 w; w.x = pk2(rc[0] * rn * g0[0], rc[1] * rn * g0[1]); w.y = pk2(rc[2] * rn * g0[2], rc[3] * rn * g0[3]);
            w.z = pk2(rc[4] * rn * g1[0], rc[5] * rn * g1[1]); w.w = pk2(rc[6] * rn * g1[2], rc[7] * rn * g1[3]);
            *(u32x4*)(MIX + row * DM + 8 * lane) = w;
        }
        __syncthreads();
    }
}

constexpr int AT_KLD = 272, AT_VLD = 336, AT_OLD = 1040;
constexpr int AT_K = 0, AT_V = AT_K + 160 * AT_KLD, AT_RED = AT_V + 128 * AT_VLD, AT_END = AT_RED + 1024;
static_assert(32 * AT_OLD <= AT_V && 12288 + AT_END <= 131072, "attention LDS map");
__device__ __forceinline__ void attn_unit(KP p, int b, int qt, LAS unsigned char* lds, int wave, int lane) {
    unsigned char* ws = p->ws;
    const bf16* Q = (const bf16*)(ws + WS_Q); const bf16* KB = (const bf16*)(ws + WS_KB); const bf16* VT = (const bf16*)(ws + WS_VT);
    bf16* MIX = (bf16*)(ws + WS_MIX);
    LAS float* red = (LAS float*)(lds + AT_RED);
    const int r = lane & 31, h = lane >> 5, kvh = wave >> 2, q0 = qt * 32, tid = wave * 64 + lane;
    const size_t rowq = (size_t)b * TSEQ + q0 + r;
    __syncthreads();
    bf16x8 qf[4];
#pragma unroll
    for (int s = 0; s < 4; ++s) qf[s] = *(const bf16x8*)(Q + rowq * 512 + wave * 64 + 16 * s + 8 * h);
    {
        u32x4 kv[5], vv[5];
#pragma unroll
        for (int i = 0; i < 5; ++i) { const int id = tid + 512 * i, row = id >> 4, c16 = id & 15; int g = q0 - 128 + row; g = g < 0 ? 0 : g;
            kv[i] = *(const u32x4*)(KB + ((size_t)b * TSEQ + g) * 128 + c16 * 8); }
#pragma unroll
        for (int i = 0; i < 5; ++i) { const int id = tid + 512 * i, row = id / 20, cc = id % 20; int k0 = q0 - 128 + 8 * cc; k0 = k0 < 0 ? 0 : k0;
            vv[i] = *(const u32x4*)(VT + ((size_t)b * 128 + row) * TSEQ + k0); }
#pragma unroll
        for (int i = 0; i < 5; ++i) { const int id = tid + 512 * i, row = id >> 4, c16 = id & 15; *(LAS u32x4*)(lds + AT_K + row * AT_KLD + c16 * 16) = kv[i]; }
#pragma unroll
        for (int i = 0; i < 5; ++i) { const int id = tid + 512 * i, row = id / 20, cc = id % 20; *(LAS u32x4*)(lds + AT_V + row * AT_VLD + cc * 16) = vv[i]; }
    }
    __syncthreads();
    const int pr = (r & ~12) | ((r & 4) << 1) | ((r & 8) >> 1);
    f32x16 S[5];
#pragma unroll
    for (int kt = 0; kt < 5; ++kt) {
#pragma unroll
        for (int i = 0; i < 16; ++i) S[kt][i] = 0.f;
#pragma unroll
        for (int s = 0; s < 4; ++s) {
            const bf16x8 kf = *(const LAS bf16x8*)(lds + AT_K + (32 * kt + pr) * AT_KLD + kvh * 128 + (16 * s + 8 * h) * 2);
            S[kt] = MFMA32(kf, qf[s], S[kt]);
        }
    }
    const float sink = p->in[I_SINK][wave];
    float m = sink;
#pragma unroll
    for (int kt = 0; kt < 5; ++kt) {
        const int kbase = q0 - 128 + 32 * kt;
#pragma unroll
        for (int i = 0; i < 16; ++i) {
            const int kl = 16 * (i >> 3) + 8 * h + (i & 7);
            bool valid = kbase >= 0;
            if (kt == 0) valid = valid && (kl >= r);
            if (kt == 4) valid = valid && (kl <= r);
            const float sv = valid ? S[kt][i] : -INFINITY;
            S[kt][i] = sv; m = fmaxf(m, sv);
        }
    }
    m = fmaxf(m, shx(m, 32, lane));
    float l = 0.f;
#pragma unroll
    for (int kt = 0; kt < 5; ++kt)
#pragma unroll
        for (int i = 0; i < 16; ++i) { const float pv = fexp(S[kt][i] - m); S[kt][i] = pv; l += pv; }
    l += shx(l, 32, lane);
    const float inv = frcp(l + fexp(sink - m));
    f32x16 O[2];
#pragma unroll
    for (int dt = 0; dt < 2; ++dt)
#pragma unroll
        for (int i = 0; i < 16; ++i) O[dt][i] = 0.f;
#pragma unroll
    for (int kt = 0; kt < 5; ++kt) {
#pragma unroll
        for (int s2 = 0; s2 < 2; ++s2) {
            u32x4 pk; pk.x = pk2(S[kt][8 * s2 + 0], S[kt][8 * s2 + 1]); pk.y = pk2(S[kt][8 * s2 + 2], S[kt][8 * s2 + 3]);
            pk.z = pk2(S[kt][8 * s2 + 4], S[kt][8 * s2 + 5]); pk.w = pk2(S[kt][8 * s2 + 6], S[kt][8 * s2 + 7]);
            const bf16x8 pb = __builtin_bit_cast(bf16x8, pk);
#pragma unroll
            for (int dt = 0; dt < 2; ++dt) {
                const bf16x8 vf = *(const LAS bf16x8*)(lds + AT_V + (kvh * 64 + 32 * dt + r) * AT_VLD + (32 * kt + 16 * s2 + 8 * h) * 2);
                O[dt] = MFMA32(vf, pb, O[dt]);
            }
        }
    }
    float ss = 0.f;
#pragma unroll
    for (int dt = 0; dt < 2; ++dt)
#pragma unroll
        for (int i = 0; i < 16; ++i) { O[dt][i] *= inv; ss += O[dt][i] * O[dt][i]; }
    ss += shx(ss, 32, lane);
    if (h == 0) red[wave * 32 + r] = ss;
    __syncthreads();
    float tot = 0.f;
#pragma unroll
    for (int w = 0; w < 8; ++w) tot += red[w * 32 + r];
    const float rn = frsq(tot * (1.0f / DATT) + EPS);
#pragma unroll
    for (int dt = 0; dt < 2; ++dt)
#pragma unroll
        for (int g4 = 0; g4 < 4; ++g4) {
            const int d = 32 * dt + 8 * g4 + 4 * h;
            const f32x4 gg = *(const f32x4*)(p->in[I_ANG] + wave * 64 + d);
            u32x2 w; w.x = pk2(O[dt][4 * g4 + 0] * rn * gg[0], O[dt][4 * g4 + 1] * rn * gg[1]); w.y = pk2(O[dt][4 * g4 + 2] * rn * gg[2], O[dt][4 * g4 + 3] * rn * gg[3]);
            *(LAS u32x2*)(lds + AT_K + r * AT_OLD + (wave * 64 + d) * 2) = w;
        }
    __syncthreads();
#pragma unroll
    for (int i = 0; i < 4; ++i) { const int id = tid + 512 * i, row = id >> 6, cc = id & 63;
        *(u32x4*)(MIX + ((size_t)b * TSEQ + q0 + row) * DM + 512 + cc * 8) = *(const LAS u32x4*)(lds + AT_K + row * AT_OLD + cc * 16); }
    __syncthreads();
}

__device__ __forceinline__ void sample_unit(KP p, int b, LAS unsigned char* lds, int tid, int wave, int lane) {
    unsigned char* ws = p->ws;
    const size_t row = (size_t)MP + b;
    bf16* MIX = (bf16*)(ws + WS_MIX);
    LAS float* xs = (LAS float*)(lds + 12288);
    LAS float* redw = (LAS float*)(lds + 12288 + 2048);
    LAS float* qs = (LAS float*)(lds + 12288 + 4096);
    LAS float* ps = (LAS float*)(lds + 12288 + 8192);
    __syncthreads();
    {
        const int c = tid;
        const float* sc = p->in[I_SCONV] + (size_t)b * 1536;
        const float* cwg = p->in[I_CONVW];
        const float xr = p->out[OFF_SCONV + (size_t)(b * 3 + 2) * 512 + c];
        const float xc = p->in[I_CONVB][c] + sc[c] * cwg[c] + sc[512 + c] * cwg[512 + c] + sc[1024 + c] * cwg[1024 + c] + xr * cwg[1536 + c];
        xs[c] = xc;
        __syncthreads();
        const int n = c >> 6, jj = c & 63;
        const float* wa = p->in[I_GAW] + n * 4096 + jj; const float* wx = p->in[I_GXW] + n * 4096 + jj;
        float ya = p->in[I_GAB][c], yx = p->in[I_GXB][c];
#pragma unroll
        for (int hb = 0; hb < 2; ++hb) {
            float wa_[32], wx_[32];
#pragma unroll
            for (int i = 0; i < 32; ++i) { wa_[i] = wa[(hb * 32 + i) * 64]; wx_[i] = wx[(hb * 32 + i) * 64]; }
#pragma unroll
            for (int i = 0; i < 32; ++i) { const float xv = xs[64 * n + hb * 32 + i]; ya += xv * wa_[i]; yx += xv * wx_[i]; }
        }
        const float ra = sigmoidf_(ya), ix = sigmoidf_(yx);
        const float la = -8.0f * ra * log1pf(__expf(-p->in[I_LAM][c]));
        const float a = __expf(la);
        const float u = fsqrt(fmaxf(1.0f - a * a, 0.f)) * ix * xc;
        const float hn = a * p->in[I_SH][(size_t)b * 512 + c] + u;
        p->out[OFF_SH + (size_t)b * 512 + c] = hn;
        const float gr = bf1(((const bf16*)(ws + WS_GR))[row * 512 + c]);
        const float rec = hn * gelu_tanh(gr);
        const float ssw = wave_sum(rec * rec, lane);
        if (lane == 0) redw[wave] = ssw;
        __syncthreads();
        float tot = 0.f;
#pragma unroll
        for (int w = 0; w < 8; ++w) tot += redw[w];
        const float rn = frsq(tot * (1.0f / DREC) + EPS);
        { const float mv = rec * rn * p->in[I_RNG][c], mo = shx(mv, 1, lane);
          if ((lane & 1) == 0) __hip_atomic_store((unsigned*)(MIX + row * DM + c), pk2(mv, mo), __ATOMIC_RELAXED, __HIP_MEMORY_SCOPE_AGENT); }
    }
    {
        const int kvh = wave >> 2;
        const float qd = bf1(((const bf16*)(ws + WS_Q))[row * 512 + wave * 64 + lane]);
        qs[wave * 64 + lane] = qd;
        const float* kself = p->out + OFF_SK + (size_t)(b * 128 + 127) * 128 + kvh * 64;
        const float* vself = p->out + OFF_SV + (size_t)(b * 128 + 127) * 128 + kvh * 64;
        const float sself = wave_sum(qd * kself[lane], lane);
        asm volatile("s_waitcnt lgkmcnt(0)" ::: "memory");
        const float* kc = p->in[I_CK] + (size_t)b * 16384 + kvh * 64;
        float s0 = 0.f, s1 = 0.f;
        const f32x4* k0 = (const f32x4*)(kc + (size_t)lane * 128);
        const f32x4* k1 = (const f32x4*)(kc + (size_t)(lane + 64) * 128);
        const LAS f32x4* q4 = (const LAS f32x4*)(qs + wave * 64);
        {
            f32x4 ka[16], kb2[16];
#pragma unroll
            for (int i = 0; i < 16; ++i) { ka[i] = k0[i]; kb2[i] = k1[i]; }
#pragma unroll
            for (int i = 0; i < 16; ++i) { const f32x4 qq = q4[i], a0 = ka[i], a1 = kb2[i];
                s0 += (qq[0] * a0[0] + qq[1] * a0[1]) + (qq[2] * a0[2] + qq[3] * a0[3]);
                s1 += (qq[0] * a1[0] + qq[1] * a1[1]) + (qq[2] * a1[2] + qq[3] * a1[3]); }
        }
        const float sink = p->in[I_SINK][wave];
        const float m = fmaxf(fmaxf(wave_max(fmaxf(s0, s1), lane), sself), sink);
        const float p0 = __expf(s0 - m), p1 = __expf(s1 - m), pself = __expf(sself - m);
        const float den = wave_sum(p0 + p1, lane) + pself + __expf(sink - m);
        ps[wave * 128 + lane] = p0; ps[wave * 128 + 64 + lane] = p1;
        asm volatile("s_waitcnt lgkmcnt(0)" ::: "memory");
        const int kg = lane >> 4, d4 = lane & 15;
        const float* vc = p->in[I_CV] + (size_t)b * 16384 + kvh * 64 + 4 * d4;
        f32x4 o4 = {0.f, 0.f, 0.f, 0.f};
#pragma unroll
        for (int hb = 0; hb < 2; ++hb) {
            f32x4 vv[16];
#pragma unroll
            for (int i = 0; i < 16; ++i) vv[i] = *(const f32x4*)(vc + (size_t)(kg + 4 * (hb * 16 + i)) * 128);
#pragma unroll
            for (int i = 0; i < 16; ++i) o4 = o4 + vv[i] * ps[wave * 128 + kg + 4 * (hb * 16 + i)];
        }
#pragma unroll
        for (int e = 0; e < 4; ++e) { o4[e] += shx(o4[e], 16, lane); o4[e] += shx(o4[e], 32, lane); }
        o4 = (o4 + *(const f32x4*)(vself + 4 * d4) * pself) * (1.0f / den);
        const float ssw = wave_sum((o4[0] * o4[0] + o4[1] * o4[1]) + (o4[2] * o4[2] + o4[3] * o4[3]), lane) * 0.25f;
        if (lane == 0) redw[8 + wave] = ssw;
        __syncthreads();
        float tot = 0.f;
#pragma unroll
        for (int w = 0; w < 8; ++w) tot += redw[8 + w];
        const float rn = frsq(tot * (1.0f / DATT) + EPS);
        if (kg == 0) { const f32x4 gg = *(const f32x4*)(p->in[I_ANG] + wave * 64 + 4 * d4);
            u32x2 w; w.x = pk2(o4[0] * rn * gg[0], o4[1] * rn * gg[1]); w.y = pk2(o4[2] * rn * gg[2], o4[3] * rn * gg[3]);
            unsigned* mp = (unsigned*)(MIX + row * DM + 512 + wave * 64 + 4 * d4);
            __hip_atomic_store(mp, w.x, __ATOMIC_RELAXED, __HIP_MEMORY_SCOPE_AGENT); __hip_atomic_store(mp + 1, w.y, __ATOMIC_RELAXED, __HIP_MEMORY_SCOPE_AGENT); }
    }
    __syncthreads();
}


template <int MODE>
__device__ __forceinline__ void small_gemm_task(KP p, const bf16* __restrict__ A, const bf16* __restrict__ Bt, int K, int n0, LAS unsigned char* lds, int wave, int lane) {
    const int r = lane & 31, h = lane >> 5, mt = wave & 3, kh = wave >> 2, Kh = K >> 1;
    const bf16* ap = A + (size_t)(32 * mt + r) * K + kh * Kh + 64 * h;
    const bf16* bp = Bt + (size_t)(n0 + r) * K + kh * Kh + 64 * h;
    f32x16 acc;
#pragma unroll
    for (int i = 0; i < 16; ++i) acc[i] = 0.f;
    bf16x8 a[8], b[8], an[8], bn[8];
#pragma unroll
    for (int i = 0; i < 8; ++i) { a[i] = *(const bf16x8*)(ap + 8 * i); b[i] = *(const bf16x8*)(bp + 8 * i); }
    for (int k = 0; k < Kh; k += 128) {
        const int kn = (k + 128 < Kh) ? k + 128 : k;
#pragma unroll
        for (int i = 0; i < 8; ++i) { an[i] = *(const bf16x8*)(ap + kn + 8 * i); bn[i] = *(const bf16x8*)(bp + kn + 8 * i); }
#pragma unroll
        for (int i = 0; i < 8; ++i) acc = MFMA32(a[i], b[i], acc);
#pragma unroll
        for (int i = 0; i < 8; ++i) { a[i] = an[i]; b[i] = bn[i]; }
    }
    LAS float* red = (LAS float*)lds;
    __syncthreads();
    if (kh == 1) {
#pragma unroll
        for (int i = 0; i < 16; ++i) red[(mt * 16 + i) * 64 + lane] = acc[i];
    }
    __syncthreads();
    if (kh == 0) {
        float* H = p->out; const int c = n0 + r;
#pragma unroll
        for (int i = 0; i < 16; ++i) {
            const int rs = 32 * mt + (i & 3) + 8 * (i >> 2) + 4 * h;
            float v = acc[i] + red[(mt * 16 + i) * 64 + lane];
            float* hp = H + (size_t)(MP + rs) * DM + c;
            if (MODE == 0) {
                v += p->in[I_XS][(size_t)rs * DM + c];
                *hp = v;
                ((bf16*)(p->ws + WS_HB))[(size_t)(MP + rs) * DM + c] = (bf16)(pk2(v, 0.f) & 0xffff);
                float s = v * v;
                s += shx(s, 1, lane); s += shx(s, 2, lane); s += shx(s, 4, lane); s += shx(s, 8, lane); s += shx(s, 16, lane);
                if (r == 0) atomicAdd((float*)(p->ws + WS_RSQH) + MP + rs, s);
            } else {
                *hp = *hp + v;
            }
        }
    }
    __syncthreads();
}

#define XB_TMO      128
#define XB_XCNT(j)  (256  + 64 * (j))
#define XB_XSUB(j)  (1280 + 64 * (j))
#define XB_XGEN(j)  (2304 + 64 * (j))
#define XB_TOP      3328
#define XB_TOPGEN   3392
#define XCD_BAR_WORDS 3456
#define XB_SPIN_CAP (1u << 18)

__device__ __forceinline__ unsigned xb_ld(unsigned* p)              { return __hip_atomic_load(p, __ATOMIC_RELAXED, __HIP_MEMORY_SCOPE_AGENT); }
__device__ __forceinline__ unsigned xb_add(unsigned* p, unsigned v) { return __hip_atomic_fetch_add(p, v, __ATOMIC_RELAXED, __HIP_MEMORY_SCOPE_AGENT); }
__device__ __forceinline__ unsigned xb_xcc_id() { return (unsigned)__builtin_amdgcn_s_getreg((3 << 11) | 20) & 0xFu; }
#define XB_SPIN(cond, bar) do { unsigned _sp = 0; while (cond) { __builtin_amdgcn_s_sleep(1); \
    if ((++_sp & 255u) == 0u) { if (xb_ld(&(bar)[XB_TMO])) break; if (_sp > XB_SPIN_CAP) { atomicAdd(&(bar)[XB_TMO], 1u); break; } } } } while (0)

struct XcdBarrier {
    unsigned* bar; unsigned x;
    volatile LAS unsigned* st;
};

__device__ __forceinline__ XcdBarrier xcd_barrier_post(unsigned* bar, volatile LAS unsigned* st) {
    XcdBarrier b; b.bar = bar; b.x = xb_xcc_id(); b.st = st;
    if (threadIdx.x == 0) (void)xb_add(&bar[XB_XCNT(b.x)], 1u);
    return b;
}
__device__ __forceinline__ void xcd_barrier_complete(unsigned* bar, unsigned x, unsigned& nloc, unsigned& nx) {
    const unsigned G = gridDim.x * gridDim.y * gridDim.z;
    unsigned sum, cnt, mine, sp = 0u;
    for (;;) {
        sum = 0u; cnt = 0u; mine = 0u;
#pragma unroll
        for (unsigned j = 0; j < 16; ++j) { const unsigned c = xb_ld(&bar[XB_XCNT(j)]); sum += c; cnt += (c > 0u) ? 1u : 0u; mine = (j == x) ? c : mine; }
        if (sum == G) break;
        __builtin_amdgcn_s_sleep(1);
        if ((++sp & 255u) == 0u) { if (xb_ld(&bar[XB_TMO])) break; if (sp > XB_SPIN_CAP) { atomicAdd(&bar[XB_TMO], 1u); break; } }
    }
    nloc = mine > 0u ? mine : 1u; nx = cnt > 0u ? cnt : 1u;
}

__device__ __forceinline__ void xcd_barrier(const XcdBarrier& b) {
    asm volatile("s_waitcnt vmcnt(0)" ::: "memory");
    __syncthreads();
    if (threadIdx.x == 0) {
        unsigned* bar = b.bar;
        __builtin_amdgcn_s_waitcnt(0);
        unsigned nloc = b.st[0], nx = b.st[1];
        if (nloc == 0u) { xcd_barrier_complete(bar, b.x, nloc, nx); b.st[0] = nloc; b.st[1] = nx; }
        const unsigned old = xb_add(&bar[XB_XSUB(b.x)], 1u);
        const unsigned gen = old / nloc;
        if (old + 1u == (gen + 1u) * nloc) {
            __builtin_amdgcn_fence(__ATOMIC_RELEASE, "agent");
            asm volatile("s_waitcnt vmcnt(0)" ::: "memory");
            const unsigned og = xb_add(&bar[XB_TOP], 1u);
            const unsigned tg = og / nx;
            if (og + 1u == (tg + 1u) * nx) xb_add(&bar[XB_TOPGEN], 1u);
            else XB_SPIN(xb_ld(&bar[XB_TOPGEN]) == tg, bar);
            __builtin_amdgcn_fence(__ATOMIC_ACQUIRE, "agent");
            xb_add(&bar[XB_XGEN(b.x)], 1u);
            asm volatile("s_waitcnt vmcnt(0)" ::: "memory");
        } else {
            XB_SPIN(xb_ld(&bar[XB_XGEN(b.x)]) == gen, bar);
            __builtin_amdgcn_fence(__ATOMIC_ACQUIRE, "agent");
            asm volatile("s_waitcnt vmcnt(0)" ::: "memory");
        }
    }
    __syncthreads();
}

#ifndef REP_P0
#define REP_P0 1
#endif
#ifndef REP_P1
#define REP_P1 1
#endif
#ifndef REP_P4
#define REP_P4 1
#endif
#ifndef REP_SYNC
#define REP_SYNC 0
#endif
#ifndef PROBE_P3
#define PROBE_P3 0
#endif
#ifndef PROBE_P5
#define PROBE_P5 0
#endif
#ifndef PROBE_P6
#define PROBE_P6 0
#endif
#ifndef STAMP_A
#define STAMP_A -1
#define STAMP_B -1
#endif
#ifndef STAMP_MULT
#define STAMP_MULT 4
#endif
#ifndef REP_ALL
#define REP_ALL 1
#endif
#ifndef REP_P2
#define REP_P2 1
#endif
#ifndef REP_P2B
#define REP_P2B 1
#endif
__device__ __forceinline__ void fwd_body(LAS unsigned char* lds, const XcdBarrier& bar);
__global__ void __launch_bounds__(NTHR, 2) fwd_megakernel(Params p_unused) {
    extern __shared__ __attribute__((aligned(16))) unsigned char lds_[];
    cg::grid_group grid = cg::this_grid();
    LAS unsigned char* lds = (LAS unsigned char*)lds_;
    if (threadIdx.x < 2) ((LAS unsigned*)(lds + 131072))[threadIdx.x] = 0u;
    __syncthreads();
    XcdBarrier bar;
    { KP p = kargs(); unsigned char* ws = p->ws;
      if (ws == nullptr) grid.sync();
      bar = xcd_barrier_post((unsigned*)(ws + WS_BAR), (volatile LAS unsigned*)(lds + 131072)); }
#define GRID_SYNC() xcd_barrier(bar)
    fwd_body(lds, bar);
#if REP_ALL > 1
    GRID_SYNC();
    fwd_body(lds, bar);
#endif
}
__device__ __forceinline__ void fwd_body(LAS unsigned char* lds, const XcdBarrier& bar) {
    const int G = gridDim.x, bx = blockIdx.x;
#define STAMP(i) do { if (STAMP_A >= 0 && blockIdx.x == 0 && threadIdx.x == 0) ((LAS unsigned long long*)(lds + 131072 + 64))[i] = __builtin_amdgcn_s_memrealtime(); } while (0)
    STAMP(0);
#define PHASE_IDS int tid_ = threadIdx.x; asm volatile("" : "+v"(tid_)); const int tid = tid_, lane = tid & 63, wave = __builtin_amdgcn_readfirstlane(tid >> 6); (void)tid; (void)lane; (void)wave;

    for (int rep = 0; rep < REP_P0; ++rep) { PHASE_IDS KP p = kargs(); p0_prologue(p, lds, bx * NWAVES + wave, G * NWAVES, wave, lane); }
    GRID_SYNC();
    STAMP(1);

    for (int rep = 0; rep < REP_SYNC; ++rep) GRID_SYNC();
    for (int rep = 0; rep < REP_P1; ++rep) {
        KP p = kargs(); unsigned char* ws = p->ws;
        pg8::Gemm g{(const bf16*)(ws + WS_XN), (const bf16*)(ws + WS_WIN), MPAD, DIN, DM}; pg8::StaticOrder S; S.init(MPAD, DIN, G, bx);
        EpiIn E{ws, p->out};
        pg8::gemm_phase<EpiIn, pg8::StaticOrder, true, true>(lds, g, S, E);
        { PHASE_IDS int slot, ns; slack_slot((MPAD / 256) * (DIN / 256), G, bx, slot, ns);
          if (slot >= 0) convert_items(p, lds, CI_G, CI_WU, slot * NWAVES + wave, ns * NWAVES, wave, lane); }
    }
    GRID_SYNC();
    STAMP(2);

    {
        PHASE_IDS KP p = kargs();
        for (int i = tid; i < 2560; i += NTHR) ((LAS float*)lds)[i] = i < 2048 ? p->in[I_CONVW][i] : p->in[I_CONVB][i - 2048];
        __syncthreads();
        unsigned* cw = (unsigned*)(p->ws + WS_BAR);
        for (int u = bx; u < 1184; u += G) {
            int tl_ = threadIdx.x; asm volatile("" : "+v"(tl_)); const int tid = tl_, lane = tl_ & 63;
            if (u < 128) { sample_unit(p, u, lds, tid, wave, lane); asm volatile("s_waitcnt vmcnt(0)" ::: "memory"); __syncthreads(); if (tid == 0) atomicAdd(cw + CW_S1, 1u); }
            else if (u < 384) { const int k = u - 128; scan_unit<false>(p, k >> 5, k & 31, lds, wave, lane); asm volatile("s_waitcnt vmcnt(0)" ::: "memory"); __syncthreads(); if (tid == 0) atomicAdd(cw + CW_SCAN + 64 * (k >> 5), 1u); }
            else if (u < 896) { const int a = u - 384; attn_unit(p, a >> 6, a & 63, lds + 12288, wave, lane); }
            else if (u < 1152) { const int k = u - 896;
                if (tid == 0) { unsigned sp = 0; while (__hip_atomic_load(cw + CW_SCAN + 64 * (k >> 5), __ATOMIC_RELAXED, __HIP_MEMORY_SCOPE_AGENT) < 32u) { __builtin_amdgcn_s_sleep(4); if (++sp > (1u << 22)) break; } }
                __syncthreads(); __builtin_amdgcn_fence(__ATOMIC_ACQUIRE, "agent");
                scan_unit<true>(p, k >> 5, k & 31, lds, wave, lane); }
            else {
                if (tid == 0) { unsigned sp = 0; while (__hip_atomic_load(cw + CW_S1, __ATOMIC_RELAXED, __HIP_MEMORY_SCOPE_AGENT) < 128u) { __builtin_amdgcn_s_sleep(4); if (++sp > (1u << 22)) break; } }
                __syncthreads(); __builtin_amdgcn_fence(__ATOMIC_ACQUIRE, "agent");
                small_gemm_task<0>(p, (const bf16*)(p->ws + WS_MIX) + (size_t)MP * DM, (const bf16*)(p->ws + WS_WOUT), DM, 32 * (u - 1152), lds, wave, lane);
            }
        }
    }
    GRID_SYNC();
    STAMP(4);

    {
        KP p = kargs(); unsigned char* ws = p->ws;
        pg8::Gemm g{(const bf16*)(ws + WS_MIX), (const bf16*)(ws + WS_WOUT), MP, DM, DM}; pg8::StaticOrder S; S.init(MP, DM, G, bx);
        if (PROBE_P3) { EpiOut E0{p->in[I_XP], p->in[I_XS], (float*)(ws + 92 * MiB), ws + 128 * MiB}; pg8::gemm_phase<EpiOut, pg8::StaticOrder, true, true>(lds, g, S, E0); }
        EpiOut E{p->in[I_XP], p->in[I_XS], p->out, ws};
        pg8::gemm_phase<EpiOut, pg8::StaticOrder, true, true>(lds, g, S, E);
    }
    GRID_SYNC();
    STAMP(5);

    for (int rep = 0; rep < REP_P4; ++rep) {
        KP p = kargs(); unsigned char* ws = p->ws;
        pg8::Gemm g{(const bf16*)(ws + WS_HB), (const bf16*)(ws + WS_WGU), MPAD, 2 * DFF, DM}; pg8::StaticOrder S; S.init(MPAD, 2 * DFF, G, bx);
        EpiGU E{ws};
        pg8::gemm_phase<EpiGU, pg8::StaticOrder, true, true>(lds, g, S, E);
        { PHASE_IDS int slot, ns; slack_slot((MPAD / 256) * (2 * DFF / 256), G, bx, slot, ns);
          if (slot >= 0) { convert_items(p, lds, CI_WU, CI_WD, slot * NWAVES + wave, ns * NWAVES, wave, lane);
                           copy_windows(p, (slot * NWAVES + wave) * 64 + lane, ns * NWAVES * 64); } }
    }
    GRID_SYNC();
    STAMP(6);

    {
        KP p = kargs(); unsigned char* ws = p->ws;
        pg8::Gemm g{(const bf16*)(ws + WS_FF), (const bf16*)(ws + WS_WD), MP, DM, DFF}; pg8::StaticOrder S; S.init(MP, DM, G, bx);
        EpiDownFused E{ws, p->out, p->in[I_FNG]};
        pg8::gemm_phase<EpiDownFused, pg8::StaticOrder, false, true>(lds, g, S, E);
        { PHASE_IDS
          int ndone = 0;
          for (int u = bx; u < 32; u += G) { small_gemm_task<1>(p, (const bf16*)(ws + WS_FF) + (size_t)MP * DFF, (const bf16*)(ws + WS_WD), DFF, 32 * u, lds, wave, lane); ++ndone; }
          if (ndone) {
              __threadfence(); __syncthreads();
              LAS unsigned* flag = (LAS unsigned*)(lds + 8192);
              if (tid == 0) { const unsigned old = atomicAdd((unsigned*)(ws + WS_BAR) + CW_SAMPLE, (unsigned)ndone); *flag = (old + (unsigned)ndone == 32u) ? 1u : 0u; }
              __syncthreads();
              if (*flag) {
                  __builtin_amdgcn_fence(__ATOMIC_ACQUIRE, "agent");
                  const f32x4* g4 = (const f32x4*)p->in[I_FNG] + lane;
                  f32x4 gq[4];
#pragma unroll
                  for (int j = 0; j < 4; ++j) gq[j] = g4[64 * j];
                  for (int m0 = MP + wave; m0 < MR; m0 += 4 * NWAVES) {
                      f32x4 v[4][4];
#pragma unroll
                      for (int q = 0; q < 4; ++q) { const f32x4* yr = (const f32x4*)(p->out + (size_t)(m0 + q * NWAVES) * DM) + lane;
#pragma unroll
                          for (int j = 0; j < 4; ++j) v[q][j] = yr[64 * j]; }
#pragma unroll
                      for (int q = 0; q < 4; ++q) { float s = 0.f;
#pragma unroll
                          for (int j = 0; j < 4; ++j) s += (v[q][j].x * v[q][j].x + v[q][j].y * v[q][j].y) + (v[q][j].z * v[q][j].z + v[q][j].w * v[q][j].w);
                          const float rs = frsq(wave_sum(s, lane) * (1.f / DM) + EPS);
                          f32x4* yw = (f32x4*)(p->out + (size_t)(m0 + q * NWAVES) * DM) + lane;
#pragma unroll
                          for (int j = 0; j < 4; ++j) yw[64 * j] = v[q][j] * rs * gq[j]; }
                  }
              }
          }
        }
    }
    STAMP(7);
    STAMP(8);
    if (STAMP_A >= 0 && blockIdx.x == 0 && threadIdx.x == 0) {
        const LAS unsigned long long* ts = (const LAS unsigned long long*)(lds + 131072 + 64);
        const unsigned long long d = (ts[STAMP_B < 0 ? 0 : STAMP_B] - ts[STAMP_A < 0 ? 0 : STAMP_A]) * STAMP_MULT, t0 = __builtin_amdgcn_s_memrealtime();
        while (__builtin_amdgcn_s_memrealtime() - t0 < d) __builtin_amdgcn_s_sleep(16);
    }
}

extern "C" void kernel_launch(void* const* d_in, const int* in_sizes, int n_in, void* d_out, int out_size, void* d_ws, size_t ws_size, hipStream_t stream) {
    static int grid = 0;
    if (grid == 0) {
        int dev = 0, cus = 0, per_cu = 0;
        hipGetDevice(&dev);
        hipDeviceGetAttribute(&cus, hipDeviceAttributeMultiprocessorCount, dev);
        hipFuncSetAttribute((const void*)fwd_megakernel, hipFuncAttributeMaxDynamicSharedMemorySize, LDS_BYTES);
        hipOccupancyMaxActiveBlocksPerMultiprocessor(&per_cu, (const void*)fwd_megakernel, NTHR, LDS_BYTES);
        if (per_cu < 1) { fprintf(stderr, "kernel_launch: occupancy query says %d blocks/CU\n", per_cu); per_cu = 1; }
        (void)hipGetLastError();
        grid = cus;
        if (n_in != 24 || ws_size < WS_END || (size_t)out_size != OUT_END) fprintf(stderr, "kernel_launch: unexpected sizes n_in %d ws %zu out %d\n", n_in, ws_size, out_size);
    }
    hipMemsetAsync((unsigned char*)d_ws + WS_BAR, 0, BAR_BYTES, stream);
    Params p{};
    for (int i = 0; i < 24; ++i) p.in[i] = (const float*)d_in[i];
    p.out = (float*)d_out; p.ws = (unsigned char*)d_ws;
    void* args[] = {&p};
    hipError_t e = hipLaunchCooperativeKernel((const void*)fwd_megakernel, dim3(grid), dim3(NTHR), args, LDS_BYTES, stream);
    if (e != hipSuccess) fprintf(stderr, "cooperative launch failed: %s (grid %d)\n", hipGetErrorString(e), grid);
}
```

```cpp
#include <hip/hip_runtime.h>
#include <hip/hip_cooperative_groups.h>
#include <cstdio>
#include <cstdint>
namespace cg = cooperative_groups;
namespace pg8 {
#define PG8_LAS __attribute__((address_space(3)))
typedef unsigned short bf16_t;
typedef short bf16x8 __attribute__((ext_vector_type(8)));
typedef float f32x4 __attribute__((ext_vector_type(4)));
typedef unsigned u32x4 __attribute__((ext_vector_type(4)));
constexpr int BM = 256, BK = 64, HALF = 128, HTB = HALF * BK * 2  , STAGE_BYTES = 8 * HTB, NXCD = 8, WGM = 8;

__host__ __device__ __forceinline__ int lds_byte(int r, int c) { const int st = (r >> 4) * 2 + (c >> 5), rr = r & 15, cc = c & 31, ob = rr * 64 + cc * 2; return st * 1024 + (ob ^ (((ob >> 9) & 1) << 5)); }
__host__ __device__ __forceinline__ void stage_rc(int b, int& R, int& C) { const int st = b / 1024, sb = b % 1024, swz = sb ^ (((sb >> 9) & 1) << 5); R = (st >> 1) * 16 + swz / 64; C = (st & 1) * 32 + (swz % 64) / 2; }
__host__ __device__ __forceinline__ int perm32(int rho) { const int n = rho >> 4, i = rho & 15; return 8 * (i >> 2) + 4 * n + (i & 3); }

struct Unit { int pm, pn; };
struct Gemm { const bf16_t* A; const bf16_t* Bt; int M, N, K; };

struct StaticOrder {
    int nM, nN, nwg, G, c;
    __host__ __device__ void init(int M, int N, int G_, int c_) { nM = M / BM; nN = N / BM; nwg = nM * nN; G = G_; c = c_; }
    __host__ __device__ bool next(int i, Unit& u) const {
        const long L = (long)i * G + c; if (L >= nwg) return false;
        int wgid = (int)L; { const int q = nwg / NXCD, r = nwg % NXCD, xcd = wgid % NXCD, off = wgid / NXCD; wgid = (xcd < r ? xcd * (q + 1) : r * (q + 1) + (xcd - r) * q) + off; }
        const int nig = WGM * nN, gid = wgid / nig, fm = gid * WGM, gsz = (nM - fm) < WGM ? (nM - fm) : WGM;
        u.pm = fm + ((wgid % nig) % gsz); u.pn = (wgid % nig) / gsz; return true;
    }
    __device__ __forceinline__ void a_ready(const Unit&) const {}
    __device__ __forceinline__ void done(const Unit&) const {}
};

template <class Epi, class Sched, bool ALIGN_EPI = false, bool SP2 = false>
__device__ __forceinline__ void gemm_phase(PG8_LAS unsigned char* lds, const Gemm g, const Sched& S, const Epi& E) {
    int tid_ = threadIdx.x; asm volatile("" : "+v"(tid_));
    const int tid = tid_, wid = __builtin_amdgcn_readfirstlane(tid >> 6), lane = tid & 63, wr = wid >> 2, wc = wid & 3, fr = lane & 15, fq = lane >> 4;
    const int K = g.K, nt = K / BK;
    unsigned voffA[2], voffB[2];
#pragma unroll
    for (int i = 0; i < 2; ++i) { int R, C; stage_rc(tid * 16 + i * 8192, R, C); const int Rb = Epi::PERM ? ((R & ~31) + perm32(R & 31)) : R;
        voffA[i] = (unsigned)(R * K + C) * 2u; voffB[i] = (unsigned)(Rb * K + C) * 2u; }
    const size_t kstep = (size_t)(BK * 2);
    const size_t hstep = (size_t)HALF * K * 2;
    const size_t tstep = 2 * hstep;
    const unsigned ldsw = (unsigned)wid * 1024u;
    const int aoff = lds_byte(wr * 64 + fr, fq * 8), boff = lds_byte(wc * 32 + fr, fq * 8);
#define PG8_SA(b, h) (((b) * 2 + (h)) * HTB)
#define PG8_SB(b, h) ((4 + (b) * 2 + (h)) * HTB)
#define PG8_STAGE(bufoff, gbase, voff) do { _Pragma("unroll") for (int _i = 0; _i < 2; ++_i) \
        __builtin_amdgcn_global_load_lds((const unsigned*)((const char*)(gbase) + (voff)[_i]), (PG8_LAS unsigned*)(lds + (bufoff) + ldsw + _i * 8192), 16, 0, 0); } while (0)
#define PG8_LDA(dst, b, h) do { _Pragma("unroll") for (int m = 0; m < 4; ++m) _Pragma("unroll") for (int k = 0; k < 2; ++k) dst[m][k] = *(const PG8_LAS bf16x8*)(lds + PG8_SA(b, h) + aoff + m * 2048 + k * 1024); } while (0)
#define PG8_LDB(dst, b, h) do { _Pragma("unroll") for (int n = 0; n < 2; ++n) _Pragma("unroll") for (int k = 0; k < 2; ++k) dst[n][k] = *(const PG8_LAS bf16x8*)(lds + PG8_SB(b, h) + boff + n * 2048 + k * 1024); } while (0)
#define PG8_MMA(ai, bj, At, Bt) do { __builtin_amdgcn_s_setprio(1); _Pragma("unroll") for (int m = 0; m < 4; ++m) _Pragma("unroll") for (int n = 0; n < 2; ++n) _Pragma("unroll") for (int k = 0; k < 2; ++k) \
        acc[ai][bj][m][n] = __builtin_amdgcn_mfma_f32_16x16x32_bf16(Bt[n][k], At[m][k], acc[ai][bj][m][n], 0, 0, 0); __builtin_amdgcn_s_setprio(0); } while (0)
#define PG8_WAIT_V(n) asm volatile("s_waitcnt vmcnt(" #n ")" ::: "memory")
#define PG8_WAIT_L(n) asm volatile("s_waitcnt lgkmcnt(" #n ")" ::: "memory")
#define PG8_BAR __builtin_amdgcn_s_barrier()
#define PG8_SCHED __builtin_amdgcn_sched_barrier(0)
    Unit cur, nxt; int ui = 0;
    if (!S.next(0, cur)) return;
    f32x4 acc[2][2][4][2];
#pragma unroll
    for (int a = 0; a < 2; ++a)
#pragma unroll
        for (int b = 0; b < 2; ++b)
#pragma unroll
            for (int m = 0; m < 4; ++m)
#pragma unroll
                for (int n = 0; n < 2; ++n) acc[a][b][m][n] = (f32x4){0.f, 0.f, 0.f, 0.f};
    bf16x8 At[4][2], B0[2][2], B1[2][2];
    const char* cA = (const char*)g.A + (size_t)cur.pm * tstep; const char* cB = (const char*)g.Bt + (size_t)cur.pn * tstep;
    S.a_ready(cur);
    if constexpr (SP2) {
        PG8_STAGE(PG8_SB(0, 0), cB, voffB); PG8_STAGE(PG8_SB(0, 1), cB + hstep, voffB); PG8_STAGE(PG8_SA(0, 0), cA, voffA); PG8_STAGE(PG8_SA(0, 1), cA + hstep, voffA);
        if (wr == 1) PG8_BAR;
        PG8_WAIT_V(2); PG8_BAR;
        PG8_STAGE(PG8_SB(1, 0), cB + kstep, voffB); PG8_STAGE(PG8_SA(1, 0), cA + kstep, voffA); PG8_STAGE(PG8_SB(1, 1), cB + hstep + kstep, voffB);
        PG8_WAIT_V(6); PG8_BAR;
    } else {
        PG8_STAGE(PG8_SB(0, 0), cB, voffB); PG8_STAGE(PG8_SA(0, 0), cA, voffA); PG8_STAGE(PG8_SB(0, 1), cB + hstep, voffB); PG8_STAGE(PG8_SA(0, 1), cA + hstep, voffA);
        if (wr == 1) PG8_BAR;
        PG8_WAIT_V(4); PG8_BAR;
        PG8_STAGE(PG8_SB(1, 0), cB + kstep, voffB); PG8_STAGE(PG8_SA(1, 0), cA + kstep, voffA); PG8_STAGE(PG8_SB(1, 1), cB + hstep + kstep, voffB);
        PG8_WAIT_V(6); PG8_BAR;
    }
    for (;;) {
        const bool has_next = S.next(ui + 1, nxt);
        const char* nA = has_next ? (const char*)g.A + (size_t)nxt.pm * tstep : cA; const char* nB = has_next ? (const char*)g.Bt + (size_t)nxt.pn * tstep : cB;
        for (int t = 0; t < nt; t += 2) {
            const bool last = (t == nt - 2);
            const char* a1 = cA + (size_t)(t + 1) * kstep;
            const char* a2 = last ? nA : cA + (size_t)(t + 2) * kstep; const char* b2 = last ? nB : cB + (size_t)(t + 2) * kstep;
            const char* a3 = a2 + kstep; const char* b3 = b2 + kstep;
            if (last && has_next) S.a_ready(nxt);
            if constexpr (SP2) {
            PG8_LDB(B0, 0, 0); PG8_LDB(B1, 0, 1); PG8_SCHED; PG8_LDA(At, 0, 0); PG8_STAGE(PG8_SA(1, 1), a1 + hstep, voffA);
            PG8_WAIT_V(8); PG8_WAIT_L(0); PG8_BAR; PG8_MMA(0, 0, At, B0); PG8_MMA(0, 1, At, B1); PG8_BAR; PG8_SCHED;
            PG8_LDA(At, 0, 1); PG8_STAGE(PG8_SB(0, 0), b2, voffB); PG8_STAGE(PG8_SB(0, 1), b2 + hstep, voffB); PG8_STAGE(PG8_SA(0, 0), a2, voffA);
            PG8_WAIT_V(8); PG8_WAIT_L(0); PG8_BAR; PG8_MMA(1, 0, At, B0); PG8_MMA(1, 1, At, B1); PG8_BAR; PG8_SCHED;
            PG8_LDB(B0, 1, 0); PG8_LDB(B1, 1, 1); PG8_SCHED; PG8_LDA(At, 1, 0); PG8_STAGE(PG8_SA(0, 1), a2 + hstep, voffA);
            PG8_WAIT_V(8); PG8_WAIT_L(0); PG8_BAR; PG8_MMA(0, 0, At, B0); PG8_MMA(0, 1, At, B1); PG8_BAR; PG8_SCHED;
            PG8_LDA(At, 1, 1); PG8_STAGE(PG8_SB(1, 0), b3, voffB); PG8_STAGE(PG8_SB(1, 1), b3 + hstep, voffB); PG8_STAGE(PG8_SA(1, 0), a3, voffA);
            PG8_WAIT_V(8); PG8_WAIT_L(0); PG8_BAR; PG8_MMA(1, 0, At, B0); PG8_MMA(1, 1, At, B1); PG8_BAR; PG8_SCHED;
            } else {
            PG8_LDB(B0, 0, 0); PG8_SCHED; PG8_LDA(At, 0, 0); PG8_STAGE(PG8_SA(1, 1), a1 + hstep, voffA);
            PG8_WAIT_L(8); PG8_BAR; PG8_WAIT_L(0); PG8_MMA(0, 0, At, B0); PG8_BAR; PG8_SCHED;
            PG8_LDB(B1, 0, 1); PG8_STAGE(PG8_SB(0, 0), b2, voffB);
            PG8_BAR; PG8_WAIT_L(0); PG8_MMA(0, 1, At, B1); PG8_BAR;
            PG8_LDA(At, 0, 1); PG8_STAGE(PG8_SA(0, 0), a2, voffA);
            PG8_BAR; PG8_WAIT_L(0); PG8_MMA(1, 0, At, B0); PG8_BAR; PG8_SCHED;
            PG8_STAGE(PG8_SB(0, 1), b2 + hstep, voffB);
            PG8_WAIT_V(6); PG8_BAR; PG8_MMA(1, 1, At, B1); PG8_BAR;
            PG8_LDB(B0, 1, 0); PG8_SCHED; PG8_LDA(At, 1, 0); PG8_STAGE(PG8_SA(0, 1), a2 + hstep, voffA);
            PG8_WAIT_L(8); PG8_BAR; PG8_WAIT_L(0); PG8_MMA(0, 0, At, B0); PG8_BAR; PG8_SCHED;
            PG8_LDB(B1, 1, 1); PG8_STAGE(PG8_SB(1, 0), b3, voffB);
            PG8_BAR; PG8_WAIT_L(0); PG8_MMA(0, 1, At, B1); PG8_BAR;
            PG8_LDA(At, 1, 1); PG8_STAGE(PG8_SA(1, 0), a3, voffA);
            PG8_BAR; PG8_WAIT_L(0); PG8_MMA(1, 0, At, B0); PG8_BAR; PG8_SCHED;
            PG8_STAGE(PG8_SB(1, 1), b3 + hstep, voffB);
            PG8_WAIT_V(6); PG8_BAR; PG8_MMA(1, 1, At, B1); PG8_BAR;
            }
        }
        if constexpr (ALIGN_EPI) { if (wr == 0) PG8_BAR; }
        if constexpr (!Epi::AFTER_DRAIN) { E(acc, cur, wr, wc, fr, fq); S.done(cur); }
        if (!has_next) break;
#pragma unroll
        for (int a = 0; a < 2; ++a)
#pragma unroll
            for (int b = 0; b < 2; ++b)
#pragma unroll
                for (int m = 0; m < 4; ++m)
#pragma unroll
                    for (int n = 0; n < 2; ++n) acc[a][b][m][n] = (f32x4){0.f, 0.f, 0.f, 0.f};
        cur = nxt; cA = nA; cB = nB; ++ui;
        if constexpr (ALIGN_EPI) { if (wr == 1) PG8_BAR; }
    }
    PG8_WAIT_V(0);
    if constexpr (!ALIGN_EPI) { if (wr == 0) PG8_BAR; }
    PG8_BAR;
    if constexpr (Epi::AFTER_DRAIN) { E.fused(acc, cur, wr, wc, fr, fq, lds, wid, lane); S.done(cur); }
#undef PG8_SA
#undef PG8_SB
#undef PG8_STAGE
#undef PG8_LDA
#undef PG8_LDB
#undef PG8_MMA
#undef PG8_WAIT_V
#undef PG8_WAIT_L
#undef PG8_BAR
#undef PG8_SCHED
}
}

#define LAS __attribute__((address_space(3)))
typedef unsigned short bf16;
typedef short bf16x8 __attribute__((ext_vector_type(8)));
typedef float f32x4 __attribute__((ext_vector_type(4)));
typedef float f32x16 __attribute__((ext_vector_type(16)));
typedef unsigned u32x4 __attribute__((ext_vector_type(4)));
typedef unsigned u32x2 __attribute__((ext_vector_type(2)));
typedef float f32x2_t __attribute__((ext_vector_type(2)));
typedef __bf16 bf16x2_t __attribute__((ext_vector_type(2)));

constexpr int DM = 1024, TSEQ = 2048, NB = 8, MP = NB * TSEQ  , NS = 128  , MR = MP + NS  , MPAD = 16640  ;
constexpr int DREC = 512, DATT = 512, DKV = 128, DFF = 2816, DIN = 1792;
constexpr float EPS = 1e-6f;
constexpr int NWAVES = 8, NTHR = 512;
constexpr size_t OFF_Y = 0, OFF_PK = (size_t)MR * DM, OFF_PV = OFF_PK + 131072, OFF_PCONV = OFF_PV + 131072, OFF_PH = OFF_PCONV + 12288,
                 OFF_SK = OFF_PH + 4096, OFF_SV = OFF_SK + 2097152, OFF_SCONV = OFF_SV + 2097152, OFF_SH = OFF_SCONV + 196608, OUT_END = OFF_SH + 65536;
constexpr size_t MiB = 1u << 20;
constexpr int CTL_WORDS = 10240, CW_DONE = CTL_WORDS - 1;
__device__ unsigned g_ctl[CTL_WORDS];
constexpr size_t WS_RSQH = 0, WS_SUMA = 1 * MiB, WS_SUMH = 1 * MiB + 512 * 1024;
constexpr size_t WS_WIN = 2 * MiB, WS_WOUT = 6 * MiB, WS_WGU = 8 * MiB, WS_WD = 19 * MiB, WS_GWT = 25 * MiB;
constexpr size_t WS_MIX = 26 * MiB, WS_HB = 59 * MiB, WS_FF = 92 * MiB;
constexpr size_t WS_XN = 92 * MiB, WS_XR = 125 * MiB, WS_GR = 142 * MiB, WS_Q = 159 * MiB, WS_KB = 176 * MiB, WS_VT = 181 * MiB, WS_END = 250 * MiB;
static_assert(WS_MIX + (size_t)MPAD * DM * 2 <= WS_HB && WS_HB + (size_t)MPAD * DM * 2 <= WS_FF && WS_FF + (size_t)MPAD * DFF * 2 <= WS_END, "ws map");
static_assert(WS_GR - WS_XR == WS_Q - WS_GR, "xr/gr/q equally spaced");
static_assert(WS_XN + (size_t)MPAD * DM * 2 <= WS_XR && WS_XR + (size_t)MPAD * 512 * 2 <= WS_GR && WS_GR + (size_t)MPAD * 512 * 2 <= WS_Q && WS_Q + (size_t)MPAD * 512 * 2 <= WS_KB && WS_KB + (size_t)MPAD * 128 * 2 <= WS_VT, "ws map 2");
constexpr int LDS_BYTES = 132096;

struct Params {
    const float* in[24];
    float* out; unsigned char* ws;
};
typedef const __attribute__((address_space(4))) Params* KP;
__device__ __forceinline__ KP kargs() { KP q = (KP)__builtin_amdgcn_kernarg_segment_ptr(); asm volatile("" : "+s"(q)); return q; }
enum { I_XP = 0, I_XS, I_CK, I_CV, I_SCONV, I_SH, I_N1G, I_WIN, I_CONVW, I_CONVB, I_GAW, I_GAB, I_GXW, I_GXB, I_LAM, I_SINK, I_RNG, I_ANG, I_WOUT, I_N2G, I_WG, I_WU, I_WD, I_FNG };

__device__ __forceinline__ unsigned pk2(float lo, float hi) { f32x2_t v = {lo, hi}; bf16x2_t b = __builtin_convertvector(v, bf16x2_t); return __builtin_bit_cast(unsigned, b); }
__device__ __forceinline__ float bflo(unsigned w) { return __uint_as_float(w << 16); }
__device__ __forceinline__ float bfhi(unsigned w) { return __uint_as_float(w & 0xffff0000u); }
__device__ __forceinline__ float bf1(bf16 u) { return __uint_as_float((unsigned)u << 16); }
__device__ __forceinline__ float shx(float v, int o, int lane) { return __int_as_float(__builtin_amdgcn_ds_bpermute((lane ^ o) << 2, __float_as_int(v))); }
__device__ __forceinline__ float shl(float v, int src) { return __int_as_float(__builtin_amdgcn_ds_bpermute(src << 2, __float_as_int(v))); }
__device__ __forceinline__ float wave_sum(float v, int lane) {
#pragma unroll
    for (int o = 1; o < 64; o <<= 1) v += shx(v, o, lane);
    return v;
}
__device__ __forceinline__ float wave_max(float v, int lane) {
#pragma unroll
    for (int o = 1; o < 64; o <<= 1) v = fmaxf(v, shx(v, o, lane));
    return v;
}
__device__ __forceinline__ float frcp(float x) { return __builtin_amdgcn_rcpf(x); }
__device__ __forceinline__ float fsqrt(float x) { return __builtin_amdgcn_sqrtf(x); }
__device__ __forceinline__ float frsq(float x) { return __builtin_amdgcn_rsqf(x); }
__device__ __forceinline__ float fexp(float x) { return __builtin_amdgcn_exp2f(x * 1.4426950408889634f); }
__device__ __forceinline__ float sigmoidf_(float x) { return frcp(1.0f + fexp(-x)); }
__device__ __forceinline__ float gelu_tanh(float x) { const float z = 0.7978845608028654f * (x + 0.044715f * x * x * x); const float e = fexp(2.0f * z); return x * (1.0f - frcp(e + 1.0f)); }

using pg8::Unit;
struct EpiIn {
    static constexpr bool PERM = true, AFTER_DRAIN = false;
    unsigned char* ws; float* out;
    __device__ __forceinline__ void operator()(const f32x4 (&acc)[2][2][4][2], const Unit& u, int wr, int wc, int fr, int fq) const {
        const int pn = u.pn;
        bf16* const KB = (bf16*)(ws + WS_KB); bf16* const VT = (bf16*)(ws + WS_VT);
#pragma unroll
        for (int ai = 0; ai < 2; ++ai)
#pragma unroll
            for (int m = 0; m < 4; ++m) {
                const int row = u.pm * 256 + ai * 128 + wr * 64 + m * 16 + fr;
                const bool isp = row < MP, iss = (row >= MP) && (row < MR);
                const int b = isp ? (row >> 11) : (row - MP), t = row & (TSEQ - 1);
#pragma unroll
                for (int bj = 0; bj < 2; ++bj) {
                    const int c = bj * 128 + wc * 32 + 8 * fq;
                    f32x4 v0 = acc[ai][bj][m][0], v1 = acc[ai][bj][m][1];
                    if (pn < 6) {
                        bf16* dst = (bf16*)(ws + WS_XR + (size_t)(pn >> 1) * (WS_GR - WS_XR));
                        const int col = (pn & 1) * 256 + c;
                        if (pn >= 4) { v0 = v0 * 0.125f; v1 = v1 * 0.125f; }
                        u32x4 w; w.x = pk2(v0[0], v0[1]); w.y = pk2(v0[2], v0[3]); w.z = pk2(v1[0], v1[1]); w.w = pk2(v1[2], v1[3]);
                        *(u32x4*)(dst + (size_t)row * 512 + col) = w;
                        if (pn < 2) {
                            float* o = nullptr;
                            if (isp && t >= TSEQ - 3) o = out + OFF_PCONV + (size_t)(b * 3 + (t - (TSEQ - 3))) * 512 + col;
                            if (iss) o = out + OFF_SCONV + (size_t)(b * 3 + 2) * 512 + col;
                            if (o) { *(f32x4*)o = v0; *(f32x4*)(o + 4) = v1; }
                        }
                    } else {
                        const int cc = wc * 32 + 8 * fq;
                        if (bj == 0) {
                            u32x4 w; w.x = pk2(v0[0], v0[1]); w.y = pk2(v0[2], v0[3]); w.z = pk2(v1[0], v1[1]); w.w = pk2(v1[2], v1[3]);
                            *(u32x4*)(KB + (size_t)row * 128 + cc) = w;
                        } else if (isp) {
                            const int kvh = cc >> 6, d0 = cc & 63;
                            bf16* vt = VT + ((size_t)(b * 2 + kvh) * 64 + d0) * TSEQ + t;
                            const unsigned w0 = pk2(v0[0], v0[1]), w1 = pk2(v0[2], v0[3]), w2 = pk2(v1[0], v1[1]), w3 = pk2(v1[2], v1[3]);
                            vt[0 * TSEQ] = (bf16)(w0 & 0xffff); vt[1 * TSEQ] = (bf16)(w0 >> 16); vt[2 * TSEQ] = (bf16)(w1 & 0xffff); vt[3 * TSEQ] = (bf16)(w1 >> 16);
                            vt[4 * TSEQ] = (bf16)(w2 & 0xffff); vt[5 * TSEQ] = (bf16)(w2 >> 16); vt[6 * TSEQ] = (bf16)(w3 & 0xffff); vt[7 * TSEQ] = (bf16)(w3 >> 16);
                        }
                        float* o = nullptr;
                        if (isp && t >= TSEQ - 128) o = out + (bj == 0 ? OFF_PK : OFF_PV) + (size_t)(b * 128 + (t - (TSEQ - 128))) * 128 + cc;
                        if (iss) o = out + (bj == 0 ? OFF_SK : OFF_SV) + (size_t)(b * 128 + 127) * 128 + cc;
                        if (o) { *(f32x4*)o = v0; *(f32x4*)(o + 4) = v1; }
                    }
                }
            }
    }
};
struct EpiOut {
    static constexpr bool PERM = false, AFTER_DRAIN = false;
    const float *xp, *xs; float* H; unsigned char* ws;
    __device__ __forceinline__ void operator()(const f32x4 (&acc)[2][2][4][2], const Unit& u, int wr, int wc, int fr, int fq) const {
        const int col0 = u.pn * 256 + wc * 32 + 4 * fq, lane = fr + 16 * fq;
        bf16* const HB = (bf16*)(ws + WS_HB); float* const rsq = (float*)(ws + WS_RSQH);
#pragma unroll
        for (int ai = 0; ai < 2; ++ai)
#pragma unroll
            for (int m = 0; m < 4; ++m) {
                const int row = u.pm * 256 + ai * 128 + wr * 64 + m * 16 + fr;
                const bool real = row < MR;
                const float* xrow = row < MP ? xp + (size_t)row * DM : xs + (size_t)(row - MP) * DM;
                float s = 0.f;
#pragma unroll
                for (int bj = 0; bj < 2; ++bj)
#pragma unroll
                    for (int n = 0; n < 2; ++n) {
                        const int c = col0 + bj * 128 + n * 16;
                        f32x4 v = acc[ai][bj][m][n];
                        if (real) v = v + *(const f32x4*)(xrow + c);
                        s += (v[0] * v[0] + v[1] * v[1]) + (v[2] * v[2] + v[3] * v[3]);
                        u32x2 w; w.x = pk2(v[0], v[1]); w.y = pk2(v[2], v[3]);
                        *(u32x2*)(HB + (size_t)row * DM + c) = w;
                    }
                s += shx(s, 16, lane); s += shx(s, 32, lane);
                if (fq == 0) atomicAdd(rsq + row, s);
            }
    }
};
struct EpiGU {
    static constexpr bool PERM = true, AFTER_DRAIN = false;
    unsigned char* ws;
    __device__ __forceinline__ void operator()(const f32x4 (&acc)[2][2][4][2], const Unit& u, int wr, int wc, int fr, int fq) const {
        const int col = u.pn * 128 + wc * 32 + 8 * fq;
        bf16* const FF = (bf16*)(ws + WS_FF); const float* const rsq = (const float*)(ws + WS_RSQH);
#pragma unroll
        for (int ai = 0; ai < 2; ++ai)
#pragma unroll
            for (int m = 0; m < 4; ++m) {
                const int row = u.pm * 256 + ai * 128 + wr * 64 + m * 16 + fr;
                const float r = frsq(rsq[row] * (1.0f / DM) + EPS);
                float o[8];
#pragma unroll
                for (int n = 0; n < 2; ++n)
#pragma unroll
                    for (int e = 0; e < 4; ++e) { const float g = acc[ai][0][m][n][e] * r, uu = acc[ai][1][m][n][e] * r; o[4 * n + e] = g * sigmoidf_(g) * uu; }
                u32x4 w; w.x = pk2(o[0], o[1]); w.y = pk2(o[2], o[3]); w.z = pk2(o[4], o[5]); w.w = pk2(o[6], o[7]);
                *(u32x4*)(FF + (size_t)row * DFF + col) = w;
            }
    }
};
struct EpiDown {
    static constexpr bool PERM = false, AFTER_DRAIN = false;
    float* H;
    __device__ __forceinline__ void operator()(const f32x4 (&acc)[2][2][4][2], const Unit& u, int wr, int wc, int fr, int fq) const {
        const int col0 = u.pn * 256 + wc * 32 + 4 * fq;
#pragma unroll
        for (int ai = 0; ai < 2; ++ai)
#pragma unroll
            for (int m = 0; m < 4; ++m) {
                const int row = u.pm * 256 + ai * 128 + wr * 64 + m * 16 + fr;
                if (row < MR) {
#pragma unroll
                    for (int bj = 0; bj < 2; ++bj)
#pragma unroll
                        for (int n = 0; n < 2; ++n) {
                            float* pp = H + (size_t)row * DM + col0 + bj * 128 + n * 16;
                            *(f32x4*)pp = *(const f32x4*)pp + acc[ai][bj][m][n];
                        }
                }
            }
    }
};

constexpr size_t WS_XBUF = 768 * 1024;
constexpr int CW_PANEL = 4096, CW_SAMPLE = 8192, CW_S1 = 8192 + 64, CW_SCAN = 8192 + 128;
struct EpiDownFused {
    static constexpr bool PERM = false, AFTER_DRAIN = true;
    unsigned char* ws; float* out; const float* gf;
    __device__ __forceinline__ void operator()(const f32x4 (&)[2][2][4][2], const Unit&, int, int, int, int) const {}
    __device__ __forceinline__ void fused(f32x4 (&acc)[2][2][4][2], const Unit& u, int wr, int wc, int fr, int fq, PG8_LAS unsigned char* lds, int wid, int lane) const {
        LAS float* P = (LAS float*)lds;
        LAS float* Sr = (LAS float*)(lds + 4096);
        const bf16* HB = (const bf16*)(ws + WS_HB);
        float* xbuf = (float*)(ws + WS_XBUF);
        unsigned* cnt = g_ctl + CW_PANEL + 64 * u.pm;
        const int col0 = u.pn * 256 + wc * 32 + 4 * fq;
#pragma unroll
        for (int ai = 0; ai < 2; ++ai)
#pragma unroll
            for (int m = 0; m < 4; ++m) {
                const int rl = ai * 128 + wr * 64 + m * 16 + fr; const size_t row = (size_t)u.pm * 256 + rl;
                float s = 0.f;
#pragma unroll
                for (int bj = 0; bj < 2; ++bj)
#pragma unroll
                    for (int n = 0; n < 2; ++n) {
                        const u32x2 hb = *(const u32x2*)(HB + row * DM + col0 + bj * 128 + n * 16);
                        f32x4 v = acc[ai][bj][m][n];
                        v[0] += bflo(hb.x); v[1] += bfhi(hb.x); v[2] += bflo(hb.y); v[3] += bfhi(hb.y);
                        acc[ai][bj][m][n] = v;
                        s += (v[0] * v[0] + v[1] * v[1]) + (v[2] * v[2] + v[3] * v[3]);
                    }
                s += shx(s, 16, lane); s += shx(s, 32, lane);
                if (fq == 0) P[rl * 4 + wc] = s;
            }
        asm volatile("s_waitcnt lgkmcnt(0)" ::: "memory"); __builtin_amdgcn_s_barrier(); asm volatile("" ::: "memory");
        const int rr = wid * 32 + (lane & 31);
        if (lane < 32) {
            const float tot = (P[rr * 4 + 0] + P[rr * 4 + 1]) + (P[rr * 4 + 2] + P[rr * 4 + 3]);
            __hip_atomic_store(xbuf + ((size_t)u.pm * 256 + rr) * 4 + u.pn, tot, __ATOMIC_RELAXED, __HIP_MEMORY_SCOPE_AGENT);
        }
        asm volatile("s_waitcnt vmcnt(0)" ::: "memory");
        if (lane == 0) __hip_atomic_fetch_add(cnt, 1u, __ATOMIC_RELAXED, __HIP_MEMORY_SCOPE_AGENT);
        if (wid == 0) {
            unsigned sp = 0;
            while ((unsigned)__builtin_amdgcn_readfirstlane(__hip_atomic_load(cnt, __ATOMIC_RELAXED, __HIP_MEMORY_SCOPE_AGENT)) < 32u) { __builtin_amdgcn_s_sleep(2); if (++sp > (1u << 22)) break; }
            __builtin_amdgcn_fence(__ATOMIC_ACQUIRE, "agent");
        }
        asm volatile("s_waitcnt vmcnt(0) lgkmcnt(0)" ::: "memory"); __builtin_amdgcn_s_barrier(); asm volatile("" ::: "memory");
        if (lane < 32) {
            const float* sl = xbuf + ((size_t)u.pm * 256 + rr) * 4; float t = 0.f;
#pragma unroll
            for (int k = 0; k < 4; ++k) t += __hip_atomic_load(sl + k, __ATOMIC_RELAXED, __HIP_MEMORY_SCOPE_AGENT);
            Sr[rr] = frsq(t * (1.0f / DM) + EPS);
        }
        asm volatile("s_waitcnt vmcnt(0) lgkmcnt(0)" ::: "memory"); __builtin_amdgcn_s_barrier(); asm volatile("" ::: "memory");
        f32x4 gv[2][2];
#pragma unroll
        for (int bj = 0; bj < 2; ++bj)
#pragma unroll
            for (int n = 0; n < 2; ++n) gv[bj][n] = *(const f32x4*)(gf + col0 + bj * 128 + n * 16);
#pragma unroll
        for (int ai = 0; ai < 2; ++ai)
#pragma unroll
            for (int m = 0; m < 4; ++m) {
                const int rl = ai * 128 + wr * 64 + m * 16 + fr; const size_t row = (size_t)u.pm * 256 + rl;
                const float sc = Sr[rl];
#pragma unroll
                for (int bj = 0; bj < 2; ++bj)
#pragma unroll
                    for (int n = 0; n < 2; ++n) *(f32x4*)(out + row * DM + col0 + bj * 128 + n * 16) = acc[ai][bj][m][n] * sc * gv[bj][n];
            }
    }
};

__device__ __forceinline__ void tr_item(const float* __restrict__ W, int N, bf16* WT, int ldt, int k0, int n0, int drow0, const float* __restrict__ kscale, LAS float* scr, int lane) {
    float wv[32];
#pragma unroll
    for (int i = 0; i < 32; ++i) wv[i] = W[(size_t)(k0 + 2 * i + (lane >> 5)) * N + n0 + (lane & 31)];
#pragma unroll
    for (int i = 0; i < 32; ++i) { const int kk = 2 * i + (lane >> 5); float v = wv[i]; if (kscale) v *= kscale[k0 + kk]; scr[kk * 33 + (lane & 31)] = v; }
    asm volatile("s_waitcnt lgkmcnt(0)" ::: "memory");
    const int c = lane & 7;
#pragma unroll
    for (int j = 0; j < 4; ++j) { const int n = (lane >> 3) + 8 * j; const LAS float* s = scr + (8 * c) * 33 + n;
        u32x4 o; o.x = pk2(s[0 * 33], s[1 * 33]); o.y = pk2(s[2 * 33], s[3 * 33]); o.z = pk2(s[4 * 33], s[5 * 33]); o.w = pk2(s[6 * 33], s[7 * 33]);
        *(u32x4*)(WT + (size_t)(drow0 + n) * ldt + k0 + 8 * c) = o; }
    asm volatile("s_waitcnt lgkmcnt(0)" ::: "memory");
}
constexpr int CI_WIN = 16 * 56, CI_G = CI_WIN + 32, CI_WOUT = CI_G + 16 * 32, CI_WU = CI_WOUT + 2 * 16 * 88, CI_WD = CI_WU + 44 * 32;
__device__ __forceinline__ void convert_items(KP p, LAS unsigned char* lds, int lo, int hi, int gw, int NGW, int wave, int lane) {
    unsigned char* ws = p->ws;
    LAS float* scr = (LAS float*)(lds + wave * 16384);
    for (int it = lo + gw; it < hi; it += NGW) {
        const float* W; const float* ks = nullptr; bf16* WT; int N, ldt, k0, n0, drow0; int r = it;
        if (r < CI_WIN) { const int kb = r / 56, nb = r % 56; W = p->in[I_WIN]; N = DIN; WT = (bf16*)(ws + WS_WIN); ldt = DM; k0 = 64 * kb; n0 = 32 * nb; drow0 = n0; }
        else if (r < CI_G) { r -= CI_WIN; const int gx = r >> 4, n = (r & 15) >> 1, nb = r & 1; W = p->in[gx ? I_GXW : I_GAW] + n * 4096; N = 64; WT = (bf16*)(ws + WS_GWT) + gx * 8 * 4096 + n * 4096; ldt = 64; k0 = 0; n0 = 32 * nb; drow0 = n0; }
        else if (r < CI_WOUT) { r -= CI_G; const int kb = r / 32, nb = r % 32; W = p->in[I_WOUT]; N = DM; WT = (bf16*)(ws + WS_WOUT); ldt = DM; k0 = 64 * kb; n0 = 32 * nb; drow0 = n0; }
        else if (r < CI_WU) { r -= CI_WOUT; const int up = r >= 16 * 88 ? 1 : 0; if (up) r -= 16 * 88; const int kb = r / 88, nb = r % 88; W = p->in[up ? I_WU : I_WG]; N = DFF; WT = (bf16*)(ws + WS_WGU); ldt = DM; k0 = 64 * kb; n0 = 32 * nb;
            drow0 = 256 * (n0 >> 7) + 128 * up + (n0 & 127); ks = p->in[I_N2G]; }
        else { r -= CI_WU; const int kb = r / 32, nb = r % 32; W = p->in[I_WD]; N = DM; WT = (bf16*)(ws + WS_WD); ldt = DFF; k0 = 64 * kb; n0 = 32 * nb; drow0 = n0; }
        tr_item(W, N, WT, ldt, k0, n0, drow0, ks, scr, lane);
    }
}
__device__ __forceinline__ void copy_windows(KP p, int gt, int NGT) {
    for (int i = gt; i < NS * 4064; i += NGT) { const int b = i / 4064, o = i % 4064;
        ((f32x4*)(p->out + OFF_SK + (size_t)b * 16384))[o] = ((const f32x4*)(p->in[I_CK] + (size_t)b * 16384 + 128))[o];
        ((f32x4*)(p->out + OFF_SV + (size_t)b * 16384))[o] = ((const f32x4*)(p->in[I_CV] + (size_t)b * 16384 + 128))[o]; }
    for (int i = gt; i < NS * 256; i += NGT) { const int b = i >> 8, o = i & 255;
        ((f32x4*)(p->out + OFF_SCONV + (size_t)b * 1536))[o] = ((const f32x4*)(p->in[I_SCONV] + (size_t)b * 1536 + 512))[o]; }
}
__device__ __forceinline__ void slack_slot(int nwg, int G, int bx, int& slot, int& nslots) {
    const int mx = (nwg + G - 1) / G, first = nwg - (mx - 1) * G;
    if (first >= G) { slot = bx; nslots = G; } else { slot = bx - first; nslots = G - first; }
}
__device__ __forceinline__ void p0_prologue(KP p, LAS unsigned char* lds, int gw, int NGW, int wave, int lane) {
    unsigned char* ws = p->ws;
    convert_items(p, lds, 0, CI_G, gw, NGW, wave, lane);
    {
        const f32x4* g4 = (const f32x4*)p->in[I_N1G] + lane;
        f32x4 g[4];
#pragma unroll
        for (int j = 0; j < 4; ++j) g[j] = g4[64 * j];
        for (int m0 = gw; m0 < MR; m0 += 2 * NGW) {
            f32x4 v[2][4];
#pragma unroll
            for (int rr = 0; rr < 2; ++rr) { const int m = m0 + rr * NGW, mc = m < MR ? m : m0;
                const float* xrow = mc < MP ? p->in[I_XP] + (size_t)mc * DM : p->in[I_XS] + (size_t)(mc - MP) * DM;
                const f32x4* xr = (const f32x4*)xrow + lane;
#pragma unroll
                for (int j = 0; j < 4; ++j) v[rr][j] = xr[64 * j]; }
#pragma unroll
            for (int rr = 0; rr < 2; ++rr) { const int m = m0 + rr * NGW;
                float s = 0.f;
#pragma unroll
                for (int j = 0; j < 4; ++j) s += (v[rr][j].x * v[rr][j].x + v[rr][j].y * v[rr][j].y) + (v[rr][j].z * v[rr][j].z + v[rr][j].w * v[rr][j].w);
                const float rs = frsq(wave_sum(s, lane) * (1.f / DM) + EPS);
                if (m < MR) { u32x2* o8 = (u32x2*)((bf16*)(ws + WS_XN) + (size_t)m * DM) + lane;
#pragma unroll
                    for (int j = 0; j < 4; ++j) { u32x2 w; w.x = pk2(v[rr][j].x * rs * g[j].x, v[rr][j].y * rs * g[j].y); w.y = pk2(v[rr][j].z * rs * g[j].z, v[rr][j].w * rs * g[j].w); o8[64 * j] = w; } }
            }
        }
    }
    const int gt = gw * 64 + lane, NGT = NGW * 64;
    for (int i = gt; i < MPAD; i += NGT) ((float*)(ws + WS_RSQH))[i] = 0.f;
}

__device__ __forceinline__ void row_scan4(float A, float H, float c0, int q, float& cin, float& At, float& Ht) {
    const auto ra = __builtin_amdgcn_permlane16_swap(__float_as_uint(A), __float_as_uint(A), false, false);
    const auto rh = __builtin_amdgcn_permlane16_swap(__float_as_uint(H), __float_as_uint(H), false, false);
    const float Ae = __uint_as_float(ra[0]), Ao = __uint_as_float(ra[1]), He = __uint_as_float(rh[0]), Ho = __uint_as_float(rh[1]);
    const float Ap = Ae * Ao, Hp = Ao * He + Ho;
    const auto pa = __builtin_amdgcn_permlane32_swap(__float_as_uint(Ap), __float_as_uint(Ap), false, false);
    const auto ph = __builtin_amdgcn_permlane32_swap(__float_as_uint(Hp), __float_as_uint(Hp), false, false);
    const float Alo = __uint_as_float(pa[0]), Ahi = __uint_as_float(pa[1]), Hlo = __uint_as_float(ph[0]), Hhi = __uint_as_float(ph[1]);
    const float c2 = Alo * c0 + Hlo, base = (q & 2) ? c2 : c0;
    cin = (q & 1) ? (Ae * base + He) : base;
    At = Alo * Ahi; Ht = Ahi * Hlo + Hhi;
}

constexpr int HS_OFF = 16384, HS_LD = 1032;
#define MFMA16(a, b, c) __builtin_amdgcn_mfma_f32_16x16x32_bf16((a), (b), (c), 0, 0, 0)
#define MFMA32(a, b, c) __builtin_amdgcn_mfma_f32_32x32x16_bf16((a), (b), (c), 0, 0, 0)
typedef float f32x2v __attribute__((ext_vector_type(2)));
constexpr size_t WS_AU = 186 * MiB;
template <bool FINAL>
__device__ __forceinline__ void scan_unit(KP p, int b, int chunk, LAS unsigned char* lds, int wave, int lane) {
    unsigned char* ws = p->ws;
    const bf16* XR = (const bf16*)(ws + WS_XR);
    const bf16* GWT = (const bf16*)(ws + WS_GWT);
    float* SA = (float*)(ws + WS_SUMA); float* SH = (float*)(ws + WS_SUMH);
    f32x2v* AU = (f32x2v*)(ws + WS_AU);
    const LAS float* cw = (const LAS float*)lds;
    const int n = wave, j = lane & 15, q = lane >> 4;
    float hprev[4] = {0.f, 0.f, 0.f, 0.f}, acum[4] = {1.f, 1.f, 1.f, 1.f};
    const size_t au0 = ((size_t)b * TSEQ + chunk * 64 + 4 * q) * 512 + 64 * n + j;
    if constexpr (FINAL) {
        unsigned pfg; { const int t_ = wave * 64 + lane; pfg = *(const unsigned*)((const bf16*)(ws + WS_GR) + ((size_t)b * TSEQ + chunk * 64 + (t_ >> 3)) * 512 + (t_ & 7) * 64); }
        f32x2v au[4][4], aun[4][4];
#define SCAN_LOADAU(dst, sc_) do { _Pragma("unroll") for (int nt = 0; nt < 4; ++nt) _Pragma("unroll") for (int r = 0; r < 4; ++r) dst[nt][r] = AU[au0 + (size_t)((sc_) * 16 + r) * 512 + 16 * nt]; } while (0)
        SCAN_LOADAU(au, 0);
        {
            float As[4] = {1.f, 1.f, 1.f, 1.f}, Hs[4] = {0.f, 0.f, 0.f, 0.f};
            float la[8][4], lh[8][4];
#pragma unroll
            for (int cc = 0; cc < 8; ++cc) { const int c = 8 * q + cc, ce = c < chunk ? c : 0;
#pragma unroll
                for (int nt = 0; nt < 4; ++nt) { const size_t o = (size_t)(b * 32 + ce) * 512 + 64 * n + 16 * nt + j; la[cc][nt] = __hip_atomic_load(SA + o, __ATOMIC_RELAXED, __HIP_MEMORY_SCOPE_AGENT); lh[cc][nt] = __hip_atomic_load(SH + o, __ATOMIC_RELAXED, __HIP_MEMORY_SCOPE_AGENT); } }
#pragma unroll
            for (int cc = 0; cc < 8; ++cc) { const bool ok = (8 * q + cc) < chunk;
#pragma unroll
                for (int nt = 0; nt < 4; ++nt) { const float a = ok ? la[cc][nt] : 1.f, hh = ok ? lh[cc][nt] : 0.f; Hs[nt] = a * Hs[nt] + hh; As[nt] *= a; } }
#pragma unroll
            for (int nt = 0; nt < 4; ++nt) { float cin_, At_, Ht_; row_scan4(As[nt], Hs[nt], 0.f, q, cin_, At_, Ht_); hprev[nt] = Ht_; }
        }
#pragma unroll
        for (int sc = 0; sc < 4; ++sc) {
            if (sc < 3) SCAN_LOADAU(aun, sc + 1);
#pragma unroll
            for (int nt = 0; nt < 4; ++nt) {
                float a4[4], u4[4];
#pragma unroll
                for (int r = 0; r < 4; ++r) { a4[r] = au[nt][r].x; u4[r] = au[nt][r].y; }
                const float A4 = (a4[0] * a4[1]) * (a4[2] * a4[3]);
                const float H4 = ((u4[0] * a4[1] + u4[1]) * a4[2] + u4[2]) * a4[3] + u4[3];
                float cin, At_, Ht_; row_scan4(A4, H4, hprev[nt], q, cin, At_, Ht_);
                hprev[nt] = At_ * hprev[nt] + Ht_;
                LAS bf16* hs = (LAS bf16*)(lds + HS_OFF + (sc * 16 + 4 * q) * HS_LD) + (64 * n + 16 * nt + j);
                float h = cin;
#pragma unroll
                for (int r = 0; r < 4; ++r) { h = a4[r] * h + u4[r]; hs[r * (HS_LD / 2)] = (bf16)(pk2(h, 0.f) & 0xffff); }
            }
#pragma unroll
            for (int nt = 0; nt < 4; ++nt)
#pragma unroll
                for (int r = 0; r < 4; ++r) au[nt][r] = aun[nt][r];
        }
#undef SCAN_LOADAU
        asm volatile("" :: "v"(pfg));
    } else {
    bf16x8 wf[2][4][2];
#pragma unroll
    for (int g = 0; g < 2; ++g)
#pragma unroll
        for (int nt = 0; nt < 4; ++nt)
#pragma unroll
            for (int s = 0; s < 2; ++s) wf[g][nt][s] = *(const bf16x8*)(GWT + ((size_t)(g * 8 + n) * 64 + 16 * nt + j) * 64 + 32 * s + 8 * q);
    bf16x8 idf[2];
#pragma unroll
    for (int e = 0; e < 2; ++e)
#pragma unroll
        for (int jj = 0; jj < 8; ++jj) idf[e][jj] = (16 * e + j - 8 * q == jj) ? (short)0x3F80 : (short)0;
    float ba[4], bx[4], sp[4];
#pragma unroll
    for (int nt = 0; nt < 4; ++nt) { const int ch = 64 * n + 16 * nt + j; ba[nt] = p->in[I_GAB][ch]; bx[nt] = p->in[I_GXB][ch]; sp[nt] = 8.0f * log1pf(__expf(-p->in[I_LAM][ch])) * 1.4426950408889634f; }
#define SCAN_LOADX(dst, sc_) do { const int tok_ = chunk * 64 + (sc_) * 16 + j; \
        _Pragma("unroll") for (int s = 0; s < 2; ++s) _Pragma("unroll") for (int w = 0; w < 4; ++w) { \
            const int tt = tok_ - 3 + w, ttc = tt < 0 ? 0 : tt; \
            u32x4 x = *(const u32x4*)(XR + (size_t)(b * TSEQ + ttc) * 512 + 64 * n + 32 * s + 8 * q); \
            if (tt < 0) x = (u32x4){0u, 0u, 0u, 0u}; dst[s][w] = x; } } while (0)
    u32x4 xcur[2][4], xnext[2][4];
    SCAN_LOADX(xcur, 0);
#pragma unroll
    for (int sc = 0; sc < 4; ++sc) {
        if (sc < 3) SCAN_LOADX(xnext, sc + 1);
        bf16x8 af[2];
#pragma unroll
        for (int s = 0; s < 2; ++s) {
            const int ch0 = 64 * n + 32 * s + 8 * q;
            float a8[8];
            { const f32x4 c0 = *(const LAS f32x4*)(cw + 2048 + ch0), c1 = *(const LAS f32x4*)(cw + 2048 + ch0 + 4);
              a8[0] = c0[0]; a8[1] = c0[1]; a8[2] = c0[2]; a8[3] = c0[3]; a8[4] = c1[0]; a8[5] = c1[1]; a8[6] = c1[2]; a8[7] = c1[3]; }
#pragma unroll
            for (int w = 0; w < 4; ++w) {
                const u32x4 x = xcur[s][w];
                const f32x4 w0 = *(const LAS f32x4*)(cw + w * 512 + ch0), w1 = *(const LAS f32x4*)(cw + w * 512 + ch0 + 4);
                a8[0] += w0[0] * bflo(x.x); a8[1] += w0[1] * bfhi(x.x); a8[2] += w0[2] * bflo(x.y); a8[3] += w0[3] * bfhi(x.y);
                a8[4] += w1[0] * bflo(x.z); a8[5] += w1[1] * bfhi(x.z); a8[6] += w1[2] * bflo(x.w); a8[7] += w1[3] * bfhi(x.w);
            }
            u32x4 pk; pk.x = pk2(a8[0], a8[1]); pk.y = pk2(a8[2], a8[3]); pk.z = pk2(a8[4], a8[5]); pk.w = pk2(a8[6], a8[7]);
            af[s] = __builtin_bit_cast(bf16x8, pk);
        }
#pragma unroll
        for (int nt = 0; nt < 4; ++nt) {
            f32x4 da = {0.f, 0.f, 0.f, 0.f}, dx = {0.f, 0.f, 0.f, 0.f}, xc = {0.f, 0.f, 0.f, 0.f};
            da = MFMA16(af[0], wf[0][nt][0], da); da = MFMA16(af[1], wf[0][nt][1], da);
            dx = MFMA16(af[0], wf[1][nt][0], dx); dx = MFMA16(af[1], wf[1][nt][1], dx);
            xc = MFMA16(af[nt >> 1], idf[nt & 1], xc);
            float a4[4], u4[4];
#pragma unroll
            for (int r = 0; r < 4; ++r) {
                const float ra = sigmoidf_(da[r] + ba[nt]), ix = sigmoidf_(dx[r] + bx[nt]);
                const float a = __builtin_amdgcn_exp2f(-ra * sp[nt]);
                a4[r] = a; u4[r] = fsqrt(fmaxf(1.0f - a * a, 0.f)) * ix * xc[r];
                AU[au0 + (size_t)(sc * 16 + r) * 512 + 16 * nt] = (f32x2v){a4[r], u4[r]};
            }
            const float A4 = (a4[0] * a4[1]) * (a4[2] * a4[3]);
            const float H4 = ((u4[0] * a4[1] + u4[1]) * a4[2] + u4[2]) * a4[3] + u4[3];
            float cin_, At_, Ht_; row_scan4(A4, H4, hprev[nt], q, cin_, At_, Ht_);
            hprev[nt] = At_ * hprev[nt] + Ht_; acum[nt] *= At_;
            asm volatile("" : "+v"(hprev[nt]), "+v"(acum[nt]));
        }
#pragma unroll
        for (int s = 0; s < 2; ++s)
#pragma unroll
            for (int w = 0; w < 4; ++w) xcur[s][w] = xnext[s][w];
    }
#undef SCAN_LOADX
    }
    if (!FINAL) {
        if (q == 0) {
#pragma unroll
            for (int nt = 0; nt < 4; ++nt) { const int ch = 64 * n + 16 * nt + j; const size_t o = (size_t)(b * 32 + chunk) * 512 + ch;
                __hip_atomic_store(SA + o, acum[nt], __ATOMIC_RELAXED, __HIP_MEMORY_SCOPE_AGENT); __hip_atomic_store(SH + o, hprev[nt], __ATOMIC_RELAXED, __HIP_MEMORY_SCOPE_AGENT); }
        }
    } else {
        if (chunk == 31 && q == 0) {
#pragma unroll
            for (int nt = 0; nt < 4; ++nt) p->out[OFF_PH + (size_t)b * 512 + 64 * n + 16 * nt + j] = hprev[nt];
        }
        __syncthreads();
        const bf16* GR = (const bf16*)(ws + WS_GR);
        bf16* MIX = (bf16*)(ws + WS_MIX);
        const f32x4 g0 = *(const f32x4*)(p->in[I_RNG] + 8 * lane), g1 = *(const f32x4*)(p->in[I_RNG] + 8 * lane + 4);
        u32x4 grv[8];
#pragma unroll
        for (int tt = 0; tt < 8; ++tt) grv[tt] = *(const u32x4*)(GR + ((size_t)b * TSEQ + chunk * 64 + wave * 8 + tt) * 512 + 8 * lane);
#pragma unroll
        for (int tt = 0; tt < 8; ++tt) {
            const int tl = wave * 8 + tt;
            const size_t row = (size_t)b * TSEQ + chunk * 64 + tl;
            const LAS u32x2* hp = (const LAS u32x2*)(lds + HS_OFF + tl * HS_LD + 16 * lane);
            const u32x2 h0 = hp[0], h1 = hp[1];
            const u32x4 gr = grv[tt];
            float rc[8];
            rc[0] = bflo(h0.x) * gelu_tanh(bflo(gr.x)); rc[1] = bfhi(h0.x) * gelu_tanh(bfhi(gr.x)); rc[2] = bflo(h0.y) * gelu_tanh(bflo(gr.y)); rc[3] = bfhi(h0.y) * gelu_tanh(bfhi(gr.y));
            rc[4] = bflo(h1.x) * gelu_tanh(bflo(gr.z)); rc[5] = bfhi(h1.x) * gelu_tanh(bfhi(gr.z)); rc[6] = bflo(h1.y) * gelu_tanh(bflo(gr.w)); rc[7] = bfhi(h1.y) * gelu_tanh(bfhi(gr.w));
            float ss = 0.f;
#pragma unroll
            for (int e = 0; e < 8; ++e) ss += rc[e] * rc[e];
            const float rn = frsq(wave_sum(ss, lane) * (1.0f / DREC) + EPS);
            u32x4 w; w.x = pk2(rc[0] * rn * g0[0], rc[1] * rn * g0[1]); w.y = pk2(rc[2] * rn * g0[2], rc[3] * rn * g0[3]);
            w.z = pk2(rc[4] * rn * g1[0], rc[5] * rn * g1[1]); w.w = pk2(rc[6] * rn * g1[2], rc[7] * rn * g1[3]);
            *(u32x4*)(MIX + row * DM + 8 * lane) = w;
        }
        __syncthreads();
    }
}

constexpr int AT_KLD = 272, AT_VLD = 336, AT_OLD = 1040;
constexpr int AT_K = 0, AT_V = AT_K + 160 * AT_KLD, AT_RED = AT_V + 128 * AT_VLD, AT_END = AT_RED + 1024;
static_assert(32 * AT_OLD <= AT_V && 12288 + AT_END <= 131072, "attention LDS map");
__device__ __forceinline__ void attn_unit(KP p, int b, int qt, LAS unsigned char* lds, int wave, int lane) {
    unsigned char* ws = p->ws;
    const bf16* Q = (const bf16*)(ws + WS_Q); const bf16* KB = (const bf16*)(ws + WS_KB); const bf16* VT = (const bf16*)(ws + WS_VT);
    bf16* MIX = (bf16*)(ws + WS_MIX);
    LAS float* red = (LAS float*)(lds + AT_RED);
    const int r = lane & 31, h = lane >> 5, kvh = wave >> 2, q0 = qt * 32, tid = wave * 64 + lane;
    const size_t rowq = (size_t)b * TSEQ + q0 + r;
    __syncthreads();
    bf16x8 qf[4];
#pragma unroll
    for (int s = 0; s < 4; ++s) qf[s] = *(const bf16x8*)(Q + rowq * 512 + wave * 64 + 16 * s + 8 * h);
    {
        u32x4 kv[5], vv[5];
#pragma unroll
        for (int i = 0; i < 5; ++i) { const int id = tid + 512 * i, row = id >> 4, c16 = id & 15; int g = q0 - 128 + row; g = g < 0 ? 0 : g;
            kv[i] = *(const u32x4*)(KB + ((size_t)b * TSEQ + g) * 128 + c16 * 8); }
#pragma unroll
        for (int i = 0; i < 5; ++i) { const int id = tid + 512 * i, row = id / 20, cc = id % 20; int k0 = q0 - 128 + 8 * cc; k0 = k0 < 0 ? 0 : k0;
            vv[i] = *(const u32x4*)(VT + ((size_t)b * 128 + row) * TSEQ + k0); }
#pragma unroll
        for (int i = 0; i < 5; ++i) { const int id = tid + 512 * i, row = id >> 4, c16 = id & 15; *(LAS u32x4*)(lds + AT_K + row * AT_KLD + c16 * 16) = kv[i]; }
#pragma unroll
        for (int i = 0; i < 5; ++i) { const int id = tid + 512 * i, row = id / 20, cc = id % 20; *(LAS u32x4*)(lds + AT_V + row * AT_VLD + cc * 16) = vv[i]; }
    }
    __syncthreads();
    const int pr = (r & ~12) | ((r & 4) << 1) | ((r & 8) >> 1);
    f32x16 S[5];
#pragma unroll
    for (int kt = 0; kt < 5; ++kt) {
#pragma unroll
        for (int i = 0; i < 16; ++i) S[kt][i] = 0.f;
#pragma unroll
        for (int s = 0; s < 4; ++s) {
            const bf16x8 kf = *(const LAS bf16x8*)(lds + AT_K + (32 * kt + pr) * AT_KLD + kvh * 128 + (16 * s + 8 * h) * 2);
            S[kt] = MFMA32(kf, qf[s], S[kt]);
        }
    }
    const float sink = p->in[I_SINK][wave];
    float m = sink;
#pragma unroll
    for (int kt = 0; kt < 5; ++kt) {
        const int kbase = q0 - 128 + 32 * kt;
#pragma unroll
        for (int i = 0; i < 16; ++i) {
            const int kl = 16 * (i >> 3) + 8 * h + (i & 7);
            bool valid = kbase >= 0;
            if (kt == 0) valid = valid && (kl >= r);
            if (kt == 4) valid = valid && (kl <= r);
            const float sv = valid ? S[kt][i] : -INFINITY;
            S[kt][i] = sv; m = fmaxf(m, sv);
        }
    }
    m = fmaxf(m, shx(m, 32, lane));
    float l = 0.f;
#pragma unroll
    for (int kt = 0; kt < 5; ++kt)
#pragma unroll
        for (int i = 0; i < 16; ++i) { const float pv = fexp(S[kt][i] - m); S[kt][i] = pv; l += pv; }
    l += shx(l, 32, lane);
    const float inv = frcp(l + fexp(sink - m));
    f32x16 O[2];
#pragma unroll
    for (int dt = 0; dt < 2; ++dt)
#pragma unroll
        for (int i = 0; i < 16; ++i) O[dt][i] = 0.f;
#pragma unroll
    for (int kt = 0; kt < 5; ++kt) {
#pragma unroll
        for (int s2 = 0; s2 < 2; ++s2) {
            u32x4 pk; pk.x = pk2(S[kt][8 * s2 + 0], S[kt][8 * s2 + 1]); pk.y = pk2(S[kt][8 * s2 + 2], S[kt][8 * s2 + 3]);
            pk.z = pk2(S[kt][8 * s2 + 4], S[kt][8 * s2 + 5]); pk.w = pk2(S[kt][8 * s2 + 6], S[kt][8 * s2 + 7]);
            const bf16x8 pb = __builtin_bit_cast(bf16x8, pk);
#pragma unroll
            for (int dt = 0; dt < 2; ++dt) {
                const bf16x8 vf = *(const LAS bf16x8*)(lds + AT_V + (kvh * 64 + 32 * dt + r) * AT_VLD + (32 * kt + 16 * s2 + 8 * h) * 2);
                O[dt] = MFMA32(vf, pb, O[dt]);
            }
        }
    }
    float ss = 0.f;
#pragma unroll
    for (int dt = 0; dt < 2; ++dt)
#pragma unroll
        for (int i = 0; i < 16; ++i) { O[dt][i] *= inv; ss += O[dt][i] * O[dt][i]; }
    ss += shx(ss, 32, lane);
    if (h == 0) red[wave * 32 + r] = ss;
    __syncthreads();
    float tot = 0.f;
#pragma unroll
    for (int w = 0; w < 8; ++w) tot += red[w * 32 + r];
    const float rn = frsq(tot * (1.0f / DATT) + EPS);
#pragma unroll
    for (int dt = 0; dt < 2; ++dt)
#pragma unroll
        for (int g4 = 0; g4 < 4; ++g4) {
            const int d = 32 * dt + 8 * g4 + 4 * h;
            const f32x4 gg = *(const f32x4*)(p->in[I_ANG] + wave * 64 + d);
            u32x2 w; w.x = pk2(O[dt][4 * g4 + 0] * rn * gg[0], O[dt][4 * g4 + 1] * rn * gg[1]); w.y = pk2(O[dt][4 * g4 + 2] * rn * gg[2], O[dt][4 * g4 + 3] * rn * gg[3]);
            *(LAS u32x2*)(lds + AT_K + r * AT_OLD + (wave * 64 + d) * 2) = w;
        }
    __syncthreads();
#pragma unroll
    for (int i = 0; i < 4; ++i) { const int id = tid + 512 * i, row = id >> 6, cc = id & 63;
        *(u32x4*)(MIX + ((size_t)b * TSEQ + q0 + row) * DM + 512 + cc * 8) = *(const LAS u32x4*)(lds + AT_K + row * AT_OLD + cc * 16); }
    __syncthreads();
}

__device__ __forceinline__ void sample_unit(KP p, int b, LAS unsigned char* lds, int tid, int wave, int lane) {
    unsigned char* ws = p->ws;
    const size_t row = (size_t)MP + b;
    bf16* MIX = (bf16*)(ws + WS_MIX);
    LAS float* xs = (LAS float*)(lds + 12288);
    LAS float* redw = (LAS float*)(lds + 12288 + 2048);
    LAS float* qs = (LAS float*)(lds + 12288 + 4096);
    LAS float* ps = (LAS float*)(lds + 12288 + 8192);
    __syncthreads();
    {
        const int c = tid;
        const float* sc = p->in[I_SCONV] + (size_t)b * 1536;
        const float* cwg = p->in[I_CONVW];
        const float xr = p->out[OFF_SCONV + (size_t)(b * 3 + 2) * 512 + c];
        const float xc = p->in[I_CONVB][c] + sc[c] * cwg[c] + sc[512 + c] * cwg[512 + c] + sc[1024 + c] * cwg[1024 + c] + xr * cwg[1536 + c];
        xs[c] = xc;
        __syncthreads();
        const int n = c >> 6, jj = c & 63;
        const float* wa = p->in[I_GAW] + n * 4096 + jj; const float* wx = p->in[I_GXW] + n * 4096 + jj;
        float ya = p->in[I_GAB][c], yx = p->in[I_GXB][c];
#pragma unroll
        for (int hb = 0; hb < 2; ++hb) {
            float wa_[32], wx_[32];
#pragma unroll
            for (int i = 0; i < 32; ++i) { wa_[i] = wa[(hb * 32 + i) * 64]; wx_[i] = wx[(hb * 32 + i) * 64]; }
#pragma unroll
            for (int i = 0; i < 32; ++i) { const float xv = xs[64 * n + hb * 32 + i]; ya += xv * wa_[i]; yx += xv * wx_[i]; }
        }
        const float ra = sigmoidf_(ya), ix = sigmoidf_(yx);
        const float la = -8.0f * ra * log1pf(__expf(-p->in[I_LAM][c]));
        const float a = __expf(la);
        const float u = fsqrt(fmaxf(1.0f - a * a, 0.f)) * ix * xc;
        const float hn = a * p->in[I_SH][(size_t)b * 512 + c] + u;
        p->out[OFF_SH + (size_t)b * 512 + c] = hn;
        const float gr = bf1(((const bf16*)(ws + WS_GR))[row * 512 + c]);
        const float rec = hn * gelu_tanh(gr);
        const float ssw = wave_sum(rec * rec, lane);
        if (lane == 0) redw[wave] = ssw;
        __syncthreads();
        float tot = 0.f;
#pragma unroll
        for (int w = 0; w < 8; ++w) tot += redw[w];
        const float rn = frsq(tot * (1.0f / DREC) + EPS);
        { const float mv = rec * rn * p->in[I_RNG][c], mo = shx(mv, 1, lane);
          if ((lane & 1) == 0) __hip_atomic_store((unsigned*)(MIX + row * DM + c), pk2(mv, mo), __ATOMIC_RELAXED, __HIP_MEMORY_SCOPE_AGENT); }
    }
    {
        const int kvh = wave >> 2;
        const float qd = bf1(((const bf16*)(ws + WS_Q))[row * 512 + wave * 64 + lane]);
        qs[wave * 64 + lane] = qd;
        const float* kself = p->out + OFF_SK + (size_t)(b * 128 + 127) * 128 + kvh * 64;
        const float* vself = p->out + OFF_SV + (size_t)(b * 128 + 127) * 128 + kvh * 64;
        const float sself = wave_sum(qd * kself[lane], lane);
        asm volatile("s_waitcnt lgkmcnt(0)" ::: "memory");
        const float* kc = p->in[I_CK] + (size_t)b * 16384 + kvh * 64;
        float s0 = 0.f, s1 = 0.f;
        const f32x4* k0 = (const f32x4*)(kc + (size_t)lane * 128);
        const f32x4* k1 = (const f32x4*)(kc + (size_t)(lane + 64) * 128);
        const LAS f32x4* q4 = (const LAS f32x4*)(qs + wave * 64);
        {
            f32x4 ka[16], kb2[16];
#pragma unroll
            for (int i = 0; i < 16; ++i) { ka[i] = k0[i]; kb2[i] = k1[i]; }
#pragma unroll
            for (int i = 0; i < 16; ++i) { const f32x4 qq = q4[i], a0 = ka[i], a1 = kb2[i];
                s0 += (qq[0] * a0[0] + qq[1] * a0[1]) + (qq[2] * a0[2] + qq[3] * a0[3]);
                s1 += (qq[0] * a1[0] + qq[1] * a1[1]) + (qq[2] * a1[2] + qq[3] * a1[3]); }
        }
        const float sink = p->in[I_SINK][wave];
        const float m = fmaxf(fmaxf(wave_max(fmaxf(s0, s1), lane), sself), sink);
        const float p0 = __expf(s0 - m), p1 = __expf(s1 - m), pself = __expf(sself - m);
        const float den = wave_sum(p0 + p1, lane) + pself + __expf(sink - m);
        ps[wave * 128 + lane] = p0; ps[wave * 128 + 64 + lane] = p1;
        asm volatile("s_waitcnt lgkmcnt(0)" ::: "memory");
        const int kg = lane >> 4, d4 = lane & 15;
        const float* vc = p->in[I_CV] + (size_t)b * 16384 + kvh * 64 + 4 * d4;
        f32x4 o4 = {0.f, 0.f, 0.f, 0.f};
#pragma unroll
        for (int hb = 0; hb < 2; ++hb) {
            f32x4 vv[16];
#pragma unroll
            for (int i = 0; i < 16; ++i) vv[i] = *(const f32x4*)(vc + (size_t)(kg + 4 * (hb * 16 + i)) * 128);
#pragma unroll
            for (int i = 0; i < 16; ++i) o4 = o4 + vv[i] * ps[wave * 128 + kg + 4 * (hb * 16 + i)];
        }
#pragma unroll
        for (int e = 0; e < 4; ++e) { o4[e] += shx(o4[e], 16, lane); o4[e] += shx(o4[e], 32, lane); }
        o4 = (o4 + *(const f32x4*)(vself + 4 * d4) * pself) * (1.0f / den);
        const float ssw = wave_sum((o4[0] * o4[0] + o4[1] * o4[1]) + (o4[2] * o4[2] + o4[3] * o4[3]), lane) * 0.25f;
        if (lane == 0) redw[8 + wave] = ssw;
        __syncthreads();
        float tot = 0.f;
#pragma unroll
        for (int w = 0; w < 8; ++w) tot += redw[8 + w];
        const float rn = frsq(tot * (1.0f / DATT) + EPS);
        if (kg == 0) { const f32x4 gg = *(const f32x4*)(p->in[I_ANG] + wave * 64 + 4 * d4);
            u32x2 w; w.x = pk2(o4[0] * rn * gg[0], o4[1] * rn * gg[1]); w.y = pk2(o4[2] * rn * gg[2], o4[3] * rn * gg[3]);
            unsigned* mp = (unsigned*)(MIX + row * DM + 512 + wave * 64 + 4 * d4);
            __hip_atomic_store(mp, w.x, __ATOMIC_RELAXED, __HIP_MEMORY_SCOPE_AGENT); __hip_atomic_store(mp + 1, w.y, __ATOMIC_RELAXED, __HIP_MEMORY_SCOPE_AGENT); }
    }
    __syncthreads();
}


template <int MODE>
__device__ __forceinline__ void small_gemm_task(KP p, const bf16* __restrict__ A, const bf16* __restrict__ Bt, int K, int n0, LAS unsigned char* lds, int wave, int lane) {
    const int r = lane & 31, h = lane >> 5, mt = wave & 3, kh = wave >> 2, Kh = K >> 1;
    const bf16* ap = A + (size_t)(32 * mt + r) * K + kh * Kh + 64 * h;
    const bf16* bp = Bt + (size_t)(n0 + r) * K + kh * Kh + 64 * h;
    f32x16 acc;
#pragma unroll
    for (int i = 0; i < 16; ++i) acc[i] = 0.f;
    bf16x8 a[8], b[8], an[8], bn[8];
#pragma unroll
    for (int i = 0; i < 8; ++i) { a[i] = *(const bf16x8*)(ap + 8 * i); b[i] = *(const bf16x8*)(bp + 8 * i); }
    for (int k = 0; k < Kh; k += 128) {
        const int kn = (k + 128 < Kh) ? k + 128 : k;
#pragma unroll
        for (int i = 0; i < 8; ++i) { an[i] = *(const bf16x8*)(ap + kn + 8 * i); bn[i] = *(const bf16x8*)(bp + kn + 8 * i); }
#pragma unroll
        for (int i = 0; i < 8; ++i) acc = MFMA32(a[i], b[i], acc);
#pragma unroll
        for (int i = 0; i < 8; ++i) { a[i] = an[i]; b[i] = bn[i]; }
    }
    LAS float* red = (LAS float*)lds;
    __syncthreads();
    if (kh == 1) {
#pragma unroll
        for (int i = 0; i < 16; ++i) red[(mt * 16 + i) * 64 + lane] = acc[i];
    }
    __syncthreads();
    if (kh == 0) {
        float* H = p->out; const int c = n0 + r;
#pragma unroll
        for (int i = 0; i < 16; ++i) {
            const int rs = 32 * mt + (i & 3) + 8 * (i >> 2) + 4 * h;
            float v = acc[i] + red[(mt * 16 + i) * 64 + lane];
            float* hp = H + (size_t)(MP + rs) * DM + c;
            if (MODE == 0) {
                v += p->in[I_XS][(size_t)rs * DM + c];
                *hp = v;
                ((bf16*)(p->ws + WS_HB))[(size_t)(MP + rs) * DM + c] = (bf16)(pk2(v, 0.f) & 0xffff);
                float s = v * v;
                s += shx(s, 1, lane); s += shx(s, 2, lane); s += shx(s, 4, lane); s += shx(s, 8, lane); s += shx(s, 16, lane);
                if (r == 0) atomicAdd((float*)(p->ws + WS_RSQH) + MP + rs, s);
            } else {
                *hp = *hp + v;
            }
        }
    }
    __syncthreads();
}

#define XB_TMO      128
#define XB_XCNT(j)  (256  + 64 * (j))
#define XB_XSUB(j)  (1280 + 64 * (j))
#define XB_XGEN(j)  (2304 + 64 * (j))
#define XB_TOP      3328
#define XB_TOPGEN   3392
#define XCD_BAR_WORDS 3456
#define XB_SPIN_CAP (1u << 18)

__device__ __forceinline__ unsigned xb_ld(unsigned* p)              { return __hip_atomic_load(p, __ATOMIC_RELAXED, __HIP_MEMORY_SCOPE_AGENT); }
__device__ __forceinline__ unsigned xb_add(unsigned* p, unsigned v) { return __hip_atomic_fetch_add(p, v, __ATOMIC_RELAXED, __HIP_MEMORY_SCOPE_AGENT); }
__device__ __forceinline__ unsigned xb_xcc_id() { return (unsigned)__builtin_amdgcn_s_getreg((3 << 11) | 20) & 0xFu; }
#define XB_SPIN(cond, bar) do { unsigned _sp = 0; while (cond) { __builtin_amdgcn_s_sleep(1); \
    if ((++_sp & 255u) == 0u) { if (xb_ld(&(bar)[XB_TMO])) break; if (_sp > XB_SPIN_CAP) { atomicAdd(&(bar)[XB_TMO], 1u); break; } } } } while (0)

struct XcdBarrier {
    unsigned* bar; unsigned x;
    volatile LAS unsigned* st;
};

__device__ __forceinline__ XcdBarrier xcd_barrier_post(unsigned* bar, volatile LAS unsigned* st) {
    XcdBarrier b; b.bar = bar; b.x = xb_xcc_id(); b.st = st;
    if (threadIdx.x == 0) (void)xb_add(&bar[XB_XCNT(b.x)], 1u);
    return b;
}
__device__ __forceinline__ void xcd_barrier_complete(unsigned* bar, unsigned x, unsigned& nloc, unsigned& nx) {
    const unsigned G = gridDim.x * gridDim.y * gridDim.z;
    unsigned sum, cnt, mine, sp = 0u;
    for (;;) {
        sum = 0u; cnt = 0u; mine = 0u;
#pragma unroll
        for (unsigned j = 0; j < 16; ++j) { const unsigned c = xb_ld(&bar[XB_XCNT(j)]); sum += c; cnt += (c > 0u) ? 1u : 0u; mine = (j == x) ? c : mine; }
        if (sum == G) break;
        __builtin_amdgcn_s_sleep(1);
        if ((++sp & 255u) == 0u) { if (xb_ld(&bar[XB_TMO])) break; if (sp > XB_SPIN_CAP) { atomicAdd(&bar[XB_TMO], 1u); break; } }
    }
    nloc = mine > 0u ? mine : 1u; nx = cnt > 0u ? cnt : 1u;
}

__device__ __forceinline__ void xcd_barrier(const XcdBarrier& b) {
    asm volatile("s_waitcnt vmcnt(0)" ::: "memory");
    __syncthreads();
    if (threadIdx.x == 0) {
        unsigned* bar = b.bar;
        __builtin_amdgcn_s_waitcnt(0);
        unsigned nloc = b.st[0], nx = b.st[1];
        if (nloc == 0u) { xcd_barrier_complete(bar, b.x, nloc, nx); b.st[0] = nloc; b.st[1] = nx; }
        const unsigned old = xb_add(&bar[XB_XSUB(b.x)], 1u);
        const unsigned gen = old / nloc;
        if (old + 1u == (gen + 1u) * nloc) {
            __builtin_amdgcn_fence(__ATOMIC_RELEASE, "agent");
            asm volatile("s_waitcnt vmcnt(0)" ::: "memory");
            const unsigned og = xb_add(&bar[XB_TOP], 1u);
            const unsigned tg = og / nx;
            if (og + 1u == (tg + 1u) * nx) xb_add(&bar[XB_TOPGEN], 1u);
            else XB_SPIN(xb_ld(&bar[XB_TOPGEN]) == tg, bar);
            __builtin_amdgcn_fence(__ATOMIC_ACQUIRE, "agent");
            xb_add(&bar[XB_XGEN(b.x)], 1u);
            asm volatile("s_waitcnt vmcnt(0)" ::: "memory");
        } else {
            XB_SPIN(xb_ld(&bar[XB_XGEN(b.x)]) == gen, bar);
            __builtin_amdgcn_fence(__ATOMIC_ACQUIRE, "agent");
            asm volatile("s_waitcnt vmcnt(0)" ::: "memory");
        }
    }
    __syncthreads();
}

#ifndef REP_P0
#define REP_P0 1
#endif
#ifndef REP_P1
#define REP_P1 1
#endif
#ifndef REP_P4
#define REP_P4 1
#endif
#ifndef REP_SYNC
#define REP_SYNC 0
#endif
#ifndef PROBE_P3
#define PROBE_P3 0
#endif
#ifndef PROBE_P5
#define PROBE_P5 0
#endif
#ifndef PROBE_P6
#define PROBE_P6 0
#endif
#ifndef STAMP_A
#define STAMP_A -1
#define STAMP_B -1
#endif
#ifndef STAMP_MULT
#define STAMP_MULT 4
#endif
#ifndef REP_ALL
#define REP_ALL 1
#endif
#ifndef REP_P2
#define REP_P2 1
#endif
#ifndef REP_P2B
#define REP_P2B 1
#endif
__device__ __forceinline__ void fwd_body(LAS unsigned char* lds, const XcdBarrier& bar);
__global__ void __launch_bounds__(NTHR, 2) fwd_megakernel(Params p_unused) {
    extern __shared__ __attribute__((aligned(16))) unsigned char lds_[];
    cg::grid_group grid = cg::this_grid();
    LAS unsigned char* lds = (LAS unsigned char*)lds_;
    if (threadIdx.x < 2) ((LAS unsigned*)(lds + 131072))[threadIdx.x] = 0u;
    __syncthreads();
    XcdBarrier bar;
    { KP p = kargs(); unsigned char* ws = p->ws;
      if (ws == nullptr) grid.sync();
      bar = xcd_barrier_post(g_ctl, (volatile LAS unsigned*)(lds + 131072)); }
#define GRID_SYNC() xcd_barrier(bar)
    fwd_body(lds, bar);
    asm volatile("s_waitcnt vmcnt(0)" ::: "memory");
    __syncthreads();
    LAS unsigned* lf = (LAS unsigned*)(lds + 131072 + 16);
    if (threadIdx.x == 0) { const unsigned old = atomicAdd(&g_ctl[CW_DONE], 1u); *lf = (old + 1u == gridDim.x) ? 1u : 0u; }
    __syncthreads();
    if (*lf) { for (int i = threadIdx.x; i < CTL_WORDS; i += NTHR) g_ctl[i] = 0u; }
}
__device__ __forceinline__ void fwd_body(LAS unsigned char* lds, const XcdBarrier& bar) {
    const int G = gridDim.x, bx = blockIdx.x;
#define STAMP(i) do { if (STAMP_A >= 0 && blockIdx.x == 0 && threadIdx.x == 0) ((LAS unsigned long long*)(lds + 131072 + 64))[i] = __builtin_amdgcn_s_memrealtime(); } while (0)
    STAMP(0);
#define PHASE_IDS int tid_ = threadIdx.x; asm volatile("" : "+v"(tid_)); const int tid = tid_, lane = tid & 63, wave = __builtin_amdgcn_readfirstlane(tid >> 6); (void)tid; (void)lane; (void)wave;

    for (int rep = 0; rep < REP_P0; ++rep) { PHASE_IDS KP p = kargs(); p0_prologue(p, lds, bx * NWAVES + wave, G * NWAVES, wave, lane); }
    GRID_SYNC();
    STAMP(1);

    for (int rep = 0; rep < REP_SYNC; ++rep) GRID_SYNC();
    for (int rep = 0; rep < REP_P1; ++rep) {
        KP p = kargs(); unsigned char* ws = p->ws;
        pg8::Gemm g{(const bf16*)(ws + WS_XN), (const bf16*)(ws + WS_WIN), MPAD, DIN, DM}; pg8::StaticOrder S; S.init(MPAD, DIN, G, bx);
        EpiIn E{ws, p->out};
        pg8::gemm_phase<EpiIn, pg8::StaticOrder, true, true>(lds, g, S, E);
        { PHASE_IDS int slot, ns; slack_slot((MPAD / 256) * (DIN / 256), G, bx, slot, ns);
          if (slot >= 0) convert_items(p, lds, CI_G, CI_WU, slot * NWAVES + wave, ns * NWAVES, wave, lane); }
    }
    GRID_SYNC();
    STAMP(2);

    {
        PHASE_IDS KP p = kargs();
        for (int i = tid; i < 2560; i += NTHR) ((LAS float*)lds)[i] = i < 2048 ? p->in[I_CONVW][i] : p->in[I_CONVB][i - 2048];
        __syncthreads();
        unsigned* cw = g_ctl;
        for (int u = bx; u < 1184; u += G) {
            int tl_ = threadIdx.x; asm volatile("" : "+v"(tl_)); const int tid = tl_, lane = tl_ & 63;
            if (u < 128) { sample_unit(p, u, lds, tid, wave, lane); asm volatile("s_waitcnt vmcnt(0)" ::: "memory"); __syncthreads(); if (tid == 0) atomicAdd(cw + CW_S1, 1u); }
            else if (u < 384) { const int k = u - 128; scan_unit<false>(p, k >> 5, k & 31, lds, wave, lane); asm volatile("s_waitcnt vmcnt(0)" ::: "memory"); __syncthreads(); if (tid == 0) atomicAdd(cw + CW_SCAN + 64 * (k >> 5), 1u); }
            else if (u < 896) { const int a = u - 384; attn_unit(p, a >> 6, a & 63, lds + 12288, wave, lane); }
            else if (u < 1152) { const int k = u - 896;
                if (tid == 0) { unsigned sp = 0; while (__hip_atomic_load(cw + CW_SCAN + 64 * (k >> 5), __ATOMIC_RELAXED, __HIP_MEMORY_SCOPE_AGENT) < 32u) { __builtin_amdgcn_s_sleep(4); if (++sp > (1u << 22)) break; } }
                __syncthreads(); __builtin_amdgcn_fence(__ATOMIC_ACQUIRE, "agent");
                scan_unit<true>(p, k >> 5, k & 31, lds, wave, lane); }
            else {
                if (tid == 0) { unsigned sp = 0; while (__hip_atomic_load(cw + CW_S1, __ATOMIC_RELAXED, __HIP_MEMORY_SCOPE_AGENT) < 128u) { __builtin_amdgcn_s_sleep(4); if (++sp > (1u << 22)) break; } }
                __syncthreads(); __builtin_amdgcn_fence(__ATOMIC_ACQUIRE, "agent");
                small_gemm_task<0>(p, (const bf16*)(p->ws + WS_MIX) + (size_t)MP * DM, (const bf16*)(p->ws + WS_WOUT), DM, 32 * (u - 1152), lds, wave, lane);
            }
        }
    }
    GRID_SYNC();
    STAMP(4);

    {
        KP p = kargs(); unsigned char* ws = p->ws;
        pg8::Gemm g{(const bf16*)(ws + WS_MIX), (const bf16*)(ws + WS_WOUT), MP, DM, DM}; pg8::StaticOrder S; S.init(MP, DM, G, bx);
        if (PROBE_P3) { EpiOut E0{p->in[I_XP], p->in[I_XS], (float*)(ws + 92 * MiB), ws + 128 * MiB}; pg8::gemm_phase<EpiOut, pg8::StaticOrder, true, true>(lds, g, S, E0); }
        EpiOut E{p->in[I_XP], p->in[I_XS], p->out, ws};
        pg8::gemm_phase<EpiOut, pg8::StaticOrder, true, true>(lds, g, S, E);
    }
    GRID_SYNC();
    STAMP(5);

    for (int rep = 0; rep < REP_P4; ++rep) {
        KP p = kargs(); unsigned char* ws = p->ws;
        pg8::Gemm g{(const bf16*)(ws + WS_HB), (const bf16*)(ws + WS_WGU), MPAD, 2 * DFF, DM}; pg8::StaticOrder S; S.init(MPAD, 2 * DFF, G, bx);
        EpiGU E{ws};
        pg8::gemm_phase<EpiGU, pg8::StaticOrder, true, true>(lds, g, S, E);
        { PHASE_IDS int slot, ns; slack_slot((MPAD / 256) * (2 * DFF / 256), G, bx, slot, ns);
          if (slot >= 0) { convert_items(p, lds, CI_WU, CI_WD, slot * NWAVES + wave, ns * NWAVES, wave, lane);
                           copy_windows(p, (slot * NWAVES + wave) * 64 + lane, ns * NWAVES * 64); } }
    }
    GRID_SYNC();
    STAMP(6);

    {
        KP p = kargs(); unsigned char* ws = p->ws;
        pg8::Gemm g{(const bf16*)(ws + WS_FF), (const bf16*)(ws + WS_WD), MP, DM, DFF}; pg8::StaticOrder S; S.init(MP, DM, G, bx);
        EpiDownFused E{ws, p->out, p->in[I_FNG]};
        pg8::gemm_phase<EpiDownFused, pg8::StaticOrder, false, true>(lds, g, S, E);
        { PHASE_IDS
          int ndone = 0;
          for (int u = bx; u < 32; u += G) { small_gemm_task<1>(p, (const bf16*)(ws + WS_FF) + (size_t)MP * DFF, (const bf16*)(ws + WS_WD), DFF, 32 * u, lds, wave, lane); ++ndone; }
          if (ndone) {
              __threadfence(); __syncthreads();
              LAS unsigned* flag = (LAS unsigned*)(lds + 8192);
              if (tid == 0) { const unsigned old = atomicAdd(g_ctl + CW_SAMPLE, (unsigned)ndone); *flag = (old + (unsigned)ndone == 32u) ? 1u : 0u; }
              __syncthreads();
              if (*flag) {
                  __builtin_amdgcn_fence(__ATOMIC_ACQUIRE, "agent");
                  const f32x4* g4 = (const f32x4*)p->in[I_FNG] + lane;
                  f32x4 gq[4];
#pragma unroll
                  for (int j = 0; j < 4; ++j) gq[j] = g4[64 * j];
                  for (int m0 = MP + wave; m0 < MR; m0 += 4 * NWAVES) {
                      f32x4 v[4][4];
#pragma unroll
                      for (int q = 0; q < 4; ++q) { const f32x4* yr = (const f32x4*)(p->out + (size_t)(m0 + q * NWAVES) * DM) + lane;
#pragma unroll
                          for (int j = 0; j < 4; ++j) v[q][j] = yr[64 * j]; }
#pragma unroll
                      for (int q = 0; q < 4; ++q) { float s = 0.f;
#pragma unroll
                          for (int j = 0; j < 4; ++j) s += (v[q][j].x * v[q][j].x + v[q][j].y * v[q][j].y) + (v[q][j].z * v[q][j].z + v[q][j].w * v[q][j].w);
                          const float rs = frsq(wave_sum(s, lane) * (1.f / DM) + EPS);
                          f32x4* yw = (f32x4*)(p->out + (size_t)(m0 + q * NWAVES) * DM) + lane;
#pragma unroll
                          for (int j = 0; j < 4; ++j) yw[64 * j] = v[q][j] * rs * gq[j]; }
                  }
              }
          }
        }
    }
    STAMP(7);
    STAMP(8);
    if (STAMP_A >= 0 && blockIdx.x == 0 && threadIdx.x == 0) {
        const LAS unsigned long long* ts = (const LAS unsigned long long*)(lds + 131072 + 64);
        const unsigned long long d = (ts[STAMP_B < 0 ? 0 : STAMP_B] - ts[STAMP_A < 0 ? 0 : STAMP_A]) * STAMP_MULT, t0 = __builtin_amdgcn_s_memrealtime();
        while (__builtin_amdgcn_s_memrealtime() - t0 < d) __builtin_amdgcn_s_sleep(16);
    }
}

extern "C" void kernel_launch(void* const* d_in, const int* in_sizes, int n_in, void* d_out, int out_size, void* d_ws, size_t ws_size, hipStream_t stream) {
    static int grid = 0;
    if (grid == 0) {
        int dev = 0, cus = 0, per_cu = 0;
        hipGetDevice(&dev);
        hipDeviceGetAttribute(&cus, hipDeviceAttributeMultiprocessorCount, dev);
        hipFuncSetAttribute((const void*)fwd_megakernel, hipFuncAttributeMaxDynamicSharedMemorySize, LDS_BYTES);
        hipOccupancyMaxActiveBlocksPerMultiprocessor(&per_cu, (const void*)fwd_megakernel, NTHR, LDS_BYTES);
        if (per_cu < 1) { fprintf(stderr, "kernel_launch: occupancy query says %d blocks/CU\n", per_cu); per_cu = 1; }
        (void)hipGetLastError();
        grid = cus;
        if (n_in != 24 || ws_size < WS_END || (size_t)out_size != OUT_END) fprintf(stderr, "kernel_launch: unexpected sizes n_in %d ws %zu out %d\n", n_in, ws_size, out_size);
    }
    Params p{};
    for (int i = 0; i < 24; ++i) p.in[i] = (const float*)d_in[i];
    p.out = (float*)d_out; p.ws = (unsigned char*)d_ws;
    void* args[] = {&p};
    hipError_t e = hipLaunchCooperativeKernel((const void*)fwd_megakernel, dim3(grid), dim3(NTHR), args, LDS_BYTES, stream);
    if (e != hipSuccess) fprintf(stderr, "cooperative launch failed: %s (grid %d)\n", hipGetErrorString(e), grid);
}
```

```cpp
#include <hip/hip_runtime.h>
#include <hip/hip_cooperative_groups.h>
#include <cstdio>
#include <cstdint>
namespace cg = cooperative_groups;
namespace pg8 {
#define PG8_LAS __attribute__((address_space(3)))
typedef unsigned short bf16_t;
typedef short bf16x8 __attribute__((ext_vector_type(8)));
typedef float f32x4 __attribute__((ext_vector_type(4)));
typedef unsigned u32x4 __attribute__((ext_vector_type(4)));
constexpr int BM = 256, BK = 64, HALF = 128, HTB = HALF * BK * 2  , STAGE_BYTES = 8 * HTB, NXCD = 8, WGM = 8;

__host__ __device__ __forceinline__ int lds_byte(int r, int c) { const int st = (r >> 4) * 2 + (c >> 5), rr = r & 15, cc = c & 31, ob = rr * 64 + cc * 2; return st * 1024 + (ob ^ (((ob >> 9) & 1) << 5)); }
__host__ __device__ __forceinline__ void stage_rc(int b, int& R, int& C) { const int st = b / 1024, sb = b % 1024, swz = sb ^ (((sb >> 9) & 1) << 5); R = (st >> 1) * 16 + swz / 64; C = (st & 1) * 32 + (swz % 64) / 2; }
__host__ __device__ __forceinline__ int perm32(int rho) { const int n = rho >> 4, i = rho & 15; return 8 * (i >> 2) + 4 * n + (i & 3); }

struct Unit { int pm, pn; };
struct Gemm { const bf16_t* A; const bf16_t* Bt; int M, N, K; };

struct StaticOrder {
    int nM, nN, nwg, G, c;
    __host__ __device__ void init(int M, int N, int G_, int c_) { nM = M / BM; nN = N / BM; nwg = nM * nN; G = G_; c = c_; }
    __host__ __device__ bool next(int i, Unit& u) const {
        const long L = (long)i * G + c; if (L >= nwg) return false;
        int wgid = (int)L; { const int q = nwg / NXCD, r = nwg % NXCD, xcd = wgid % NXCD, off = wgid / NXCD; wgid = (xcd < r ? xcd * (q + 1) : r * (q + 1) + (xcd - r) * q) + off; }
        const int nig = WGM * nN, gid = wgid / nig, fm = gid * WGM, gsz = (nM - fm) < WGM ? (nM - fm) : WGM;
        u.pm = fm + ((wgid % nig) % gsz); u.pn = (wgid % nig) / gsz; return true;
    }
    __device__ __forceinline__ void a_ready(const Unit&) const {}
    __device__ __forceinline__ void done(const Unit&) const {}
};

template <class Epi, class Sched, bool ALIGN_EPI = false, bool SP2 = false>
__device__ __forceinline__ void gemm_phase(PG8_LAS unsigned char* lds, const Gemm g, const Sched& S, const Epi& E) {
    int tid_ = threadIdx.x; asm volatile("" : "+v"(tid_));
    const int tid = tid_, wid = __builtin_amdgcn_readfirstlane(tid >> 6), lane = tid & 63, wr = wid >> 2, wc = wid & 3, fr = lane & 15, fq = lane >> 4;
    const int K = g.K, nt = K / BK;
    unsigned voffA[2], voffB[2];
#pragma unroll
    for (int i = 0; i < 2; ++i) { int R, C; stage_rc(tid * 16 + i * 8192, R, C); const int Rb = Epi::PERM ? ((R & ~31) + perm32(R & 31)) : R;
        voffA[i] = (unsigned)(R * K + C) * 2u; voffB[i] = (unsigned)(Rb * K + C) * 2u; }
    const size_t kstep = (size_t)(BK * 2);
    const size_t hstep = (size_t)HALF * K * 2;
    const size_t tstep = 2 * hstep;
    const unsigned ldsw = (unsigned)wid * 1024u;
    const int aoff = lds_byte(wr * 64 + fr, fq * 8), boff = lds_byte(wc * 32 + fr, fq * 8);
#define PG8_SA(b, h) (((b) * 2 + (h)) * HTB)
#define PG8_SB(b, h) ((4 + (b) * 2 + (h)) * HTB)
#define PG8_STAGE(bufoff, gbase, voff) do { _Pragma("unroll") for (int _i = 0; _i < 2; ++_i) \
        __builtin_amdgcn_global_load_lds((const unsigned*)((const char*)(gbase) + (voff)[_i]), (PG8_LAS unsigned*)(lds + (bufoff) + ldsw + _i * 8192), 16, 0, 0); } while (0)
#define PG8_LDA(dst, b, h) do { _Pragma("unroll") for (int m = 0; m < 4; ++m) _Pragma("unroll") for (int k = 0; k < 2; ++k) dst[m][k] = *(const PG8_LAS bf16x8*)(lds + PG8_SA(b, h) + aoff + m * 2048 + k * 1024); } while (0)
#define PG8_LDB(dst, b, h) do { _Pragma("unroll") for (int n = 0; n < 2; ++n) _Pragma("unroll") for (int k = 0; k < 2; ++k) dst[n][k] = *(const PG8_LAS bf16x8*)(lds + PG8_SB(b, h) + boff + n * 2048 + k * 1024); } while (0)
#define PG8_MMA(ai, bj, At, Bt) do { __builtin_amdgcn_s_setprio(1); _Pragma("unroll") for (int m = 0; m < 4; ++m) _Pragma("unroll") for (int n = 0; n < 2; ++n) _Pragma("unroll") for (int k = 0; k < 2; ++k) \
        acc[ai][bj][m][n] = __builtin_amdgcn_mfma_f32_16x16x32_bf16(Bt[n][k], At[m][k], acc[ai][bj][m][n], 0, 0, 0); __builtin_amdgcn_s_setprio(0); } while (0)
#define PG8_WAIT_V(n) asm volatile("s_waitcnt vmcnt(" #n ")" ::: "memory")
#define PG8_WAIT_L(n) asm volatile("s_waitcnt lgkmcnt(" #n ")" ::: "memory")
#define PG8_BAR __builtin_amdgcn_s_barrier()
#define PG8_SCHED __builtin_amdgcn_sched_barrier(0)
    Unit cur, nxt; int ui = 0;
    if (!S.next(0, cur)) return;
    f32x4 acc[2][2][4][2];
#pragma unroll
    for (int a = 0; a < 2; ++a)
#pragma unroll
        for (int b = 0; b < 2; ++b)
#pragma unroll
            for (int m = 0; m < 4; ++m)
#pragma unroll
                for (int n = 0; n < 2; ++n) acc[a][b][m][n] = (f32x4){0.f, 0.f, 0.f, 0.f};
    bf16x8 At[4][2], B0[2][2], B1[2][2];
    const char* cA = (const char*)g.A + (size_t)cur.pm * tstep; const char* cB = (const char*)g.Bt + (size_t)cur.pn * tstep;
    S.a_ready(cur);
    if constexpr (SP2) {
        PG8_STAGE(PG8_SB(0, 0), cB, voffB); PG8_STAGE(PG8_SB(0, 1), cB + hstep, voffB); PG8_STAGE(PG8_SA(0, 0), cA, voffA); PG8_STAGE(PG8_SA(0, 1), cA + hstep, voffA);
        if (wr == 1) PG8_BAR;
        PG8_WAIT_V(2); PG8_BAR;
        PG8_STAGE(PG8_SB(1, 0), cB + kstep, voffB); PG8_STAGE(PG8_SA(1, 0), cA + kstep, voffA); PG8_STAGE(PG8_SB(1, 1), cB + hstep + kstep, voffB);
        PG8_WAIT_V(6); PG8_BAR;
    } else {
        PG8_STAGE(PG8_SB(0, 0), cB, voffB); PG8_STAGE(PG8_SA(0, 0), cA, voffA); PG8_STAGE(PG8_SB(0, 1), cB + hstep, voffB); PG8_STAGE(PG8_SA(0, 1), cA + hstep, voffA);
        if (wr == 1) PG8_BAR;
        PG8_WAIT_V(4); PG8_BAR;
        PG8_STAGE(PG8_SB(1, 0), cB + kstep, voffB); PG8_STAGE(PG8_SA(1, 0), cA + kstep, voffA); PG8_STAGE(PG8_SB(1, 1), cB + hstep + kstep, voffB);
        PG8_WAIT_V(6); PG8_BAR;
    }
    for (;;) {
        const bool has_next = S.next(ui + 1, nxt);
        const char* nA = has_next ? (const char*)g.A + (size_t)nxt.pm * tstep : cA; const char* nB = has_next ? (const char*)g.Bt + (size_t)nxt.pn * tstep : cB;
        for (int t = 0; t < nt; t += 2) {
            const bool last = (t == nt - 2);
            const char* a1 = cA + (size_t)(t + 1) * kstep;
            const char* a2 = last ? nA : cA + (size_t)(t + 2) * kstep; const char* b2 = last ? nB : cB + (size_t)(t + 2) * kstep;
            const char* a3 = a2 + kstep; const char* b3 = b2 + kstep;
            if (last && has_next) S.a_ready(nxt);
            if constexpr (SP2) {
            PG8_LDB(B0, 0, 0); PG8_LDB(B1, 0, 1); PG8_SCHED; PG8_LDA(At, 0, 0); PG8_STAGE(PG8_SA(1, 1), a1 + hstep, voffA);
            PG8_WAIT_V(8); PG8_WAIT_L(0); PG8_BAR; PG8_MMA(0, 0, At, B0); PG8_MMA(0, 1, At, B1); PG8_BAR; PG8_SCHED;
            PG8_LDA(At, 0, 1); PG8_STAGE(PG8_SB(0, 0), b2, voffB); PG8_STAGE(PG8_SB(0, 1), b2 + hstep, voffB); PG8_STAGE(PG8_SA(0, 0), a2, voffA);
            PG8_WAIT_V(8); PG8_WAIT_L(0); PG8_BAR; PG8_MMA(1, 0, At, B0); PG8_MMA(1, 1, At, B1); PG8_BAR; PG8_SCHED;
            PG8_LDB(B0, 1, 0); PG8_LDB(B1, 1, 1); PG8_SCHED; PG8_LDA(At, 1, 0); PG8_STAGE(PG8_SA(0, 1), a2 + hstep, voffA);
            PG8_WAIT_V(8); PG8_WAIT_L(0); PG8_BAR; PG8_MMA(0, 0, At, B0); PG8_MMA(0, 1, At, B1); PG8_BAR; PG8_SCHED;
            PG8_LDA(At, 1, 1); PG8_STAGE(PG8_SB(1, 0), b3, voffB); PG8_STAGE(PG8_SB(1, 1), b3 + hstep, voffB); PG8_STAGE(PG8_SA(1, 0), a3, voffA);
            PG8_WAIT_V(8); PG8_WAIT_L(0); PG8_BAR; PG8_MMA(1, 0, At, B0); PG8_MMA(1, 1, At, B1); PG8_BAR; PG8_SCHED;
            } else {
            PG8_LDB(B0, 0, 0); PG8_SCHED; PG8_LDA(At, 0, 0); PG8_STAGE(PG8_SA(1, 1), a1 + hstep, voffA);
            PG8_WAIT_L(8); PG8_BAR; PG8_WAIT_L(0); PG8_MMA(0, 0, At, B0); PG8_BAR; PG8_SCHED;
            PG8_LDB(B1, 0, 1); PG8_STAGE(PG8_SB(0, 0), b2, voffB);
            PG8_BAR; PG8_WAIT_L(0); PG8_MMA(0, 1, At, B1); PG8_BAR;
            PG8_LDA(At, 0, 1); PG8_STAGE(PG8_SA(0, 0), a2, voffA);
            PG8_BAR; PG8_WAIT_L(0); PG8_MMA(1, 0, At, B0); PG8_BAR; PG8_SCHED;
            PG8_STAGE(PG8_SB(0, 1), b2 + hstep, voffB);
            PG8_WAIT_V(6); PG8_BAR; PG8_MMA(1, 1, At, B1); PG8_BAR;
            PG8_LDB(B0, 1, 0); PG8_SCHED; PG8_LDA(At, 1, 0); PG8_STAGE(PG8_SA(0, 1), a2 + hstep, voffA);
            PG8_WAIT_L(8); PG8_BAR; PG8_WAIT_L(0); PG8_MMA(0, 0, At, B0); PG8_BAR; PG8_SCHED;
            PG8_LDB(B1, 1, 1); PG8_STAGE(PG8_SB(1, 0), b3, voffB);
            PG8_BAR; PG8_WAIT_L(0); PG8_MMA(0, 1, At, B1); PG8_BAR;
            PG8_LDA(At, 1, 1); PG8_STAGE(PG8_SA(1, 0), a3, voffA);
            PG8_BAR; PG8_WAIT_L(0); PG8_MMA(1, 0, At, B0); PG8_BAR; PG8_SCHED;
            PG8_STAGE(PG8_SB(1, 1), b3 + hstep, voffB);
            PG8_WAIT_V(6); PG8_BAR; PG8_MMA(1, 1, At, B1); PG8_BAR;
            }
        }
        if constexpr (ALIGN_EPI) { if (wr == 0) PG8_BAR; }
        if constexpr (!Epi::AFTER_DRAIN) { E(acc, cur, wr, wc, fr, fq); S.done(cur); }
        if (!has_next) break;
#pragma unroll
        for (int a = 0; a < 2; ++a)
#pragma unroll
            for (int b = 0; b < 2; ++b)
#pragma unroll
                for (int m = 0; m < 4; ++m)
#pragma unroll
                    for (int n = 0; n < 2; ++n) acc[a][b][m][n] = (f32x4){0.f, 0.f, 0.f, 0.f};
        cur = nxt; cA = nA; cB = nB; ++ui;
        if constexpr (ALIGN_EPI) { if (wr == 1) PG8_BAR; }
    }
    PG8_WAIT_V(0);
    if constexpr (!ALIGN_EPI) { if (wr == 0) PG8_BAR; }
    PG8_BAR;
    if constexpr (Epi::AFTER_DRAIN) { E.fused(acc, cur, wr, wc, fr, fq, lds, wid, lane); S.done(cur); }
#undef PG8_SA
#undef PG8_SB
#undef PG8_STAGE
#undef PG8_LDA
#undef PG8_LDB
#undef PG8_MMA
#undef PG8_WAIT_V
#undef PG8_WAIT_L
#undef PG8_BAR
#undef PG8_SCHED
}
}

#define LAS __attribute__((address_space(3)))
typedef unsigned short bf16;
typedef short bf16x8 __attribute__((ext_vector_type(8)));
typedef float f32x4 __attribute__((ext_vector_type(4)));
typedef float f32x16 __attribute__((ext_vector_type(16)));
typedef unsigned u32x4 __attribute__((ext_vector_type(4)));
typedef unsigned u32x2 __attribute__((ext_vector_type(2)));
typedef float f32x2_t __attribute__((ext_vector_type(2)));
typedef __bf16 bf16x2_t __attribute__((ext_vector_type(2)));

constexpr int DM = 1024, TSEQ = 2048, NB = 8, MP = NB * TSEQ  , NS = 128  , MR = MP + NS  , MPAD = 16640  ;
constexpr int DREC = 512, DATT = 512, DKV = 128, DFF = 2816, DIN = 1792;
constexpr float EPS = 1e-6f;
constexpr int NWAVES = 8, NTHR = 512;
constexpr size_t OFF_Y = 0, OFF_PK = (size_t)MR * DM, OFF_PV = OFF_PK + 131072, OFF_PCONV = OFF_PV + 131072, OFF_PH = OFF_PCONV + 12288,
                 OFF_SK = OFF_PH + 4096, OFF_SV = OFF_SK + 2097152, OFF_SCONV = OFF_SV + 2097152, OFF_SH = OFF_SCONV + 196608, OUT_END = OFF_SH + 65536;
constexpr size_t MiB = 1u << 20;
constexpr int CTL_WORDS = 10240, CW_DONE = CTL_WORDS - 1;
__device__ unsigned g_ctl[CTL_WORDS];
constexpr size_t WS_RSQH = 0, WS_SUMA = 1 * MiB, WS_SUMH = 1 * MiB + 512 * 1024;
constexpr size_t WS_WIN = 2 * MiB, WS_WOUT = 6 * MiB, WS_WGU = 8 * MiB, WS_WD = 19 * MiB, WS_GWT = 25 * MiB;
constexpr size_t WS_MIX = 26 * MiB, WS_HB = 59 * MiB, WS_FF = 92 * MiB;
constexpr size_t WS_XN = 92 * MiB, WS_XR = 125 * MiB, WS_GR = 142 * MiB, WS_Q = 159 * MiB, WS_KB = 176 * MiB, WS_VT = 181 * MiB, WS_END = 250 * MiB;
static_assert(WS_MIX + (size_t)MPAD * DM * 2 <= WS_HB && WS_HB + (size_t)MPAD * DM * 2 <= WS_FF && WS_FF + (size_t)MPAD * DFF * 2 <= WS_END, "ws map");
static_assert(WS_GR - WS_XR == WS_Q - WS_GR, "xr/gr/q equally spaced");
static_assert(WS_XN + (size_t)MPAD * DM * 2 <= WS_XR && WS_XR + (size_t)MPAD * 512 * 2 <= WS_GR && WS_GR + (size_t)MPAD * 512 * 2 <= WS_Q && WS_Q + (size_t)MPAD * 512 * 2 <= WS_KB && WS_KB + (size_t)MPAD * 128 * 2 <= WS_VT, "ws map 2");
constexpr int LDS_BYTES = 132096;

struct Params {
    const float* in[24];
    float* out; unsigned char* ws;
};
typedef const __attribute__((address_space(4))) Params* KP;
__device__ __forceinline__ KP kargs() { KP q = (KP)__builtin_amdgcn_kernarg_segment_ptr(); asm volatile("" : "+s"(q)); return q; }
enum { I_XP = 0, I_XS, I_CK, I_CV, I_SCONV, I_SH, I_N1G, I_WIN, I_CONVW, I_CONVB, I_GAW, I_GAB, I_GXW, I_GXB, I_LAM, I_SINK, I_RNG, I_ANG, I_WOUT, I_N2G, I_WG, I_WU, I_WD, I_FNG };

__device__ __forceinline__ unsigned pk2(float lo, float hi) { f32x2_t v = {lo, hi}; bf16x2_t b = __builtin_convertvector(v, bf16x2_t); return __builtin_bit_cast(unsigned, b); }
__device__ __forceinline__ float bflo(unsigned w) { return __uint_as_float(w << 16); }
__device__ __forceinline__ float bfhi(unsigned w) { return __uint_as_float(w & 0xffff0000u); }
__device__ __forceinline__ float bf1(bf16 u) { return __uint_as_float((unsigned)u << 16); }
__device__ __forceinline__ float shx(float v, int o, int lane) { return __int_as_float(__builtin_amdgcn_ds_bpermute((lane ^ o) << 2, __float_as_int(v))); }
__device__ __forceinline__ float shl(float v, int src) { return __int_as_float(__builtin_amdgcn_ds_bpermute(src << 2, __float_as_int(v))); }
__device__ __forceinline__ float wave_sum(float v, int lane) {
#pragma unroll
    for (int o = 1; o < 64; o <<= 1) v += shx(v, o, lane);
    return v;
}
__device__ __forceinline__ float wave_max(float v, int lane) {
#pragma unroll
    for (int o = 1; o < 64; o <<= 1) v = fmaxf(v, shx(v, o, lane));
    return v;
}
__device__ __forceinline__ float frcp(float x) { return __builtin_amdgcn_rcpf(x); }
__device__ __forceinline__ float fsqrt(float x) { return __builtin_amdgcn_sqrtf(x); }
__device__ __forceinline__ float frsq(float x) { return __builtin_amdgcn_rsqf(x); }
__device__ __forceinline__ float fexp(float x) { return __builtin_amdgcn_exp2f(x * 1.4426950408889634f); }
__device__ __forceinline__ float sigmoidf_(float x) { return frcp(1.0f + fexp(-x)); }
__device__ __forceinline__ float gelu_tanh(float x) { const float z = 0.7978845608028654f * (x + 0.044715f * x * x * x); const float e = fexp(2.0f * z); return x * (1.0f - frcp(e + 1.0f)); }

using pg8::Unit;
struct EpiIn {
    static constexpr bool PERM = true, AFTER_DRAIN = false;
    unsigned char* ws; float* out;
    __device__ __forceinline__ void operator()(const f32x4 (&acc)[2][2][4][2], const Unit& u, int wr, int wc, int fr, int fq) const {
        const int pn = u.pn;
        bf16* const KB = (bf16*)(ws + WS_KB); bf16* const VT = (bf16*)(ws + WS_VT);
#pragma unroll
        for (int ai = 0; ai < 2; ++ai)
#pragma unroll
            for (int m = 0; m < 4; ++m) {
                const int row = u.pm * 256 + ai * 128 + wr * 64 + m * 16 + fr;
                const bool isp = row < MP, iss = (row >= MP) && (row < MR);
                const int b = isp ? (row >> 11) : (row - MP), t = row & (TSEQ - 1);
#pragma unroll
                for (int bj = 0; bj < 2; ++bj) {
                    const int c = bj * 128 + wc * 32 + 8 * fq;
                    f32x4 v0 = acc[ai][bj][m][0], v1 = acc[ai][bj][m][1];
                    if (pn < 6) {
                        bf16* dst = (bf16*)(ws + WS_XR + (size_t)(pn >> 1) * (WS_GR - WS_XR));
                        const int col = (pn & 1) * 256 + c;
                        if (pn >= 4) { v0 = v0 * 0.125f; v1 = v1 * 0.125f; }
                        u32x4 w; w.x = pk2(v0[0], v0[1]); w.y = pk2(v0[2], v0[3]); w.z = pk2(v1[0], v1[1]); w.w = pk2(v1[2], v1[3]);
                        *(u32x4*)(dst + (size_t)row * 512 + col) = w;
                        if (pn < 2) {
                            float* o = nullptr;
                            if (isp && t >= TSEQ - 3) o = out + OFF_PCONV + (size_t)(b * 3 + (t - (TSEQ - 3))) * 512 + col;
                            if (iss) o = out + OFF_SCONV + (size_t)(b * 3 + 2) * 512 + col;
                            if (o) { *(f32x4*)o = v0; *(f32x4*)(o + 4) = v1; }
                        }
                    } else {
                        const int cc = wc * 32 + 8 * fq;
                        if (bj == 0) {
                            u32x4 w; w.x = pk2(v0[0], v0[1]); w.y = pk2(v0[2], v0[3]); w.z = pk2(v1[0], v1[1]); w.w = pk2(v1[2], v1[3]);
                            *(u32x4*)(KB + (size_t)row * 128 + cc) = w;
                        } else if (isp) {
                            const int kvh = cc >> 6, d0 = cc & 63;
                            bf16* vt = VT + ((size_t)(b * 2 + kvh) * 64 + d0) * TSEQ + t;
                            const unsigned w0 = pk2(v0[0], v0[1]), w1 = pk2(v0[2], v0[3]), w2 = pk2(v1[0], v1[1]), w3 = pk2(v1[2], v1[3]);
                            vt[0 * TSEQ] = (bf16)(w0 & 0xffff); vt[1 * TSEQ] = (bf16)(w0 >> 16); vt[2 * TSEQ] = (bf16)(w1 & 0xffff); vt[3 * TSEQ] = (bf16)(w1 >> 16);
                            vt[4 * TSEQ] = (bf16)(w2 & 0xffff); vt[5 * TSEQ] = (bf16)(w2 >> 16); vt[6 * TSEQ] = (bf16)(w3 & 0xffff); vt[7 * TSEQ] = (bf16)(w3 >> 16);
                        }
                        float* o = nullptr;
                        if (isp && t >= TSEQ - 128) o = out + (bj == 0 ? OFF_PK : OFF_PV) + (size_t)(b * 128 + (t - (TSEQ - 128))) * 128 + cc;
                        if (iss) o = out + (bj == 0 ? OFF_SK : OFF_SV) + (size_t)(b * 128 + 127) * 128 + cc;
                        if (o) { *(f32x4*)o = v0; *(f32x4*)(o + 4) = v1; }
                    }
                }
            }
    }
};
struct EpiOut {
    static constexpr bool PERM = false, AFTER_DRAIN = false;
    const float *xp, *xs; float* H; unsigned char* ws;
    __device__ __forceinline__ void operator()(const f32x4 (&acc)[2][2][4][2], const Unit& u, int wr, int wc, int fr, int fq) const {
        const int col0 = u.pn * 256 + wc * 32 + 4 * fq, lane = fr + 16 * fq;
        bf16* const HB = (bf16*)(ws + WS_HB); float* const rsq = (float*)(ws + WS_RSQH);
#pragma unroll
        for (int ai = 0; ai < 2; ++ai)
#pragma unroll
            for (int m = 0; m < 4; ++m) {
                const int row = u.pm * 256 + ai * 128 + wr * 64 + m * 16 + fr;
                const bool real = row < MR;
                const float* xrow = row < MP ? xp + (size_t)row * DM : xs + (size_t)(row - MP) * DM;
                float s = 0.f;
#pragma unroll
                for (int bj = 0; bj < 2; ++bj)
#pragma unroll
                    for (int n = 0; n < 2; ++n) {
                        const int c = col0 + bj * 128 + n * 16;
                        f32x4 v = acc[ai][bj][m][n];
                        if (real) v = v + __builtin_nontemporal_load((const f32x4*)(xrow + c));
                        s += (v[0] * v[0] + v[1] * v[1]) + (v[2] * v[2] + v[3] * v[3]);
                        u32x2 w; w.x = pk2(v[0], v[1]); w.y = pk2(v[2], v[3]);
                        *(u32x2*)(HB + (size_t)row * DM + c) = w;
                    }
                s += shx(s, 16, lane); s += shx(s, 32, lane);
                if (fq == 0) atomicAdd(rsq + row, s);
            }
    }
};
struct EpiGU {
    static constexpr bool PERM = true, AFTER_DRAIN = false;
    unsigned char* ws;
    __device__ __forceinline__ void operator()(const f32x4 (&acc)[2][2][4][2], const Unit& u, int wr, int wc, int fr, int fq) const {
        const int col = u.pn * 128 + wc * 32 + 8 * fq;
        bf16* const FF = (bf16*)(ws + WS_FF); const float* const rsq = (const float*)(ws + WS_RSQH);
#pragma unroll
        for (int ai = 0; ai < 2; ++ai)
#pragma unroll
            for (int m = 0; m < 4; ++m) {
                const int row = u.pm * 256 + ai * 128 + wr * 64 + m * 16 + fr;
                const float r = frsq(rsq[row] * (1.0f / DM) + EPS);
                float o[8];
#pragma unroll
                for (int n = 0; n < 2; ++n)
#pragma unroll
                    for (int e = 0; e < 4; ++e) { const float g = acc[ai][0][m][n][e] * r, uu = acc[ai][1][m][n][e] * r; o[4 * n + e] = g * sigmoidf_(g) * uu; }
                u32x4 w; w.x = pk2(o[0], o[1]); w.y = pk2(o[2], o[3]); w.z = pk2(o[4], o[5]); w.w = pk2(o[6], o[7]);
                *(u32x4*)(FF + (size_t)row * DFF + col) = w;
            }
    }
};
struct EpiDown {
    static constexpr bool PERM = false, AFTER_DRAIN = false;
    float* H;
    __device__ __forceinline__ void operator()(const f32x4 (&acc)[2][2][4][2], const Unit& u, int wr, int wc, int fr, int fq) const {
        const int col0 = u.pn * 256 + wc * 32 + 4 * fq;
#pragma unroll
        for (int ai = 0; ai < 2; ++ai)
#pragma unroll
            for (int m = 0; m < 4; ++m) {
                const int row = u.pm * 256 + ai * 128 + wr * 64 + m * 16 + fr;
                if (row < MR) {
#pragma unroll
                    for (int bj = 0; bj < 2; ++bj)
#pragma unroll
                        for (int n = 0; n < 2; ++n) {
                            float* pp = H + (size_t)row * DM + col0 + bj * 128 + n * 16;
                            *(f32x4*)pp = *(const f32x4*)pp + acc[ai][bj][m][n];
                        }
                }
            }
    }
};

constexpr size_t WS_XBUF = 768 * 1024;
constexpr int CW_PANEL = 4096, CW_SAMPLE = 8192, CW_S1 = 8192 + 64, CW_SCAN = 8192 + 128;
struct EpiDownFused {
    static constexpr bool PERM = false, AFTER_DRAIN = true;
    unsigned char* ws; float* out; const float* gf;
    __device__ __forceinline__ void operator()(const f32x4 (&)[2][2][4][2], const Unit&, int, int, int, int) const {}
    __device__ __forceinline__ void fused(f32x4 (&acc)[2][2][4][2], const Unit& u, int wr, int wc, int fr, int fq, PG8_LAS unsigned char* lds, int wid, int lane) const {
        LAS float* P = (LAS float*)lds;
        LAS float* Sr = (LAS float*)(lds + 4096);
        const bf16* HB = (const bf16*)(ws + WS_HB);
        float* xbuf = (float*)(ws + WS_XBUF);
        unsigned* cnt = g_ctl + CW_PANEL + 64 * u.pm;
        const int col0 = u.pn * 256 + wc * 32 + 4 * fq;
#pragma unroll
        for (int ai = 0; ai < 2; ++ai)
#pragma unroll
            for (int m = 0; m < 4; ++m) {
                const int rl = ai * 128 + wr * 64 + m * 16 + fr; const size_t row = (size_t)u.pm * 256 + rl;
                float s = 0.f;
#pragma unroll
                for (int bj = 0; bj < 2; ++bj)
#pragma unroll
                    for (int n = 0; n < 2; ++n) {
                        const u32x2 hb = __builtin_nontemporal_load((const u32x2*)(HB + row * DM + col0 + bj * 128 + n * 16));
                        f32x4 v = acc[ai][bj][m][n];
                        v[0] += bflo(hb.x); v[1] += bfhi(hb.x); v[2] += bflo(hb.y); v[3] += bfhi(hb.y);
                        acc[ai][bj][m][n] = v;
                        s += (v[0] * v[0] + v[1] * v[1]) + (v[2] * v[2] + v[3] * v[3]);
                    }
                s += shx(s, 16, lane); s += shx(s, 32, lane);
                if (fq == 0) P[rl * 4 + wc] = s;
            }
        asm volatile("s_waitcnt lgkmcnt(0)" ::: "memory"); __builtin_amdgcn_s_barrier(); asm volatile("" ::: "memory");
        const int rr = wid * 32 + (lane & 31);
        if (lane < 32) {
            const float tot = (P[rr * 4 + 0] + P[rr * 4 + 1]) + (P[rr * 4 + 2] + P[rr * 4 + 3]);
            __hip_atomic_store(xbuf + ((size_t)u.pm * 256 + rr) * 4 + u.pn, tot, __ATOMIC_RELAXED, __HIP_MEMORY_SCOPE_AGENT);
        }
        asm volatile("s_waitcnt vmcnt(0)" ::: "memory");
        if (lane == 0) __hip_atomic_fetch_add(cnt, 1u, __ATOMIC_RELAXED, __HIP_MEMORY_SCOPE_AGENT);
        if (wid == 0) {
            unsigned sp = 0;
            while ((unsigned)__builtin_amdgcn_readfirstlane(__hip_atomic_load(cnt, __ATOMIC_RELAXED, __HIP_MEMORY_SCOPE_AGENT)) < 32u) { __builtin_amdgcn_s_sleep(2); if (++sp > (1u << 22)) break; }
            __builtin_amdgcn_fence(__ATOMIC_ACQUIRE, "agent");
        }
        asm volatile("s_waitcnt vmcnt(0) lgkmcnt(0)" ::: "memory"); __builtin_amdgcn_s_barrier(); asm volatile("" ::: "memory");
        if (lane < 32) {
            const float* sl = xbuf + ((size_t)u.pm * 256 + rr) * 4; float t = 0.f;
#pragma unroll
            for (int k = 0; k < 4; ++k) t += __hip_atomic_load(sl + k, __ATOMIC_RELAXED, __HIP_MEMORY_SCOPE_AGENT);
            Sr[rr] = frsq(t * (1.0f / DM) + EPS);
        }
        asm volatile("s_waitcnt vmcnt(0) lgkmcnt(0)" ::: "memory"); __builtin_amdgcn_s_barrier(); asm volatile("" ::: "memory");
        f32x4 gv[2][2];
#pragma unroll
        for (int bj = 0; bj < 2; ++bj)
#pragma unroll
            for (int n = 0; n < 2; ++n) gv[bj][n] = *(const f32x4*)(gf + col0 + bj * 128 + n * 16);
#pragma unroll
        for (int ai = 0; ai < 2; ++ai)
#pragma unroll
            for (int m = 0; m < 4; ++m) {
                const int rl = ai * 128 + wr * 64 + m * 16 + fr; const size_t row = (size_t)u.pm * 256 + rl;
                const float sc = Sr[rl];
#pragma unroll
                for (int bj = 0; bj < 2; ++bj)
#pragma unroll
                    for (int n = 0; n < 2; ++n) __builtin_nontemporal_store(acc[ai][bj][m][n] * sc * gv[bj][n], (f32x4*)(out + row * DM + col0 + bj * 128 + n * 16));
            }
    }
};

__device__ __forceinline__ void tr_item(const float* __restrict__ W, int N, bf16* WT, int ldt, int k0, int n0, int drow0, const float* __restrict__ kscale, LAS float* scr, int lane) {
    float wv[32];
#pragma unroll
    for (int i = 0; i < 32; ++i) wv[i] = __builtin_nontemporal_load(W + (size_t)(k0 + 2 * i + (lane >> 5)) * N + n0 + (lane & 31));
#pragma unroll
    for (int i = 0; i < 32; ++i) { const int kk = 2 * i + (lane >> 5); float v = wv[i]; if (kscale) v *= kscale[k0 + kk]; scr[kk * 33 + (lane & 31)] = v; }
    asm volatile("s_waitcnt lgkmcnt(0)" ::: "memory");
    const int c = lane & 7;
#pragma unroll
    for (int j = 0; j < 4; ++j) { const int n = (lane >> 3) + 8 * j; const LAS float* s = scr + (8 * c) * 33 + n;
        u32x4 o; o.x = pk2(s[0 * 33], s[1 * 33]); o.y = pk2(s[2 * 33], s[3 * 33]); o.z = pk2(s[4 * 33], s[5 * 33]); o.w = pk2(s[6 * 33], s[7 * 33]);
        *(u32x4*)(WT + (size_t)(drow0 + n) * ldt + k0 + 8 * c) = o; }
    asm volatile("s_waitcnt lgkmcnt(0)" ::: "memory");
}
constexpr int CI_WIN = 16 * 56, CI_G = CI_WIN + 32, CI_WOUT = CI_G + 16 * 32, CI_WU = CI_WOUT + 2 * 16 * 88, CI_WD = CI_WU + 44 * 32;
__device__ __forceinline__ void convert_items(KP p, LAS unsigned char* lds, int lo, int hi, int gw, int NGW, int wave, int lane) {
    unsigned char* ws = p->ws;
    LAS float* scr = (LAS float*)(lds + wave * 16384);
    for (int it = lo + gw; it < hi; it += NGW) {
        const float* W; const float* ks = nullptr; bf16* WT; int N, ldt, k0, n0, drow0; int r = it;
        if (r < CI_WIN) { const int kb = r / 56, nb = r % 56; W = p->in[I_WIN]; N = DIN; WT = (bf16*)(ws + WS_WIN); ldt = DM; k0 = 64 * kb; n0 = 32 * nb; drow0 = n0; }
        else if (r < CI_G) { r -= CI_WIN; const int gx = r >> 4, n = (r & 15) >> 1, nb = r & 1; W = p->in[gx ? I_GXW : I_GAW] + n * 4096; N = 64; WT = (bf16*)(ws + WS_GWT) + gx * 8 * 4096 + n * 4096; ldt = 64; k0 = 0; n0 = 32 * nb; drow0 = n0; }
        else if (r < CI_WOUT) { r -= CI_G; const int kb = r / 32, nb = r % 32; W = p->in[I_WOUT]; N = DM; WT = (bf16*)(ws + WS_WOUT); ldt = DM; k0 = 64 * kb; n0 = 32 * nb; drow0 = n0; }
        else if (r < CI_WU) { r -= CI_WOUT; const int up = r >= 16 * 88 ? 1 : 0; if (up) r -= 16 * 88; const int kb = r / 88, nb = r % 88; W = p->in[up ? I_WU : I_WG]; N = DFF; WT = (bf16*)(ws + WS_WGU); ldt = DM; k0 = 64 * kb; n0 = 32 * nb;
            drow0 = 256 * (n0 >> 7) + 128 * up + (n0 & 127); ks = p->in[I_N2G]; }
        else { r -= CI_WU; const int kb = r / 32, nb = r % 32; W = p->in[I_WD]; N = DM; WT = (bf16*)(ws + WS_WD); ldt = DFF; k0 = 64 * kb; n0 = 32 * nb; drow0 = n0; }
        tr_item(W, N, WT, ldt, k0, n0, drow0, ks, scr, lane);
    }
}
__device__ __forceinline__ void copy_windows(KP p, int gt, int NGT) {
    for (int i = gt; i < NS * 4064; i += NGT) { const int b = i / 4064, o = i % 4064;
        __builtin_nontemporal_store(__builtin_nontemporal_load((const f32x4*)(p->in[I_CK] + (size_t)b * 16384 + 128) + o), (f32x4*)(p->out + OFF_SK + (size_t)b * 16384) + o);
        __builtin_nontemporal_store(__builtin_nontemporal_load((const f32x4*)(p->in[I_CV] + (size_t)b * 16384 + 128) + o), (f32x4*)(p->out + OFF_SV + (size_t)b * 16384) + o); }
    for (int i = gt; i < NS * 256; i += NGT) { const int b = i >> 8, o = i & 255;
        ((f32x4*)(p->out + OFF_SCONV + (size_t)b * 1536))[o] = ((const f32x4*)(p->in[I_SCONV] + (size_t)b * 1536 + 512))[o]; }
}
__device__ __forceinline__ void slack_slot(int nwg, int G, int bx, int& slot, int& nslots) {
    const int mx = (nwg + G - 1) / G, first = nwg - (mx - 1) * G;
    if (first >= G) { slot = bx; nslots = G; } else { slot = bx - first; nslots = G - first; }
}
__device__ __forceinline__ void p0_prologue(KP p, LAS unsigned char* lds, int gw, int NGW, int wave, int lane) {
    unsigned char* ws = p->ws;
    convert_items(p, lds, 0, CI_G, gw, NGW, wave, lane);
    {
        const f32x4* g4 = (const f32x4*)p->in[I_N1G] + lane;
        f32x4 g[4];
#pragma unroll
        for (int j = 0; j < 4; ++j) g[j] = g4[64 * j];
        for (int m0 = gw; m0 < MR; m0 += 2 * NGW) {
            f32x4 v[2][4];
#pragma unroll
            for (int rr = 0; rr < 2; ++rr) { const int m = m0 + rr * NGW, mc = m < MR ? m : m0;
                const float* xrow = mc < MP ? p->in[I_XP] + (size_t)mc * DM : p->in[I_XS] + (size_t)(mc - MP) * DM;
                const f32x4* xr = (const f32x4*)xrow + lane;
#pragma unroll
                for (int j = 0; j < 4; ++j) v[rr][j] = __builtin_nontemporal_load(xr + 64 * j); }
#pragma unroll
            for (int rr = 0; rr < 2; ++rr) { const int m = m0 + rr * NGW;
                float s = 0.f;
#pragma unroll
                for (int j = 0; j < 4; ++j) s += (v[rr][j].x * v[rr][j].x + v[rr][j].y * v[rr][j].y) + (v[rr][j].z * v[rr][j].z + v[rr][j].w * v[rr][j].w);
                const float rs = frsq(wave_sum(s, lane) * (1.f / DM) + EPS);
                if (m < MR) { u32x2* o8 = (u32x2*)((bf16*)(ws + WS_XN) + (size_t)m * DM) + lane;
#pragma unroll
                    for (int j = 0; j < 4; ++j) { u32x2 w; w.x = pk2(v[rr][j].x * rs * g[j].x, v[rr][j].y * rs * g[j].y); w.y = pk2(v[rr][j].z * rs * g[j].z, v[rr][j].w * rs * g[j].w); o8[64 * j] = w; } }
            }
        }
    }
    const int gt = gw * 64 + lane, NGT = NGW * 64;
    for (int i = gt; i < MPAD; i += NGT) ((float*)(ws + WS_RSQH))[i] = 0.f;
}

__device__ __forceinline__ void row_scan4(float A, float H, float c0, int q, float& cin, float& At, float& Ht) {
    const auto ra = __builtin_amdgcn_permlane16_swap(__float_as_uint(A), __float_as_uint(A), false, false);
    const auto rh = __builtin_amdgcn_permlane16_swap(__float_as_uint(H), __float_as_uint(H), false, false);
    const float Ae = __uint_as_float(ra[0]), Ao = __uint_as_float(ra[1]), He = __uint_as_float(rh[0]), Ho = __uint_as_float(rh[1]);
    const float Ap = Ae * Ao, Hp = Ao * He + Ho;
    const auto pa = __builtin_amdgcn_permlane32_swap(__float_as_uint(Ap), __float_as_uint(Ap), false, false);
    const auto ph = __builtin_amdgcn_permlane32_swap(__float_as_uint(Hp), __float_as_uint(Hp), false, false);
    const float Alo = __uint_as_float(pa[0]), Ahi = __uint_as_float(pa[1]), Hlo = __uint_as_float(ph[0]), Hhi = __uint_as_float(ph[1]);
    const float c2 = Alo * c0 + Hlo, base = (q & 2) ? c2 : c0;
    cin = (q & 1) ? (Ae * base + He) : base;
    At = Alo * Ahi; Ht = Ahi * Hlo + Hhi;
}

constexpr int HS_OFF = 16384, HS_LD = 1032;
#define MFMA16(a, b, c) __builtin_amdgcn_mfma_f32_16x16x32_bf16((a), (b), (c), 0, 0, 0)
#define MFMA32(a, b, c) __builtin_amdgcn_mfma_f32_32x32x16_bf16((a), (b), (c), 0, 0, 0)
typedef float f32x2v __attribute__((ext_vector_type(2)));
constexpr size_t WS_AU = 186 * MiB;
template <bool FINAL>
__device__ __forceinline__ void scan_unit(KP p, int b, int chunk, LAS unsigned char* lds, int wave, int lane) {
    unsigned char* ws = p->ws;
    const bf16* XR = (const bf16*)(ws + WS_XR);
    const bf16* GWT = (const bf16*)(ws + WS_GWT);
    float* SA = (float*)(ws + WS_SUMA); float* SH = (float*)(ws + WS_SUMH);
    f32x2v* AU = (f32x2v*)(ws + WS_AU);
    const LAS float* cw = (const LAS float*)lds;
    const int n = wave, j = lane & 15, q = lane >> 4;
    float hprev[4] = {0.f, 0.f, 0.f, 0.f}, acum[4] = {1.f, 1.f, 1.f, 1.f};
    const size_t au0 = ((size_t)b * TSEQ + chunk * 64 + 4 * q) * 512 + 64 * n + j;
    if constexpr (FINAL) {
        unsigned pfg; { const int t_ = wave * 64 + lane; pfg = *(const unsigned*)((const bf16*)(ws + WS_GR) + ((size_t)b * TSEQ + chunk * 64 + (t_ >> 3)) * 512 + (t_ & 7) * 64); }
        f32x2v au[4][4], aun[4][4];
#define SCAN_LOADAU(dst, sc_) do { _Pragma("unroll") for (int nt = 0; nt < 4; ++nt) _Pragma("unroll") for (int r = 0; r < 4; ++r) dst[nt][r] = __builtin_nontemporal_load(AU + au0 + (size_t)((sc_) * 16 + r) * 512 + 16 * nt); } while (0)
        SCAN_LOADAU(au, 0);
        {
            float As[4] = {1.f, 1.f, 1.f, 1.f}, Hs[4] = {0.f, 0.f, 0.f, 0.f};
            float la[8][4], lh[8][4];
#pragma unroll
            for (int cc = 0; cc < 8; ++cc) { const int c = 8 * q + cc, ce = c < chunk ? c : 0;
#pragma unroll
                for (int nt = 0; nt < 4; ++nt) { const size_t o = (size_t)(b * 32 + ce) * 512 + 64 * n + 16 * nt + j; la[cc][nt] = __hip_atomic_load(SA + o, __ATOMIC_RELAXED, __HIP_MEMORY_SCOPE_AGENT); lh[cc][nt] = __hip_atomic_load(SH + o, __ATOMIC_RELAXED, __HIP_MEMORY_SCOPE_AGENT); } }
#pragma unroll
            for (int cc = 0; cc < 8; ++cc) { const bool ok = (8 * q + cc) < chunk;
#pragma unroll
                for (int nt = 0; nt < 4; ++nt) { const float a = ok ? la[cc][nt] : 1.f, hh = ok ? lh[cc][nt] : 0.f; Hs[nt] = a * Hs[nt] + hh; As[nt] *= a; } }
#pragma unroll
            for (int nt = 0; nt < 4; ++nt) { float cin_, At_, Ht_; row_scan4(As[nt], Hs[nt], 0.f, q, cin_, At_, Ht_); hprev[nt] = Ht_; }
        }
#pragma unroll
        for (int sc = 0; sc < 4; ++sc) {
            if (sc < 3) SCAN_LOADAU(aun, sc + 1);
#pragma unroll
            for (int nt = 0; nt < 4; ++nt) {
                float a4[4], u4[4];
#pragma unroll
                for (int r = 0; r < 4; ++r) { a4[r] = au[nt][r].x; u4[r] = au[nt][r].y; }
                const float A4 = (a4[0] * a4[1]) * (a4[2] * a4[3]);
                const float H4 = ((u4[0] * a4[1] + u4[1]) * a4[2] + u4[2]) * a4[3] + u4[3];
                float cin, At_, Ht_; row_scan4(A4, H4, hprev[nt], q, cin, At_, Ht_);
                hprev[nt] = At_ * hprev[nt] + Ht_;
                LAS bf16* hs = (LAS bf16*)(lds + HS_OFF + (sc * 16 + 4 * q) * HS_LD) + (64 * n + 16 * nt + j);
                float h = cin;
#pragma unroll
                for (int r = 0; r < 4; ++r) { h = a4[r] * h + u4[r]; hs[r * (HS_LD / 2)] = (bf16)(pk2(h, 0.f) & 0xffff); }
            }
#pragma unroll
            for (int nt = 0; nt < 4; ++nt)
#pragma unroll
                for (int r = 0; r < 4; ++r) au[nt][r] = aun[nt][r];
        }
#undef SCAN_LOADAU
        asm volatile("" :: "v"(pfg));
    } else {
    bf16x8 wf[2][4][2];
#pragma unroll
    for (int g = 0; g < 2; ++g)
#pragma unroll
        for (int nt = 0; nt < 4; ++nt)
#pragma unroll
            for (int s = 0; s < 2; ++s) wf[g][nt][s] = *(const bf16x8*)(GWT + ((size_t)(g * 8 + n) * 64 + 16 * nt + j) * 64 + 32 * s + 8 * q);
    bf16x8 idf[2];
#pragma unroll
    for (int e = 0; e < 2; ++e)
#pragma unroll
        for (int jj = 0; jj < 8; ++jj) idf[e][jj] = (16 * e + j - 8 * q == jj) ? (short)0x3F80 : (short)0;
    float ba[4], bx[4], sp[4];
#pragma unroll
    for (int nt = 0; nt < 4; ++nt) { const int ch = 64 * n + 16 * nt + j; ba[nt] = p->in[I_GAB][ch]; bx[nt] = p->in[I_GXB][ch]; sp[nt] = 8.0f * log1pf(__expf(-p->in[I_LAM][ch])) * 1.4426950408889634f; }
#define SCAN_LOADX(dst, sc_) do { const int tok_ = chunk * 64 + (sc_) * 16 + j; \
        _Pragma("unroll") for (int s = 0; s < 2; ++s) _Pragma("unroll") for (int w = 0; w < 4; ++w) { \
            const int tt = tok_ - 3 + w, ttc = tt < 0 ? 0 : tt; \
            u32x4 x = *(const u32x4*)(XR + (size_t)(b * TSEQ + ttc) * 512 + 64 * n + 32 * s + 8 * q); \
            if (tt < 0) x = (u32x4){0u, 0u, 0u, 0u}; dst[s][w] = x; } } while (0)
    u32x4 xcur[2][4], xnext[2][4];
    SCAN_LOADX(xcur, 0);
#pragma unroll
    for (int sc = 0; sc < 4; ++sc) {
        if (sc < 3) SCAN_LOADX(xnext, sc + 1);
        bf16x8 af[2];
#pragma unroll
        for (int s = 0; s < 2; ++s) {
            const int ch0 = 64 * n + 32 * s + 8 * q;
            float a8[8];
            { const f32x4 c0 = *(const LAS f32x4*)(cw + 2048 + ch0), c1 = *(const LAS f32x4*)(cw + 2048 + ch0 + 4);
              a8[0] = c0[0]; a8[1] = c0[1]; a8[2] = c0[2]; a8[3] = c0[3]; a8[4] = c1[0]; a8[5] = c1[1]; a8[6] = c1[2]; a8[7] = c1[3]; }
#pragma unroll
            for (int w = 0; w < 4; ++w) {
                const u32x4 x = xcur[s][w];
                const f32x4 w0 = *(const LAS f32x4*)(cw + w * 512 + ch0), w1 = *(const LAS f32x4*)(cw + w * 512 + ch0 + 4);
                a8[0] += w0[0] * bflo(x.x); a8[1] += w0[1] * bfhi(x.x); a8[2] += w0[2] * bflo(x.y); a8[3] += w0[3] * bfhi(x.y);
                a8[4] += w1[0] * bflo(x.z); a8[5] += w1[1] * bfhi(x.z); a8[6] += w1[2] * bflo(x.w); a8[7] += w1[3] * bfhi(x.w);
            }
            u32x4 pk; pk.x = pk2(a8[0], a8[1]); pk.y = pk2(a8[2], a8[3]); pk.z = pk2(a8[4], a8[5]); pk.w = pk2(a8[6], a8[7]);
            af[s] = __builtin_bit_cast(bf16x8, pk);
        }
#pragma unroll
        for (int nt = 0; nt < 4; ++nt) {
            f32x4 da = {0.f, 0.f, 0.f, 0.f}, dx = {0.f, 0.f, 0.f, 0.f}, xc = {0.f, 0.f, 0.f, 0.f};
            da = MFMA16(af[0], wf[0][nt][0], da); da = MFMA16(af[1], wf[0][nt][1], da);
            dx = MFMA16(af[0], wf[1][nt][0], dx); dx = MFMA16(af[1], wf[1][nt][1], dx);
            xc = MFMA16(af[nt >> 1], idf[nt & 1], xc);
            float a4[4], u4[4];
#pragma unroll
            for (int r = 0; r < 4; ++r) {
                const float ra = sigmoidf_(da[r] + ba[nt]), ix = sigmoidf_(dx[r] + bx[nt]);
                const float a = __builtin_amdgcn_exp2f(-ra * sp[nt]);
                a4[r] = a; u4[r] = fsqrt(fmaxf(1.0f - a * a, 0.f)) * ix * xc[r];
                AU[au0 + (size_t)(sc * 16 + r) * 512 + 16 * nt] = (f32x2v){a4[r], u4[r]};
            }
            const float A4 = (a4[0] * a4[1]) * (a4[2] * a4[3]);
            const float H4 = ((u4[0] * a4[1] + u4[1]) * a4[2] + u4[2]) * a4[3] + u4[3];
            float cin_, At_, Ht_; row_scan4(A4, H4, hprev[nt], q, cin_, At_, Ht_);
            hprev[nt] = At_ * hprev[nt] + Ht_; acum[nt] *= At_;
            asm volatile("" : "+v"(hprev[nt]), "+v"(acum[nt]));
        }
#pragma unroll
        for (int s = 0; s < 2; ++s)
#pragma unroll
            for (int w = 0; w < 4; ++w) xcur[s][w] = xnext[s][w];
    }
#undef SCAN_LOADX
    }
    if (!FINAL) {
        if (q == 0) {
#pragma unroll
            for (int nt = 0; nt < 4; ++nt) { const int ch = 64 * n + 16 * nt + j; const size_t o = (size_t)(b * 32 + chunk) * 512 + ch;
                __hip_atomic_store(SA + o, acum[nt], __ATOMIC_RELAXED, __HIP_MEMORY_SCOPE_AGENT); __hip_atomic_store(SH + o, hprev[nt], __ATOMIC_RELAXED, __HIP_MEMORY_SCOPE_AGENT); }
        }
    } else {
        if (chunk == 31 && q == 0) {
#pragma unroll
            for (int nt = 0; nt < 4; ++nt) p->out[OFF_PH + (size_t)b * 512 + 64 * n + 16 * nt + j] = hprev[nt];
        }
        __syncthreads();
        const bf16* GR = (const bf16*)(ws + WS_GR);
        bf16* MIX = (bf16*)(ws + WS_MIX);
        const f32x4 g0 = *(const f32x4*)(p->in[I_RNG] + 8 * lane), g1 = *(const f32x4*)(p->in[I_RNG] + 8 * lane + 4);
        u32x4 grv[8];
#pragma unroll
        for (int tt = 0; tt < 8; ++tt) grv[tt] = __builtin_nontemporal_load((const u32x4*)(GR + ((size_t)b * TSEQ + chunk * 64 + wave * 8 + tt) * 512 + 8 * lane));
#pragma unroll
        for (int tt = 0; tt < 8; ++tt) {
            const int tl = wave * 8 + tt;
            const size_t row = (size_t)b * TSEQ + chunk * 64 + tl;
            const LAS u32x2* hp = (const LAS u32x2*)(lds + HS_OFF + tl * HS_LD + 16 * lane);
            const u32x2 h0 = hp[0], h1 = hp[1];
            const u32x4 gr = grv[tt];
            float rc[8];
            rc[0] = bflo(h0.x) * gelu_tanh(bflo(gr.x)); rc[1] = bfhi(h0.x) * gelu_tanh(bfhi(gr.x)); rc[2] = bflo(h0.y) * gelu_tanh(bflo(gr.y)); rc[3] = bfhi(h0.y) * gelu_tanh(bfhi(gr.y));
            rc[4] = bflo(h1.x) * gelu_tanh(bflo(gr.z)); rc[5] = bfhi(h1.x) * gelu_tanh(bfhi(gr.z)); rc[6] = bflo(h1.y) * gelu_tanh(bflo(gr.w)); rc[7] = bfhi(h1.y) * gelu_tanh(bfhi(gr.w));
            float ss = 0.f;
#pragma unroll
            for (int e = 0; e < 8; ++e) ss += rc[e] * rc[e];
            const float rn = frsq(wave_sum(ss, lane) * (1.0f / DREC) + EPS);
            u32x4 w; w.x = pk2(rc[0] * rn * g0[0], rc[1] * rn * g0[1]); w.y = pk2(rc[2] * rn * g0[2], rc[3] * rn * g0[3]);
            w.z = pk2(rc[4] * rn * g1[0], rc[5] * rn * g1[1]); w.w = pk2(rc[6] * rn * g1[2], rc[7] * rn * g1[3]);
            *(u32x4*)(MIX + row * DM + 8 * lane) = w;
        }
        __syncthreads();
    }
}

constexpr int AT_KLD = 272, AT_VLD = 336, AT_OLD = 1040;
constexpr int AT_K = 0, AT_V = AT_K + 160 * AT_KLD, AT_RED = AT_V + 128 * AT_VLD, AT_END = AT_RED + 1024;
static_assert(32 * AT_OLD <= AT_V && 12288 + AT_END <= 131072, "attention LDS map");
__device__ __forceinline__ void attn_unit(KP p, int b, int qt, LAS unsigned char* lds, int wave, int lane) {
    unsigned char* ws = p->ws;
    const bf16* Q = (const bf16*)(ws + WS_Q); const bf16* KB = (const bf16*)(ws + WS_KB); const bf16* VT = (const bf16*)(ws + WS_VT);
    bf16* MIX = (bf16*)(ws + WS_MIX);
    LAS float* red = (LAS float*)(lds + AT_RED);
    const int r = lane & 31, h = lane >> 5, kvh = wave >> 2, q0 = qt * 32, tid = wave * 64 + lane;
    const size_t rowq = (size_t)b * TSEQ + q0 + r;
    __syncthreads();
    bf16x8 qf[4];
#pragma unroll
    for (int s = 0; s < 4; ++s) qf[s] = *(const bf16x8*)(Q + rowq * 512 + wave * 64 + 16 * s + 8 * h);
    {
        u32x4 kv[5], vv[5];
#pragma unroll
        for (int i = 0; i < 5; ++i) { const int id = tid + 512 * i, row = id >> 4, c16 = id & 15; int g = q0 - 128 + row; g = g < 0 ? 0 : g;
            kv[i] = *(const u32x4*)(KB + ((size_t)b * TSEQ + g) * 128 + c16 * 8); }
#pragma unroll
        for (int i = 0; i < 5; ++i) { const int id = tid + 512 * i, row = id / 20, cc = id % 20; int k0 = q0 - 128 + 8 * cc; k0 = k0 < 0 ? 0 : k0;
            vv[i] = *(const u32x4*)(VT + ((size_t)b * 128 + row) * TSEQ + k0); }
#pragma unroll
        for (int i = 0; i < 5; ++i) { const int id = tid + 512 * i, row = id >> 4, c16 = id & 15; *(LAS u32x4*)(lds + AT_K + row * AT_KLD + c16 * 16) = kv[i]; }
#pragma unroll
        for (int i = 0; i < 5; ++i) { const int id = tid + 512 * i, row = id / 20, cc = id % 20; *(LAS u32x4*)(lds + AT_V + row * AT_VLD + cc * 16) = vv[i]; }
    }
    __syncthreads();
    const int pr = (r & ~12) | ((r & 4) << 1) | ((r & 8) >> 1);
    f32x16 S[5];
#pragma unroll
    for (int kt = 0; kt < 5; ++kt) {
#pragma unroll
        for (int i = 0; i < 16; ++i) S[kt][i] = 0.f;
#pragma unroll
        for (int s = 0; s < 4; ++s) {
            const bf16x8 kf = *(const LAS bf16x8*)(lds + AT_K + (32 * kt + pr) * AT_KLD + kvh * 128 + (16 * s + 8 * h) * 2);
            S[kt] = MFMA32(kf, qf[s], S[kt]);
        }
    }
    const float sink = p->in[I_SINK][wave];
    float m = sink;
#pragma unroll
    for (int kt = 0; kt < 5; ++kt) {
        const int kbase = q0 - 128 + 32 * kt;
#pragma unroll
        for (int i = 0; i < 16; ++i) {
            const int kl = 16 * (i >> 3) + 8 * h + (i & 7);
            bool valid = kbase >= 0;
            if (kt == 0) valid = valid && (kl >= r);
            if (kt == 4) valid = valid && (kl <= r);
            const float sv = valid ? S[kt][i] : -INFINITY;
            S[kt][i] = sv; m = fmaxf(m, sv);
        }
    }
    m = fmaxf(m, shx(m, 32, lane));
    float l = 0.f;
#pragma unroll
    for (int kt = 0; kt < 5; ++kt)
#pragma unroll
        for (int i = 0; i < 16; ++i) { const float pv = fexp(S[kt][i] - m); S[kt][i] = pv; l += pv; }
    l += shx(l, 32, lane);
    const float inv = frcp(l + fexp(sink - m));
    f32x16 O[2];
#pragma unroll
    for (int dt = 0; dt < 2; ++dt)
#pragma unroll
        for (int i = 0; i < 16; ++i) O[dt][i] = 0.f;
#pragma unroll
    for (int kt = 0; kt < 5; ++kt) {
#pragma unroll
        for (int s2 = 0; s2 < 2; ++s2) {
            u32x4 pk; pk.x = pk2(S[kt][8 * s2 + 0], S[kt][8 * s2 + 1]); pk.y = pk2(S[kt][8 * s2 + 2], S[kt][8 * s2 + 3]);
            pk.z = pk2(S[kt][8 * s2 + 4], S[kt][8 * s2 + 5]); pk.w = pk2(S[kt][8 * s2 + 6], S[kt][8 * s2 + 7]);
            const bf16x8 pb = __builtin_bit_cast(bf16x8, pk);
#pragma unroll
            for (int dt = 0; dt < 2; ++dt) {
                const bf16x8 vf = *(const LAS bf16x8*)(lds + AT_V + (kvh * 64 + 32 * dt + r) * AT_VLD + (32 * kt + 16 * s2 + 8 * h) * 2);
                O[dt] = MFMA32(vf, pb, O[dt]);
            }
        }
    }
    float ss = 0.f;
#pragma unroll
    for (int dt = 0; dt < 2; ++dt)
#pragma unroll
        for (int i = 0; i < 16; ++i) { O[dt][i] *= inv; ss += O[dt][i] * O[dt][i]; }
    ss += shx(ss, 32, lane);
    if (h == 0) red[wave * 32 + r] = ss;
    __syncthreads();
    float tot = 0.f;
#pragma unroll
    for (int w = 0; w < 8; ++w) tot += red[w * 32 + r];
    const float rn = frsq(tot * (1.0f / DATT) + EPS);
#pragma unroll
    for (int dt = 0; dt < 2; ++dt)
#pragma unroll
        for (int g4 = 0; g4 < 4; ++g4) {
            const int d = 32 * dt + 8 * g4 + 4 * h;
            const f32x4 gg = *(const f32x4*)(p->in[I_ANG] + wave * 64 + d);
            u32x2 w; w.x = pk2(O[dt][4 * g4 + 0] * rn * gg[0], O[dt][4 * g4 + 1] * rn * gg[1]); w.y = pk2(O[dt][4 * g4 + 2] * rn * gg[2], O[dt][4 * g4 + 3] * rn * gg[3]);
            *(LAS u32x2*)(lds + AT_K + r * AT_OLD + (wave * 64 + d) * 2) = w;
        }
    __syncthreads();
#pragma unroll
    for (int i = 0; i < 4; ++i) { const int id = tid + 512 * i, row = id >> 6, cc = id & 63;
        *(u32x4*)(MIX + ((size_t)b * TSEQ + q0 + row) * DM + 512 + cc * 8) = *(const LAS u32x4*)(lds + AT_K + row * AT_OLD + cc * 16); }
    __syncthreads();
}

__device__ __forceinline__ void sample_unit(KP p, int b, LAS unsigned char* lds, int tid, int wave, int lane) {
    unsigned char* ws = p->ws;
    const size_t row = (size_t)MP + b;
    bf16* MIX = (bf16*)(ws + WS_MIX);
    LAS float* xs = (LAS float*)(lds + 12288);
    LAS float* redw = (LAS float*)(lds + 12288 + 2048);
    LAS float* qs = (LAS float*)(lds + 12288 + 4096);
    LAS float* ps = (LAS float*)(lds + 12288 + 8192);
    __syncthreads();
    {
        const int c = tid;
        const float* sc = p->in[I_SCONV] + (size_t)b * 1536;
        const float* cwg = p->in[I_CONVW];
        const float xr = p->out[OFF_SCONV + (size_t)(b * 3 + 2) * 512 + c];
        const float xc = p->in[I_CONVB][c] + sc[c] * cwg[c] + sc[512 + c] * cwg[512 + c] + sc[1024 + c] * cwg[1024 + c] + xr * cwg[1536 + c];
        xs[c] = xc;
        __syncthreads();
        const int n = c >> 6, jj = c & 63;
        const float* wa = p->in[I_GAW] + n * 4096 + jj; const float* wx = p->in[I_GXW] + n * 4096 + jj;
        float ya = p->in[I_GAB][c], yx = p->in[I_GXB][c];
#pragma unroll
        for (int hb = 0; hb < 2; ++hb) {
            float wa_[32], wx_[32];
#pragma unroll
            for (int i = 0; i < 32; ++i) { wa_[i] = wa[(hb * 32 + i) * 64]; wx_[i] = wx[(hb * 32 + i) * 64]; }
#pragma unroll
            for (int i = 0; i < 32; ++i) { const float xv = xs[64 * n + hb * 32 + i]; ya += xv * wa_[i]; yx += xv * wx_[i]; }
        }
        const float ra = sigmoidf_(ya), ix = sigmoidf_(yx);
        const float la = -8.0f * ra * log1pf(__expf(-p->in[I_LAM][c]));
        const float a = __expf(la);
        const float u = fsqrt(fmaxf(1.0f - a * a, 0.f)) * ix * xc;
        const float hn = a * p->in[I_SH][(size_t)b * 512 + c] + u;
        p->out[OFF_SH + (size_t)b * 512 + c] = hn;
        const float gr = bf1(((const bf16*)(ws + WS_GR))[row * 512 + c]);
        const float rec = hn * gelu_tanh(gr);
        const float ssw = wave_sum(rec * rec, lane);
        if (lane == 0) redw[wave] = ssw;
        __syncthreads();
        float tot = 0.f;
#pragma unroll
        for (int w = 0; w < 8; ++w) tot += redw[w];
        const float rn = frsq(tot * (1.0f / DREC) + EPS);
        { const float mv = rec * rn * p->in[I_RNG][c], mo = shx(mv, 1, lane);
          if ((lane & 1) == 0) __hip_atomic_store((unsigned*)(MIX + row * DM + c), pk2(mv, mo), __ATOMIC_RELAXED, __HIP_MEMORY_SCOPE_AGENT); }
    }
    {
        const int kvh = wave >> 2;
        const float qd = bf1(((const bf16*)(ws + WS_Q))[row * 512 + wave * 64 + lane]);
        qs[wave * 64 + lane] = qd;
        const float* kself = p->out + OFF_SK + (size_t)(b * 128 + 127) * 128 + kvh * 64;
        const float* vself = p->out + OFF_SV + (size_t)(b * 128 + 127) * 128 + kvh * 64;
        const float sself = wave_sum(qd * kself[lane], lane);
        asm volatile("s_waitcnt lgkmcnt(0)" ::: "memory");
        const float* kc = p->in[I_CK] + (size_t)b * 16384 + kvh * 64;
        float s0 = 0.f, s1 = 0.f;
        const f32x4* k0 = (const f32x4*)(kc + (size_t)lane * 128);
        const f32x4* k1 = (const f32x4*)(kc + (size_t)(lane + 64) * 128);
        const LAS f32x4* q4 = (const LAS f32x4*)(qs + wave * 64);
        {
            f32x4 ka[16], kb2[16];
#pragma unroll
            for (int i = 0; i < 16; ++i) { ka[i] = k0[i]; kb2[i] = k1[i]; }
#pragma unroll
            for (int i = 0; i < 16; ++i) { const f32x4 qq = q4[i], a0 = ka[i], a1 = kb2[i];
                s0 += (qq[0] * a0[0] + qq[1] * a0[1]) + (qq[2] * a0[2] + qq[3] * a0[3]);
                s1 += (qq[0] * a1[0] + qq[1] * a1[1]) + (qq[2] * a1[2] + qq[3] * a1[3]); }
        }
        const float sink = p->in[I_SINK][wave];
        const float m = fmaxf(fmaxf(wave_max(fmaxf(s0, s1), lane), sself), sink);
        const float p0 = __expf(s0 - m), p1 = __expf(s1 - m), pself = __expf(sself - m);
        const float den = wave_sum(p0 + p1, lane) + pself + __expf(sink - m);
        ps[wave * 128 + lane] = p0; ps[wave * 128 + 64 + lane] = p1;
        asm volatile("s_waitcnt lgkmcnt(0)" ::: "memory");
        const int kg = lane >> 4, d4 = lane & 15;
        const float* vc = p->in[I_CV] + (size_t)b * 16384 + kvh * 64 + 4 * d4;
        f32x4 o4 = {0.f, 0.f, 0.f, 0.f};
#pragma unroll
        for (int hb = 0; hb < 2; ++hb) {
            f32x4 vv[16];
#pragma unroll
            for (int i = 0; i < 16; ++i) vv[i] = *(const f32x4*)(vc + (size_t)(kg + 4 * (hb * 16 + i)) * 128);
#pragma unroll
            for (int i = 0; i < 16; ++i) o4 = o4 + vv[i] * ps[wave * 128 + kg + 4 * (hb * 16 + i)];
        }
#pragma unroll
        for (int e = 0; e < 4; ++e) { o4[e] += shx(o4[e], 16, lane); o4[e] += shx(o4[e], 32, lane); }
        o4 = (o4 + *(const f32x4*)(vself + 4 * d4) * pself) * (1.0f / den);
        const float ssw = wave_sum((o4[0] * o4[0] + o4[1] * o4[1]) + (o4[2] * o4[2] + o4[3] * o4[3]), lane) * 0.25f;
        if (lane == 0) redw[8 + wave] = ssw;
        __syncthreads();
        float tot = 0.f;
#pragma unroll
        for (int w = 0; w < 8; ++w) tot += redw[8 + w];
        const float rn = frsq(tot * (1.0f / DATT) + EPS);
        if (kg == 0) { const f32x4 gg = *(const f32x4*)(p->in[I_ANG] + wave * 64 + 4 * d4);
            u32x2 w; w.x = pk2(o4[0] * rn * gg[0], o4[1] * rn * gg[1]); w.y = pk2(o4[2] * rn * gg[2], o4[3] * rn * gg[3]);
            unsigned* mp = (unsigned*)(MIX + row * DM + 512 + wave * 64 + 4 * d4);
            __hip_atomic_store(mp, w.x, __ATOMIC_RELAXED, __HIP_MEMORY_SCOPE_AGENT); __hip_atomic_store(mp + 1, w.y, __ATOMIC_RELAXED, __HIP_MEMORY_SCOPE_AGENT); }
    }
    __syncthreads();
}


template <int MODE>
__device__ __forceinline__ void small_gemm_task(KP p, const bf16* __restrict__ A, const bf16* __restrict__ Bt, int K, int n0, LAS unsigned char* lds, int wave, int lane) {
    const int r = lane & 31, h = lane >> 5, mt = wave & 3, kh = wave >> 2, Kh = K >> 1;
    const bf16* ap = A + (size_t)(32 * mt + r) * K + kh * Kh + 64 * h;
    const bf16* bp = Bt + (size_t)(n0 + r) * K + kh * Kh + 64 * h;
    f32x16 acc;
#pragma unroll
    for (int i = 0; i < 16; ++i) acc[i] = 0.f;
    bf16x8 a[8], b[8], an[8], bn[8];
#pragma unroll
    for (int i = 0; i < 8; ++i) { a[i] = *(const bf16x8*)(ap + 8 * i); b[i] = *(const bf16x8*)(bp + 8 * i); }
    for (int k = 0; k < Kh; k += 128) {
        const int kn = (k + 128 < Kh) ? k + 128 : k;
#pragma unroll
        for (int i = 0; i < 8; ++i) { an[i] = *(const bf16x8*)(ap + kn + 8 * i); bn[i] = *(const bf16x8*)(bp + kn + 8 * i); }
#pragma unroll
        for (int i = 0; i < 8; ++i) acc = MFMA32(a[i], b[i], acc);
#pragma unroll
        for (int i = 0; i < 8; ++i) { a[i] = an[i]; b[i] = bn[i]; }
    }
    LAS float* red = (LAS float*)lds;
    __syncthreads();
    if (kh == 1) {
#pragma unroll
        for (int i = 0; i < 16; ++i) red[(mt * 16 + i) * 64 + lane] = acc[i];
    }
    __syncthreads();
    if (kh == 0) {
        float* H = p->out; const int c = n0 + r;
#pragma unroll
        for (int i = 0; i < 16; ++i) {
            const int rs = 32 * mt + (i & 3) + 8 * (i >> 2) + 4 * h;
            float v = acc[i] + red[(mt * 16 + i) * 64 + lane];
            float* hp = H + (size_t)(MP + rs) * DM + c;
            if (MODE == 0) {
                v += p->in[I_XS][(size_t)rs * DM + c];
                *hp = v;
                ((bf16*)(p->ws + WS_HB))[(size_t)(MP + rs) * DM + c] = (bf16)(pk2(v, 0.f) & 0xffff);
                float s = v * v;
                s += shx(s, 1, lane); s += shx(s, 2, lane); s += shx(s, 4, lane); s += shx(s, 8, lane); s += shx(s, 16, lane);
                if (r == 0) atomicAdd((float*)(p->ws + WS_RSQH) + MP + rs, s);
            } else {
                *hp = *hp + v;
            }
        }
    }
    __syncthreads();
}

#define XB_TMO      128
#define XB_XCNT(j)  (256  + 64 * (j))
#define XB_XSUB(j)  (1280 + 64 * (j))
#define XB_XGEN(j)  (2304 + 64 * (j))
#define XB_TOP      3328
#define XB_TOPGEN   3392
#define XCD_BAR_WORDS 3456
#define XB_SPIN_CAP (1u << 18)

__device__ __forceinline__ unsigned xb_ld(unsigned* p)              { return __hip_atomic_load(p, __ATOMIC_RELAXED, __HIP_MEMORY_SCOPE_AGENT); }
__device__ __forceinline__ unsigned xb_add(unsigned* p, unsigned v) { return __hip_atomic_fetch_add(p, v, __ATOMIC_RELAXED, __HIP_MEMORY_SCOPE_AGENT); }
__device__ __forceinline__ unsigned xb_xcc_id() { return (unsigned)__builtin_amdgcn_s_getreg((3 << 11) | 20) & 0xFu; }
#define XB_SPIN(cond, bar) do { unsigned _sp = 0; while (cond) { __builtin_amdgcn_s_sleep(1); \
    if ((++_sp & 255u) == 0u) { if (xb_ld(&(bar)[XB_TMO])) break; if (_sp > XB_SPIN_CAP) { atomicAdd(&(bar)[XB_TMO], 1u); break; } } } } while (0)

struct XcdBarrier {
    unsigned* bar; unsigned x;
    volatile LAS unsigned* st;
};

__device__ __forceinline__ XcdBarrier xcd_barrier_post(unsigned* bar, volatile LAS unsigned* st) {
    XcdBarrier b; b.bar = bar; b.x = xb_xcc_id(); b.st = st;
    if (threadIdx.x == 0) (void)xb_add(&bar[XB_XCNT(b.x)], 1u);
    return b;
}
__device__ __forceinline__ void xcd_barrier_complete(unsigned* bar, unsigned x, unsigned& nloc, unsigned& nx) {
    const unsigned G = gridDim.x * gridDim.y * gridDim.z;
    unsigned sum, cnt, mine, sp = 0u;
    for (;;) {
        sum = 0u; cnt = 0u; mine = 0u;
#pragma unroll
        for (unsigned j = 0; j < 16; ++j) { const unsigned c = xb_ld(&bar[XB_XCNT(j)]); sum += c; cnt += (c > 0u) ? 1u : 0u; mine = (j == x) ? c : mine; }
        if (sum == G) break;
        __builtin_amdgcn_s_sleep(1);
        if ((++sp & 255u) == 0u) { if (xb_ld(&bar[XB_TMO])) break; if (sp > XB_SPIN_CAP) { atomicAdd(&bar[XB_TMO], 1u); break; } }
    }
    nloc = mine > 0u ? mine : 1u; nx = cnt > 0u ? cnt : 1u;
}

__device__ __forceinline__ void xcd_barrier(const XcdBarrier& b) {
    asm volatile("s_waitcnt vmcnt(0)" ::: "memory");
    __syncthreads();
    if (threadIdx.x == 0) {
        unsigned* bar = b.bar;
        __builtin_amdgcn_s_waitcnt(0);
        unsigned nloc = b.st[0], nx = b.st[1];
        if (nloc == 0u) { xcd_barrier_complete(bar, b.x, nloc, nx); b.st[0] = nloc; b.st[1] = nx; }
        const unsigned old = xb_add(&bar[XB_XSUB(b.x)], 1u);
        const unsigned gen = old / nloc;
        if (old + 1u == (gen + 1u) * nloc) {
            __builtin_amdgcn_fence(__ATOMIC_RELEASE, "agent");
            asm volatile("s_waitcnt vmcnt(0)" ::: "memory");
            const unsigned og = xb_add(&bar[XB_TOP], 1u);
            const unsigned tg = og / nx;
            if (og + 1u == (tg + 1u) * nx) xb_add(&bar[XB_TOPGEN], 1u);
            else XB_SPIN(xb_ld(&bar[XB_TOPGEN]) == tg, bar);
            __builtin_amdgcn_fence(__ATOMIC_ACQUIRE, "agent");
            xb_add(&bar[XB_XGEN(b.x)], 1u);
            asm volatile("s_waitcnt vmcnt(0)" ::: "memory");
        } else {
            XB_SPIN(xb_ld(&bar[XB_XGEN(b.x)]) == gen, bar);
            __builtin_amdgcn_fence(__ATOMIC_ACQUIRE, "agent");
            asm volatile("s_waitcnt vmcnt(0)" ::: "memory");
        }
    }
    __syncthreads();
}

#ifndef REP_P0
#define REP_P0 1
#endif
#ifndef REP_P1
#define REP_P1 1
#endif
#ifndef REP_P4
#define REP_P4 1
#endif
#ifndef REP_SYNC
#define REP_SYNC 0
#endif
#ifndef PROBE_P3
#define PROBE_P3 0
#endif
#ifndef PROBE_P5
#define PROBE_P5 0
#endif
#ifndef PROBE_P6
#define PROBE_P6 0
#endif
#ifndef STAMP_A
#define STAMP_A -1
#define STAMP_B -1
#endif
#ifndef STAMP_MULT
#define STAMP_MULT 4
#endif
#ifndef REP_ALL
#define REP_ALL 1
#endif
#ifndef REP_P2
#define REP_P2 1
#endif
#ifndef REP_P2B
#define REP_P2B 1
#endif
__device__ __forceinline__ void fwd_body(LAS unsigned char* lds, const XcdBarrier& bar);
__global__ void __launch_bounds__(NTHR, 2) fwd_megakernel(Params p_unused) {
    extern __shared__ __attribute__((aligned(16))) unsigned char lds_[];
    cg::grid_group grid = cg::this_grid();
    LAS unsigned char* lds = (LAS unsigned char*)lds_;
    if (threadIdx.x < 2) ((LAS unsigned*)(lds + 131072))[threadIdx.x] = 0u;
    __syncthreads();
    XcdBarrier bar;
    { KP p = kargs(); unsigned char* ws = p->ws;
      if (ws == nullptr) grid.sync();
      bar = xcd_barrier_post(g_ctl, (volatile LAS unsigned*)(lds + 131072)); }
#define GRID_SYNC() xcd_barrier(bar)
    fwd_body(lds, bar);
    asm volatile("s_waitcnt vmcnt(0)" ::: "memory");
    __syncthreads();
    LAS unsigned* lf = (LAS unsigned*)(lds + 131072 + 16);
    if (threadIdx.x == 0) { const unsigned old = atomicAdd(&g_ctl[CW_DONE], 1u); *lf = (old + 1u == gridDim.x) ? 1u : 0u; }
    __syncthreads();
    if (*lf) { for (int i = threadIdx.x; i < CTL_WORDS; i += NTHR) g_ctl[i] = 0u; }
}
__device__ __forceinline__ void fwd_body(LAS unsigned char* lds, const XcdBarrier& bar) {
    const int G = gridDim.x, bx = blockIdx.x;
#define STAMP(i) do { if (STAMP_A >= 0 && blockIdx.x == 0 && threadIdx.x == 0) ((LAS unsigned long long*)(lds + 131072 + 64))[i] = __builtin_amdgcn_s_memrealtime(); } while (0)
    STAMP(0);
#define PHASE_IDS int tid_ = threadIdx.x; asm volatile("" : "+v"(tid_)); const int tid = tid_, lane = tid & 63, wave = __builtin_amdgcn_readfirstlane(tid >> 6); (void)tid; (void)lane; (void)wave;

    for (int rep = 0; rep < REP_P0; ++rep) { PHASE_IDS KP p = kargs(); p0_prologue(p, lds, bx * NWAVES + wave, G * NWAVES, wave, lane); }
    GRID_SYNC();
    STAMP(1);

    for (int rep = 0; rep < REP_SYNC; ++rep) GRID_SYNC();
    for (int rep = 0; rep < REP_P1; ++rep) {
        KP p = kargs(); unsigned char* ws = p->ws;
        pg8::Gemm g{(const bf16*)(ws + WS_XN), (const bf16*)(ws + WS_WIN), MPAD, DIN, DM}; pg8::StaticOrder S; S.init(MPAD, DIN, G, bx);
        EpiIn E{ws, p->out};
        pg8::gemm_phase<EpiIn, pg8::StaticOrder, true, true>(lds, g, S, E);
        { PHASE_IDS int slot, ns; slack_slot((MPAD / 256) * (DIN / 256), G, bx, slot, ns);
          if (slot >= 0) convert_items(p, lds, CI_G, CI_WU, slot * NWAVES + wave, ns * NWAVES, wave, lane); }
    }
    GRID_SYNC();
    STAMP(2);

    {
        PHASE_IDS KP p = kargs();
        for (int i = tid; i < 2560; i += NTHR) ((LAS float*)lds)[i] = i < 2048 ? p->in[I_CONVW][i] : p->in[I_CONVB][i - 2048];
        __syncthreads();
        unsigned* cw = g_ctl;
        for (int u = bx; u < 1184; u += G) {
            int tl_ = threadIdx.x; asm volatile("" : "+v"(tl_)); const int tid = tl_, lane = tl_ & 63;
            if (u < 128) { sample_unit(p, u, lds, tid, wave, lane); asm volatile("s_waitcnt vmcnt(0)" ::: "memory"); __syncthreads(); if (tid == 0) atomicAdd(cw + CW_S1, 1u); }
            else if (u < 384) { const int k = u - 128; scan_unit<false>(p, k >> 5, k & 31, lds, wave, lane); asm volatile("s_waitcnt vmcnt(0)" ::: "memory"); __syncthreads(); if (tid == 0) atomicAdd(cw + CW_SCAN + 64 * (k >> 5), 1u); }
            else if (u < 896) { const int a = u - 384; attn_unit(p, a >> 6, a & 63, lds + 12288, wave, lane); }
            else if (u < 1152) { const int k = u - 896;
                if (tid == 0) { unsigned sp = 0; while (__hip_atomic_load(cw + CW_SCAN + 64 * (k >> 5), __ATOMIC_RELAXED, __HIP_MEMORY_SCOPE_AGENT) < 32u) { __builtin_amdgcn_s_sleep(4); if (++sp > (1u << 22)) break; } }
                __syncthreads(); __builtin_amdgcn_fence(__ATOMIC_ACQUIRE, "agent");
                scan_unit<true>(p, k >> 5, k & 31, lds, wave, lane); }
            else {
                if (tid == 0) { unsigned sp = 0; while (__hip_atomic_load(cw + CW_S1, __ATOMIC_RELAXED, __HIP_MEMORY_SCOPE_AGENT) < 128u) { __builtin_amdgcn_s_sleep(4); if (++sp > (1u << 22)) break; } }
                __syncthreads(); __builtin_amdgcn_fence(__ATOMIC_ACQUIRE, "agent");
                small_gemm_task<0>(p, (const bf16*)(p->ws + WS_MIX) + (size_t)MP * DM, (const bf16*)(p->ws + WS_WOUT), DM, 32 * (u - 1152), lds, wave, lane);
            }
        }
    }
    GRID_SYNC();
    STAMP(4);

    {
        KP p = kargs(); unsigned char* ws = p->ws;
        pg8::Gemm g{(const bf16*)(ws + WS_MIX), (const bf16*)(ws + WS_WOUT), MP, DM, DM}; pg8::StaticOrder S; S.init(MP, DM, G, bx);
        if (PROBE_P3) { EpiOut E0{p->in[I_XP], p->in[I_XS], (float*)(ws + 92 * MiB), ws + 128 * MiB}; pg8::gemm_phase<EpiOut, pg8::StaticOrder, true, true>(lds, g, S, E0); }
        EpiOut E{p->in[I_XP], p->in[I_XS], p->out, ws};
        pg8::gemm_phase<EpiOut, pg8::StaticOrder, true, true>(lds, g, S, E);
    }
    GRID_SYNC();
    STAMP(5);

    for (int rep = 0; rep < REP_P4; ++rep) {
        KP p = kargs(); unsigned char* ws = p->ws;
        pg8::Gemm g{(const bf16*)(ws + WS_HB), (const bf16*)(ws + WS_WGU), MPAD, 2 * DFF, DM}; pg8::StaticOrder S; S.init(MPAD, 2 * DFF, G, bx);
        EpiGU E{ws};
        pg8::gemm_phase<EpiGU, pg8::StaticOrder, true, true>(lds, g, S, E);
        { PHASE_IDS int slot, ns; slack_slot((MPAD / 256) * (2 * DFF / 256), G, bx, slot, ns);
          if (slot >= 0) { convert_items(p, lds, CI_WU, CI_WD, slot * NWAVES + wave, ns * NWAVES, wave, lane);
                           copy_windows(p, (slot * NWAVES + wave) * 64 + lane, ns * NWAVES * 64); } }
    }
    GRID_SYNC();
    STAMP(6);

    {
        KP p = kargs(); unsigned char* ws = p->ws;
        pg8::Gemm g{(const bf16*)(ws + WS_FF), (const bf16*)(ws + WS_WD), MP, DM, DFF}; pg8::StaticOrder S; S.init(MP, DM, G, bx);
        EpiDownFused E{ws, p->out, p->in[I_FNG]};
        pg8::gemm_phase<EpiDownFused, pg8::StaticOrder, false, true>(lds, g, S, E);
        { PHASE_IDS
          int ndone = 0;
          for (int u = bx; u < 32; u += G) { small_gemm_task<1>(p, (const bf16*)(ws + WS_FF) + (size_t)MP * DFF, (const bf16*)(ws + WS_WD), DFF, 32 * u, lds, wave, lane); ++ndone; }
          if (ndone) {
              __threadfence(); __syncthreads();
              LAS unsigned* flag = (LAS unsigned*)(lds + 8192);
              if (tid == 0) { const unsigned old = atomicAdd(g_ctl + CW_SAMPLE, (unsigned)ndone); *flag = (old + (unsigned)ndone == 32u) ? 1u : 0u; }
              __syncthreads();
              if (*flag) {
                  __builtin_amdgcn_fence(__ATOMIC_ACQUIRE, "agent");
                  const f32x4* g4 = (const f32x4*)p->in[I_FNG] + lane;
                  f32x4 gq[4];
#pragma unroll
                  for (int j = 0; j < 4; ++j) gq[j] = g4[64 * j];
                  for (int m0 = MP + wave; m0 < MR; m0 += 4 * NWAVES) {
                      f32x4 v[4][4];
#pragma unroll
                      for (int q = 0; q < 4; ++q) { const f32x4* yr = (const f32x4*)(p->out + (size_t)(m0 + q * NWAVES) * DM) + lane;
#pragma unroll
                          for (int j = 0; j < 4; ++j) v[q][j] = yr[64 * j]; }
#pragma unroll
                      for (int q = 0; q < 4; ++q) { float s = 0.f;
#pragma unroll
                          for (int j = 0; j < 4; ++j) s += (v[q][j].x * v[q][j].x + v[q][j].y * v[q][j].y) + (v[q][j].z * v[q][j].z + v[q][j].w * v[q][j].w);
                          const float rs = frsq(wave_sum(s, lane) * (1.f / DM) + EPS);
                          f32x4* yw = (f32x4*)(p->out + (size_t)(m0 + q * NWAVES) * DM) + lane;
#pragma unroll
                          for (int j = 0; j < 4; ++j) yw[64 * j] = v[q][j] * rs * gq[j]; }
                  }
              }
          }
        }
    }
    STAMP(7);
    STAMP(8);
    if (STAMP_A >= 0 && blockIdx.x == 0 && threadIdx.x == 0) {
        const LAS unsigned long long* ts = (const LAS unsigned long long*)(lds + 131072 + 64);
        const unsigned long long d = (ts[STAMP_B < 0 ? 0 : STAMP_B] - ts[STAMP_A < 0 ? 0 : STAMP_A]) * STAMP_MULT, t0 = __builtin_amdgcn_s_memrealtime();
        while (__builtin_amdgcn_s_memrealtime() - t0 < d) __builtin_amdgcn_s_sleep(16);
    }
}

extern "C" void kernel_launch(void* const* d_in, const int* in_sizes, int n_in, void* d_out, int out_size, void* d_ws, size_t ws_size, hipStream_t stream) {
    static int grid = 0;
    if (grid == 0) {
        int dev = 0, cus = 0, per_cu = 0;
        hipGetDevice(&dev);
        hipDeviceGetAttribute(&cus, hipDeviceAttributeMultiprocessorCount, dev);
        hipFuncSetAttribute((const void*)fwd_megakernel, hipFuncAttributeMaxDynamicSharedMemorySize, LDS_BYTES);
        hipOccupancyMaxActiveBlocksPerMultiprocessor(&per_cu, (const void*)fwd_megakernel, NTHR, LDS_BYTES);
        if (per_cu < 1) { fprintf(stderr, "kernel_launch: occupancy query says %d blocks/CU\n", per_cu); per_cu = 1; }
        (void)hipGetLastError();
        grid = cus;
        if (n_in != 24 || ws_size < WS_END || (size_t)out_size != OUT_END) fprintf(stderr, "kernel_launch: unexpected sizes n_in %d ws %zu out %d\n", n_in, ws_size, out_size);
    }
    Params p{};
    for (int i = 0; i < 24; ++i) p.in[i] = (const float*)d_in[i];
    p.out = (float*)d_out; p.ws = (unsigned char*)d_ws;
    void* args[] = {&p};
    hipError_t e = hipLaunchCooperativeKernel((const void*)fwd_megakernel, dim3(grid), dim3(NTHR), args, LDS_BYTES, stream);
    if (e != hipSuccess) fprintf(stderr, "cooperative launch failed: %s (grid %d)\n", hipGetErrorString(e), grid);
}
```

```cpp
#include <hip/hip_runtime.h>
#include <hip/hip_cooperative_groups.h>
#include <cstdio>
#include <cstdint>
namespace cg = cooperative_groups;
namespace pg8 {
#define PG8_LAS __attribute__((address_space(3)))
typedef unsigned short bf16_t;
typedef short bf16x8 __attribute__((ext_vector_type(8)));
typedef float f32x4 __attribute__((ext_vector_type(4)));
typedef unsigned u32x4 __attribute__((ext_vector_type(4)));
constexpr int BM = 256, BK = 64, HALF = 128, HTB = HALF * BK * 2  , STAGE_BYTES = 8 * HTB, NXCD = 8, WGM = 8;

__host__ __device__ __forceinline__ int lds_byte(int r, int c) { const int st = (r >> 4) * 2 + (c >> 5), rr = r & 15, cc = c & 31, ob = rr * 64 + cc * 2; return st * 1024 + (ob ^ (((ob >> 9) & 1) << 5)); }
__host__ __device__ __forceinline__ void stage_rc(int b, int& R, int& C) { const int st = b / 1024, sb = b % 1024, swz = sb ^ (((sb >> 9) & 1) << 5); R = (st >> 1) * 16 + swz / 64; C = (st & 1) * 32 + (swz % 64) / 2; }
__host__ __device__ __forceinline__ int perm32(int rho) { const int n = rho >> 4, i = rho & 15; return 8 * (i >> 2) + 4 * n + (i & 3); }

struct Unit { int pm, pn; };
struct Gemm { const bf16_t* A; const bf16_t* Bt; int M, N, K; };

struct StaticOrder {
    int nM, nN, nwg, G, c;
    __host__ __device__ void init(int M, int N, int G_, int c_) { nM = M / BM; nN = N / BM; nwg = nM * nN; G = G_; c = c_; }
    __host__ __device__ bool next(int i, Unit& u) const {
        const long L = (long)i * G + c; if (L >= nwg) return false;
        int wgid = (int)L; { const int q = nwg / NXCD, r = nwg % NXCD, xcd = wgid % NXCD, off = wgid / NXCD; wgid = (xcd < r ? xcd * (q + 1) : r * (q + 1) + (xcd - r) * q) + off; }
        const int nig = WGM * nN, gid = wgid / nig, fm = gid * WGM, gsz = (nM - fm) < WGM ? (nM - fm) : WGM;
        u.pm = fm + ((wgid % nig) % gsz); u.pn = (wgid % nig) / gsz; return true;
    }
    __device__ __forceinline__ void a_ready(const Unit&) const {}
    __device__ __forceinline__ void done(const Unit&) const {}
};

template <class Epi, class Sched, bool ALIGN_EPI = false, bool SP2 = false>
__device__ __forceinline__ void gemm_phase(PG8_LAS unsigned char* lds, const Gemm g, const Sched& S, const Epi& E) {
    int tid_ = threadIdx.x; asm volatile("" : "+v"(tid_));
    const int tid = tid_, wid = __builtin_amdgcn_readfirstlane(tid >> 6), lane = tid & 63, wr = wid >> 2, wc = wid & 3, fr = lane & 15, fq = lane >> 4;
    const int K = g.K, nt = K / BK;
    unsigned voffA[2], voffB[2];
#pragma unroll
    for (int i = 0; i < 2; ++i) { int R, C; stage_rc(tid * 16 + i * 8192, R, C); const int Rb = Epi::PERM ? ((R & ~31) + perm32(R & 31)) : R;
        voffA[i] = (unsigned)(R * K + C) * 2u; voffB[i] = (unsigned)(Rb * K + C) * 2u; }
    const size_t kstep = (size_t)(BK * 2);
    const size_t hstep = (size_t)HALF * K * 2;
    const size_t tstep = 2 * hstep;
    const unsigned ldsw = (unsigned)wid * 1024u;
    const int aoff = lds_byte(wr * 64 + fr, fq * 8), boff = lds_byte(wc * 32 + fr, fq * 8);
#define PG8_SA(b, h) (((b) * 2 + (h)) * HTB)
#define PG8_SB(b, h) ((4 + (b) * 2 + (h)) * HTB)
#define PG8_STAGE(bufoff, gbase, voff) do { _Pragma("unroll") for (int _i = 0; _i < 2; ++_i) \
        __builtin_amdgcn_global_load_lds((const unsigned*)((const char*)(gbase) + (voff)[_i]), (PG8_LAS unsigned*)(lds + (bufoff) + ldsw + _i * 8192), 16, 0, 0); } while (0)
#define PG8_LDA(dst, b, h) do { _Pragma("unroll") for (int m = 0; m < 4; ++m) _Pragma("unroll") for (int k = 0; k < 2; ++k) dst[m][k] = *(const PG8_LAS bf16x8*)(lds + PG8_SA(b, h) + aoff + m * 2048 + k * 1024); } while (0)
#define PG8_LDB(dst, b, h) do { _Pragma("unroll") for (int n = 0; n < 2; ++n) _Pragma("unroll") for (int k = 0; k < 2; ++k) dst[n][k] = *(const PG8_LAS bf16x8*)(lds + PG8_SB(b, h) + boff + n * 2048 + k * 1024); } while (0)
#define PG8_MMA(ai, bj, At, Bt) do { __builtin_amdgcn_s_setprio(1); _Pragma("unroll") for (int m = 0; m < 4; ++m) _Pragma("unroll") for (int n = 0; n < 2; ++n) _Pragma("unroll") for (int k = 0; k < 2; ++k) \
        acc[ai][bj][m][n] = __builtin_amdgcn_mfma_f32_16x16x32_bf16(Bt[n][k], At[m][k], acc[ai][bj][m][n], 0, 0, 0); __builtin_amdgcn_s_setprio(0); } while (0)
#define PG8_WAIT_V(n) asm volatile("s_waitcnt vmcnt(" #n ")" ::: "memory")
#define PG8_WAIT_L(n) asm volatile("s_waitcnt lgkmcnt(" #n ")" ::: "memory")
#define PG8_BAR __builtin_amdgcn_s_barrier()
#define PG8_SCHED __builtin_amdgcn_sched_barrier(0)
    Unit cur, nxt; int ui = 0;
    if (!S.next(0, cur)) return;
    f32x4 acc[2][2][4][2];
#pragma unroll
    for (int a = 0; a < 2; ++a)
#pragma unroll
        for (int b = 0; b < 2; ++b)
#pragma unroll
            for (int m = 0; m < 4; ++m)
#pragma unroll
                for (int n = 0; n < 2; ++n) acc[a][b][m][n] = (f32x4){0.f, 0.f, 0.f, 0.f};
    bf16x8 At[4][2], B0[2][2], B1[2][2];
    const char* cA = (const char*)g.A + (size_t)cur.pm * tstep; const char* cB = (const char*)g.Bt + (size_t)cur.pn * tstep;
    S.a_ready(cur);
    if constexpr (SP2) {
        PG8_STAGE(PG8_SB(0, 0), cB, voffB); PG8_STAGE(PG8_SB(0, 1), cB + hstep, voffB); PG8_STAGE(PG8_SA(0, 0), cA, voffA); PG8_STAGE(PG8_SA(0, 1), cA + hstep, voffA);
        if (wr == 1) PG8_BAR;
        PG8_WAIT_V(2); PG8_BAR;
        PG8_STAGE(PG8_SB(1, 0), cB + kstep, voffB); PG8_STAGE(PG8_SA(1, 0), cA + kstep, voffA); PG8_STAGE(PG8_SB(1, 1), cB + hstep + kstep, voffB);
        PG8_WAIT_V(6); PG8_BAR;
    } else {
        PG8_STAGE(PG8_SB(0, 0), cB, voffB); PG8_STAGE(PG8_SA(0, 0), cA, voffA); PG8_STAGE(PG8_SB(0, 1), cB + hstep, voffB); PG8_STAGE(PG8_SA(0, 1), cA + hstep, voffA);
        if (wr == 1) PG8_BAR;
        PG8_WAIT_V(4); PG8_BAR;
        PG8_STAGE(PG8_SB(1, 0), cB + kstep, voffB); PG8_STAGE(PG8_SA(1, 0), cA + kstep, voffA); PG8_STAGE(PG8_SB(1, 1), cB + hstep + kstep, voffB);
        PG8_WAIT_V(6); PG8_BAR;
    }
    for (;;) {
        const bool has_next = S.next(ui + 1, nxt);
        const char* nA = has_next ? (const char*)g.A + (size_t)nxt.pm * tstep : cA; const char* nB = has_next ? (const char*)g.Bt + (size_t)nxt.pn * tstep : cB;
        for (int t = 0; t < nt; t += 2) {
            const bool last = (t == nt - 2);
            const char* a1 = cA + (size_t)(t + 1) * kstep;
            const char* a2 = last ? nA : cA + (size_t)(t + 2) * kstep; const char* b2 = last ? nB : cB + (size_t)(t + 2) * kstep;
            const char* a3 = a2 + kstep; const char* b3 = b2 + kstep;
            if (last && has_next) S.a_ready(nxt);
            if constexpr (SP2) {
            PG8_LDB(B0, 0, 0); PG8_LDB(B1, 0, 1); PG8_SCHED; PG8_LDA(At, 0, 0); PG8_STAGE(PG8_SA(1, 1), a1 + hstep, voffA);
            PG8_WAIT_V(8); PG8_WAIT_L(0); PG8_BAR; PG8_MMA(0, 0, At, B0); PG8_MMA(0, 1, At, B1); PG8_BAR; PG8_SCHED;
            PG8_LDA(At, 0, 1); PG8_STAGE(PG8_SB(0, 0), b2, voffB); PG8_STAGE(PG8_SB(0, 1), b2 + hstep, voffB); PG8_STAGE(PG8_SA(0, 0), a2, voffA);
            PG8_WAIT_V(8); PG8_WAIT_L(0); PG8_BAR; PG8_MMA(1, 0, At, B0); PG8_MMA(1, 1, At, B1); PG8_BAR; PG8_SCHED;
            PG8_LDB(B0, 1, 0); PG8_LDB(B1, 1, 1); PG8_SCHED; PG8_LDA(At, 1, 0); PG8_STAGE(PG8_SA(0, 1), a2 + hstep, voffA);
            PG8_WAIT_V(8); PG8_WAIT_L(0); PG8_BAR; PG8_MMA(0, 0, At, B0); PG8_MMA(0, 1, At, B1); PG8_BAR; PG8_SCHED;
            PG8_LDA(At, 1, 1); PG8_STAGE(PG8_SB(1, 0), b3, voffB); PG8_STAGE(PG8_SB(1, 1), b3 + hstep, voffB); PG8_STAGE(PG8_SA(1, 0), a3, voffA);
            PG8_WAIT_V(8); PG8_WAIT_L(0); PG8_BAR; PG8_MMA(1, 0, At, B0); PG8_MMA(1, 1, At, B1); PG8_BAR; PG8_SCHED;
            } else {
            PG8_LDB(B0, 0, 0); PG8_SCHED; PG8_LDA(At, 0, 0); PG8_STAGE(PG8_SA(1, 1), a1 + hstep, voffA);
            PG8_WAIT_L(8); PG8_BAR; PG8_WAIT_L(0); PG8_MMA(0, 0, At, B0); PG8_BAR; PG8_SCHED;
            PG8_LDB(B1, 0, 1); PG8_STAGE(PG8_SB(0, 0), b2, voffB);
            PG8_BAR; PG8_WAIT_L(0); PG8_MMA(0, 1, At, B1); PG8_BAR;
            PG8_LDA(At, 0, 1); PG8_STAGE(PG8_SA(0, 0), a2, voffA);
            PG8_BAR; PG8_WAIT_L(0); PG8_MMA(1, 0, At, B0); PG8_BAR; PG8_SCHED;
            PG8_STAGE(PG8_SB(0, 1), b2 + hstep, voffB);
            PG8_WAIT_V(6); PG8_BAR; PG8_MMA(1, 1, At, B1); PG8_BAR;
            PG8_LDB(B0, 1, 0); PG8_SCHED; PG8_LDA(At, 1, 0); PG8_STAGE(PG8_SA(0, 1), a2 + hstep, voffA);
            PG8_WAIT_L(8); PG8_BAR; PG8_WAIT_L(0); PG8_MMA(0, 0, At, B0); PG8_BAR; PG8_SCHED;
            PG8_LDB(B1, 1, 1); PG8_STAGE(PG8_SB(1, 0), b3, voffB);
            PG8_BAR; PG8_WAIT_L(0); PG8_MMA(0, 1, At, B1); PG8_BAR;
            PG8_LDA(At, 1, 1); PG8_STAGE(PG8_SA(1, 0), a3, voffA);
            PG8_BAR; PG8_WAIT_L(0); PG8_MMA(1, 0, At, B0); PG8_BAR; PG8_SCHED;
            PG8_STAGE(PG8_SB(1, 1), b3 + hstep, voffB);
            PG8_WAIT_V(6); PG8_BAR; PG8_MMA(1, 1, At, B1); PG8_BAR;
            }
        }
        if constexpr (ALIGN_EPI) { if (wr == 0) PG8_BAR; }
        if constexpr (!Epi::AFTER_DRAIN) { E(acc, cur, wr, wc, fr, fq); S.done(cur); }
        if (!has_next) break;
#pragma unroll
        for (int a = 0; a < 2; ++a)
#pragma unroll
            for (int b = 0; b < 2; ++b)
#pragma unroll
                for (int m = 0; m < 4; ++m)
#pragma unroll
                    for (int n = 0; n < 2; ++n) acc[a][b][m][n] = (f32x4){0.f, 0.f, 0.f, 0.f};
        cur = nxt; cA = nA; cB = nB; ++ui;
        if constexpr (ALIGN_EPI) { if (wr == 1) PG8_BAR; }
    }
    PG8_WAIT_V(0);
    if constexpr (!ALIGN_EPI) { if (wr == 0) PG8_BAR; }
    PG8_BAR;
    if constexpr (Epi::AFTER_DRAIN) { E.fused(acc, cur, wr, wc, fr, fq, lds, wid, lane); S.done(cur); }
#undef PG8_SA
#undef PG8_SB
#undef PG8_STAGE
#undef PG8_LDA
#undef PG8_LDB
#undef PG8_MMA
#undef PG8_WAIT_V
#undef PG8_WAIT_L
#undef PG8_BAR
#undef PG8_SCHED
}
}

#define LAS __attribute__((address_space(3)))
typedef unsigned short bf16;
typedef short bf16x8 __attribute__((ext_vector_type(8)));
typedef float f32x4 __attribute__((ext_vector_type(4)));
typedef float f32x16 __attribute__((ext_vector_type(16)));
typedef unsigned u32x4 __attribute__((ext_vector_type(4)));
typedef unsigned u32x2 __attribute__((ext_vector_type(2)));
typedef float f32x2_t __attribute__((ext_vector_type(2)));
typedef __bf16 bf16x2_t __attribute__((ext_vector_type(2)));

constexpr int DM = 1024, TSEQ = 2048, NB = 8, MP = NB * TSEQ  , NS = 128  , MR = MP + NS  , MPAD = 16640  ;
constexpr int DREC = 512, DATT = 512, DKV = 128, DFF = 2816, DIN = 1792;
constexpr float EPS = 1e-6f;
constexpr int NWAVES = 8, NTHR = 512;
constexpr size_t OFF_Y = 0, OFF_PK = (size_t)MR * DM, OFF_PV = OFF_PK + 131072, OFF_PCONV = OFF_PV + 131072, OFF_PH = OFF_PCONV + 12288,
                 OFF_SK = OFF_PH + 4096, OFF_SV = OFF_SK + 2097152, OFF_SCONV = OFF_SV + 2097152, OFF_SH = OFF_SCONV + 196608, OUT_END = OFF_SH + 65536;
constexpr size_t MiB = 1u << 20;
constexpr int CTL_WORDS = 10240, CW_DONE = CTL_WORDS - 1;
__device__ unsigned g_ctl[CTL_WORDS];
constexpr size_t WS_RSQH = 0, WS_SUMA = 1 * MiB, WS_SUMH = 1 * MiB + 512 * 1024;
constexpr size_t WS_WIN = 2 * MiB, WS_WOUT = 6 * MiB, WS_WGU = 8 * MiB, WS_WD = 19 * MiB, WS_GWT = 25 * MiB;
constexpr size_t WS_MIX = 26 * MiB, WS_HB = 59 * MiB, WS_FF = 92 * MiB;
constexpr size_t WS_XN = 92 * MiB, WS_XR = 125 * MiB, WS_GR = 142 * MiB, WS_Q = 159 * MiB, WS_KB = 176 * MiB, WS_VT = 181 * MiB, WS_END = 250 * MiB;
static_assert(WS_MIX + (size_t)MPAD * DM * 2 <= WS_HB && WS_HB + (size_t)MPAD * DM * 2 <= WS_FF && WS_FF + (size_t)MPAD * DFF * 2 <= WS_END, "ws map");
static_assert(WS_GR - WS_XR == WS_Q - WS_GR, "xr/gr/q equally spaced");
static_assert(WS_XN + (size_t)MPAD * DM * 2 <= WS_XR && WS_XR + (size_t)MPAD * 512 * 2 <= WS_GR && WS_GR + (size_t)MPAD * 512 * 2 <= WS_Q && WS_Q + (size_t)MPAD * 512 * 2 <= WS_KB && WS_KB + (size_t)MPAD * 128 * 2 <= WS_VT, "ws map 2");
constexpr int LDS_BYTES = 132096;

struct Params {
    const float* in[24];
    float* out; unsigned char* ws;
};
typedef const __attribute__((address_space(4))) Params* KP;
__device__ __forceinline__ KP kargs() { KP q = (KP)__builtin_amdgcn_kernarg_segment_ptr(); asm volatile("" : "+s"(q)); return q; }
enum { I_XP = 0, I_XS, I_CK, I_CV, I_SCONV, I_SH, I_N1G, I_WIN, I_CONVW, I_CONVB, I_GAW, I_GAB, I_GXW, I_GXB, I_LAM, I_SINK, I_RNG, I_ANG, I_WOUT, I_N2G, I_WG, I_WU, I_WD, I_FNG };

__device__ __forceinline__ unsigned pk2(float lo, float hi) { f32x2_t v = {lo, hi}; bf16x2_t b = __builtin_convertvector(v, bf16x2_t); return __builtin_bit_cast(unsigned, b); }
__device__ __forceinline__ float bflo(unsigned w) { return __uint_as_float(w << 16); }
__device__ __forceinline__ float bfhi(unsigned w) { return __uint_as_float(w & 0xffff0000u); }
__device__ __forceinline__ float bf1(bf16 u) { return __uint_as_float((unsigned)u << 16); }
__device__ __forceinline__ float shx(float v, int o, int lane) { return __int_as_float(__builtin_amdgcn_ds_bpermute((lane ^ o) << 2, __float_as_int(v))); }
__device__ __forceinline__ float shl(float v, int src) { return __int_as_float(__builtin_amdgcn_ds_bpermute(src << 2, __float_as_int(v))); }
__device__ __forceinline__ float wave_sum(float v, int lane) {
#pragma unroll
    for (int o = 1; o < 64; o <<= 1) v += shx(v, o, lane);
    return v;
}
__device__ __forceinline__ float wave_max(float v, int lane) {
#pragma unroll
    for (int o = 1; o < 64; o <<= 1) v = fmaxf(v, shx(v, o, lane));
    return v;
}
__device__ __forceinline__ float frcp(float x) { return __builtin_amdgcn_rcpf(x); }
__device__ __forceinline__ float fsqrt(float x) { return __builtin_amdgcn_sqrtf(x); }
__device__ __forceinline__ float frsq(float x) { return __builtin_amdgcn_rsqf(x); }
__device__ __forceinline__ float fexp(float x) { return __builtin_amdgcn_exp2f(x * 1.4426950408889634f); }
__device__ __forceinline__ float sigmoidf_(float x) { return frcp(1.0f + fexp(-x)); }
__device__ __forceinline__ float gelu_tanh(float x) { const float z = 0.7978845608028654f * (x + 0.044715f * x * x * x); const float e = fexp(2.0f * z); return x * (1.0f - frcp(e + 1.0f)); }

using pg8::Unit;
struct EpiIn {
    static constexpr bool PERM = true, AFTER_DRAIN = false;
    unsigned char* ws; float* out;
    __device__ __forceinline__ void operator()(const f32x4 (&acc)[2][2][4][2], const Unit& u, int wr, int wc, int fr, int fq) const {
        const int pn = u.pn;
        bf16* const KB = (bf16*)(ws + WS_KB); bf16* const VT = (bf16*)(ws + WS_VT);
#pragma unroll
        for (int ai = 0; ai < 2; ++ai)
#pragma unroll
            for (int m = 0; m < 4; ++m) {
                const int row = u.pm * 256 + ai * 128 + wr * 64 + m * 16 + fr;
                const bool isp = row < MP, iss = (row >= MP) && (row < MR);
                const int b = isp ? (row >> 11) : (row - MP), t = row & (TSEQ - 1);
#pragma unroll
                for (int bj = 0; bj < 2; ++bj) {
                    const int c = bj * 128 + wc * 32 + 8 * fq;
                    f32x4 v0 = acc[ai][bj][m][0], v1 = acc[ai][bj][m][1];
                    if (pn < 6) {
                        bf16* dst = (bf16*)(ws + WS_XR + (size_t)(pn >> 1) * (WS_GR - WS_XR));
                        const int col = (pn & 1) * 256 + c;
                        if (pn >= 4) { v0 = v0 * 0.125f; v1 = v1 * 0.125f; }
                        u32x4 w; w.x = pk2(v0[0], v0[1]); w.y = pk2(v0[2], v0[3]); w.z = pk2(v1[0], v1[1]); w.w = pk2(v1[2], v1[3]);
                        *(u32x4*)(dst + (size_t)row * 512 + col) = w;
                        if (pn < 2) {
                            float* o = nullptr;
                            if (isp && t >= TSEQ - 3) o = out + OFF_PCONV + (size_t)(b * 3 + (t - (TSEQ - 3))) * 512 + col;
                            if (iss) o = out + OFF_SCONV + (size_t)(b * 3 + 2) * 512 + col;
                            if (o) { *(f32x4*)o = v0; *(f32x4*)(o + 4) = v1; }
                        }
                    } else {
                        const int cc = wc * 32 + 8 * fq;
                        if (bj == 0) {
                            u32x4 w; w.x = pk2(v0[0], v0[1]); w.y = pk2(v0[2], v0[3]); w.z = pk2(v1[0], v1[1]); w.w = pk2(v1[2], v1[3]);
                            *(u32x4*)(KB + (size_t)row * 128 + cc) = w;
                        } else if (isp) {
                            const int kvh = cc >> 6, d0 = cc & 63;
                            bf16* vt = VT + ((size_t)(b * 2 + kvh) * 64 + d0) * TSEQ + t;
                            const unsigned w0 = pk2(v0[0], v0[1]), w1 = pk2(v0[2], v0[3]), w2 = pk2(v1[0], v1[1]), w3 = pk2(v1[2], v1[3]);
                            vt[0 * TSEQ] = (bf16)(w0 & 0xffff); vt[1 * TSEQ] = (bf16)(w0 >> 16); vt[2 * TSEQ] = (bf16)(w1 & 0xffff); vt[3 * TSEQ] = (bf16)(w1 >> 16);
                            vt[4 * TSEQ] = (bf16)(w2 & 0xffff); vt[5 * TSEQ] = (bf16)(w2 >> 16); vt[6 * TSEQ] = (bf16)(w3 & 0xffff); vt[7 * TSEQ] = (bf16)(w3 >> 16);
                        }
                        float* o = nullptr;
                        if (isp && t >= TSEQ - 128) o = out + (bj == 0 ? OFF_PK : OFF_PV) + (size_t)(b * 128 + (t - (TSEQ - 128))) * 128 + cc;
                        if (iss) o = out + (bj == 0 ? OFF_SK : OFF_SV) + (size_t)(b * 128 + 127) * 128 + cc;
                        if (o) { *(f32x4*)o = v0; *(f32x4*)(o + 4) = v1; }
                    }
                }
            }
    }
};
struct EpiOut {
    static constexpr bool PERM = false, AFTER_DRAIN = false;
    const float *xp, *xs; float* H; unsigned char* ws;
    __device__ __forceinline__ void operator()(const f32x4 (&acc)[2][2][4][2], const Unit& u, int wr, int wc, int fr, int fq) const {
        const int col0 = u.pn * 256 + wc * 32 + 4 * fq, lane = fr + 16 * fq;
        bf16* const HB = (bf16*)(ws + WS_HB); float* const rsq = (float*)(ws + WS_RSQH);
#pragma unroll
        for (int ai = 0; ai < 2; ++ai)
#pragma unroll
            for (int m = 0; m < 4; ++m) {
                const int row = u.pm * 256 + ai * 128 + wr * 64 + m * 16 + fr;
                const bool real = row < MR;
                const float* xrow = row < MP ? xp + (size_t)row * DM : xs + (size_t)(row - MP) * DM;
                float s = 0.f;
#pragma unroll
                for (int bj = 0; bj < 2; ++bj)
#pragma unroll
                    for (int n = 0; n < 2; ++n) {
                        const int c = col0 + bj * 128 + n * 16;
                        f32x4 v = acc[ai][bj][m][n];
                        if (real) v = v + __builtin_nontemporal_load((const f32x4*)(xrow + c));
                        s += (v[0] * v[0] + v[1] * v[1]) + (v[2] * v[2] + v[3] * v[3]);
                        u32x2 w; w.x = pk2(v[0], v[1]); w.y = pk2(v[2], v[3]);
                        *(u32x2*)(HB + (size_t)row * DM + c) = w;
                    }
                s += shx(s, 16, lane); s += shx(s, 32, lane);
                if (fq == 0) atomicAdd(rsq + row, s);
            }
    }
};
struct EpiGU {
    static constexpr bool PERM = true, AFTER_DRAIN = false;
    unsigned char* ws;
    __device__ __forceinline__ void operator()(const f32x4 (&acc)[2][2][4][2], const Unit& u, int wr, int wc, int fr, int fq) const {
        const int col = u.pn * 128 + wc * 32 + 8 * fq;
        bf16* const FF = (bf16*)(ws + WS_FF); const float* const rsq = (const float*)(ws + WS_RSQH);
#pragma unroll
        for (int ai = 0; ai < 2; ++ai)
#pragma unroll
            for (int m = 0; m < 4; ++m) {
                const int row = u.pm * 256 + ai * 128 + wr * 64 + m * 16 + fr;
                const float r = frsq(rsq[row] * (1.0f / DM) + EPS);
                float o[8];
#pragma unroll
                for (int n = 0; n < 2; ++n)
#pragma unroll
                    for (int e = 0; e < 4; ++e) { const float g = acc[ai][0][m][n][e] * r, uu = acc[ai][1][m][n][e] * r; o[4 * n + e] = g * sigmoidf_(g) * uu; }
                u32x4 w; w.x = pk2(o[0], o[1]); w.y = pk2(o[2], o[3]); w.z = pk2(o[4], o[5]); w.w = pk2(o[6], o[7]);
                *(u32x4*)(FF + (size_t)row * DFF + col) = w;
            }
    }
};
struct EpiDown {
    static constexpr bool PERM = false, AFTER_DRAIN = false;
    float* H;
    __device__ __forceinline__ void operator()(const f32x4 (&acc)[2][2][4][2], const Unit& u, int wr, int wc, int fr, int fq) const {
        const int col0 = u.pn * 256 + wc * 32 + 4 * fq;
#pragma unroll
        for (int ai = 0; ai < 2; ++ai)
#pragma unroll
            for (int m = 0; m < 4; ++m) {
                const int row = u.pm * 256 + ai * 128 + wr * 64 + m * 16 + fr;
                if (row < MR) {
#pragma unroll
                    for (int bj = 0; bj < 2; ++bj)
#pragma unroll
                        for (int n = 0; n < 2; ++n) {
                            float* pp = H + (size_t)row * DM + col0 + bj * 128 + n * 16;
                            *(f32x4*)pp = *(const f32x4*)pp + acc[ai][bj][m][n];
                        }
                }
            }
    }
};

constexpr size_t WS_XBUF = 768 * 1024;
constexpr int CW_PANEL = 4096, CW_SAMPLE = 8192, CW_S1 = 8192 + 64, CW_SCAN = 8192 + 128;
struct EpiDownFused {
    static constexpr bool PERM = false, AFTER_DRAIN = true;
    unsigned char* ws; float* out; const float* gf;
    __device__ __forceinline__ void operator()(const f32x4 (&)[2][2][4][2], const Unit&, int, int, int, int) const {}
    __device__ __forceinline__ void fused(f32x4 (&acc)[2][2][4][2], const Unit& u, int wr, int wc, int fr, int fq, PG8_LAS unsigned char* lds, int wid, int lane) const {
        LAS float* P = (LAS float*)lds;
        LAS float* Sr = (LAS float*)(lds + 4096);
        const bf16* HB = (const bf16*)(ws + WS_HB);
        float* xbuf = (float*)(ws + WS_XBUF);
        unsigned* cnt = g_ctl + CW_PANEL + 64 * u.pm;
        const int col0 = u.pn * 256 + wc * 32 + 4 * fq;
#pragma unroll
        for (int ai = 0; ai < 2; ++ai)
#pragma unroll
            for (int m = 0; m < 4; ++m) {
                const int rl = ai * 128 + wr * 64 + m * 16 + fr; const size_t row = (size_t)u.pm * 256 + rl;
                float s = 0.f;
#pragma unroll
                for (int bj = 0; bj < 2; ++bj)
#pragma unroll
                    for (int n = 0; n < 2; ++n) {
                        const u32x2 hb = __builtin_nontemporal_load((const u32x2*)(HB + row * DM + col0 + bj * 128 + n * 16));
                        f32x4 v = acc[ai][bj][m][n];
                        v[0] += bflo(hb.x); v[1] += bfhi(hb.x); v[2] += bflo(hb.y); v[3] += bfhi(hb.y);
                        acc[ai][bj][m][n] = v;
                        s += (v[0] * v[0] + v[1] * v[1]) + (v[2] * v[2] + v[3] * v[3]);
                    }
                s += shx(s, 16, lane); s += shx(s, 32, lane);
                if (fq == 0) P[rl * 4 + wc] = s;
            }
        asm volatile("s_waitcnt lgkmcnt(0)" ::: "memory"); __builtin_amdgcn_s_barrier(); asm volatile("" ::: "memory");
        const int rr = wid * 32 + (lane & 31);
        if (lane < 32) {
            const float tot = (P[rr * 4 + 0] + P[rr * 4 + 1]) + (P[rr * 4 + 2] + P[rr * 4 + 3]);
            __hip_atomic_store(xbuf + ((size_t)u.pm * 256 + rr) * 4 + u.pn, tot, __ATOMIC_RELAXED, __HIP_MEMORY_SCOPE_AGENT);
        }
        asm volatile("s_waitcnt vmcnt(0)" ::: "memory");
        if (lane == 0) __hip_atomic_fetch_add(cnt, 1u, __ATOMIC_RELAXED, __HIP_MEMORY_SCOPE_AGENT);
        if (wid == 0) {
            unsigned sp = 0;
            while ((unsigned)__builtin_amdgcn_readfirstlane(__hip_atomic_load(cnt, __ATOMIC_RELAXED, __HIP_MEMORY_SCOPE_AGENT)) < 32u) { __builtin_amdgcn_s_sleep(2); if (++sp > (1u << 22)) break; }
            __builtin_amdgcn_fence(__ATOMIC_ACQUIRE, "agent");
        }
        asm volatile("s_waitcnt vmcnt(0) lgkmcnt(0)" ::: "memory"); __builtin_amdgcn_s_barrier(); asm volatile("" ::: "memory");
        if (lane < 32) {
            const float* sl = xbuf + ((size_t)u.pm * 256 + rr) * 4; float t = 0.f;
#pragma unroll
            for (int k = 0; k < 4; ++k) t += __hip_atomic_load(sl + k, __ATOMIC_RELAXED, __HIP_MEMORY_SCOPE_AGENT);
            Sr[rr] = frsq(t * (1.0f / DM) + EPS);
        }
        asm volatile("s_waitcnt vmcnt(0) lgkmcnt(0)" ::: "memory"); __builtin_amdgcn_s_barrier(); asm volatile("" ::: "memory");
        f32x4 gv[2][2];
#pragma unroll
        for (int bj = 0; bj < 2; ++bj)
#pragma unroll
            for (int n = 0; n < 2; ++n) gv[bj][n] = *(const f32x4*)(gf + col0 + bj * 128 + n * 16);
#pragma unroll
        for (int ai = 0; ai < 2; ++ai)
#pragma unroll
            for (int m = 0; m < 4; ++m) {
                const int rl = ai * 128 + wr * 64 + m * 16 + fr; const size_t row = (size_t)u.pm * 256 + rl;
                const float sc = Sr[rl];
#pragma unroll
                for (int bj = 0; bj < 2; ++bj)
#pragma unroll
                    for (int n = 0; n < 2; ++n) __builtin_nontemporal_store(acc[ai][bj][m][n] * sc * gv[bj][n], (f32x4*)(out + row * DM + col0 + bj * 128 + n * 16));
            }
    }
};

__device__ __forceinline__ void tr_item(const float* __restrict__ W, int N, bf16* WT, int ldt, int k0, int n0, int drow0, const float* __restrict__ kscale, LAS float* scr, int lane) {
    float wv[32];
#pragma unroll
    for (int i = 0; i < 32; ++i) wv[i] = __builtin_nontemporal_load(W + (size_t)(k0 + 2 * i + (lane >> 5)) * N + n0 + (lane & 31));
#pragma unroll
    for (int i = 0; i < 32; ++i) { const int kk = 2 * i + (lane >> 5); float v = wv[i]; if (kscale) v *= kscale[k0 + kk]; scr[kk * 33 + (lane & 31)] = v; }
    asm volatile("s_waitcnt lgkmcnt(0)" ::: "memory");
    const int c = lane & 7;
#pragma unroll
    for (int j = 0; j < 4; ++j) { const int n = (lane >> 3) + 8 * j; const LAS float* s = scr + (8 * c) * 33 + n;
        u32x4 o; o.x = pk2(s[0 * 33], s[1 * 33]); o.y = pk2(s[2 * 33], s[3 * 33]); o.z = pk2(s[4 * 33], s[5 * 33]); o.w = pk2(s[6 * 33], s[7 * 33]);
        *(u32x4*)(WT + (size_t)(drow0 + n) * ldt + k0 + 8 * c) = o; }
    asm volatile("s_waitcnt lgkmcnt(0)" ::: "memory");
}
constexpr int CI_WIN = 16 * 56, CI_G = CI_WIN + 32, CI_WOUT = CI_G + 16 * 32, CI_WU = CI_WOUT + 2 * 16 * 88, CI_WD = CI_WU + 44 * 32;
__device__ __forceinline__ void convert_items(KP p, LAS unsigned char* lds, int lo, int hi, int gw, int NGW, int wave, int lane) {
    unsigned char* ws = p->ws;
    LAS float* scr = (LAS float*)(lds + wave * 16384);
    for (int it = lo + gw; it < hi; it += NGW) {
        const float* W; const float* ks = nullptr; bf16* WT; int N, ldt, k0, n0, drow0; int r = it;
        if (r < CI_WIN) { const int kb = r / 56, nb = r % 56; W = p->in[I_WIN]; N = DIN; WT = (bf16*)(ws + WS_WIN); ldt = DM; k0 = 64 * kb; n0 = 32 * nb; drow0 = n0; }
        else if (r < CI_G) { r -= CI_WIN; const int gx = r >> 4, n = (r & 15) >> 1, nb = r & 1; W = p->in[gx ? I_GXW : I_GAW] + n * 4096; N = 64; WT = (bf16*)(ws + WS_GWT) + gx * 8 * 4096 + n * 4096; ldt = 64; k0 = 0; n0 = 32 * nb; drow0 = n0; }
        else if (r < CI_WOUT) { r -= CI_G; const int kb = r / 32, nb = r % 32; W = p->in[I_WOUT]; N = DM; WT = (bf16*)(ws + WS_WOUT); ldt = DM; k0 = 64 * kb; n0 = 32 * nb; drow0 = n0; }
        else if (r < CI_WU) { r -= CI_WOUT; const int up = r >= 16 * 88 ? 1 : 0; if (up) r -= 16 * 88; const int kb = r / 88, nb = r % 88; W = p->in[up ? I_WU : I_WG]; N = DFF; WT = (bf16*)(ws + WS_WGU); ldt = DM; k0 = 64 * kb; n0 = 32 * nb;
            drow0 = 256 * (n0 >> 7) + 128 * up + (n0 & 127); ks = p->in[I_N2G]; }
        else { r -= CI_WU; const int kb = r / 32, nb = r % 32; W = p->in[I_WD]; N = DM; WT = (bf16*)(ws + WS_WD); ldt = DFF; k0 = 64 * kb; n0 = 32 * nb; drow0 = n0; }
        tr_item(W, N, WT, ldt, k0, n0, drow0, ks, scr, lane);
    }
}
__device__ __forceinline__ void copy_windows(KP p, int gt, int NGT) {
    for (int i = gt; i < NS * 4064; i += NGT) { const int b = i / 4064, o = i % 4064;
        __builtin_nontemporal_store(__builtin_nontemporal_load((const f32x4*)(p->in[I_CK] + (size_t)b * 16384 + 128) + o), (f32x4*)(p->out + OFF_SK + (size_t)b * 16384) + o);
        __builtin_nontemporal_store(__builtin_nontemporal_load((const f32x4*)(p->in[I_CV] + (size_t)b * 16384 + 128) + o), (f32x4*)(p->out + OFF_SV + (size_t)b * 16384) + o); }
    for (int i = gt; i < NS * 256; i += NGT) { const int b = i >> 8, o = i & 255;
        ((f32x4*)(p->out + OFF_SCONV + (size_t)b * 1536))[o] = ((const f32x4*)(p->in[I_SCONV] + (size_t)b * 1536 + 512))[o]; }
}
__device__ __forceinline__ void slack_slot(int nwg, int G, int bx, int& slot, int& nslots) {
    const int mx = (nwg + G - 1) / G, first = nwg - (mx - 1) * G;
    if (first >= G) { slot = bx; nslots = G; } else { slot = bx - first; nslots = G - first; }
}
__device__ __forceinline__ void p0_prologue(KP p, LAS unsigned char* lds, int gw, int NGW, int wave, int lane) {
    unsigned char* ws = p->ws;
    convert_items(p, lds, 0, CI_G, gw, NGW, wave, lane);
    {
        const f32x4* g4 = (const f32x4*)p->in[I_N1G] + lane;
        f32x4 g[4];
#pragma unroll
        for (int j = 0; j < 4; ++j) g[j] = g4[64 * j];
        for (int m0 = gw; m0 < MR; m0 += 2 * NGW) {
            f32x4 v[2][4];
#pragma unroll
            for (int rr = 0; rr < 2; ++rr) { const int m = m0 + rr * NGW, mc = m < MR ? m : m0;
                const float* xrow = mc < MP ? p->in[I_XP] + (size_t)mc * DM : p->in[I_XS] + (size_t)(mc - MP) * DM;
                const f32x4* xr = (const f32x4*)xrow + lane;
#pragma unroll
                for (int j = 0; j < 4; ++j) v[rr][j] = __builtin_nontemporal_load(xr + 64 * j); }
#pragma unroll
            for (int rr = 0; rr < 2; ++rr) { const int m = m0 + rr * NGW;
                float s = 0.f;
#pragma unroll
                for (int j = 0; j < 4; ++j) s += (v[rr][j].x * v[rr][j].x + v[rr][j].y * v[rr][j].y) + (v[rr][j].z * v[rr][j].z + v[rr][j].w * v[rr][j].w);
                const float rs = frsq(wave_sum(s, lane) * (1.f / DM) + EPS);
                if (m < MR) { u32x2* o8 = (u32x2*)((bf16*)(ws + WS_XN) + (size_t)m * DM) + lane;
#pragma unroll
                    for (int j = 0; j < 4; ++j) { u32x2 w; w.x = pk2(v[rr][j].x * rs * g[j].x, v[rr][j].y * rs * g[j].y); w.y = pk2(v[rr][j].z * rs * g[j].z, v[rr][j].w * rs * g[j].w); o8[64 * j] = w; } }
            }
        }
    }
    const int gt = gw * 64 + lane, NGT = NGW * 64;
    for (int i = gt; i < MPAD; i += NGT) ((float*)(ws + WS_RSQH))[i] = 0.f;
}

__device__ __forceinline__ void row_scan4(float A, float H, float c0, int q, float& cin, float& At, float& Ht) {
    const auto ra = __builtin_amdgcn_permlane16_swap(__float_as_uint(A), __float_as_uint(A), false, false);
    const auto rh = __builtin_amdgcn_permlane16_swap(__float_as_uint(H), __float_as_uint(H), false, false);
    const float Ae = __uint_as_float(ra[0]), Ao = __uint_as_float(ra[1]), He = __uint_as_float(rh[0]), Ho = __uint_as_float(rh[1]);
    const float Ap = Ae * Ao, Hp = Ao * He + Ho;
    const auto pa = __builtin_amdgcn_permlane32_swap(__float_as_uint(Ap), __float_as_uint(Ap), false, false);
    const auto ph = __builtin_amdgcn_permlane32_swap(__float_as_uint(Hp), __float_as_uint(Hp), false, false);
    const float Alo = __uint_as_float(pa[0]), Ahi = __uint_as_float(pa[1]), Hlo = __uint_as_float(ph[0]), Hhi = __uint_as_float(ph[1]);
    const float c2 = Alo * c0 + Hlo, base = (q & 2) ? c2 : c0;
    cin = (q & 1) ? (Ae * base + He) : base;
    At = Alo * Ahi; Ht = Ahi * Hlo + Hhi;
}

constexpr int HS_OFF = 16384, HS_LD = 1032;
#define MFMA16(a, b, c) __builtin_amdgcn_mfma_f32_16x16x32_bf16((a), (b), (c), 0, 0, 0)
#define MFMA32(a, b, c) __builtin_amdgcn_mfma_f32_32x32x16_bf16((a), (b), (c), 0, 0, 0)
typedef float f32x2v __attribute__((ext_vector_type(2)));
constexpr size_t WS_AU = 186 * MiB;
template <bool FINAL>
__device__ __forceinline__ void scan_unit(KP p, int b, int chunk, LAS unsigned char* lds, int wave, int lane) {
    unsigned char* ws = p->ws;
    const bf16* XR = (const bf16*)(ws + WS_XR);
    const bf16* GWT = (const bf16*)(ws + WS_GWT);
    float* SA = (float*)(ws + WS_SUMA); float* SH = (float*)(ws + WS_SUMH);
    f32x2v* AU = (f32x2v*)(ws + WS_AU);
    const LAS float* cw = (const LAS float*)lds;
    const int n = wave, j = lane & 15, q = lane >> 4;
    float hprev[4] = {0.f, 0.f, 0.f, 0.f}, acum[4] = {1.f, 1.f, 1.f, 1.f};
    const size_t au0 = ((size_t)b * TSEQ + chunk * 64 + 4 * q) * 512 + 64 * n + j;
    if constexpr (FINAL) {
        unsigned pfg; { const int t_ = wave * 64 + lane; pfg = *(const unsigned*)((const bf16*)(ws + WS_GR) + ((size_t)b * TSEQ + chunk * 64 + (t_ >> 3)) * 512 + (t_ & 7) * 64); }
        f32x2v au[4][4], aun[4][4];
#define SCAN_LOADAU(dst, sc_) do { _Pragma("unroll") for (int nt = 0; nt < 4; ++nt) _Pragma("unroll") for (int r = 0; r < 4; ++r) dst[nt][r] = __builtin_nontemporal_load(AU + au0 + (size_t)((sc_) * 16 + r) * 512 + 16 * nt); } while (0)
        SCAN_LOADAU(au, 0);
        {
            float As[4] = {1.f, 1.f, 1.f, 1.f}, Hs[4] = {0.f, 0.f, 0.f, 0.f};
            float la[8][4], lh[8][4];
#pragma unroll
            for (int cc = 0; cc < 8; ++cc) { const int c = 8 * q + cc, ce = c < chunk ? c : 0;
#pragma unroll
                for (int nt = 0; nt < 4; ++nt) { const size_t o = (size_t)(b * 32 + ce) * 512 + 64 * n + 16 * nt + j; la[cc][nt] = __hip_atomic_load(SA + o, __ATOMIC_RELAXED, __HIP_MEMORY_SCOPE_AGENT); lh[cc][nt] = __hip_atomic_load(SH + o, __ATOMIC_RELAXED, __HIP_MEMORY_SCOPE_AGENT); } }
#pragma unroll
            for (int cc = 0; cc < 8; ++cc) { const bool ok = (8 * q + cc) < chunk;
#pragma unroll
                for (int nt = 0; nt < 4; ++nt) { const float a = ok ? la[cc][nt] : 1.f, hh = ok ? lh[cc][nt] : 0.f; Hs[nt] = a * Hs[nt] + hh; As[nt] *= a; } }
#pragma unroll
            for (int nt = 0; nt < 4; ++nt) { float cin_, At_, Ht_; row_scan4(As[nt], Hs[nt], 0.f, q, cin_, At_, Ht_); hprev[nt] = Ht_; }
        }
#pragma unroll
        for (int sc = 0; sc < 4; ++sc) {
            if (sc < 3) SCAN_LOADAU(aun, sc + 1);
#pragma unroll
            for (int nt = 0; nt < 4; ++nt) {
                float a4[4], u4[4];
#pragma unroll
                for (int r = 0; r < 4; ++r) { a4[r] = au[nt][r].x; u4[r] = au[nt][r].y; }
                const float A4 = (a4[0] * a4[1]) * (a4[2] * a4[3]);
                const float H4 = ((u4[0] * a4[1] + u4[1]) * a4[2] + u4[2]) * a4[3] + u4[3];
                float cin, At_, Ht_; row_scan4(A4, H4, hprev[nt], q, cin, At_, Ht_);
                hprev[nt] = At_ * hprev[nt] + Ht_;
                LAS bf16* hs = (LAS bf16*)(lds + HS_OFF + (sc * 16 + 4 * q) * HS_LD) + (64 * n + 16 * nt + j);
                float h = cin;
#pragma unroll
                for (int r = 0; r < 4; ++r) { h = a4[r] * h + u4[r]; hs[r * (HS_LD / 2)] = (bf16)(pk2(h, 0.f) & 0xffff); }
            }
#pragma unroll
            for (int nt = 0; nt < 4; ++nt)
#pragma unroll
                for (int r = 0; r < 4; ++r) au[nt][r] = aun[nt][r];
        }
#undef SCAN_LOADAU
        asm volatile("" :: "v"(pfg));
    } else {
    bf16x8 wf[2][4][2];
#pragma unroll
    for (int g = 0; g < 2; ++g)
#pragma unroll
        for (int nt = 0; nt < 4; ++nt)
#pragma unroll
            for (int s = 0; s < 2; ++s) wf[g][nt][s] = *(const bf16x8*)(GWT + ((size_t)(g * 8 + n) * 64 + 16 * nt + j) * 64 + 32 * s + 8 * q);
    bf16x8 idf[2];
#pragma unroll
    for (int e = 0; e < 2; ++e)
#pragma unroll
        for (int jj = 0; jj < 8; ++jj) idf[e][jj] = (16 * e + j - 8 * q == jj) ? (short)0x3F80 : (short)0;
    float ba[4], bx[4], sp[4];
#pragma unroll
    for (int nt = 0; nt < 4; ++nt) { const int ch = 64 * n + 16 * nt + j; ba[nt] = p->in[I_GAB][ch]; bx[nt] = p->in[I_GXB][ch]; sp[nt] = 8.0f * log1pf(__expf(-p->in[I_LAM][ch])) * 1.4426950408889634f; }
#define SCAN_LOADX(dst, sc_) do { const int tok_ = chunk * 64 + (sc_) * 16 + j; \
        _Pragma("unroll") for (int s = 0; s < 2; ++s) _Pragma("unroll") for (int w = 0; w < 4; ++w) { \
            const int tt = tok_ - 3 + w, ttc = tt < 0 ? 0 : tt; \
            u32x4 x = __builtin_nontemporal_load((const u32x4*)(XR + (size_t)(b * TSEQ + ttc) * 512 + 64 * n + 32 * s + 8 * q)); \
            if (tt < 0) x = (u32x4){0u, 0u, 0u, 0u}; dst[s][w] = x; } } while (0)
    u32x4 xcur[2][4], xnext[2][4];
    SCAN_LOADX(xcur, 0);
#pragma unroll
    for (int sc = 0; sc < 4; ++sc) {
        if (sc < 3) SCAN_LOADX(xnext, sc + 1);
        bf16x8 af[2];
#pragma unroll
        for (int s = 0; s < 2; ++s) {
            const int ch0 = 64 * n + 32 * s + 8 * q;
            float a8[8];
            { const f32x4 c0 = *(const LAS f32x4*)(cw + 2048 + ch0), c1 = *(const LAS f32x4*)(cw + 2048 + ch0 + 4);
              a8[0] = c0[0]; a8[1] = c0[1]; a8[2] = c0[2]; a8[3] = c0[3]; a8[4] = c1[0]; a8[5] = c1[1]; a8[6] = c1[2]; a8[7] = c1[3]; }
#pragma unroll
            for (int w = 0; w < 4; ++w) {
                const u32x4 x = xcur[s][w];
                const f32x4 w0 = *(const LAS f32x4*)(cw + w * 512 + ch0), w1 = *(const LAS f32x4*)(cw + w * 512 + ch0 + 4);
                a8[0] += w0[0] * bflo(x.x); a8[1] += w0[1] * bfhi(x.x); a8[2] += w0[2] * bflo(x.y); a8[3] += w0[3] * bfhi(x.y);
                a8[4] += w1[0] * bflo(x.z); a8[5] += w1[1] * bfhi(x.z); a8[6] += w1[2] * bflo(x.w); a8[7] += w1[3] * bfhi(x.w);
            }
            u32x4 pk; pk.x = pk2(a8[0], a8[1]); pk.y = pk2(a8[2], a8[3]); pk.z = pk2(a8[4], a8[5]); pk.w = pk2(a8[6], a8[7]);
            af[s] = __builtin_bit_cast(bf16x8, pk);
        }
#pragma unroll
        for (int nt = 0; nt < 4; ++nt) {
            f32x4 da = {0.f, 0.f, 0.f, 0.f}, dx = {0.f, 0.f, 0.f, 0.f}, xc = {0.f, 0.f, 0.f, 0.f};
            da = MFMA16(af[0], wf[0][nt][0], da); da = MFMA16(af[1], wf[0][nt][1], da);
            dx = MFMA16(af[0], wf[1][nt][0], dx); dx = MFMA16(af[1], wf[1][nt][1], dx);
            xc = MFMA16(af[nt >> 1], idf[nt & 1], xc);
            float a4[4], u4[4];
#pragma unroll
            for (int r = 0; r < 4; ++r) {
                const float ra = sigmoidf_(da[r] + ba[nt]), ix = sigmoidf_(dx[r] + bx[nt]);
                const float a = __builtin_amdgcn_exp2f(-ra * sp[nt]);
                a4[r] = a; u4[r] = fsqrt(fmaxf(1.0f - a * a, 0.f)) * ix * xc[r];
                AU[au0 + (size_t)(sc * 16 + r) * 512 + 16 * nt] = (f32x2v){a4[r], u4[r]};
            }
            const float A4 = (a4[0] * a4[1]) * (a4[2] * a4[3]);
            const float H4 = ((u4[0] * a4[1] + u4[1]) * a4[2] + u4[2]) * a4[3] + u4[3];
            float cin_, At_, Ht_; row_scan4(A4, H4, hprev[nt], q, cin_, At_, Ht_);
            hprev[nt] = At_ * hprev[nt] + Ht_; acum[nt] *= At_;
            asm volatile("" : "+v"(hprev[nt]), "+v"(acum[nt]));
        }
#pragma unroll
        for (int s = 0; s < 2; ++s)
#pragma unroll
            for (int w = 0; w < 4; ++w) xcur[s][w] = xnext[s][w];
    }
#undef SCAN_LOADX
    }
    if (!FINAL) {
        if (q == 0) {
#pragma unroll
            for (int nt = 0; nt < 4; ++nt) { const int ch = 64 * n + 16 * nt + j; const size_t o = (size_t)(b * 32 + chunk) * 512 + ch;
                __hip_atomic_store(SA + o, acum[nt], __ATOMIC_RELAXED, __HIP_MEMORY_SCOPE_AGENT); __hip_atomic_store(SH + o, hprev[nt], __ATOMIC_RELAXED, __HIP_MEMORY_SCOPE_AGENT); }
        }
    } else {
        if (chunk == 31 && q == 0) {
#pragma unroll
            for (int nt = 0; nt < 4; ++nt) p->out[OFF_PH + (size_t)b * 512 + 64 * n + 16 * nt + j] = hprev[nt];
        }
        __syncthreads();
        const bf16* GR = (const bf16*)(ws + WS_GR);
        bf16* MIX = (bf16*)(ws + WS_MIX);
        const f32x4 g0 = *(const f32x4*)(p->in[I_RNG] + 8 * lane), g1 = *(const f32x4*)(p->in[I_RNG] + 8 * lane + 4);
        u32x4 grv[8];
#pragma unroll
        for (int tt = 0; tt < 8; ++tt) grv[tt] = __builtin_nontemporal_load((const u32x4*)(GR + ((size_t)b * TSEQ + chunk * 64 + wave * 8 + tt) * 512 + 8 * lane));
#pragma unroll
        for (int tt = 0; tt < 8; ++tt) {
            const int tl = wave * 8 + tt;
            const size_t row = (size_t)b * TSEQ + chunk * 64 + tl;
            const LAS u32x2* hp = (const LAS u32x2*)(lds + HS_OFF + tl * HS_LD + 16 * lane);
            const u32x2 h0 = hp[0], h1 = hp[1];
            const u32x4 gr = grv[tt];
            float rc[8];
            rc[0] = bflo(h0.x) * gelu_tanh(bflo(gr.x)); rc[1] = bfhi(h0.x) * gelu_tanh(bfhi(gr.x)); rc[2] = bflo(h0.y) * gelu_tanh(bflo(gr.y)); rc[3] = bfhi(h0.y) * gelu_tanh(bfhi(gr.y));
            rc[4] = bflo(h1.x) * gelu_tanh(bflo(gr.z)); rc[5] = bfhi(h1.x) * gelu_tanh(bfhi(gr.z)); rc[6] = bflo(h1.y) * gelu_tanh(bflo(gr.w)); rc[7] = bfhi(h1.y) * gelu_tanh(bfhi(gr.w));
            float ss = 0.f;
#pragma unroll
            for (int e = 0; e < 8; ++e) ss += rc[e] * rc[e];
            const float rn = frsq(wave_sum(ss, lane) * (1.0f / DREC) + EPS);
            u32x4 w; w.x = pk2(rc[0] * rn * g0[0], rc[1] * rn * g0[1]); w.y = pk2(rc[2] * rn * g0[2], rc[3] * rn * g0[3]);
            w.z = pk2(rc[4] * rn * g1[0], rc[5] * rn * g1[1]); w.w = pk2(rc[6] * rn * g1[2], rc[7] * rn * g1[3]);
            *(u32x4*)(MIX + row * DM + 8 * lane) = w;
        }
        __syncthreads();
    }
}

constexpr int AT_KLD = 272, AT_VLD = 336, AT_OLD = 1040;
constexpr int AT_K = 0, AT_V = AT_K + 160 * AT_KLD, AT_RED = AT_V + 128 * AT_VLD, AT_END = AT_RED + 1024;
static_assert(32 * AT_OLD <= AT_V && 12288 + AT_END <= 131072, "attention LDS map");
__device__ __forceinline__ void attn_unit(KP p, int b, int qt, LAS unsigned char* lds, int wave, int lane) {
    unsigned char* ws = p->ws;
    const bf16* Q = (const bf16*)(ws + WS_Q); const bf16* KB = (const bf16*)(ws + WS_KB); const bf16* VT = (const bf16*)(ws + WS_VT);
    bf16* MIX = (bf16*)(ws + WS_MIX);
    LAS float* red = (LAS float*)(lds + AT_RED);
    const int r = lane & 31, h = lane >> 5, kvh = wave >> 2, q0 = qt * 32, tid = wave * 64 + lane;
    const size_t rowq = (size_t)b * TSEQ + q0 + r;
    __syncthreads();
    bf16x8 qf[4];
#pragma unroll
    for (int s = 0; s < 4; ++s) qf[s] = __builtin_nontemporal_load((const bf16x8*)(Q + rowq * 512 + wave * 64 + 16 * s + 8 * h));
    {
        u32x4 kv[5], vv[5];
#pragma unroll
        for (int i = 0; i < 5; ++i) { const int id = tid + 512 * i, row = id >> 4, c16 = id & 15; int g = q0 - 128 + row; g = g < 0 ? 0 : g;
            kv[i] = *(const u32x4*)(KB + ((size_t)b * TSEQ + g) * 128 + c16 * 8); }
#pragma unroll
        for (int i = 0; i < 5; ++i) { const int id = tid + 512 * i, row = id / 20, cc = id % 20; int k0 = q0 - 128 + 8 * cc; k0 = k0 < 0 ? 0 : k0;
            vv[i] = *(const u32x4*)(VT + ((size_t)b * 128 + row) * TSEQ + k0); }
#pragma unroll
        for (int i = 0; i < 5; ++i) { const int id = tid + 512 * i, row = id >> 4, c16 = id & 15; *(LAS u32x4*)(lds + AT_K + row * AT_KLD + c16 * 16) = kv[i]; }
#pragma unroll
        for (int i = 0; i < 5; ++i) { const int id = tid + 512 * i, row = id / 20, cc = id % 20; *(LAS u32x4*)(lds + AT_V + row * AT_VLD + cc * 16) = vv[i]; }
    }
    __syncthreads();
    const int pr = (r & ~12) | ((r & 4) << 1) | ((r & 8) >> 1);
    f32x16 S[5];
#pragma unroll
    for (int kt = 0; kt < 5; ++kt) {
#pragma unroll
        for (int i = 0; i < 16; ++i) S[kt][i] = 0.f;
#pragma unroll
        for (int s = 0; s < 4; ++s) {
            const bf16x8 kf = *(const LAS bf16x8*)(lds + AT_K + (32 * kt + pr) * AT_KLD + kvh * 128 + (16 * s + 8 * h) * 2);
            S[kt] = MFMA32(kf, qf[s], S[kt]);
        }
    }
    const float sink = p->in[I_SINK][wave];
    float m = sink;
#pragma unroll
    for (int kt = 0; kt < 5; ++kt) {
        const int kbase = q0 - 128 + 32 * kt;
#pragma unroll
        for (int i = 0; i < 16; ++i) {
            const int kl = 16 * (i >> 3) + 8 * h + (i & 7);
            bool valid = kbase >= 0;
            if (kt == 0) valid = valid && (kl >= r);
            if (kt == 4) valid = valid && (kl <= r);
            const float sv = valid ? S[kt][i] : -INFINITY;
            S[kt][i] = sv; m = fmaxf(m, sv);
        }
    }
    m = fmaxf(m, shx(m, 32, lane));
    float l = 0.f;
#pragma unroll
    for (int kt = 0; kt < 5; ++kt)
#pragma unroll
        for (int i = 0; i < 16; ++i) { const float pv = fexp(S[kt][i] - m); S[kt][i] = pv; l += pv; }
    l += shx(l, 32, lane);
    const float inv = frcp(l + fexp(sink - m));
    f32x16 O[2];
#pragma unroll
    for (int dt = 0; dt < 2; ++dt)
#pragma unroll
        for (int i = 0; i < 16; ++i) O[dt][i] = 0.f;
#pragma unroll
    for (int kt = 0; kt < 5; ++kt) {
#pragma unroll
        for (int s2 = 0; s2 < 2; ++s2) {
            u32x4 pk; pk.x = pk2(S[kt][8 * s2 + 0], S[kt][8 * s2 + 1]); pk.y = pk2(S[kt][8 * s2 + 2], S[kt][8 * s2 + 3]);
            pk.z = pk2(S[kt][8 * s2 + 4], S[kt][8 * s2 + 5]); pk.w = pk2(S[kt][8 * s2 + 6], S[kt][8 * s2 + 7]);
            const bf16x8 pb = __builtin_bit_cast(bf16x8, pk);
#pragma unroll
            for (int dt = 0; dt < 2; ++dt) {
                const bf16x8 vf = *(const LAS bf16x8*)(lds + AT_V + (kvh * 64 + 32 * dt + r) * AT_VLD + (32 * kt + 16 * s2 + 8 * h) * 2);
                O[dt] = MFMA32(vf, pb, O[dt]);
            }
        }
    }
    float ss = 0.f;
#pragma unroll
    for (int dt = 0; dt < 2; ++dt)
#pragma unroll
        for (int i = 0; i < 16; ++i) { O[dt][i] *= inv; ss += O[dt][i] * O[dt][i]; }
    ss += shx(ss, 32, lane);
    if (h == 0) red[wave * 32 + r] = ss;
    __syncthreads();
    float tot = 0.f;
#pragma unroll
    for (int w = 0; w < 8; ++w) tot += red[w * 32 + r];
    const float rn = frsq(tot * (1.0f / DATT) + EPS);
#pragma unroll
    for (int dt = 0; dt < 2; ++dt)
#pragma unroll
        for (int g4 = 0; g4 < 4; ++g4) {
            const int d = 32 * dt + 8 * g4 + 4 * h;
            const f32x4 gg = *(const f32x4*)(p->in[I_ANG] + wave * 64 + d);
            u32x2 w; w.x = pk2(O[dt][4 * g4 + 0] * rn * gg[0], O[dt][4 * g4 + 1] * rn * gg[1]); w.y = pk2(O[dt][4 * g4 + 2] * rn * gg[2], O[dt][4 * g4 + 3] * rn * gg[3]);
            *(LAS u32x2*)(lds + AT_K + r * AT_OLD + (wave * 64 + d) * 2) = w;
        }
    __syncthreads();
#pragma unroll
    for (int i = 0; i < 4; ++i) { const int id = tid + 512 * i, row = id >> 6, cc = id & 63;
        *(u32x4*)(MIX + ((size_t)b * TSEQ + q0 + row) * DM + 512 + cc * 8) = *(const LAS u32x4*)(lds + AT_K + row * AT_OLD + cc * 16); }
    __syncthreads();
}

__device__ __forceinline__ void sample_unit(KP p, int b, LAS unsigned char* lds, int tid, int wave, int lane) {
    unsigned char* ws = p->ws;
    const size_t row = (size_t)MP + b;
    bf16* MIX = (bf16*)(ws + WS_MIX);
    LAS float* xs = (LAS float*)(lds + 12288);
    LAS float* redw = (LAS float*)(lds + 12288 + 2048);
    LAS float* qs = (LAS float*)(lds + 12288 + 4096);
    LAS float* ps = (LAS float*)(lds + 12288 + 8192);
    __syncthreads();
    {
        const int c = tid;
        const float* sc = p->in[I_SCONV] + (size_t)b * 1536;
        const float* cwg = p->in[I_CONVW];
        const float xr = p->out[OFF_SCONV + (size_t)(b * 3 + 2) * 512 + c];
        const float xc = p->in[I_CONVB][c] + sc[c] * cwg[c] + sc[512 + c] * cwg[512 + c] + sc[1024 + c] * cwg[1024 + c] + xr * cwg[1536 + c];
        xs[c] = xc;
        __syncthreads();
        const int n = c >> 6, jj = c & 63;
        const float* wa = p->in[I_GAW] + n * 4096 + jj; const float* wx = p->in[I_GXW] + n * 4096 + jj;
        float ya = p->in[I_GAB][c], yx = p->in[I_GXB][c];
#pragma unroll
        for (int hb = 0; hb < 2; ++hb) {
            float wa_[32], wx_[32];
#pragma unroll
            for (int i = 0; i < 32; ++i) { wa_[i] = wa[(hb * 32 + i) * 64]; wx_[i] = wx[(hb * 32 + i) * 64]; }
#pragma unroll
            for (int i = 0; i < 32; ++i) { const float xv = xs[64 * n + hb * 32 + i]; ya += xv * wa_[i]; yx += xv * wx_[i]; }
        }
        const float ra = sigmoidf_(ya), ix = sigmoidf_(yx);
        const float la = -8.0f * ra * log1pf(__expf(-p->in[I_LAM][c]));
        const float a = __expf(la);
        const float u = fsqrt(fmaxf(1.0f - a * a, 0.f)) * ix * xc;
        const float hn = a * p->in[I_SH][(size_t)b * 512 + c] + u;
        p->out[OFF_SH + (size_t)b * 512 + c] = hn;
        const float gr = bf1(((const bf16*)(ws + WS_GR))[row * 512 + c]);
        const float rec = hn * gelu_tanh(gr);
        const float ssw = wave_sum(rec * rec, lane);
        if (lane == 0) redw[wave] = ssw;
        __syncthreads();
        float tot = 0.f;
#pragma unroll
        for (int w = 0; w < 8; ++w) tot += redw[w];
        const float rn = frsq(tot * (1.0f / DREC) + EPS);
        { const float mv = rec * rn * p->in[I_RNG][c], mo = shx(mv, 1, lane);
          if ((lane & 1) == 0) __hip_atomic_store((unsigned*)(MIX + row * DM + c), pk2(mv, mo), __ATOMIC_RELAXED, __HIP_MEMORY_SCOPE_AGENT); }
    }
    {
        const int kvh = wave >> 2;
        const float qd = bf1(((const bf16*)(ws + WS_Q))[row * 512 + wave * 64 + lane]);
        qs[wave * 64 + lane] = qd;
        const float* kself = p->out + OFF_SK + (size_t)(b * 128 + 127) * 128 + kvh * 64;
        const float* vself = p->out + OFF_SV + (size_t)(b * 128 + 127) * 128 + kvh * 64;
        const float sself = wave_sum(qd * kself[lane], lane);
        asm volatile("s_waitcnt lgkmcnt(0)" ::: "memory");
        const float* kc = p->in[I_CK] + (size_t)b * 16384 + kvh * 64;
        float s0 = 0.f, s1 = 0.f;
        const f32x4* k0 = (const f32x4*)(kc + (size_t)lane * 128);
        const f32x4* k1 = (const f32x4*)(kc + (size_t)(lane + 64) * 128);
        const LAS f32x4* q4 = (const LAS f32x4*)(qs + wave * 64);
        {
            f32x4 ka[16], kb2[16];
#pragma unroll
            for (int i = 0; i < 16; ++i) { ka[i] = k0[i]; kb2[i] = k1[i]; }
#pragma unroll
            for (int i = 0; i < 16; ++i) { const f32x4 qq = q4[i], a0 = ka[i], a1 = kb2[i];
                s0 += (qq[0] * a0[0] + qq[1] * a0[1]) + (qq[2] * a0[2] + qq[3] * a0[3]);
                s1 += (qq[0] * a1[0] + qq[1] * a1[1]) + (qq[2] * a1[2] + qq[3] * a1[3]); }
        }
        const float sink = p->in[I_SINK][wave];
        const float m = fmaxf(fmaxf(wave_max(fmaxf(s0, s1), lane), sself), sink);
        const float p0 = __expf(s0 - m), p1 = __expf(s1 - m), pself = __expf(sself - m);
        const float den = wave_sum(p0 + p1, lane) + pself + __expf(sink - m);
        ps[wave * 128 + lane] = p0; ps[wave * 128 + 64 + lane] = p1;
        asm volatile("s_waitcnt lgkmcnt(0)" ::: "memory");
        const int kg = lane >> 4, d4 = lane & 15;
        const float* vc = p->in[I_CV] + (size_t)b * 16384 + kvh * 64 + 4 * d4;
        f32x4 o4 = {0.f, 0.f, 0.f, 0.f};
#pragma unroll
        for (int hb = 0; hb < 2; ++hb) {
            f32x4 vv[16];
#pragma unroll
            for (int i = 0; i < 16; ++i) vv[i] = *(const f32x4*)(vc + (size_t)(kg + 4 * (hb * 16 + i)) * 128);
#pragma unroll
            for (int i = 0; i < 16; ++i) o4 = o4 + vv[i] * ps[wave * 128 + kg + 4 * (hb * 16 + i)];
        }
#pragma unroll
        for (int e = 0; e < 4; ++e) { o4[e] += shx(o4[e], 16, lane); o4[e] += shx(o4[e], 32, lane); }
        o4 = (o4 + *(const f32x4*)(vself + 4 * d4) * pself) * (1.0f / den);
        const float ssw = wave_sum((o4[0] * o4[0] + o4[1] * o4[1]) + (o4[2] * o4[2] + o4[3] * o4[3]), lane) * 0.25f;
        if (lane == 0) redw[8 + wave] = ssw;
        __syncthreads();
        float tot = 0.f;
#pragma unroll
        for (int w = 0; w < 8; ++w) tot += redw[8 + w];
        const float rn = frsq(tot * (1.0f / DATT) + EPS);
        if (kg == 0) { const f32x4 gg = *(const f32x4*)(p->in[I_ANG] + wave * 64 + 4 * d4);
            u32x2 w; w.x = pk2(o4[0] * rn * gg[0], o4[1] * rn * gg[1]); w.y = pk2(o4[2] * rn * gg[2], o4[3] * rn * gg[3]);
            unsigned* mp = (unsigned*)(MIX + row * DM + 512 + wave * 64 + 4 * d4);
            __hip_atomic_store(mp, w.x, __ATOMIC_RELAXED, __HIP_MEMORY_SCOPE_AGENT); __hip_atomic_store(mp + 1, w.y, __ATOMIC_RELAXED, __HIP_MEMORY_SCOPE_AGENT); }
    }
    __syncthreads();
}


template <int MODE>
__device__ __forceinline__ void small_gemm_task(KP p, const bf16* __restrict__ A, const bf16* __restrict__ Bt, int K, int n0, LAS unsigned char* lds, int wave, int lane) {
    const int r = lane & 31, h = lane >> 5, mt = wave & 3, kh = wave >> 2, Kh = K >> 1;
    const bf16* ap = A + (size_t)(32 * mt + r) * K + kh * Kh + 64 * h;
    const bf16* bp = Bt + (size_t)(n0 + r) * K + kh * Kh + 64 * h;
    f32x16 acc;
#pragma unroll
    for (int i = 0; i < 16; ++i) acc[i] = 0.f;
    bf16x8 a[8], b[8], an[8], bn[8];
#pragma unroll
    for (int i = 0; i < 8; ++i) { a[i] = *(const bf16x8*)(ap + 8 * i); b[i] = *(const bf16x8*)(bp + 8 * i); }
    for (int k = 0; k < Kh; k += 128) {
        const int kn = (k + 128 < Kh) ? k + 128 : k;
#pragma unroll
        for (int i = 0; i < 8; ++i) { an[i] = *(const bf16x8*)(ap + kn + 8 * i); bn[i] = *(const bf16x8*)(bp + kn + 8 * i); }
#pragma unroll
        for (int i = 0; i < 8; ++i) acc = MFMA32(a[i], b[i], acc);
#pragma unroll
        for (int i = 0; i < 8; ++i) { a[i] = an[i]; b[i] = bn[i]; }
    }
    LAS float* red = (LAS float*)lds;
    __syncthreads();
    if (kh == 1) {
#pragma unroll
        for (int i = 0; i < 16; ++i) red[(mt * 16 + i) * 64 + lane] = acc[i];
    }
    __syncthreads();
    if (kh == 0) {
        float* H = p->out; const int c = n0 + r;
#pragma unroll
        for (int i = 0; i < 16; ++i) {
            const int rs = 32 * mt + (i & 3) + 8 * (i >> 2) + 4 * h;
            float v = acc[i] + red[(mt * 16 + i) * 64 + lane];
            float* hp = H + (size_t)(MP + rs) * DM + c;
            if (MODE == 0) {
                v += p->in[I_XS][(size_t)rs * DM + c];
                *hp = v;
                ((bf16*)(p->ws + WS_HB))[(size_t)(MP + rs) * DM + c] = (bf16)(pk2(v, 0.f) & 0xffff);
                float s = v * v;
                s += shx(s, 1, lane); s += shx(s, 2, lane); s += shx(s, 4, lane); s += shx(s, 8, lane); s += shx(s, 16, lane);
                if (r == 0) atomicAdd((float*)(p->ws + WS_RSQH) + MP + rs, s);
            } else {
                *hp = *hp + v;
            }
        }
    }
    __syncthreads();
}

#define XB_TMO      128
#define XB_XCNT(j)  (256  + 64 * (j))
#define XB_XSUB(j)  (1280 + 64 * (j))
#define XB_XGEN(j)  (2304 + 64 * (j))
#define XB_TOP      3328
#define XB_TOPGEN   3392
#define XCD_BAR_WORDS 3456
#define XB_SPIN_CAP (1u << 18)

__device__ __forceinline__ unsigned xb_ld(unsigned* p)              { return __hip_atomic_load(p, __ATOMIC_RELAXED, __HIP_MEMORY_SCOPE_AGENT); }
__device__ __forceinline__ unsigned xb_add(unsigned* p, unsigned v) { return __hip_atomic_fetch_add(p, v, __ATOMIC_RELAXED, __HIP_MEMORY_SCOPE_AGENT); }
__device__ __forceinline__ unsigned xb_xcc_id() { return (unsigned)__builtin_amdgcn_s_getreg((3 << 11) | 20) & 0xFu; }
#define XB_SPIN(cond, bar) do { unsigned _sp = 0; while (cond) { __builtin_amdgcn_s_sleep(1); \
    if ((++_sp & 255u) == 0u) { if (xb_ld(&(bar)[XB_TMO])) break; if (_sp > XB_SPIN_CAP) { atomicAdd(&(bar)[XB_TMO], 1u); break; } } } } while (0)

struct XcdBarrier {
    unsigned* bar; unsigned x;
    volatile LAS unsigned* st;
};

__device__ __forceinline__ XcdBarrier xcd_barrier_post(unsigned* bar, volatile LAS unsigned* st) {
    XcdBarrier b; b.bar = bar; b.x = xb_xcc_id(); b.st = st;
    if (threadIdx.x == 0) (void)xb_add(&bar[XB_XCNT(b.x)], 1u);
    return b;
}
__device__ __forceinline__ void xcd_barrier_complete(unsigned* bar, unsigned x, unsigned& nloc, unsigned& nx) {
    const unsigned G = gridDim.x * gridDim.y * gridDim.z;
    unsigned sum, cnt, mine, sp = 0u;
    for (;;) {
        sum = 0u; cnt = 0u; mine = 0u;
#pragma unroll
        for (unsigned j = 0; j < 16; ++j) { const unsigned c = xb_ld(&bar[XB_XCNT(j)]); sum += c; cnt += (c > 0u) ? 1u : 0u; mine = (j == x) ? c : mine; }
        if (sum == G) break;
        __builtin_amdgcn_s_sleep(1);
        if ((++sp & 255u) == 0u) { if (xb_ld(&bar[XB_TMO])) break; if (sp > XB_SPIN_CAP) { atomicAdd(&bar[XB_TMO], 1u); break; } }
    }
    nloc = mine > 0u ? mine : 1u; nx = cnt > 0u ? cnt : 1u;
}

__device__ __forceinline__ void xcd_barrier(const XcdBarrier& b) {
    asm volatile("s_waitcnt vmcnt(0)" ::: "memory");
    __syncthreads();
    if (threadIdx.x == 0) {
        unsigned* bar = b.bar;
        __builtin_amdgcn_s_waitcnt(0);
        unsigned nloc = b.st[0], nx = b.st[1];
        if (nloc == 0u) { xcd_barrier_complete(bar, b.x, nloc, nx); b.st[0] = nloc; b.st[1] = nx; }
        const unsigned old = xb_add(&bar[XB_XSUB(b.x)], 1u);
        const unsigned gen = old / nloc;
        if (old + 1u == (gen + 1u) * nloc) {
            __builtin_amdgcn_fence(__ATOMIC_RELEASE, "agent");
            asm volatile("s_waitcnt vmcnt(0)" ::: "memory");
            const unsigned og = xb_add(&bar[XB_TOP], 1u);
            const unsigned tg = og / nx;
            if (og + 1u == (tg + 1u) * nx) xb_add(&bar[XB_TOPGEN], 1u);
            else XB_SPIN(xb_ld(&bar[XB_TOPGEN]) == tg, bar);
            __builtin_amdgcn_fence(__ATOMIC_ACQUIRE, "agent");
            xb_add(&bar[XB_XGEN(b.x)], 1u);
            asm volatile("s_waitcnt vmcnt(0)" ::: "memory");
        } else {
            XB_SPIN(xb_ld(&bar[XB_XGEN(b.x)]) == gen, bar);
            __builtin_amdgcn_fence(__ATOMIC_ACQUIRE, "agent");
            asm volatile("s_waitcnt vmcnt(0)" ::: "memory");
        }
    }
    __syncthreads();
}

#ifndef REP_P0
#define REP_P0 1
#endif
#ifndef REP_P1
#define REP_P1 1
#endif
#ifndef REP_P4
#define REP_P4 1
#endif
#ifndef REP_SYNC
#define REP_SYNC 0
#endif
#ifndef PROBE_P3
#define PROBE_P3 0
#endif
#ifndef PROBE_P5
#define PROBE_P5 0
#endif
#ifndef PROBE_P6
#define PROBE_P6 0
#endif
#ifndef STAMP_A
#define STAMP_A -1
#define STAMP_B -1
#endif
#ifndef STAMP_MULT
#define STAMP_MULT 4
#endif
#ifndef REP_ALL
#define REP_ALL 1
#endif
#ifndef REP_P2
#define REP_P2 1
#endif
#ifndef REP_P2B
#define REP_P2B 1
#endif
__device__ __forceinline__ void fwd_body(LAS unsigned char* lds, const XcdBarrier& bar);
__global__ void __launch_bounds__(NTHR, 2) fwd_megakernel(Params p_unused) {
    extern __shared__ __attribute__((aligned(16))) unsigned char lds_[];
    cg::grid_group grid = cg::this_grid();
    LAS unsigned char* lds = (LAS unsigned char*)lds_;
    if (threadIdx.x < 2) ((LAS unsigned*)(lds + 131072))[threadIdx.x] = 0u;
    __syncthreads();
    XcdBarrier bar;
    { KP p = kargs(); unsigned char* ws = p->ws;
      if (ws == nullptr) grid.sync();
      bar = xcd_barrier_post(g_ctl, (volatile LAS unsigned*)(lds + 131072)); }
#define GRID_SYNC() xcd_barrier(bar)
    fwd_body(lds, bar);
    asm volatile("s_waitcnt vmcnt(0)" ::: "memory");
    __syncthreads();
    LAS unsigned* lf = (LAS unsigned*)(lds + 131072 + 16);
    if (threadIdx.x == 0) { const unsigned old = atomicAdd(&g_ctl[CW_DONE], 1u); *lf = (old + 1u == gridDim.x) ? 1u : 0u; }
    __syncthreads();
    if (*lf) { for (int i = threadIdx.x; i < CTL_WORDS; i += NTHR) g_ctl[i] = 0u; }
}
__device__ __forceinline__ void fwd_body(LAS unsigned char* lds, const XcdBarrier& bar) {
    const int G = gridDim.x, bx = blockIdx.x;
#define STAMP(i) do { if (STAMP_A >= 0 && blockIdx.x == 0 && threadIdx.x == 0) ((LAS unsigned long long*)(lds + 131072 + 64))[i] = __builtin_amdgcn_s_memrealtime(); } while (0)
    STAMP(0);
#define PHASE_IDS int tid_ = threadIdx.x; asm volatile("" : "+v"(tid_)); const int tid = tid_, lane = tid & 63, wave = __builtin_amdgcn_readfirstlane(tid >> 6); (void)tid; (void)lane; (void)wave;

    for (int rep = 0; rep < REP_P0; ++rep) { PHASE_IDS KP p = kargs(); p0_prologue(p, lds, bx * NWAVES + wave, G * NWAVES, wave, lane); }
    GRID_SYNC();
    STAMP(1);

    for (int rep = 0; rep < REP_SYNC; ++rep) GRID_SYNC();
    for (int rep = 0; rep < REP_P1; ++rep) {
        KP p = kargs(); unsigned char* ws = p->ws;
        pg8::Gemm g{(const bf16*)(ws + WS_XN), (const bf16*)(ws + WS_WIN), MPAD, DIN, DM}; pg8::StaticOrder S; S.init(MPAD, DIN, G, bx);
        EpiIn E{ws, p->out};
        pg8::gemm_phase<EpiIn, pg8::StaticOrder, true, true>(lds, g, S, E);
        { PHASE_IDS int slot, ns; slack_slot((MPAD / 256) * (DIN / 256), G, bx, slot, ns);
          if (slot >= 0) convert_items(p, lds, CI_G, CI_WU, slot * NWAVES + wave, ns * NWAVES, wave, lane); }
    }
    GRID_SYNC();
    STAMP(2);

    {
        PHASE_IDS KP p = kargs();
        for (int i = tid; i < 2560; i += NTHR) ((LAS float*)lds)[i] = i < 2048 ? p->in[I_CONVW][i] : p->in[I_CONVB][i - 2048];
        __syncthreads();
        unsigned* cw = g_ctl;
        for (int u = bx; u < 1184; u += G) {
            int tl_ = threadIdx.x; asm volatile("" : "+v"(tl_)); const int tid = tl_, lane = tl_ & 63;
            if (u < 128) { sample_unit(p, u, lds, tid, wave, lane); asm volatile("s_waitcnt vmcnt(0)" ::: "memory"); __syncthreads(); if (tid == 0) atomicAdd(cw + CW_S1, 1u); }
            else if (u < 384) { const int k = u - 128; scan_unit<false>(p, k >> 5, k & 31, lds, wave, lane); asm volatile("s_waitcnt vmcnt(0)" ::: "memory"); __syncthreads(); if (tid == 0) atomicAdd(cw + CW_SCAN + 64 * (k >> 5), 1u); }
            else if (u < 896) { const int a = u - 384; attn_unit(p, a >> 6, a & 63, lds + 12288, wave, lane); }
            else if (u < 1152) { const int k = u - 896;
                if (tid == 0) { unsigned sp = 0; while (__hip_atomic_load(cw + CW_SCAN + 64 * (k >> 5), __ATOMIC_RELAXED, __HIP_MEMORY_SCOPE_AGENT) < 32u) { __builtin_amdgcn_s_sleep(4); if (++sp > (1u << 22)) break; } }
                __syncthreads(); __builtin_amdgcn_fence(__ATOMIC_ACQUIRE, "agent");
                scan_unit<true>(p, k >> 5, k & 31, lds, wave, lane); }
            else {
                if (tid == 0) { unsigned sp = 0; while (__hip_atomic_load(cw + CW_S1, __ATOMIC_RELAXED, __HIP_MEMORY_SCOPE_AGENT) < 128u) { __builtin_amdgcn_s_sleep(4); if (++sp > (1u << 22)) break; } }
                __syncthreads(); __builtin_amdgcn_fence(__ATOMIC_ACQUIRE, "agent");
                small_gemm_task<0>(p, (const bf16*)(p->ws + WS_MIX) + (size_t)MP * DM, (const bf16*)(p->ws + WS_WOUT), DM, 32 * (u - 1152), lds, wave, lane);
            }
        }
    }
    GRID_SYNC();
    STAMP(4);

    {
        KP p = kargs(); unsigned char* ws = p->ws;
        pg8::Gemm g{(const bf16*)(ws + WS_MIX), (const bf16*)(ws + WS_WOUT), MP, DM, DM}; pg8::StaticOrder S; S.init(MP, DM, G, bx);
        if (PROBE_P3) { EpiOut E0{p->in[I_XP], p->in[I_XS], (float*)(ws + 92 * MiB), ws + 128 * MiB}; pg8::gemm_phase<EpiOut, pg8::StaticOrder, true, true>(lds, g, S, E0); }
        EpiOut E{p->in[I_XP], p->in[I_XS], p->out, ws};
        pg8::gemm_phase<EpiOut, pg8::StaticOrder, true, true>(lds, g, S, E);
    }
    GRID_SYNC();
    STAMP(5);

    for (int rep = 0; rep < REP_P4; ++rep) {
        KP p = kargs(); unsigned char* ws = p->ws;
        pg8::Gemm g{(const bf16*)(ws + WS_HB), (const bf16*)(ws + WS_WGU), MPAD, 2 * DFF, DM}; pg8::StaticOrder S; S.init(MPAD, 2 * DFF, G, bx);
        EpiGU E{ws};
        pg8::gemm_phase<EpiGU, pg8::StaticOrder, true, true>(lds, g, S, E);
        { PHASE_IDS int slot, ns; slack_slot((MPAD / 256) * (2 * DFF / 256), G, bx, slot, ns);
          if (slot >= 0) { convert_items(p, lds, CI_WU, CI_WD, slot * NWAVES + wave, ns * NWAVES, wave, lane);
                           copy_windows(p, (slot * NWAVES + wave) * 64 + lane, ns * NWAVES * 64); } }
    }
    GRID_SYNC();
    STAMP(6);

    {
        KP p = kargs(); unsigned char* ws = p->ws;
        pg8::Gemm g{(const bf16*)(ws + WS_FF), (const bf16*)(ws + WS_WD), MP, DM, DFF}; pg8::StaticOrder S; S.init(MP, DM, G, bx);
        EpiDownFused E{ws, p->out, p->in[I_FNG]};
        pg8::gemm_phase<EpiDownFused, pg8::StaticOrder, false, true>(lds, g, S, E);
        { PHASE_IDS
          int ndone = 0;
          for (int u = bx; u < 32; u += G) { small_gemm_task<1>(p, (const bf16*)(ws + WS_FF) + (size_t)MP * DFF, (const bf16*)(ws + WS_WD), DFF, 32 * u, lds, wave, lane); ++ndone; }
          if (ndone) {
              __threadfence(); __syncthreads();
              LAS unsigned* flag = (LAS unsigned*)(lds + 8192);
              if (tid == 0) { const unsigned old = atomicAdd(g_ctl + CW_SAMPLE, (unsigned)ndone); *flag = (old + (unsigned)ndone == 32u) ? 1u : 0u; }
              __syncthreads();
              if (*flag) {
                  __builtin_amdgcn_fence(__ATOMIC_ACQUIRE, "agent");
                  const f32x4* g4 = (const f32x4*)p->in[I_FNG] + lane;
                  f32x4 gq[4];
#pragma unroll
                  for (int j = 0; j < 4; ++j) gq[j] = g4[64 * j];
                  for (int m0 = MP + wave; m0 < MR; m0 += 4 * NWAVES) {
                      f32x4 v[4][4];
#pragma unroll
                      for (int q = 0; q < 4; ++q) { const f32x4* yr = (const f32x4*)(p->out + (size_t)(m0 + q * NWAVES) * DM) + lane;
#pragma unroll
                          for (int j = 0; j < 4; ++j) v[q][j] = yr[64 * j]; }
#pragma unroll
                      for (int q = 0; q < 4; ++q) { float s = 0.f;
#pragma unroll
                          for (int j = 0; j < 4; ++j) s += (v[q][j].x * v[q][j].x + v[q][j].y * v[q][j].y) + (v[q][j].z * v[q][j].z + v[q][j].w * v[q][j].w);
                          const float rs = frsq(wave_sum(s, lane) * (1.f / DM) + EPS);
                          f32x4* yw = (f32x4*)(p->out + (size_t)(m0 + q * NWAVES) * DM) + lane;
#pragma unroll
                          for (int j = 0; j < 4; ++j) yw[64 * j] = v[q][j] * rs * gq[j]; }
                  }
              }
          }
        }
    }
    STAMP(7);
    STAMP(8);
    if (STAMP_A >= 0 && blockIdx.x == 0 && threadIdx.x == 0) {
        const LAS unsigned long long* ts = (const LAS unsigned long long*)(lds + 131072 + 64);
        const unsigned long long d = (ts[STAMP_B < 0 ? 0 : STAMP_B] - ts[STAMP_A < 0 ? 0 : STAMP_A]) * STAMP_MULT, t0 = __builtin_amdgcn_s_memrealtime();
        while (__builtin_amdgcn_s_memrealtime() - t0 < d) __builtin_amdgcn_s_sleep(16);
    }
}

extern "C" void kernel_launch(void* const* d_in, const int* in_sizes, int n_in, void* d_out, int out_size, void* d_ws, size_t ws_size, hipStream_t stream) {
    static int grid = 0;
    if (grid == 0) {
        int dev = 0, cus = 0, per_cu = 0;
        hipGetDevice(&dev);
        hipDeviceGetAttribute(&cus, hipDeviceAttributeMultiprocessorCount, dev);
        hipFuncSetAttribute((const void*)fwd_megakernel, hipFuncAttributeMaxDynamicSharedMemorySize, LDS_BYTES);
        hipOccupancyMaxActiveBlocksPerMultiprocessor(&per_cu, (const void*)fwd_megakernel, NTHR, LDS_BYTES);
        if (per_cu < 1) { fprintf(stderr, "kernel_launch: occupancy query says %d blocks/CU\n", per_cu); per_cu = 1; }
        (void)hipGetLastError();
        grid = cus;
        if (n_in != 24 || ws_size < WS_END || (size_t)out_size != OUT_END) fprintf(stderr, "kernel_launch: unexpected sizes n_in %d ws %zu out %d\n", n_in, ws_size, out_size);
    }
    Params p{};
    for (int i = 0; i < 24; ++i) p.in[i] = (const float*)d_in[i];
    p.out = (float*)d_out; p.ws = (unsigned char*)d_ws;
    void* args[] = {&p};
    hipError_t e = hipLaunchCooperativeKernel((const void*)fwd_megakernel, dim3(grid), dim3(NTHR), args, LDS_BYTES, stream);
    if (e != hipSuccess) fprintf(stderr, "cooperative launch failed: %s (grid %d)\n", hipGetErrorString(e), grid);
}
```

```cpp
#include <hip/hip_runtime.h>
#include <hip/hip_cooperative_groups.h>
#include <cstdio>
#include <cstdint>
namespace cg = cooperative_groups;
namespace pg8 {
#define PG8_LAS __attribute__((address_space(3)))
typedef unsigned short bf16_t;
typedef short bf16x8 __attribute__((ext_vector_type(8)));
typedef float f32x4 __attribute__((ext_vector_type(4)));
typedef unsigned u32x4 __attribute__((ext_vector_type(4)));
constexpr int BM = 256, BK = 64, HALF = 128, HTB = HALF * BK * 2  , STAGE_BYTES = 8 * HTB, NXCD = 8, WGM = 8;

__host__ __device__ __forceinline__ int lds_byte(int r, int c) { const int st = (r >> 4) * 2 + (c >> 5), rr = r & 15, cc = c & 31, ob = rr * 64 + cc * 2; return st * 1024 + (ob ^ (((ob >> 9) & 1) << 5)); }
__host__ __device__ __forceinline__ void stage_rc(int b, int& R, int& C) { const int st = b / 1024, sb = b % 1024, swz = sb ^ (((sb >> 9) & 1) << 5); R = (st >> 1) * 16 + swz / 64; C = (st & 1) * 32 + (swz % 64) / 2; }
__host__ __device__ __forceinline__ int perm32(int rho) { const int n = rho >> 4, i = rho & 15; return 8 * (i >> 2) + 4 * n + (i & 3); }

struct Unit { int pm, pn; };
struct Gemm { const bf16_t* A; const bf16_t* Bt; int M, N, K; };

struct StaticOrder {
    int nM, nN, nwg, G, c;
    __host__ __device__ void init(int M, int N, int G_, int c_) { nM = M / BM; nN = N / BM; nwg = nM * nN; G = G_; c = c_; }
    __host__ __device__ bool next(int i, Unit& u) const {
        const long L = (long)i * G + c; if (L >= nwg) return false;
        int wgid = (int)L; { const int q = nwg / NXCD, r = nwg % NXCD, xcd = wgid % NXCD, off = wgid / NXCD; wgid = (xcd < r ? xcd * (q + 1) : r * (q + 1) + (xcd - r) * q) + off; }
        const int nig = WGM * nN, gid = wgid / nig, fm = gid * WGM, gsz = (nM - fm) < WGM ? (nM - fm) : WGM;
        u.pm = fm + ((wgid % nig) % gsz); u.pn = (wgid % nig) / gsz; return true;
    }
    __device__ __forceinline__ void a_ready(const Unit&) const {}
    __device__ __forceinline__ void done(const Unit&) const {}
};

template <class Epi, class Sched, bool ALIGN_EPI = false, bool SP2 = false>
__device__ __forceinline__ void gemm_phase(PG8_LAS unsigned char* lds, const Gemm g, const Sched& S, const Epi& E) {
    int tid_ = threadIdx.x; asm volatile("" : "+v"(tid_));
    const int tid = tid_, wid = __builtin_amdgcn_readfirstlane(tid >> 6), lane = tid & 63, wr = wid >> 2, wc = wid & 3, fr = lane & 15, fq = lane >> 4;
    const int K = g.K, nt = K / BK;
    unsigned voffA[2], voffB[2];
#pragma unroll
    for (int i = 0; i < 2; ++i) { int R, C; stage_rc(tid * 16 + i * 8192, R, C); const int Rb = Epi::PERM ? ((R & ~31) + perm32(R & 31)) : R;
        voffA[i] = (unsigned)(R * K + C) * 2u; voffB[i] = (unsigned)(Rb * K + C) * 2u; }
    const size_t kstep = (size_t)(BK * 2);
    const size_t hstep = (size_t)HALF * K * 2;
    const size_t tstep = 2 * hstep;
    const unsigned ldsw = (unsigned)wid * 1024u;
    const int aoff = lds_byte(wr * 64 + fr, fq * 8), boff = lds_byte(wc * 32 + fr, fq * 8);
#define PG8_SA(b, h) (((b) * 2 + (h)) * HTB)
#define PG8_SB(b, h) ((4 + (b) * 2 + (h)) * HTB)
#define PG8_STAGE(bufoff, gbase, voff) do { _Pragma("unroll") for (int _i = 0; _i < 2; ++_i) \
        __builtin_amdgcn_global_load_lds((const unsigned*)((const char*)(gbase) + (voff)[_i]), (PG8_LAS unsigned*)(lds + (bufoff) + ldsw + _i * 8192), 16, 0, 0); } while (0)
#define PG8_LDA(dst, b, h) do { _Pragma("unroll") for (int m = 0; m < 4; ++m) _Pragma("unroll") for (int k = 0; k < 2; ++k) dst[m][k] = *(const PG8_LAS bf16x8*)(lds + PG8_SA(b, h) + aoff + m * 2048 + k * 1024); } while (0)
#define PG8_LDB(dst, b, h) do { _Pragma("unroll") for (int n = 0; n < 2; ++n) _Pragma("unroll") for (int k = 0; k < 2; ++k) dst[n][k] = *(const PG8_LAS bf16x8*)(lds + PG8_SB(b, h) + boff + n * 2048 + k * 1024); } while (0)
#define PG8_MMA(ai, bj, At, Bt) do { __builtin_amdgcn_s_setprio(1); _Pragma("unroll") for (int m = 0; m < 4; ++m) _Pragma("unroll") for (int n = 0; n < 2; ++n) _Pragma("unroll") for (int k = 0; k < 2; ++k) \
        acc[ai][bj][m][n] = __builtin_amdgcn_mfma_f32_16x16x32_bf16(Bt[n][k], At[m][k], acc[ai][bj][m][n], 0, 0, 0); __builtin_amdgcn_s_setprio(0); } while (0)
#define PG8_WAIT_V(n) asm volatile("s_waitcnt vmcnt(" #n ")" ::: "memory")
#define PG8_WAIT_L(n) asm volatile("s_waitcnt lgkmcnt(" #n ")" ::: "memory")
#define PG8_BAR __builtin_amdgcn_s_barrier()
#define PG8_SCHED __builtin_amdgcn_sched_barrier(0)
    Unit cur, nxt; int ui = 0;
    if (!S.next(0, cur)) return;
    f32x4 acc[2][2][4][2];
#pragma unroll
    for (int a = 0; a < 2; ++a)
#pragma unroll
        for (int b = 0; b < 2; ++b)
#pragma unroll
            for (int m = 0; m < 4; ++m)
#pragma unroll
                for (int n = 0; n < 2; ++n) acc[a][b][m][n] = (f32x4){0.f, 0.f, 0.f, 0.f};
    bf16x8 At[4][2], B0[2][2], B1[2][2];
    const char* cA = (const char*)g.A + (size_t)cur.pm * tstep; const char* cB = (const char*)g.Bt + (size_t)cur.pn * tstep;
    S.a_ready(cur);
    if constexpr (SP2) {
        PG8_STAGE(PG8_SB(0, 0), cB, voffB); PG8_STAGE(PG8_SB(0, 1), cB + hstep, voffB); PG8_STAGE(PG8_SA(0, 0), cA, voffA); PG8_STAGE(PG8_SA(0, 1), cA + hstep, voffA);
        if (wr == 1) PG8_BAR;
        PG8_WAIT_V(2); PG8_BAR;
        PG8_STAGE(PG8_SB(1, 0), cB + kstep, voffB); PG8_STAGE(PG8_SA(1, 0), cA + kstep, voffA); PG8_STAGE(PG8_SB(1, 1), cB + hstep + kstep, voffB);
        PG8_WAIT_V(6); PG8_BAR;
    } else {
        PG8_STAGE(PG8_SB(0, 0), cB, voffB); PG8_STAGE(PG8_SA(0, 0), cA, voffA); PG8_STAGE(PG8_SB(0, 1), cB + hstep, voffB); PG8_STAGE(PG8_SA(0, 1), cA + hstep, voffA);
        if (wr == 1) PG8_BAR;
        PG8_WAIT_V(4); PG8_BAR;
        PG8_STAGE(PG8_SB(1, 0), cB + kstep, voffB); PG8_STAGE(PG8_SA(1, 0), cA + kstep, voffA); PG8_STAGE(PG8_SB(1, 1), cB + hstep + kstep, voffB);
        PG8_WAIT_V(6); PG8_BAR;
    }
    for (;;) {
        const bool has_next = S.next(ui + 1, nxt);
        const char* nA = has_next ? (const char*)g.A + (size_t)nxt.pm * tstep : cA; const char* nB = has_next ? (const char*)g.Bt + (size_t)nxt.pn * tstep : cB;
        for (int t = 0; t < nt; t += 2) {
            const bool last = (t == nt - 2);
            const char* a1 = cA + (size_t)(t + 1) * kstep;
            const char* a2 = last ? nA : cA + (size_t)(t + 2) * kstep; const char* b2 = last ? nB : cB + (size_t)(t + 2) * kstep;
            const char* a3 = a2 + kstep; const char* b3 = b2 + kstep;
            if (last && has_next) S.a_ready(nxt);
            if constexpr (SP2) {
            PG8_LDB(B0, 0, 0); PG8_LDB(B1, 0, 1); PG8_SCHED; PG8_LDA(At, 0, 0); PG8_STAGE(PG8_SA(1, 1), a1 + hstep, voffA);
            PG8_WAIT_V(8); PG8_WAIT_L(0); PG8_BAR; PG8_MMA(0, 0, At, B0); PG8_MMA(0, 1, At, B1); PG8_BAR; PG8_SCHED;
            PG8_LDA(At, 0, 1); PG8_STAGE(PG8_SB(0, 0), b2, voffB); PG8_STAGE(PG8_SB(0, 1), b2 + hstep, voffB); PG8_STAGE(PG8_SA(0, 0), a2, voffA);
            PG8_WAIT_V(8); PG8_WAIT_L(0); PG8_BAR; PG8_MMA(1, 0, At, B0); PG8_MMA(1, 1, At, B1); PG8_BAR; PG8_SCHED;
            PG8_LDB(B0, 1, 0); PG8_LDB(B1, 1, 1); PG8_SCHED; PG8_LDA(At, 1, 0); PG8_STAGE(PG8_SA(0, 1), a2 + hstep, voffA);
            PG8_WAIT_V(8); PG8_WAIT_L(0); PG8_BAR; PG8_MMA(0, 0, At, B0); PG8_MMA(0, 1, At, B1); PG8_BAR; PG8_SCHED;
            PG8_LDA(At, 1, 1); PG8_STAGE(PG8_SB(1, 0), b3, voffB); PG8_STAGE(PG8_SB(1, 1), b3 + hstep, voffB); PG8_STAGE(PG8_SA(1, 0), a3, voffA);
            PG8_WAIT_V(8); PG8_WAIT_L(0); PG8_BAR; PG8_MMA(1, 0, At, B0); PG8_MMA(1, 1, At, B1); PG8_BAR; PG8_SCHED;
            } else {
            PG8_LDB(B0, 0, 0); PG8_SCHED; PG8_LDA(At, 0, 0); PG8_STAGE(PG8_SA(1, 1), a1 + hstep, voffA);
            PG8_WAIT_L(8); PG8_BAR; PG8_WAIT_L(0); PG8_MMA(0, 0, At, B0); PG8_BAR; PG8_SCHED;
            PG8_LDB(B1, 0, 1); PG8_STAGE(PG8_SB(0, 0), b2, voffB);
            PG8_BAR; PG8_WAIT_L(0); PG8_MMA(0, 1, At, B1); PG8_BAR;
            PG8_LDA(At, 0, 1); PG8_STAGE(PG8_SA(0, 0), a2, voffA);
            PG8_BAR; PG8_WAIT_L(0); PG8_MMA(1, 0, At, B0); PG8_BAR; PG8_SCHED;
            PG8_STAGE(PG8_SB(0, 1), b2 + hstep, voffB);
            PG8_WAIT_V(6); PG8_BAR; PG8_MMA(1, 1, At, B1); PG8_BAR;
            PG8_LDB(B0, 1, 0); PG8_SCHED; PG8_LDA(At, 1, 0); PG8_STAGE(PG8_SA(0, 1), a2 + hstep, voffA);
            PG8_WAIT_L(8); PG8_BAR; PG8_WAIT_L(0); PG8_MMA(0, 0, At, B0); PG8_BAR; PG8_SCHED;
            PG8_LDB(B1, 1, 1); PG8_STAGE(PG8_SB(1, 0), b3, voffB);
            PG8_BAR; PG8_WAIT_L(0); PG8_MMA(0, 1, At, B1); PG8_BAR;
            PG8_LDA(At, 1, 1); PG8_STAGE(PG8_SA(1, 0), a3, voffA);
            PG8_BAR; PG8_WAIT_L(0); PG8_MMA(1, 0, At, B0); PG8_BAR; PG8_SCHED;
            PG8_STAGE(PG8_SB(1, 1), b3 + hstep, voffB);
            PG8_WAIT_V(6); PG8_BAR; PG8_MMA(1, 1, At, B1); PG8_BAR;
            }
        }
        if constexpr (ALIGN_EPI) { if (wr == 0) PG8_BAR; }
        if constexpr (!Epi::AFTER_DRAIN) { E(acc, cur, wr, wc, fr, fq); S.done(cur); }
        if (!has_next) break;
#pragma unroll
        for (int a = 0; a < 2; ++a)
#pragma unroll
            for (int b = 0; b < 2; ++b)
#pragma unroll
                for (int m = 0; m < 4; ++m)
#pragma unroll
                    for (int n = 0; n < 2; ++n) acc[a][b][m][n] = (f32x4){0.f, 0.f, 0.f, 0.f};
        cur = nxt; cA = nA; cB = nB; ++ui;
        if constexpr (ALIGN_EPI) { if (wr == 1) PG8_BAR; }
    }
    PG8_WAIT_V(0);
    if constexpr (!ALIGN_EPI) { if (wr == 0) PG8_BAR; }
    PG8_BAR;
    if constexpr (Epi::AFTER_DRAIN) { E.fused(acc, cur, wr, wc, fr, fq, lds, wid, lane); S.done(cur); }
#undef PG8_SA
#undef PG8_SB
#undef PG8_STAGE
#undef PG8_LDA
#undef PG8_LDB
#undef PG8_MMA
#undef PG8_WAIT_V
#undef PG8_WAIT_L
#undef PG8_BAR
#undef PG8_SCHED
}
}

#define LAS __attribute__((address_space(3)))
typedef unsigned short bf16;
typedef short bf16x8 __attribute__((ext_vector_type(8)));
typedef float f32x4 __attribute__((ext_vector_type(4)));
typedef float f32x16 __attribute__((ext_vector_type(16)));
typedef unsigned u32x4 __attribute__((ext_vector_type(4)));
typedef unsigned u32x2 __attribute__((ext_vector_type(2)));
typedef float f32x2_t __attribute__((ext_vector_type(2)));
typedef __bf16 bf16x2_t __attribute__((ext_vector_type(2)));

constexpr int DM = 1024, TSEQ = 2048, NB = 8, MP = NB * TSEQ  , NS = 128  , MR = MP + NS  , MPAD = 16640  ;
constexpr int DREC = 512, DATT = 512, DKV = 128, DFF = 2816, DIN = 1792;
constexpr float EPS = 1e-6f;
constexpr int NWAVES = 8, NTHR = 512;
constexpr size_t OFF_Y = 0, OFF_PK = (size_t)MR * DM, OFF_PV = OFF_PK + 131072, OFF_PCONV = OFF_PV + 131072, OFF_PH = OFF_PCONV + 12288,
                 OFF_SK = OFF_PH + 4096, OFF_SV = OFF_SK + 2097152, OFF_SCONV = OFF_SV + 2097152, OFF_SH = OFF_SCONV + 196608, OUT_END = OFF_SH + 65536;
constexpr size_t MiB = 1u << 20;
constexpr int CTL_WORDS = 10240, CW_DONE = CTL_WORDS - 1;
__device__ unsigned g_ctl[CTL_WORDS];
constexpr size_t WS_RSQH = 0, WS_SUMA = 1 * MiB, WS_SUMH = 1 * MiB + 512 * 1024;
constexpr size_t WS_WIN = 2 * MiB, WS_WOUT = 6 * MiB, WS_WGU = 8 * MiB, WS_WD = 19 * MiB, WS_GWT = 25 * MiB;
constexpr size_t WS_MIX = 26 * MiB, WS_HB = 59 * MiB, WS_FF = 92 * MiB;
constexpr size_t WS_XN = 92 * MiB, WS_XR = 125 * MiB, WS_GR = 142 * MiB, WS_Q = 159 * MiB, WS_KB = 176 * MiB, WS_VT = 181 * MiB, WS_END = 250 * MiB;
static_assert(WS_MIX + (size_t)MPAD * DM * 2 <= WS_HB && WS_HB + (size_t)MPAD * DM * 2 <= WS_FF && WS_FF + (size_t)MPAD * DFF * 2 <= WS_END, "ws map");
static_assert(WS_GR - WS_XR == WS_Q - WS_GR, "xr/gr/q equally spaced");
static_assert(WS_XN + (size_t)MPAD * DM * 2 <= WS_XR && WS_XR + (size_t)MPAD * 512 * 2 <= WS_GR && WS_GR + (size_t)MPAD * 512 * 2 <= WS_Q && WS_Q + (size_t)MPAD * 512 * 2 <= WS_KB && WS_KB + (size_t)MPAD * 128 * 2 <= WS_VT, "ws map 2");
constexpr int LDS_BYTES = 132096;

struct Params {
    const float* in[24];
    float* out; unsigned char* ws;
};
typedef const __attribute__((address_space(4))) Params* KP;
__device__ __forceinline__ KP kargs() { KP q = (KP)__builtin_amdgcn_kernarg_segment_ptr(); asm volatile("" : "+s"(q)); return q; }
enum { I_XP = 0, I_XS, I_CK, I_CV, I_SCONV, I_SH, I_N1G, I_WIN, I_CONVW, I_CONVB, I_GAW, I_GAB, I_GXW, I_GXB, I_LAM, I_SINK, I_RNG, I_ANG, I_WOUT, I_N2G, I_WG, I_WU, I_WD, I_FNG };

__device__ __forceinline__ unsigned pk2(float lo, float hi) { f32x2_t v = {lo, hi}; bf16x2_t b = __builtin_convertvector(v, bf16x2_t); return __builtin_bit_cast(unsigned, b); }
__device__ __forceinline__ float bflo(unsigned w) { return __uint_as_float(w << 16); }
__device__ __forceinline__ float bfhi(unsigned w) { return __uint_as_float(w & 0xffff0000u); }
__device__ __forceinline__ float bf1(bf16 u) { return __uint_as_float((unsigned)u << 16); }
__device__ __forceinline__ float shx(float v, int o, int lane) { return __int_as_float(__builtin_amdgcn_ds_bpermute((lane ^ o) << 2, __float_as_int(v))); }
__device__ __forceinline__ float shl(float v, int src) { return __int_as_float(__builtin_amdgcn_ds_bpermute(src << 2, __float_as_int(v))); }
__device__ __forceinline__ float wave_sum(float v, int lane) {
#pragma unroll
    for (int o = 1; o < 64; o <<= 1) v += shx(v, o, lane);
    return v;
}
__device__ __forceinline__ float wave_max(float v, int lane) {
#pragma unroll
    for (int o = 1; o < 64; o <<= 1) v = fmaxf(v, shx(v, o, lane));
    return v;
}
__device__ __forceinline__ float frcp(float x) { return __builtin_amdgcn_rcpf(x); }
__device__ __forceinline__ float fsqrt(float x) { return __builtin_amdgcn_sqrtf(x); }
__device__ __forceinline__ float frsq(float x) { return __builtin_amdgcn_rsqf(x); }
__device__ __forceinline__ float fexp(float x) { return __builtin_amdgcn_exp2f(x * 1.4426950408889634f); }
__device__ __forceinline__ float sigmoidf_(float x) { return frcp(1.0f + fexp(-x)); }
__device__ __forceinline__ float gelu_tanh(float x) { const float z = 0.7978845608028654f * (x + 0.044715f * x * x * x); const float e = fexp(2.0f * z); return x * (1.0f - frcp(e + 1.0f)); }

using pg8::Unit;
struct EpiIn {
    static constexpr bool PERM = true, AFTER_DRAIN = false;
    unsigned char* ws; float* out;
    __device__ __forceinline__ void operator()(const f32x4 (&acc)[2][2][4][2], const Unit& u, int wr, int wc, int fr, int fq) const {
        const int pn = u.pn;
        bf16* const KB = (bf16*)(ws + WS_KB); bf16* const VT = (bf16*)(ws + WS_VT);
#pragma unroll
        for (int ai = 0; ai < 2; ++ai)
#pragma unroll
            for (int m = 0; m < 4; ++m) {
                const int row = u.pm * 256 + ai * 128 + wr * 64 + m * 16 + fr;
                const bool isp = row < MP, iss = (row >= MP) && (row < MR);
                const int b = isp ? (row >> 11) : (row - MP), t = row & (TSEQ - 1);
#pragma unroll
                for (int bj = 0; bj < 2; ++bj) {
                    const int c = bj * 128 + wc * 32 + 8 * fq;
                    f32x4 v0 = acc[ai][bj][m][0], v1 = acc[ai][bj][m][1];
                    if (pn < 6) {
                        bf16* dst = (bf16*)(ws + WS_XR + (size_t)(pn >> 1) * (WS_GR - WS_XR));
                        const int col = (pn & 1) * 256 + c;
                        if (pn >= 4) { v0 = v0 * 0.125f; v1 = v1 * 0.125f; }
                        u32x4 w; w.x = pk2(v0[0], v0[1]); w.y = pk2(v0[2], v0[3]); w.z = pk2(v1[0], v1[1]); w.w = pk2(v1[2], v1[3]);
                        *(u32x4*)(dst + (size_t)row * 512 + col) = w;
                        if (pn < 2) {
                            float* o = nullptr;
                            if (isp && t >= TSEQ - 3) o = out + OFF_PCONV + (size_t)(b * 3 + (t - (TSEQ - 3))) * 512 + col;
                            if (iss) o = out + OFF_SCONV + (size_t)(b * 3 + 2) * 512 + col;
                            if (o) { *(f32x4*)o = v0; *(f32x4*)(o + 4) = v1; }
                        }
                    } else {
                        const int cc = wc * 32 + 8 * fq;
                        if (bj == 0) {
                            u32x4 w; w.x = pk2(v0[0], v0[1]); w.y = pk2(v0[2], v0[3]); w.z = pk2(v1[0], v1[1]); w.w = pk2(v1[2], v1[3]);
                            *(u32x4*)(KB + (size_t)row * 128 + cc) = w;
                        } else if (isp) {
                            const int kvh = cc >> 6, d0 = cc & 63;
                            bf16* vt = VT + ((size_t)(b * 2 + kvh) * 64 + d0) * TSEQ + t;
                            const unsigned w0 = pk2(v0[0], v0[1]), w1 = pk2(v0[2], v0[3]), w2 = pk2(v1[0], v1[1]), w3 = pk2(v1[2], v1[3]);
                            vt[0 * TSEQ] = (bf16)(w0 & 0xffff); vt[1 * TSEQ] = (bf16)(w0 >> 16); vt[2 * TSEQ] = (bf16)(w1 & 0xffff); vt[3 * TSEQ] = (bf16)(w1 >> 16);
                            vt[4 * TSEQ] = (bf16)(w2 & 0xffff); vt[5 * TSEQ] = (bf16)(w2 >> 16); vt[6 * TSEQ] = (bf16)(w3 & 0xffff); vt[7 * TSEQ] = (bf16)(w3 >> 16);
                        }
                        float* o = nullptr;
                        if (isp && t >= TSEQ - 128) o = out + (bj == 0 ? OFF_PK : OFF_PV) + (size_t)(b * 128 + (t - (TSEQ - 128))) * 128 + cc;
                        if (iss) o = out + (bj == 0 ? OFF_SK : OFF_SV) + (size_t)(b * 128 + 127) * 128 + cc;
                        if (o) { *(f32x4*)o = v0; *(f32x4*)(o + 4) = v1; }
                    }
                }
            }
    }
};
struct EpiOut {
    static constexpr bool PERM = false, AFTER_DRAIN = false;
    const float *xp, *xs; float* H; unsigned char* ws;
    __device__ __forceinline__ void operator()(const f32x4 (&acc)[2][2][4][2], const Unit& u, int wr, int wc, int fr, int fq) const {
        const int col0 = u.pn * 256 + wc * 32 + 4 * fq, lane = fr + 16 * fq;
        bf16* const HB = (bf16*)(ws + WS_HB); float* const rsq = (float*)(ws + WS_RSQH);
#pragma unroll
        for (int ai = 0; ai < 2; ++ai)
#pragma unroll
            for (int m = 0; m < 4; ++m) {
                const int row = u.pm * 256 + ai * 128 + wr * 64 + m * 16 + fr;
                const bool real = row < MR;
                const float* xrow = row < MP ? xp + (size_t)row * DM : xs + (size_t)(row - MP) * DM;
                float s = 0.f;
#pragma unroll
                for (int bj = 0; bj < 2; ++bj)
#pragma unroll
                    for (int n = 0; n < 2; ++n) {
                        const int c = col0 + bj * 128 + n * 16;
                        f32x4 v = acc[ai][bj][m][n];
                        if (real) v = v + __builtin_nontemporal_load((const f32x4*)(xrow + c));
                        s += (v[0] * v[0] + v[1] * v[1]) + (v[2] * v[2] + v[3] * v[3]);
                        u32x2 w; w.x = pk2(v[0], v[1]); w.y = pk2(v[2], v[3]);
                        *(u32x2*)(HB + (size_t)row * DM + c) = w;
                    }
                s += shx(s, 16, lane); s += shx(s, 32, lane);
                if (fq == 0) atomicAdd(rsq + row, s);
            }
    }
};
struct EpiGU {
    static constexpr bool PERM = true, AFTER_DRAIN = false;
    unsigned char* ws;
    __device__ __forceinline__ void operator()(const f32x4 (&acc)[2][2][4][2], const Unit& u, int wr, int wc, int fr, int fq) const {
        const int col = u.pn * 128 + wc * 32 + 8 * fq;
        bf16* const FF = (bf16*)(ws + WS_FF); const float* const rsq = (const float*)(ws + WS_RSQH);
#pragma unroll
        for (int ai = 0; ai < 2; ++ai)
#pragma unroll
            for (int m = 0; m < 4; ++m) {
                const int row = u.pm * 256 + ai * 128 + wr * 64 + m * 16 + fr;
                const float r = frsq(rsq[row] * (1.0f / DM) + EPS);
                float o[8];
#pragma unroll
                for (int n = 0; n < 2; ++n)
#pragma unroll
                    for (int e = 0; e < 4; ++e) { const float g = acc[ai][0][m][n][e] * r, uu = acc[ai][1][m][n][e] * r; o[4 * n + e] = g * sigmoidf_(g) * uu; }
                u32x4 w; w.x = pk2(o[0], o[1]); w.y = pk2(o[2], o[3]); w.z = pk2(o[4], o[5]); w.w = pk2(o[6], o[7]);
                *(u32x4*)(FF + (size_t)row * DFF + col) = w;
            }
    }
};
struct EpiDown {
    static constexpr bool PERM = false, AFTER_DRAIN = false;
    float* H;
    __device__ __forceinline__ void operator()(const f32x4 (&acc)[2][2][4][2], const Unit& u, int wr, int wc, int fr, int fq) const {
        const int col0 = u.pn * 256 + wc * 32 + 4 * fq;
#pragma unroll
        for (int ai = 0; ai < 2; ++ai)
#pragma unroll
            for (int m = 0; m < 4; ++m) {
                const int row = u.pm * 256 + ai * 128 + wr * 64 + m * 16 + fr;
                if (row < MR) {
#pragma unroll
                    for (int bj = 0; bj < 2; ++bj)
#pragma unroll
                        for (int n = 0; n < 2; ++n) {
                            float* pp = H + (size_t)row * DM + col0 + bj * 128 + n * 16;
                            *(f32x4*)pp = *(const f32x4*)pp + acc[ai][bj][m][n];
                        }
                }
            }
    }
};

constexpr size_t WS_XBUF = 768 * 1024;
constexpr int CW_PANEL = 4096, CW_SAMPLE = 8192, CW_S1 = 8192 + 64, CW_SCAN = 8192 + 128;
struct EpiDownFused {
    static constexpr bool PERM = false, AFTER_DRAIN = true;
    unsigned char* ws; float* out; const float* gf;
    __device__ __forceinline__ void operator()(const f32x4 (&)[2][2][4][2], const Unit&, int, int, int, int) const {}
    __device__ __forceinline__ void fused(f32x4 (&acc)[2][2][4][2], const Unit& u, int wr, int wc, int fr, int fq, PG8_LAS unsigned char* lds, int wid, int lane) const {
        LAS float* P = (LAS float*)lds;
        LAS float* Sr = (LAS float*)(lds + 4096);
        const bf16* HB = (const bf16*)(ws + WS_HB);
        float* xbuf = (float*)(ws + WS_XBUF);
        unsigned* cnt = g_ctl + CW_PANEL + 64 * u.pm;
        const int col0 = u.pn * 256 + wc * 32 + 4 * fq;
#pragma unroll
        for (int ai = 0; ai < 2; ++ai)
#pragma unroll
            for (int m = 0; m < 4; ++m) {
                const int rl = ai * 128 + wr * 64 + m * 16 + fr; const size_t row = (size_t)u.pm * 256 + rl;
                float s = 0.f;
#pragma unroll
                for (int bj = 0; bj < 2; ++bj)
#pragma unroll
                    for (int n = 0; n < 2; ++n) {
                        const u32x2 hb = __builtin_nontemporal_load((const u32x2*)(HB + row * DM + col0 + bj * 128 + n * 16));
                        f32x4 v = acc[ai][bj][m][n];
                        v[0] += bflo(hb.x); v[1] += bfhi(hb.x); v[2] += bflo(hb.y); v[3] += bfhi(hb.y);
                        acc[ai][bj][m][n] = v;
                        s += (v[0] * v[0] + v[1] * v[1]) + (v[2] * v[2] + v[3] * v[3]);
                    }
                s += shx(s, 16, lane); s += shx(s, 32, lane);
                if (fq == 0) P[rl * 4 + wc] = s;
            }
        asm volatile("s_waitcnt lgkmcnt(0)" ::: "memory"); __builtin_amdgcn_s_barrier(); asm volatile("" ::: "memory");
        const int rr = wid * 32 + (lane & 31);
        if (lane < 32) {
            const float tot = (P[rr * 4 + 0] + P[rr * 4 + 1]) + (P[rr * 4 + 2] + P[rr * 4 + 3]);
            __hip_atomic_store(xbuf + ((size_t)u.pm * 256 + rr) * 4 + u.pn, tot, __ATOMIC_RELAXED, __HIP_MEMORY_SCOPE_AGENT);
        }
        asm volatile("s_waitcnt vmcnt(0)" ::: "memory");
        if (lane == 0) __hip_atomic_fetch_add(cnt, 1u, __ATOMIC_RELAXED, __HIP_MEMORY_SCOPE_AGENT);
        if (wid == 0) {
            unsigned sp = 0;
            while ((unsigned)__builtin_amdgcn_readfirstlane(__hip_atomic_load(cnt, __ATOMIC_RELAXED, __HIP_MEMORY_SCOPE_AGENT)) < 32u) { __builtin_amdgcn_s_sleep(2); if (++sp > (1u << 22)) break; }
            __builtin_amdgcn_fence(__ATOMIC_ACQUIRE, "agent");
        }
        asm volatile("s_waitcnt vmcnt(0) lgkmcnt(0)" ::: "memory"); __builtin_amdgcn_s_barrier(); asm volatile("" ::: "memory");
        if (lane < 32) {
            const float* sl = xbuf + ((size_t)u.pm * 256 + rr) * 4; float t = 0.f;
#pragma unroll
            for (int k = 0; k < 4; ++k) t += __hip_atomic_load(sl + k, __ATOMIC_RELAXED, __HIP_MEMORY_SCOPE_AGENT);
            Sr[rr] = frsq(t * (1.0f / DM) + EPS);
        }
        asm volatile("s_waitcnt vmcnt(0) lgkmcnt(0)" ::: "memory"); __builtin_amdgcn_s_barrier(); asm volatile("" ::: "memory");
        f32x4 gv[2][2];
#pragma unroll
        for (int bj = 0; bj < 2; ++bj)
#pragma unroll
            for (int n = 0; n < 2; ++n) gv[bj][n] = *(const f32x4*)(gf + col0 + bj * 128 + n * 16);
#pragma unroll
        for (int ai = 0; ai < 2; ++ai)
#pragma unroll
            for (int m = 0; m < 4; ++m) {
                const int rl = ai * 128 + wr * 64 + m * 16 + fr; const size_t row = (size_t)u.pm * 256 + rl;
                const float sc = Sr[rl];
#pragma unroll
                for (int bj = 0; bj < 2; ++bj)
#pragma unroll
                    for (int n = 0; n < 2; ++n) __builtin_nontemporal_store(acc[ai][bj][m][n] * sc * gv[bj][n], (f32x4*)(out + row * DM + col0 + bj * 128 + n * 16));
            }
    }
};

__device__ __forceinline__ void tr_item(const float* __restrict__ W, int N, bf16* WT, int ldt, int k0, int n0, int drow0, const float* __restrict__ kscale, LAS float* scr, int lane) {
    float wv[32];
#pragma unroll
    for (int i = 0; i < 32; ++i) wv[i] = __builtin_nontemporal_load(W + (size_t)(k0 + 2 * i + (lane >> 5)) * N + n0 + (lane & 31));
#pragma unroll
    for (int i = 0; i < 32; ++i) { const int kk = 2 * i + (lane >> 5); float v = wv[i]; if (kscale) v *= kscale[k0 + kk]; scr[kk * 33 + (lane & 31)] = v; }
    asm volatile("s_waitcnt lgkmcnt(0)" ::: "memory");
    const int c = lane & 7;
#pragma unroll
    for (int j = 0; j < 4; ++j) { const int n = (lane >> 3) + 8 * j; const LAS float* s = scr + (8 * c) * 33 + n;
        u32x4 o; o.x = pk2(s[0 * 33], s[1 * 33]); o.y = pk2(s[2 * 33], s[3 * 33]); o.z = pk2(s[4 * 33], s[5 * 33]); o.w = pk2(s[6 * 33], s[7 * 33]);
        *(u32x4*)(WT + (size_t)(drow0 + n) * ldt + k0 + 8 * c) = o; }
    asm volatile("s_waitcnt lgkmcnt(0)" ::: "memory");
}
constexpr int CI_WIN = 16 * 56, CI_G = CI_WIN + 32, CI_WOUT = CI_G + 16 * 32, CI_WU = CI_WOUT + 2 * 16 * 88, CI_WD = CI_WU + 44 * 32;
__device__ __forceinline__ void convert_items(KP p, LAS unsigned char* lds, int lo, int hi, int gw, int NGW, int wave, int lane) {
    unsigned char* ws = p->ws;
    LAS float* scr = (LAS float*)(lds + wave * 16384);
    for (int it = lo + gw; it < hi; it += NGW) {
        const float* W; const float* ks = nullptr; bf16* WT; int N, ldt, k0, n0, drow0; int r = it;
        if (r < CI_WIN) { const int kb = r / 56, nb = r % 56; W = p->in[I_WIN]; N = DIN; WT = (bf16*)(ws + WS_WIN); ldt = DM; k0 = 64 * kb; n0 = 32 * nb; drow0 = n0; }
        else if (r < CI_G) { r -= CI_WIN; const int gx = r >> 4, n = (r & 15) >> 1, nb = r & 1; W = p->in[gx ? I_GXW : I_GAW] + n * 4096; N = 64; WT = (bf16*)(ws + WS_GWT) + gx * 8 * 4096 + n * 4096; ldt = 64; k0 = 0; n0 = 32 * nb; drow0 = n0; }
        else if (r < CI_WOUT) { r -= CI_G; const int kb = r / 32, nb = r % 32; W = p->in[I_WOUT]; N = DM; WT = (bf16*)(ws + WS_WOUT); ldt = DM; k0 = 64 * kb; n0 = 32 * nb; drow0 = n0; }
        else if (r < CI_WU) { r -= CI_WOUT; const int up = r >= 16 * 88 ? 1 : 0; if (up) r -= 16 * 88; const int kb = r / 88, nb = r % 88; W = p->in[up ? I_WU : I_WG]; N = DFF; WT = (bf16*)(ws + WS_WGU); ldt = DM; k0 = 64 * kb; n0 = 32 * nb;
            drow0 = 256 * (n0 >> 7) + 128 * up + (n0 & 127); ks = p->in[I_N2G]; }
        else { r -= CI_WU; const int kb = r / 32, nb = r % 32; W = p->in[I_WD]; N = DM; WT = (bf16*)(ws + WS_WD); ldt = DFF; k0 = 64 * kb; n0 = 32 * nb; drow0 = n0; }
        tr_item(W, N, WT, ldt, k0, n0, drow0, ks, scr, lane);
    }
}
__device__ __forceinline__ void copy_windows(KP p, int gt, int NGT) {
    for (int i = gt; i < NS * 4064; i += NGT) { const int b = i / 4064, o = i % 4064;
        __builtin_nontemporal_store(__builtin_nontemporal_load((const f32x4*)(p->in[I_CK] + (size_t)b * 16384 + 128) + o), (f32x4*)(p->out + OFF_SK + (size_t)b * 16384) + o);
        __builtin_nontemporal_store(__builtin_nontemporal_load((const f32x4*)(p->in[I_CV] + (size_t)b * 16384 + 128) + o), (f32x4*)(p->out + OFF_SV + (size_t)b * 16384) + o); }
    for (int i = gt; i < NS * 256; i += NGT) { const int b = i >> 8, o = i & 255;
        ((f32x4*)(p->out + OFF_SCONV + (size_t)b * 1536))[o] = ((const f32x4*)(p->in[I_SCONV] + (size_t)b * 1536 + 512))[o]; }
}
__device__ __forceinline__ void slack_slot(int nwg, int G, int bx, int& slot, int& nslots) {
    const int mx = (nwg + G - 1) / G, first = nwg - (mx - 1) * G;
    if (first >= G) { slot = bx; nslots = G; } else { slot = bx - first; nslots = G - first; }
}
__device__ __forceinline__ void p0_prologue(KP p, LAS unsigned char* lds, int gw, int NGW, int wave, int lane) {
    unsigned char* ws = p->ws;
    convert_items(p, lds, 0, CI_G, gw, NGW, wave, lane);
    {
        const f32x4* g4 = (const f32x4*)p->in[I_N1G] + lane;
        f32x4 g[4];
#pragma unroll
        for (int j = 0; j < 4; ++j) g[j] = g4[64 * j];
        for (int m0 = gw; m0 < MR; m0 += 2 * NGW) {
            f32x4 v[2][4];
#pragma unroll
            for (int rr = 0; rr < 2; ++rr) { const int m = m0 + rr * NGW, mc = m < MR ? m : m0;
                const float* xrow = mc < MP ? p->in[I_XP] + (size_t)mc * DM : p->in[I_XS] + (size_t)(mc - MP) * DM;
                const f32x4* xr = (const f32x4*)xrow + lane;
#pragma unroll
                for (int j = 0; j < 4; ++j) v[rr][j] = __builtin_nontemporal_load(xr + 64 * j); }
#pragma unroll
            for (int rr = 0; rr < 2; ++rr) { const int m = m0 + rr * NGW;
                float s = 0.f;
#pragma unroll
                for (int j = 0; j < 4; ++j) s += (v[rr][j].x * v[rr][j].x + v[rr][j].y * v[rr][j].y) + (v[rr][j].z * v[rr][j].z + v[rr][j].w * v[rr][j].w);
                const float rs = frsq(wave_sum(s, lane) * (1.f / DM) + EPS);
                if (m < MR) { u32x2* o8 = (u32x2*)((bf16*)(ws + WS_XN) + (size_t)m * DM) + lane;
#pragma unroll
                    for (int j = 0; j < 4; ++j) { u32x2 w; w.x = pk2(v[rr][j].x * rs * g[j].x, v[rr][j].y * rs * g[j].y); w.y = pk2(v[rr][j].z * rs * g[j].z, v[rr][j].w * rs * g[j].w); o8[64 * j] = w; } }
            }
        }
    }
    const int gt = gw * 64 + lane, NGT = NGW * 64;
    for (int i = gt; i < MPAD; i += NGT) ((float*)(ws + WS_RSQH))[i] = 0.f;
}

__device__ __forceinline__ void row_scan4(float A, float H, float c0, int q, float& cin, float& At, float& Ht) {
    const auto ra = __builtin_amdgcn_permlane16_swap(__float_as_uint(A), __float_as_uint(A), false, false);
    const auto rh = __builtin_amdgcn_permlane16_swap(__float_as_uint(H), __float_as_uint(H), false, false);
    const float Ae = __uint_as_float(ra[0]), Ao = __uint_as_float(ra[1]), He = __uint_as_float(rh[0]), Ho = __uint_as_float(rh[1]);
    const float Ap = Ae * Ao, Hp = Ao * He + Ho;
    const auto pa = __builtin_amdgcn_permlane32_swap(__float_as_uint(Ap), __float_as_uint(Ap), false, false);
    const auto ph = __builtin_amdgcn_permlane32_swap(__float_as_uint(Hp), __float_as_uint(Hp), false, false);
    const float Alo = __uint_as_float(pa[0]), Ahi = __uint_as_float(pa[1]), Hlo = __uint_as_float(ph[0]), Hhi = __uint_as_float(ph[1]);
    const float c2 = Alo * c0 + Hlo, base = (q & 2) ? c2 : c0;
    cin = (q & 1) ? (Ae * base + He) : base;
    At = Alo * Ahi; Ht = Ahi * Hlo + Hhi;
}

constexpr int HS_OFF = 16384, HS_LD = 1032;
#define MFMA16(a, b, c) __builtin_amdgcn_mfma_f32_16x16x32_bf16((a), (b), (c), 0, 0, 0)
#define MFMA32(a, b, c) __builtin_amdgcn_mfma_f32_32x32x16_bf16((a), (b), (c), 0, 0, 0)
typedef float f32x2v __attribute__((ext_vector_type(2)));
constexpr size_t WS_AU = 186 * MiB;
template <bool FINAL>
__device__ __forceinline__ void scan_unit(KP p, int b, int chunk, LAS unsigned char* lds, int wave, int lane) {
    unsigned char* ws = p->ws;
    const bf16* XR = (const bf16*)(ws + WS_XR);
    const bf16* GWT = (const bf16*)(ws + WS_GWT);
    float* SA = (float*)(ws + WS_SUMA); float* SH = (float*)(ws + WS_SUMH);
    unsigned* AU = (unsigned*)(ws + WS_AU);
    const LAS float* cw = (const LAS float*)lds;
    const int n = wave, j = lane & 15, q = lane >> 4;
    float hprev[4] = {0.f, 0.f, 0.f, 0.f}, acum[4] = {1.f, 1.f, 1.f, 1.f};
    const size_t au0 = ((size_t)b * TSEQ + chunk * 64 + 4 * q) * 512 + 64 * n + j;
    if constexpr (FINAL) {
        unsigned pfg; { const int t_ = wave * 64 + lane; pfg = *(const unsigned*)((const bf16*)(ws + WS_GR) + ((size_t)b * TSEQ + chunk * 64 + (t_ >> 3)) * 512 + (t_ & 7) * 64); }
        unsigned au[4][4], aun[4][4];
#define SCAN_LOADAU(dst, sc_) do { _Pragma("unroll") for (int nt = 0; nt < 4; ++nt) _Pragma("unroll") for (int r = 0; r < 4; ++r) dst[nt][r] = __builtin_nontemporal_load(AU + au0 + (size_t)((sc_) * 16 + r) * 512 + 16 * nt); } while (0)
        SCAN_LOADAU(au, 0);
        {
            float As[4] = {1.f, 1.f, 1.f, 1.f}, Hs[4] = {0.f, 0.f, 0.f, 0.f};
            float la[8][4], lh[8][4];
#pragma unroll
            for (int cc = 0; cc < 8; ++cc) { const int c = 8 * q + cc, ce = c < chunk ? c : 0;
#pragma unroll
                for (int nt = 0; nt < 4; ++nt) { const size_t o = (size_t)(b * 32 + ce) * 512 + 64 * n + 16 * nt + j; la[cc][nt] = __hip_atomic_load(SA + o, __ATOMIC_RELAXED, __HIP_MEMORY_SCOPE_AGENT); lh[cc][nt] = __hip_atomic_load(SH + o, __ATOMIC_RELAXED, __HIP_MEMORY_SCOPE_AGENT); } }
#pragma unroll
            for (int cc = 0; cc < 8; ++cc) { const bool ok = (8 * q + cc) < chunk;
#pragma unroll
                for (int nt = 0; nt < 4; ++nt) { const float a = ok ? la[cc][nt] : 1.f, hh = ok ? lh[cc][nt] : 0.f; Hs[nt] = a * Hs[nt] + hh; As[nt] *= a; } }
#pragma unroll
            for (int nt = 0; nt < 4; ++nt) { float cin_, At_, Ht_; row_scan4(As[nt], Hs[nt], 0.f, q, cin_, At_, Ht_); hprev[nt] = Ht_; }
        }
#pragma unroll
        for (int sc = 0; sc < 4; ++sc) {
            if (sc < 3) SCAN_LOADAU(aun, sc + 1);
#pragma unroll
            for (int nt = 0; nt < 4; ++nt) {
                float a4[4], u4[4];
#pragma unroll
                for (int r = 0; r < 4; ++r) { a4[r] = 1.0f - bflo(au[nt][r]); u4[r] = bfhi(au[nt][r]); }
                const float A4 = (a4[0] * a4[1]) * (a4[2] * a4[3]);
                const float H4 = ((u4[0] * a4[1] + u4[1]) * a4[2] + u4[2]) * a4[3] + u4[3];
                float cin, At_, Ht_; row_scan4(A4, H4, hprev[nt], q, cin, At_, Ht_);
                hprev[nt] = At_ * hprev[nt] + Ht_;
                LAS bf16* hs = (LAS bf16*)(lds + HS_OFF + (sc * 16 + 4 * q) * HS_LD) + (64 * n + 16 * nt + j);
                float h = cin;
#pragma unroll
                for (int r = 0; r < 4; ++r) { h = a4[r] * h + u4[r]; hs[r * (HS_LD / 2)] = (bf16)(pk2(h, 0.f) & 0xffff); }
            }
#pragma unroll
            for (int nt = 0; nt < 4; ++nt)
#pragma unroll
                for (int r = 0; r < 4; ++r) au[nt][r] = aun[nt][r];
        }
#undef SCAN_LOADAU
        asm volatile("" :: "v"(pfg));
    } else {
    bf16x8 wf[2][4][2];
#pragma unroll
    for (int g = 0; g < 2; ++g)
#pragma unroll
        for (int nt = 0; nt < 4; ++nt)
#pragma unroll
            for (int s = 0; s < 2; ++s) wf[g][nt][s] = *(const bf16x8*)(GWT + ((size_t)(g * 8 + n) * 64 + 16 * nt + j) * 64 + 32 * s + 8 * q);
    bf16x8 idf[2];
#pragma unroll
    for (int e = 0; e < 2; ++e)
#pragma unroll
        for (int jj = 0; jj < 8; ++jj) idf[e][jj] = (16 * e + j - 8 * q == jj) ? (short)0x3F80 : (short)0;
    float ba[4], bx[4], sp[4];
#pragma unroll
    for (int nt = 0; nt < 4; ++nt) { const int ch = 64 * n + 16 * nt + j; ba[nt] = p->in[I_GAB][ch]; bx[nt] = p->in[I_GXB][ch]; sp[nt] = 8.0f * log1pf(__expf(-p->in[I_LAM][ch])) * 1.4426950408889634f; }
#define SCAN_LOADX(dst, sc_) do { const int tok_ = chunk * 64 + (sc_) * 16 + j; \
        _Pragma("unroll") for (int s = 0; s < 2; ++s) _Pragma("unroll") for (int w = 0; w < 4; ++w) { \
            const int tt = tok_ - 3 + w, ttc = tt < 0 ? 0 : tt; \
            u32x4 x = __builtin_nontemporal_load((const u32x4*)(XR + (size_t)(b * TSEQ + ttc) * 512 + 64 * n + 32 * s + 8 * q)); \
            if (tt < 0) x = (u32x4){0u, 0u, 0u, 0u}; dst[s][w] = x; } } while (0)
    u32x4 xcur[2][4], xnext[2][4];
    SCAN_LOADX(xcur, 0);
#pragma unroll
    for (int sc = 0; sc < 4; ++sc) {
        if (sc < 3) SCAN_LOADX(xnext, sc + 1);
        bf16x8 af[2];
#pragma unroll
        for (int s = 0; s < 2; ++s) {
            const int ch0 = 64 * n + 32 * s + 8 * q;
            float a8[8];
            { const f32x4 c0 = *(const LAS f32x4*)(cw + 2048 + ch0), c1 = *(const LAS f32x4*)(cw + 2048 + ch0 + 4);
              a8[0] = c0[0]; a8[1] = c0[1]; a8[2] = c0[2]; a8[3] = c0[3]; a8[4] = c1[0]; a8[5] = c1[1]; a8[6] = c1[2]; a8[7] = c1[3]; }
#pragma unroll
            for (int w = 0; w < 4; ++w) {
                const u32x4 x = xcur[s][w];
                const f32x4 w0 = *(const LAS f32x4*)(cw + w * 512 + ch0), w1 = *(const LAS f32x4*)(cw + w * 512 + ch0 + 4);
                a8[0] += w0[0] * bflo(x.x); a8[1] += w0[1] * bfhi(x.x); a8[2] += w0[2] * bflo(x.y); a8[3] += w0[3] * bfhi(x.y);
                a8[4] += w1[0] * bflo(x.z); a8[5] += w1[1] * bfhi(x.z); a8[6] += w1[2] * bflo(x.w); a8[7] += w1[3] * bfhi(x.w);
            }
            u32x4 pk; pk.x = pk2(a8[0], a8[1]); pk.y = pk2(a8[2], a8[3]); pk.z = pk2(a8[4], a8[5]); pk.w = pk2(a8[6], a8[7]);
            af[s] = __builtin_bit_cast(bf16x8, pk);
        }
#pragma unroll
        for (int nt = 0; nt < 4; ++nt) {
            f32x4 da = {0.f, 0.f, 0.f, 0.f}, dx = {0.f, 0.f, 0.f, 0.f}, xc = {0.f, 0.f, 0.f, 0.f};
            da = MFMA16(af[0], wf[0][nt][0], da); da = MFMA16(af[1], wf[0][nt][1], da);
            dx = MFMA16(af[0], wf[1][nt][0], dx); dx = MFMA16(af[1], wf[1][nt][1], dx);
            xc = MFMA16(af[nt >> 1], idf[nt & 1], xc);
            float a4[4], u4[4];
#pragma unroll
            for (int r = 0; r < 4; ++r) {
                const float ra = sigmoidf_(da[r] + ba[nt]), ix = sigmoidf_(dx[r] + bx[nt]);
                const float a = __builtin_amdgcn_exp2f(-ra * sp[nt]);
                a4[r] = a; u4[r] = fsqrt(fmaxf(1.0f - a * a, 0.f)) * ix * xc[r];
                AU[au0 + (size_t)(sc * 16 + r) * 512 + 16 * nt] = pk2(1.0f - a4[r], u4[r]);
            }
            const float A4 = (a4[0] * a4[1]) * (a4[2] * a4[3]);
            const float H4 = ((u4[0] * a4[1] + u4[1]) * a4[2] + u4[2]) * a4[3] + u4[3];
            float cin_, At_, Ht_; row_scan4(A4, H4, hprev[nt], q, cin_, At_, Ht_);
            hprev[nt] = At_ * hprev[nt] + Ht_; acum[nt] *= At_;
            asm volatile("" : "+v"(hprev[nt]), "+v"(acum[nt]));
        }
#pragma unroll
        for (int s = 0; s < 2; ++s)
#pragma unroll
            for (int w = 0; w < 4; ++w) xcur[s][w] = xnext[s][w];
    }
#undef SCAN_LOADX
    }
    if (!FINAL) {
        if (q == 0) {
#pragma unroll
            for (int nt = 0; nt < 4; ++nt) { const int ch = 64 * n + 16 * nt + j; const size_t o = (size_t)(b * 32 + chunk) * 512 + ch;
                __hip_atomic_store(SA + o, acum[nt], __ATOMIC_RELAXED, __HIP_MEMORY_SCOPE_AGENT); __hip_atomic_store(SH + o, hprev[nt], __ATOMIC_RELAXED, __HIP_MEMORY_SCOPE_AGENT); }
        }
    } else {
        if (chunk == 31 && q == 0) {
#pragma unroll
            for (int nt = 0; nt < 4; ++nt) p->out[OFF_PH + (size_t)b * 512 + 64 * n + 16 * nt + j] = hprev[nt];
        }
        __syncthreads();
        const bf16* GR = (const bf16*)(ws + WS_GR);
        bf16* MIX = (bf16*)(ws + WS_MIX);
        const f32x4 g0 = *(const f32x4*)(p->in[I_RNG] + 8 * lane), g1 = *(const f32x4*)(p->in[I_RNG] + 8 * lane + 4);
        u32x4 grv[8];
#pragma unroll
        for (int tt = 0; tt < 8; ++tt) grv[tt] = __builtin_nontemporal_load((const u32x4*)(GR + ((size_t)b * TSEQ + chunk * 64 + wave * 8 + tt) * 512 + 8 * lane));
#pragma unroll
        for (int tt = 0; tt < 8; ++tt) {
            const int tl = wave * 8 + tt;
            const size_t row = (size_t)b * TSEQ + chunk * 64 + tl;
            const LAS u32x2* hp = (const LAS u32x2*)(lds + HS_OFF + tl * HS_LD + 16 * lane);
            const u32x2 h0 = hp[0], h1 = hp[1];
            const u32x4 gr = grv[tt];
            float rc[8];
            rc[0] = bflo(h0.x) * gelu_tanh(bflo(gr.x)); rc[1] = bfhi(h0.x) * gelu_tanh(bfhi(gr.x)); rc[2] = bflo(h0.y) * gelu_tanh(bflo(gr.y)); rc[3] = bfhi(h0.y) * gelu_tanh(bfhi(gr.y));
            rc[4] = bflo(h1.x) * gelu_tanh(bflo(gr.z)); rc[5] = bfhi(h1.x) * gelu_tanh(bfhi(gr.z)); rc[6] = bflo(h1.y) * gelu_tanh(bflo(gr.w)); rc[7] = bfhi(h1.y) * gelu_tanh(bfhi(gr.w));
            float ss = 0.f;
#pragma unroll
            for (int e = 0; e < 8; ++e) ss += rc[e] * rc[e];
            const float rn = frsq(wave_sum(ss, lane) * (1.0f / DREC) + EPS);
            u32x4 w; w.x = pk2(rc[0] * rn * g0[0], rc[1] * rn * g0[1]); w.y = pk2(rc[2] * rn * g0[2], rc[3] * rn * g0[3]);
            w.z = pk2(rc[4] * rn * g1[0], rc[5] * rn * g1[1]); w.w = pk2(rc[6] * rn * g1[2], rc[7] * rn * g1[3]);
            *(u32x4*)(MIX + row * DM + 8 * lane) = w;
        }
        __syncthreads();
    }
}

constexpr int AT_KLD = 272, AT_VLD = 336, AT_OLD = 1040;
constexpr int AT_K = 0, AT_V = AT_K + 160 * AT_KLD, AT_RED = AT_V + 128 * AT_VLD, AT_END = AT_RED + 1024;
static_assert(32 * AT_OLD <= AT_V && 12288 + AT_END <= 131072, "attention LDS map");
__device__ __forceinline__ void attn_unit(KP p, int b, int qt, LAS unsigned char* lds, int wave, int lane) {
    unsigned char* ws = p->ws;
    const bf16* Q = (const bf16*)(ws + WS_Q); const bf16* KB = (const bf16*)(ws + WS_KB); const bf16* VT = (const bf16*)(ws + WS_VT);
    bf16* MIX = (bf16*)(ws + WS_MIX);
    LAS float* red = (LAS float*)(lds + AT_RED);
    const int r = lane & 31, h = lane >> 5, kvh = wave >> 2, q0 = qt * 32, tid = wave * 64 + lane;
    const size_t rowq = (size_t)b * TSEQ + q0 + r;
    __syncthreads();
    bf16x8 qf[4];
#pragma unroll
    for (int s = 0; s < 4; ++s) qf[s] = __builtin_nontemporal_load((const bf16x8*)(Q + rowq * 512 + wave * 64 + 16 * s + 8 * h));
    {
        u32x4 kv[5], vv[5];
#pragma unroll
        for (int i = 0; i < 5; ++i) { const int id = tid + 512 * i, row = id >> 4, c16 = id & 15; int g = q0 - 128 + row; g = g < 0 ? 0 : g;
            kv[i] = *(const u32x4*)(KB + ((size_t)b * TSEQ + g) * 128 + c16 * 8); }
#pragma unroll
        for (int i = 0; i < 5; ++i) { const int id = tid + 512 * i, row = id / 20, cc = id % 20; int k0 = q0 - 128 + 8 * cc; k0 = k0 < 0 ? 0 : k0;
            vv[i] = *(const u32x4*)(VT + ((size_t)b * 128 + row) * TSEQ + k0); }
#pragma unroll
        for (int i = 0; i < 5; ++i) { const int id = tid + 512 * i, row = id >> 4, c16 = id & 15; *(LAS u32x4*)(lds + AT_K + row * AT_KLD + c16 * 16) = kv[i]; }
#pragma unroll
        for (int i = 0; i < 5; ++i) { const int id = tid + 512 * i, row = id / 20, cc = id % 20; *(LAS u32x4*)(lds + AT_V + row * AT_VLD + cc * 16) = vv[i]; }
    }
    __syncthreads();
    const int pr = (r & ~12) | ((r & 4) << 1) | ((r & 8) >> 1);
    f32x16 S[5];
#pragma unroll
    for (int kt = 0; kt < 5; ++kt) {
#pragma unroll
        for (int i = 0; i < 16; ++i) S[kt][i] = 0.f;
#pragma unroll
        for (int s = 0; s < 4; ++s) {
            const bf16x8 kf = *(const LAS bf16x8*)(lds + AT_K + (32 * kt + pr) * AT_KLD + kvh * 128 + (16 * s + 8 * h) * 2);
            S[kt] = MFMA32(kf, qf[s], S[kt]);
        }
    }
    const float sink = p->in[I_SINK][wave];
    float m = sink;
#pragma unroll
    for (int kt = 0; kt < 5; ++kt) {
        const int kbase = q0 - 128 + 32 * kt;
#pragma unroll
        for (int i = 0; i < 16; ++i) {
            const int kl = 16 * (i >> 3) + 8 * h + (i & 7);
            bool valid = kbase >= 0;
            if (kt == 0) valid = valid && (kl >= r);
            if (kt == 4) valid = valid && (kl <= r);
            const float sv = valid ? S[kt][i] : -INFINITY;
            S[kt][i] = sv; m = fmaxf(m, sv);
        }
    }
    m = fmaxf(m, shx(m, 32, lane));
    float l = 0.f;
#pragma unroll
    for (int kt = 0; kt < 5; ++kt)
#pragma unroll
        for (int i = 0; i < 16; ++i) { const float pv = fexp(S[kt][i] - m); S[kt][i] = pv; l += pv; }
    l += shx(l, 32, lane);
    const float inv = frcp(l + fexp(sink - m));
    f32x16 O[2];
#pragma unroll
    for (int dt = 0; dt < 2; ++dt)
#pragma unroll
        for (int i = 0; i < 16; ++i) O[dt][i] = 0.f;
#pragma unroll
    for (int kt = 0; kt < 5; ++kt) {
#pragma unroll
        for (int s2 = 0; s2 < 2; ++s2) {
            u32x4 pk; pk.x = pk2(S[kt][8 * s2 + 0], S[kt][8 * s2 + 1]); pk.y = pk2(S[kt][8 * s2 + 2], S[kt][8 * s2 + 3]);
            pk.z = pk2(S[kt][8 * s2 + 4], S[kt][8 * s2 + 5]); pk.w = pk2(S[kt][8 * s2 + 6], S[kt][8 * s2 + 7]);
            const bf16x8 pb = __builtin_bit_cast(bf16x8, pk);
#pragma unroll
            for (int dt = 0; dt < 2; ++dt) {
                const bf16x8 vf = *(const LAS bf16x8*)(lds + AT_V + (kvh * 64 + 32 * dt + r) * AT_VLD + (32 * kt + 16 * s2 + 8 * h) * 2);
                O[dt] = MFMA32(vf, pb, O[dt]);
            }
        }
    }
    float ss = 0.f;
#pragma unroll
    for (int dt = 0; dt < 2; ++dt)
#pragma unroll
        for (int i = 0; i < 16; ++i) { O[dt][i] *= inv; ss += O[dt][i] * O[dt][i]; }
    ss += shx(ss, 32, lane);
    if (h == 0) red[wave * 32 + r] = ss;
    __syncthreads();
    float tot = 0.f;
#pragma unroll
    for (int w = 0; w < 8; ++w) tot += red[w * 32 + r];
    const float rn = frsq(tot * (1.0f / DATT) + EPS);
#pragma unroll
    for (int dt = 0; dt < 2; ++dt)
#pragma unroll
        for (int g4 = 0; g4 < 4; ++g4) {
            const int d = 32 * dt + 8 * g4 + 4 * h;
            const f32x4 gg = *(const f32x4*)(p->in[I_ANG] + wave * 64 + d);
            u32x2 w; w.x = pk2(O[dt][4 * g4 + 0] * rn * gg[0], O[dt][4 * g4 + 1] * rn * gg[1]); w.y = pk2(O[dt][4 * g4 + 2] * rn * gg[2], O[dt][4 * g4 + 3] * rn * gg[3]);
            *(LAS u32x2*)(lds + AT_K + r * AT_OLD + (wave * 64 + d) * 2) = w;
        }
    __syncthreads();
#pragma unroll
    for (int i = 0; i < 4; ++i) { const int id = tid + 512 * i, row = id >> 6, cc = id & 63;
        *(u32x4*)(MIX + ((size_t)b * TSEQ + q0 + row) * DM + 512 + cc * 8) = *(const LAS u32x4*)(lds + AT_K + row * AT_OLD + cc * 16); }
    __syncthreads();
}

__device__ __forceinline__ void sample_unit(KP p, int b, LAS unsigned char* lds, int tid, int wave, int lane) {
    unsigned char* ws = p->ws;
    const size_t row = (size_t)MP + b;
    bf16* MIX = (bf16*)(ws + WS_MIX);
    LAS float* xs = (LAS float*)(lds + 12288);
    LAS float* redw = (LAS float*)(lds + 12288 + 2048);
    LAS float* qs = (LAS float*)(lds + 12288 + 4096);
    LAS float* ps = (LAS float*)(lds + 12288 + 8192);
    __syncthreads();
    {
        const int c = tid;
        const float* sc = p->in[I_SCONV] + (size_t)b * 1536;
        const float* cwg = p->in[I_CONVW];
        const float xr = p->out[OFF_SCONV + (size_t)(b * 3 + 2) * 512 + c];
        const float xc = p->in[I_CONVB][c] + sc[c] * cwg[c] + sc[512 + c] * cwg[512 + c] + sc[1024 + c] * cwg[1024 + c] + xr * cwg[1536 + c];
        xs[c] = xc;
        __syncthreads();
        const int n = c >> 6, jj = c & 63;
        const float* wa = p->in[I_GAW] + n * 4096 + jj; const float* wx = p->in[I_GXW] + n * 4096 + jj;
        float ya = p->in[I_GAB][c], yx = p->in[I_GXB][c];
#pragma unroll
        for (int hb = 0; hb < 2; ++hb) {
            float wa_[32], wx_[32];
#pragma unroll
            for (int i = 0; i < 32; ++i) { wa_[i] = wa[(hb * 32 + i) * 64]; wx_[i] = wx[(hb * 32 + i) * 64]; }
#pragma unroll
            for (int i = 0; i < 32; ++i) { const float xv = xs[64 * n + hb * 32 + i]; ya += xv * wa_[i]; yx += xv * wx_[i]; }
        }
        const float ra = sigmoidf_(ya), ix = sigmoidf_(yx);
        const float la = -8.0f * ra * log1pf(__expf(-p->in[I_LAM][c]));
        const float a = __expf(la);
        const float u = fsqrt(fmaxf(1.0f - a * a, 0.f)) * ix * xc;
        const float hn = a * p->in[I_SH][(size_t)b * 512 + c] + u;
        p->out[OFF_SH + (size_t)b * 512 + c] = hn;
        const float gr = bf1(((const bf16*)(ws + WS_GR))[row * 512 + c]);
        const float rec = hn * gelu_tanh(gr);
        const float ssw = wave_sum(rec * rec, lane);
        if (lane == 0) redw[wave] = ssw;
        __syncthreads();
        float tot = 0.f;
#pragma unroll
        for (int w = 0; w < 8; ++w) tot += redw[w];
        const float rn = frsq(tot * (1.0f / DREC) + EPS);
        { const float mv = rec * rn * p->in[I_RNG][c], mo = shx(mv, 1, lane);
          if ((lane & 1) == 0) __hip_atomic_store((unsigned*)(MIX + row * DM + c), pk2(mv, mo), __ATOMIC_RELAXED, __HIP_MEMORY_SCOPE_AGENT); }
    }
    {
        const int kvh = wave >> 2;
        const float qd = bf1(((const bf16*)(ws + WS_Q))[row * 512 + wave * 64 + lane]);
        qs[wave * 64 + lane] = qd;
        const float* kself = p->out + OFF_SK + (size_t)(b * 128 + 127) * 128 + kvh * 64;
        const float* vself = p->out + OFF_SV + (size_t)(b * 128 + 127) * 128 + kvh * 64;
        const float sself = wave_sum(qd * kself[lane], lane);
        asm volatile("s_waitcnt lgkmcnt(0)" ::: "memory");
        const float* kc = p->in[I_CK] + (size_t)b * 16384 + kvh * 64;
        float s0 = 0.f, s1 = 0.f;
        const f32x4* k0 = (const f32x4*)(kc + (size_t)lane * 128);
        const f32x4* k1 = (const f32x4*)(kc + (size_t)(lane + 64) * 128);
        const LAS f32x4* q4 = (const LAS f32x4*)(qs + wave * 64);
        {
            f32x4 ka[16], kb2[16];
#pragma unroll
            for (int i = 0; i < 16; ++i) { ka[i] = k0[i]; kb2[i] = k1[i]; }
#pragma unroll
            for (int i = 0; i < 16; ++i) { const f32x4 qq = q4[i], a0 = ka[i], a1 = kb2[i];
                s0 += (qq[0] * a0[0] + qq[1] * a0[1]) + (qq[2] * a0[2] + qq[3] * a0[3]);
                s1 += (qq[0] * a1[0] + qq[1] * a1[1]) + (qq[2] * a1[2] + qq[3] * a1[3]); }
        }
        const float sink = p->in[I_SINK][wave];
        const float m = fmaxf(fmaxf(wave_max(fmaxf(s0, s1), lane), sself), sink);
        const float p0 = __expf(s0 - m), p1 = __expf(s1 - m), pself = __expf(sself - m);
        const float den = wave_sum(p0 + p1, lane) + pself + __expf(sink - m);
        ps[wave * 128 + lane] = p0; ps[wave * 128 + 64 + lane] = p1;
        asm volatile("s_waitcnt lgkmcnt(0)" ::: "memory");
        const int kg = lane >> 4, d4 = lane & 15;
        const float* vc = p->in[I_CV] + (size_t)b * 16384 + kvh * 64 + 4 * d4;
        f32x4 o4 = {0.f, 0.f, 0.f, 0.f};
#pragma unroll
        for (int hb = 0; hb < 2; ++hb) {
            f32x4 vv[16];
#pragma unroll
            for (int i = 0; i < 16; ++i) vv[i] = *(const f32x4*)(vc + (size_t)(kg + 4 * (hb * 16 + i)) * 128);
#pragma unroll
            for (int i = 0; i < 16; ++i) o4 = o4 + vv[i] * ps[wave * 128 + kg + 4 * (hb * 16 + i)];
        }
#pragma unroll
        for (int e = 0; e < 4; ++e) { o4[e] += shx(o4[e], 16, lane); o4[e] += shx(o4[e], 32, lane); }
        o4 = (o4 + *(const f32x4*)(vself + 4 * d4) * pself) * (1.0f / den);
        const float ssw = wave_sum((o4[0] * o4[0] + o4[1] * o4[1]) + (o4[2] * o4[2] + o4[3] * o4[3]), lane) * 0.25f;
        if (lane == 0) redw[8 + wave] = ssw;
        __syncthreads();
        float tot = 0.f;
#pragma unroll
        for (int w = 0; w < 8; ++w) tot += redw[8 + w];
        const float rn = frsq(tot * (1.0f / DATT) + EPS);
        if (kg == 0) { const f32x4 gg = *(const f32x4*)(p->in[I_ANG] + wave * 64 + 4 * d4);
            u32x2 w; w.x = pk2(o4[0] * rn * gg[0], o4[1] * rn * gg[1]); w.y = pk2(o4[2] * rn * gg[2], o4[3] * rn * gg[3]);
            unsigned* mp = (unsigned*)(MIX + row * DM + 512 + wave * 64 + 4 * d4);
            __hip_atomic_store(mp, w.x, __ATOMIC_RELAXED, __HIP_MEMORY_SCOPE_AGENT); __hip_atomic_store(mp + 1, w.y, __ATOMIC_RELAXED, __HIP_MEMORY_SCOPE_AGENT); }
    }
    __syncthreads();
}


template <int MODE>
__device__ __forceinline__ void small_gemm_task(KP p, const bf16* __restrict__ A, const bf16* __restrict__ Bt, int K, int n0, LAS unsigned char* lds, int wave, int lane) {
    const int r = lane & 31, h = lane >> 5, mt = wave & 3, kh = wave >> 2, Kh = K >> 1;
    const bf16* ap = A + (size_t)(32 * mt + r) * K + kh * Kh + 64 * h;
    const bf16* bp = Bt + (size_t)(n0 + r) * K + kh * Kh + 64 * h;
    f32x16 acc;
#pragma unroll
    for (int i = 0; i < 16; ++i) acc[i] = 0.f;
    bf16x8 a[8], b[8], an[8], bn[8];
#pragma unroll
    for (int i = 0; i < 8; ++i) { a[i] = *(const bf16x8*)(ap + 8 * i); b[i] = *(const bf16x8*)(bp + 8 * i); }
    for (int k = 0; k < Kh; k += 128) {
        const int kn = (k + 128 < Kh) ? k + 128 : k;
#pragma unroll
        for (int i = 0; i < 8; ++i) { an[i] = *(const bf16x8*)(ap + kn + 8 * i); bn[i] = *(const bf16x8*)(bp + kn + 8 * i); }
#pragma unroll
        for (int i = 0; i < 8; ++i) acc = MFMA32(a[i], b[i], acc);
#pragma unroll
        for (int i = 0; i < 8; ++i) { a[i] = an[i]; b[i] = bn[i]; }
    }
    LAS float* red = (LAS float*)lds;
    __syncthreads();
    if (kh == 1) {
#pragma unroll
        for (int i = 0; i < 16; ++i) red[(mt * 16 + i) * 64 + lane] = acc[i];
    }
    __syncthreads();
    if (kh == 0) {
        float* H = p->out; const int c = n0 + r;
#pragma unroll
        for (int i = 0; i < 16; ++i) {
            const int rs = 32 * mt + (i & 3) + 8 * (i >> 2) + 4 * h;
            float v = acc[i] + red[(mt * 16 + i) * 64 + lane];
            float* hp = H + (size_t)(MP + rs) * DM + c;
            if (MODE == 0) {
                v += p->in[I_XS][(size_t)rs * DM + c];
                *hp = v;
                ((bf16*)(p->ws + WS_HB))[(size_t)(MP + rs) * DM + c] = (bf16)(pk2(v, 0.f) & 0xffff);
                float s = v * v;
                s += shx(s, 1, lane); s += shx(s, 2, lane); s += shx(s, 4, lane); s += shx(s, 8, lane); s += shx(s, 16, lane);
                if (r == 0) atomicAdd((float*)(p->ws + WS_RSQH) + MP + rs, s);
            } else {
                *hp = *hp + v;
            }
        }
    }
    __syncthreads();
}

#define XB_TMO      128
#define XB_XCNT(j)  (256  + 64 * (j))
#define XB_XSUB(j)  (1280 + 64 * (j))
#define XB_XGEN(j)  (2304 + 64 * (j))
#define XB_TOP      3328
#define XB_TOPGEN   3392
#define XCD_BAR_WORDS 3456
#define XB_SPIN_CAP (1u << 18)

__device__ __forceinline__ unsigned xb_ld(unsigned* p)              { return __hip_atomic_load(p, __ATOMIC_RELAXED, __HIP_MEMORY_SCOPE_AGENT); }
__device__ __forceinline__ unsigned xb_add(unsigned* p, unsigned v) { return __hip_atomic_fetch_add(p, v, __ATOMIC_RELAXED, __HIP_MEMORY_SCOPE_AGENT); }
__device__ __forceinline__ unsigned xb_xcc_id() { return (unsigned)__builtin_amdgcn_s_getreg((3 << 11) | 20) & 0xFu; }
#define XB_SPIN(cond, bar) do { unsigned _sp = 0; while (cond) { __builtin_amdgcn_s_sleep(1); \
    if ((++_sp & 255u) == 0u) { if (xb_ld(&(bar)[XB_TMO])) break; if (_sp > XB_SPIN_CAP) { atomicAdd(&(bar)[XB_TMO], 1u); break; } } } } while (0)

struct XcdBarrier {
    unsigned* bar; unsigned x;
    volatile LAS unsigned* st;
};

__device__ __forceinline__ XcdBarrier xcd_barrier_post(unsigned* bar, volatile LAS unsigned* st) {
    XcdBarrier b; b.bar = bar; b.x = xb_xcc_id(); b.st = st;
    if (threadIdx.x == 0) (void)xb_add(&bar[XB_XCNT(b.x)], 1u);
    return b;
}
__device__ __forceinline__ void xcd_barrier_complete(unsigned* bar, unsigned x, unsigned& nloc, unsigned& nx) {
    const unsigned G = gridDim.x * gridDim.y * gridDim.z;
    unsigned sum, cnt, mine, sp = 0u;
    for (;;) {
        sum = 0u; cnt = 0u; mine = 0u;
#pragma unroll
        for (unsigned j = 0; j < 16; ++j) { const unsigned c = xb_ld(&bar[XB_XCNT(j)]); sum += c; cnt += (c > 0u) ? 1u : 0u; mine = (j == x) ? c : mine; }
        if (sum == G) break;
        __builtin_amdgcn_s_sleep(1);
        if ((++sp & 255u) == 0u) { if (xb_ld(&bar[XB_TMO])) break; if (sp > XB_SPIN_CAP) { atomicAdd(&bar[XB_TMO], 1u); break; } }
    }
    nloc = mine > 0u ? mine : 1u; nx = cnt > 0u ? cnt : 1u;
}

__device__ __forceinline__ void xcd_barrier(const XcdBarrier& b) {
    asm volatile("s_waitcnt vmcnt(0)" ::: "memory");
    __syncthreads();
    if (threadIdx.x == 0) {
        unsigned* bar = b.bar;
        __builtin_amdgcn_s_waitcnt(0);
        unsigned nloc = b.st[0], nx = b.st[1];
        if (nloc == 0u) { xcd_barrier_complete(bar, b.x, nloc, nx); b.st[0] = nloc; b.st[1] = nx; }
        const unsigned old = xb_add(&bar[XB_XSUB(b.x)], 1u);
        const unsigned gen = old / nloc;
        if (old + 1u == (gen + 1u) * nloc) {
            __builtin_amdgcn_fence(__ATOMIC_RELEASE, "agent");
            asm volatile("s_waitcnt vmcnt(0)" ::: "memory");
            const unsigned og = xb_add(&bar[XB_TOP], 1u);
            const unsigned tg = og / nx;
            if (og + 1u == (tg + 1u) * nx) xb_add(&bar[XB_TOPGEN], 1u);
            else XB_SPIN(xb_ld(&bar[XB_TOPGEN]) == tg, bar);
            __builtin_amdgcn_fence(__ATOMIC_ACQUIRE, "agent");
            xb_add(&bar[XB_XGEN(b.x)], 1u);
            asm volatile("s_waitcnt vmcnt(0)" ::: "memory");
        } else {
            XB_SPIN(xb_ld(&bar[XB_XGEN(b.x)]) == gen, bar);
            __builtin_amdgcn_fence(__ATOMIC_ACQUIRE, "agent");
            asm volatile("s_waitcnt vmcnt(0)" ::: "memory");
        }
    }
    __syncthreads();
}

#ifndef REP_P0
#define REP_P0 1
#endif
#ifndef REP_P1
#define REP_P1 1
#endif
#ifndef REP_P4
#define REP_P4 1
#endif
#ifndef REP_SYNC
#define REP_SYNC 0
#endif
#ifndef PROBE_P3
#define PROBE_P3 0
#endif
#ifndef PROBE_P5
#define PROBE_P5 0
#endif
#ifndef PROBE_P6
#define PROBE_P6 0
#endif
#ifndef STAMP_A
#define STAMP_A -1
#define STAMP_B -1
#endif
#ifndef STAMP_MULT
#define STAMP_MULT 4
#endif
#ifndef REP_ALL
#define REP_ALL 1
#endif
#ifndef REP_P2
#define REP_P2 1
#endif
#ifndef REP_P2B
#define REP_P2B 1
#endif
__device__ __forceinline__ void fwd_body(LAS unsigned char* lds, const XcdBarrier& bar);
__global__ void __launch_bounds__(NTHR, 2) fwd_megakernel(Params p_unused) {
    extern __shared__ __attribute__((aligned(16))) unsigned char lds_[];
    cg::grid_group grid = cg::this_grid();
    LAS unsigned char* lds = (LAS unsigned char*)lds_;
    if (threadIdx.x < 2) ((LAS unsigned*)(lds + 131072))[threadIdx.x] = 0u;
    __syncthreads();
    XcdBarrier bar;
    { KP p = kargs(); unsigned char* ws = p->ws;
      if (ws == nullptr) grid.sync();
      bar = xcd_barrier_post(g_ctl, (volatile LAS unsigned*)(lds + 131072)); }
#define GRID_SYNC() xcd_barrier(bar)
    fwd_body(lds, bar);
    asm volatile("s_waitcnt vmcnt(0)" ::: "memory");
    __syncthreads();
    LAS unsigned* lf = (LAS unsigned*)(lds + 131072 + 16);
    if (threadIdx.x == 0) { const unsigned old = atomicAdd(&g_ctl[CW_DONE], 1u); *lf = (old + 1u == gridDim.x) ? 1u : 0u; }
    __syncthreads();
    if (*lf) { for (int i = threadIdx.x; i < CTL_WORDS; i += NTHR) g_ctl[i] = 0u; }
}
__device__ __forceinline__ void fwd_body(LAS unsigned char* lds, const XcdBarrier& bar) {
    const int G = gridDim.x, bx = blockIdx.x;
#define STAMP(i) do { if (STAMP_A >= 0 && blockIdx.x == 0 && threadIdx.x == 0) ((LAS unsigned long long*)(lds + 131072 + 64))[i] = __builtin_amdgcn_s_memrealtime(); } while (0)
    STAMP(0);
#define PHASE_IDS int tid_ = threadIdx.x; asm volatile("" : "+v"(tid_)); const int tid = tid_, lane = tid & 63, wave = __builtin_amdgcn_readfirstlane(tid >> 6); (void)tid; (void)lane; (void)wave;

    for (int rep = 0; rep < REP_P0; ++rep) { PHASE_IDS KP p = kargs(); p0_prologue(p, lds, bx * NWAVES + wave, G * NWAVES, wave, lane); }
    GRID_SYNC();
    STAMP(1);

    for (int rep = 0; rep < REP_SYNC; ++rep) GRID_SYNC();
    for (int rep = 0; rep < REP_P1; ++rep) {
        KP p = kargs(); unsigned char* ws = p->ws;
        pg8::Gemm g{(const bf16*)(ws + WS_XN), (const bf16*)(ws + WS_WIN), MPAD, DIN, DM}; pg8::StaticOrder S; S.init(MPAD, DIN, G, bx);
        EpiIn E{ws, p->out};
        pg8::gemm_phase<EpiIn, pg8::StaticOrder, true, true>(lds, g, S, E);
        { PHASE_IDS int slot, ns; slack_slot((MPAD / 256) * (DIN / 256), G, bx, slot, ns);
          if (slot >= 0) convert_items(p, lds, CI_G, CI_WU, slot * NWAVES + wave, ns * NWAVES, wave, lane); }
    }
    GRID_SYNC();
    STAMP(2);

    {
        PHASE_IDS KP p = kargs();
        for (int i = tid; i < 2560; i += NTHR) ((LAS float*)lds)[i] = i < 2048 ? p->in[I_CONVW][i] : p->in[I_CONVB][i - 2048];
        __syncthreads();
        unsigned* cw = g_ctl;
        for (int u = bx; u < 1184; u += G) {
            int tl_ = threadIdx.x; asm volatile("" : "+v"(tl_)); const int tid = tl_, lane = tl_ & 63;
            if (u < 128) { sample_unit(p, u, lds, tid, wave, lane); asm volatile("s_waitcnt vmcnt(0)" ::: "memory"); __syncthreads(); if (tid == 0) atomicAdd(cw + CW_S1, 1u); }
            else if (u < 384) { const int k = u - 128; scan_unit<false>(p, k >> 5, k & 31, lds, wave, lane); asm volatile("s_waitcnt vmcnt(0)" ::: "memory"); __syncthreads(); if (tid == 0) atomicAdd(cw + CW_SCAN + 64 * (k >> 5), 1u); }
            else if (u < 896) { const int a = u - 384; attn_unit(p, a >> 6, a & 63, lds + 12288, wave, lane); }
            else if (u < 1152) { const int k = u - 896;
                if (tid == 0) { unsigned sp = 0; while (__hip_atomic_load(cw + CW_SCAN + 64 * (k >> 5), __ATOMIC_RELAXED, __HIP_MEMORY_SCOPE_AGENT) < 32u) { __builtin_amdgcn_s_sleep(4); if (++sp > (1u << 22)) break; } }
                __syncthreads(); __builtin_amdgcn_fence(__ATOMIC_ACQUIRE, "agent");
                scan_unit<true>(p, k >> 5, k & 31, lds, wave, lane); }
            else {
                if (tid == 0) { unsigned sp = 0; while (__hip_atomic_load(cw + CW_S1, __ATOMIC_RELAXED, __HIP_MEMORY_SCOPE_AGENT) < 128u) { __builtin_amdgcn_s_sleep(4); if (++sp > (1u << 22)) break; } }
                __syncthreads(); __builtin_amdgcn_fence(__ATOMIC_ACQUIRE, "agent");
                small_gemm_task<0>(p, (const bf16*)(p->ws + WS_MIX) + (size_t)MP * DM, (const bf16*)(p->ws + WS_WOUT), DM, 32 * (u - 1152), lds, wave, lane);
            }
        }
    }
    GRID_SYNC();
    STAMP(4);

    {
        KP p = kargs(); unsigned char* ws = p->ws;
        pg8::Gemm g{(const bf16*)(ws + WS_MIX), (const bf16*)(ws + WS_WOUT), MP, DM, DM}; pg8::StaticOrder S; S.init(MP, DM, G, bx);
        if (PROBE_P3) { EpiOut E0{p->in[I_XP], p->in[I_XS], (float*)(ws + 92 * MiB), ws + 128 * MiB}; pg8::gemm_phase<EpiOut, pg8::StaticOrder, true, true>(lds, g, S, E0); }
        EpiOut E{p->in[I_XP], p->in[I_XS], p->out, ws};
        pg8::gemm_phase<EpiOut, pg8::StaticOrder, true, true>(lds, g, S, E);
    }
    GRID_SYNC();
    STAMP(5);

    for (int rep = 0; rep < REP_P4; ++rep) {
        KP p = kargs(); unsigned char* ws = p->ws;
        pg8::Gemm g{(const bf16*)(ws + WS_HB), (const bf16*)(ws + WS_WGU), MPAD, 2 * DFF, DM}; pg8::StaticOrder S; S.init(MPAD, 2 * DFF, G, bx);
        EpiGU E{ws};
        pg8::gemm_phase<EpiGU, pg8::StaticOrder, true, true>(lds, g, S, E);
        { PHASE_IDS int slot, ns; slack_slot((MPAD / 256) * (2 * DFF / 256), G, bx, slot, ns);
          if (slot >= 0) { convert_items(p, lds, CI_WU, CI_WD, slot * NWAVES + wave, ns * NWAVES, wave, lane);
                           copy_windows(p, (slot * NWAVES + wave) * 64 + lane, ns * NWAVES * 64); } }
    }
    GRID_SYNC();
    STAMP(6);

    {
        KP p = kargs(); unsigned char* ws = p->ws;
        pg8::Gemm g{(const bf16*)(ws + WS_FF), (const bf16*)(ws + WS_WD), MP, DM, DFF}; pg8::StaticOrder S; S.init(MP, DM, G, bx);
        EpiDownFused E{ws, p->out, p->in[I_FNG]};
        pg8::gemm_phase<EpiDownFused, pg8::StaticOrder, false, true>(lds, g, S, E);
        { PHASE_IDS
          int ndone = 0;
          for (int u = bx; u < 32; u += G) { small_gemm_task<1>(p, (const bf16*)(ws + WS_FF) + (size_t)MP * DFF, (const bf16*)(ws + WS_WD), DFF, 32 * u, lds, wave, lane); ++ndone; }
          if (ndone) {
              __threadfence(); __syncthreads();
              LAS unsigned* flag = (LAS unsigned*)(lds + 8192);
              if (tid == 0) { const unsigned old = atomicAdd(g_ctl + CW_SAMPLE, (unsigned)ndone); *flag = (old + (unsigned)ndone == 32u) ? 1u : 0u; }
              __syncthreads();
              if (*flag) {
                  __builtin_amdgcn_fence(__ATOMIC_ACQUIRE, "agent");
                  const f32x4* g4 = (const f32x4*)p->in[I_FNG] + lane;
                  f32x4 gq[4];
#pragma unroll
                  for (int j = 0; j < 4; ++j) gq[j] = g4[64 * j];
                  for (int m0 = MP + wave; m0 < MR; m0 += 4 * NWAVES) {
                      f32x4 v[4][4];
#pragma unroll
                      for (int q = 0; q < 4; ++q) { const f32x4* yr = (const f32x4*)(p->out + (size_t)(m0 + q * NWAVES) * DM) + lane;
#pragma unroll
                          for (int j = 0; j < 4; ++j) v[q][j] = yr[64 * j]; }
#pragma unroll
                      for (int q = 0; q < 4; ++q) { float s = 0.f;
#pragma unroll
                          for (int j = 0; j < 4; ++j) s += (v[q][j].x * v[q][j].x + v[q][j].y * v[q][j].y) + (v[q][j].z * v[q][j].z + v[q][j].w * v[q][j].w);
                          const float rs = frsq(wave_sum(s, lane) * (1.f / DM) + EPS);
                          f32x4* yw = (f32x4*)(p->out + (size_t)(m0 + q * NWAVES) * DM) + lane;
#pragma unroll
                          for (int j = 0; j < 4; ++j) yw[64 * j] = v[q][j] * rs * gq[j]; }
                  }
              }
          }
        }
    }
    STAMP(7);
    STAMP(8);
    if (STAMP_A >= 0 && blockIdx.x == 0 && threadIdx.x == 0) {
        const LAS unsigned long long* ts = (const LAS unsigned long long*)(lds + 131072 + 64);
        const unsigned long long d = (ts[STAMP_B < 0 ? 0 : STAMP_B] - ts[STAMP_A < 0 ? 0 : STAMP_A]) * STAMP_MULT, t0 = __builtin_amdgcn_s_memrealtime();
        while (__builtin_amdgcn_s_memrealtime() - t0 < d) __builtin_amdgcn_s_sleep(16);
    }
}

extern "C" void kernel_launch(void* const* d_in, const int* in_sizes, int n_in, void* d_out, int out_size, void* d_ws, size_t ws_size, hipStream_t stream) {
    static int grid = 0;
    if (grid == 0) {
        int dev = 0, cus = 0, per_cu = 0;
        hipGetDevice(&dev);
        hipDeviceGetAttribute(&cus, hipDeviceAttributeMultiprocessorCount, dev);
        hipFuncSetAttribute((const void*)fwd_megakernel, hipFuncAttributeMaxDynamicSharedMemorySize, LDS_BYTES);
        hipOccupancyMaxActiveBlocksPerMultiprocessor(&per_cu, (const void*)fwd_megakernel, NTHR, LDS_BYTES);
        if (per_cu < 1) { fprintf(stderr, "kernel_launch: occupancy query says %d blocks/CU\n", per_cu); per_cu = 1; }
        (void)hipGetLastError();
        grid = cus;
        if (n_in != 24 || ws_size < WS_END || (size_t)out_size != OUT_END) fprintf(stderr, "kernel_launch: unexpected sizes n_in %d ws %zu out %d\n", n_in, ws_size, out_size);
    }
    Params p{};
    for (int i = 0; i < 24; ++i) p.in[i] = (const float*)d_in[i];
    p.out = (float*)d_out; p.ws = (unsigned char*)d_ws;
    void* args[] = {&p};
    hipError_t e = hipLaunchCooperativeKernel((const void*)fwd_megakernel, dim3(grid), dim3(NTHR), args, LDS_BYTES, stream);
    if (e != hipSuccess) fprintf(stderr, "cooperative launch failed: %s (grid %d)\n", hipGetErrorString(e), grid);
}
```

```cpp
#include <hip/hip_runtime.h>
#include <hip/hip_cooperative_groups.h>
#include <cstdio>
#include <cstdint>
namespace cg = cooperative_groups;
namespace pg8 {
#define PG8_LAS __attribute__((address_space(3)))
typedef unsigned short bf16_t;
typedef short bf16x8 __attribute__((ext_vector_type(8)));
typedef float f32x4 __attribute__((ext_vector_type(4)));
typedef unsigned u32x4 __attribute__((ext_vector_type(4)));
constexpr int BM = 256, BK = 64, HALF = 128, HTB = HALF * BK * 2  , STAGE_BYTES = 8 * HTB, NXCD = 8, WGM = 8;

__host__ __device__ __forceinline__ int lds_byte(int r, int c) { const int st = (r >> 4) * 2 + (c >> 5), rr = r & 15, cc = c & 31, ob = rr * 64 + cc * 2; return st * 1024 + (ob ^ (((ob >> 9) & 1) << 5)); }
__host__ __device__ __forceinline__ void stage_rc(int b, int& R, int& C) { const int st = b / 1024, sb = b % 1024, swz = sb ^ (((sb >> 9) & 1) << 5); R = (st >> 1) * 16 + swz / 64; C = (st & 1) * 32 + (swz % 64) / 2; }
__host__ __device__ __forceinline__ int perm32(int rho) { const int n = rho >> 4, i = rho & 15; return 8 * (i >> 2) + 4 * n + (i & 3); }

struct Unit { int pm, pn; };
struct Gemm { const bf16_t* A; const bf16_t* Bt; int M, N, K; };

struct StaticOrder {
    int nM, nN, nwg, G, c;
    __host__ __device__ void init(int M, int N, int G_, int c_) { nM = M / BM; nN = N / BM; nwg = nM * nN; G = G_; c = c_; }
    __host__ __device__ bool next(int i, Unit& u) const {
        const long L = (long)i * G + c; if (L >= nwg) return false;
        int wgid = (int)L; { const int q = nwg / NXCD, r = nwg % NXCD, xcd = wgid % NXCD, off = wgid / NXCD; wgid = (xcd < r ? xcd * (q + 1) : r * (q + 1) + (xcd - r) * q) + off; }
        const int nig = WGM * nN, gid = wgid / nig, fm = gid * WGM, gsz = (nM - fm) < WGM ? (nM - fm) : WGM;
        u.pm = fm + ((wgid % nig) % gsz); u.pn = (wgid % nig) / gsz; return true;
    }
    __device__ __forceinline__ void a_ready(const Unit&) const {}
    __device__ __forceinline__ void done(const Unit&) const {}
};

template <class Epi, class Sched, bool ALIGN_EPI = false, bool SP2 = false>
__device__ __forceinline__ void gemm_phase(PG8_LAS unsigned char* lds, const Gemm g, const Sched& S, const Epi& E) {
    int tid_ = threadIdx.x; asm volatile("" : "+v"(tid_));
    const int tid = tid_, wid = __builtin_amdgcn_readfirstlane(tid >> 6), lane = tid & 63, wr = wid >> 2, wc = wid & 3, fr = lane & 15, fq = lane >> 4;
    const int K = g.K, nt = K / BK;
    unsigned voffA[2], voffB[2];
#pragma unroll
    for (int i = 0; i < 2; ++i) { int R, C; stage_rc(tid * 16 + i * 8192, R, C); const int Rb = Epi::PERM ? ((R & ~31) + perm32(R & 31)) : R;
        voffA[i] = (unsigned)(R * K + C) * 2u; voffB[i] = (unsigned)(Rb * K + C) * 2u; }
    const size_t kstep = (size_t)(BK * 2);
    const size_t hstep = (size_t)HALF * K * 2;
    const size_t tstep = 2 * hstep;
    const unsigned ldsw = (unsigned)wid * 1024u;
    const int aoff = lds_byte(wr * 64 + fr, fq * 8), boff = lds_byte(wc * 32 + fr, fq * 8);
#define PG8_SA(b, h) (((b) * 2 + (h)) * HTB)
#define PG8_SB(b, h) ((4 + (b) * 2 + (h)) * HTB)
#define PG8_STAGE(bufoff, gbase, voff) do { _Pragma("unroll") for (int _i = 0; _i < 2; ++_i) \
        __builtin_amdgcn_global_load_lds((const unsigned*)((const char*)(gbase) + (voff)[_i]), (PG8_LAS unsigned*)(lds + (bufoff) + ldsw + _i * 8192), 16, 0, 0); } while (0)
#define PG8_LDA(dst, b, h) do { _Pragma("unroll") for (int m = 0; m < 4; ++m) _Pragma("unroll") for (int k = 0; k < 2; ++k) dst[m][k] = *(const PG8_LAS bf16x8*)(lds + PG8_SA(b, h) + aoff + m * 2048 + k * 1024); } while (0)
#define PG8_LDB(dst, b, h) do { _Pragma("unroll") for (int n = 0; n < 2; ++n) _Pragma("unroll") for (int k = 0; k < 2; ++k) dst[n][k] = *(const PG8_LAS bf16x8*)(lds + PG8_SB(b, h) + boff + n * 2048 + k * 1024); } while (0)
#define PG8_MMA(ai, bj, At, Bt) do { __builtin_amdgcn_s_setprio(1); _Pragma("unroll") for (int m = 0; m < 4; ++m) _Pragma("unroll") for (int n = 0; n < 2; ++n) _Pragma("unroll") for (int k = 0; k < 2; ++k) \
        acc[ai][bj][m][n] = __builtin_amdgcn_mfma_f32_16x16x32_bf16(Bt[n][k], At[m][k], acc[ai][bj][m][n], 0, 0, 0); __builtin_amdgcn_s_setprio(0); } while (0)
#define PG8_WAIT_V(n) asm volatile("s_waitcnt vmcnt(" #n ")" ::: "memory")
#define PG8_WAIT_L(n) asm volatile("s_waitcnt lgkmcnt(" #n ")" ::: "memory")
#define PG8_BAR __builtin_amdgcn_s_barrier()
#define PG8_SCHED __builtin_amdgcn_sched_barrier(0)
    Unit cur, nxt; int ui = 0;
    if (!S.next(0, cur)) return;
    f32x4 acc[2][2][4][2];
#pragma unroll
    for (int a = 0; a < 2; ++a)
#pragma unroll
        for (int b = 0; b < 2; ++b)
#pragma unroll
            for (int m = 0; m < 4; ++m)
#pragma unroll
                for (int n = 0; n < 2; ++n) acc[a][b][m][n] = (f32x4){0.f, 0.f, 0.f, 0.f};
    bf16x8 At[4][2], B0[2][2], B1[2][2];
    const char* cA = (const char*)g.A + (size_t)cur.pm * tstep; const char* cB = (const char*)g.Bt + (size_t)cur.pn * tstep;
    S.a_ready(cur);
    if constexpr (SP2) {
        PG8_STAGE(PG8_SB(0, 0), cB, voffB); PG8_STAGE(PG8_SB(0, 1), cB + hstep, voffB); PG8_STAGE(PG8_SA(0, 0), cA, voffA); PG8_STAGE(PG8_SA(0, 1), cA + hstep, voffA);
        if (wr == 1) PG8_BAR;
        PG8_WAIT_V(2); PG8_BAR;
        PG8_STAGE(PG8_SB(1, 0), cB + kstep, voffB); PG8_STAGE(PG8_SA(1, 0), cA + kstep, voffA); PG8_STAGE(PG8_SB(1, 1), cB + hstep + kstep, voffB);
        PG8_WAIT_V(6); PG8_BAR;
    } else {
        PG8_STAGE(PG8_SB(0, 0), cB, voffB); PG8_STAGE(PG8_SA(0, 0), cA, voffA); PG8_STAGE(PG8_SB(0, 1), cB + hstep, voffB); PG8_STAGE(PG8_SA(0, 1), cA + hstep, voffA);
        if (wr == 1) PG8_BAR;
        PG8_WAIT_V(4); PG8_BAR;
        PG8_STAGE(PG8_SB(1, 0), cB + kstep, voffB); PG8_STAGE(PG8_SA(1, 0), cA + kstep, voffA); PG8_STAGE(PG8_SB(1, 1), cB + hstep + kstep, voffB);
        PG8_WAIT_V(6); PG8_BAR;
    }
    for (;;) {
        const bool has_next = S.next(ui + 1, nxt);
        const char* nA = has_next ? (const char*)g.A + (size_t)nxt.pm * tstep : cA; const char* nB = has_next ? (const char*)g.Bt + (size_t)nxt.pn * tstep : cB;
        for (int t = 0; t < nt; t += 2) {
            const bool last = (t == nt - 2);
            const char* a1 = cA + (size_t)(t + 1) * kstep;
            const char* a2 = last ? nA : cA + (size_t)(t + 2) * kstep; const char* b2 = last ? nB : cB + (size_t)(t + 2) * kstep;
            const char* a3 = a2 + kstep; const char* b3 = b2 + kstep;
            if (last && has_next) S.a_ready(nxt);
            if constexpr (SP2) {
            PG8_LDB(B0, 0, 0); PG8_LDB(B1, 0, 1); PG8_SCHED; PG8_LDA(At, 0, 0); PG8_STAGE(PG8_SA(1, 1), a1 + hstep, voffA);
            PG8_WAIT_V(8); PG8_WAIT_L(0); PG8_BAR; PG8_MMA(0, 0, At, B0); PG8_MMA(0, 1, At, B1); PG8_BAR; PG8_SCHED;
            PG8_LDA(At, 0, 1); PG8_STAGE(PG8_SB(0, 0), b2, voffB); PG8_STAGE(PG8_SB(0, 1), b2 + hstep, voffB); PG8_STAGE(PG8_SA(0, 0), a2, voffA);
            PG8_WAIT_V(8); PG8_WAIT_L(0); PG8_BAR; PG8_MMA(1, 0, At, B0); PG8_MMA(1, 1, At, B1); PG8_BAR; PG8_SCHED;
            PG8_LDB(B0, 1, 0); PG8_LDB(B1, 1, 1); PG8_SCHED; PG8_LDA(At, 1, 0); PG8_STAGE(PG8_SA(0, 1), a2 + hstep, voffA);
            PG8_WAIT_V(8); PG8_WAIT_L(0); PG8_BAR; PG8_MMA(0, 0, At, B0); PG8_MMA(0, 1, At, B1); PG8_BAR; PG8_SCHED;
            PG8_LDA(At, 1, 1); PG8_STAGE(PG8_SB(1, 0), b3, voffB); PG8_STAGE(PG8_SB(1, 1), b3 + hstep, voffB); PG8_STAGE(PG8_SA(1, 0), a3, voffA);
            PG8_WAIT_V(8); PG8_WAIT_L(0); PG8_BAR; PG8_MMA(1, 0, At, B0); PG8_MMA(1, 1, At, B1); PG8_BAR; PG8_SCHED;
            } else {
            PG8_LDB(B0, 0, 0); PG8_SCHED; PG8_LDA(At, 0, 0); PG8_STAGE(PG8_SA(1, 1), a1 + hstep, voffA);
            PG8_WAIT_L(8); PG8_BAR; PG8_WAIT_L(0); PG8_MMA(0, 0, At, B0); PG8_BAR; PG8_SCHED;
            PG8_LDB(B1, 0, 1); PG8_STAGE(PG8_SB(0, 0), b2, voffB);
            PG8_BAR; PG8_WAIT_L(0); PG8_MMA(0, 1, At, B1); PG8_BAR;
            PG8_LDA(At, 0, 1); PG8_STAGE(PG8_SA(0, 0), a2, voffA);
            PG8_BAR; PG8_WAIT_L(0); PG8_MMA(1, 0, At, B0); PG8_BAR; PG8_SCHED;
            PG8_STAGE(PG8_SB(0, 1), b2 + hstep, voffB);
            PG8_WAIT_V(6); PG8_BAR; PG8_MMA(1, 1, At, B1); PG8_BAR;
            PG8_LDB(B0, 1, 0); PG8_SCHED; PG8_LDA(At, 1, 0); PG8_STAGE(PG8_SA(0, 1), a2 + hstep, voffA);
            PG8_WAIT_L(8); PG8_BAR; PG8_WAIT_L(0); PG8_MMA(0, 0, At, B0); PG8_BAR; PG8_SCHED;
            PG8_LDB(B1, 1, 1); PG8_STAGE(PG8_SB(1, 0), b3, voffB);
            PG8_BAR; PG8_WAIT_L(0); PG8_MMA(0, 1, At, B1); PG8_BAR;
            PG8_LDA(At, 1, 1); PG8_STAGE(PG8_SA(1, 0), a3, voffA);
            PG8_BAR; PG8_WAIT_L(0); PG8_MMA(1, 0, At, B0); PG8_BAR; PG8_SCHED;
            PG8_STAGE(PG8_SB(1, 1), b3 + hstep, voffB);
            PG8_WAIT_V(6); PG8_BAR; PG8_MMA(1, 1, At, B1); PG8_BAR;
            }
        }
        if constexpr (ALIGN_EPI) { if (wr == 0) PG8_BAR; }
        if constexpr (!Epi::AFTER_DRAIN) { E(acc, cur, wr, wc, fr, fq); S.done(cur); }
        if (!has_next) break;
#pragma unroll
        for (int a = 0; a < 2; ++a)
#pragma unroll
            for (int b = 0; b < 2; ++b)
#pragma unroll
                for (int m = 0; m < 4; ++m)
#pragma unroll
                    for (int n = 0; n < 2; ++n) acc[a][b][m][n] = (f32x4){0.f, 0.f, 0.f, 0.f};
        cur = nxt; cA = nA; cB = nB; ++ui;
        if constexpr (ALIGN_EPI) { if (wr == 1) PG8_BAR; }
    }
    PG8_WAIT_V(0);
    if constexpr (!ALIGN_EPI) { if (wr == 0) PG8_BAR; }
    PG8_BAR;
    if constexpr (Epi::AFTER_DRAIN) { E.fused(acc, cur, wr, wc, fr, fq, lds, wid, lane); S.done(cur); }
#undef PG8_SA
#undef PG8_SB
#undef PG8_STAGE
#undef PG8_LDA
#undef PG8_LDB
#undef PG8_MMA
#undef PG8_WAIT_V
#undef PG8_WAIT_L
#undef PG8_BAR
#undef PG8_SCHED
}
}

#define LAS __attribute__((address_space(3)))
typedef unsigned short bf16;
typedef short bf16x8 __attribute__((ext_vector_type(8)));
typedef float f32x4 __attribute__((ext_vector_type(4)));
typedef float f32x16 __attribute__((ext_vector_type(16)));
typedef unsigned u32x4 __attribute__((ext_vector_type(4)));
typedef unsigned u32x2 __attribute__((ext_vector_type(2)));
typedef float f32x2_t __attribute__((ext_vector_type(2)));
typedef __bf16 bf16x2_t __attribute__((ext_vector_type(2)));

constexpr int DM = 1024, TSEQ = 2048, NB = 8, MP = NB * TSEQ  , NS = 128  , MR = MP + NS  , MPAD = 16640  ;
constexpr int DREC = 512, DATT = 512, DKV = 128, DFF = 2816, DIN = 1792;
constexpr float EPS = 1e-6f;
constexpr int NWAVES = 8, NTHR = 512;
constexpr size_t OFF_Y = 0, OFF_PK = (size_t)MR * DM, OFF_PV = OFF_PK + 131072, OFF_PCONV = OFF_PV + 131072, OFF_PH = OFF_PCONV + 12288,
                 OFF_SK = OFF_PH + 4096, OFF_SV = OFF_SK + 2097152, OFF_SCONV = OFF_SV + 2097152, OFF_SH = OFF_SCONV + 196608, OUT_END = OFF_SH + 65536;
constexpr size_t MiB = 1u << 20;
constexpr int CTL_WORDS = 10240, CW_DONE = CTL_WORDS - 1;
__device__ unsigned g_ctl[CTL_WORDS];
constexpr size_t WS_RSI = 128 * 1024;
constexpr size_t WS_RSQH = 0, WS_SUMA = 1 * MiB, WS_SUMH = 1 * MiB + 512 * 1024;
constexpr size_t WS_WIN = 2 * MiB, WS_WOUT = 6 * MiB, WS_WGU = 8 * MiB, WS_WD = 19 * MiB, WS_GWT = 25 * MiB;
constexpr size_t WS_MIX = 26 * MiB, WS_HB = 59 * MiB, WS_FF = 92 * MiB;
constexpr size_t WS_XN = 92 * MiB, WS_XR = 125 * MiB, WS_GR = 142 * MiB, WS_Q = 159 * MiB, WS_KB = 176 * MiB, WS_VT = 181 * MiB, WS_END = 250 * MiB;
static_assert(WS_MIX + (size_t)MPAD * DM * 2 <= WS_HB && WS_HB + (size_t)MPAD * DM * 2 <= WS_FF && WS_FF + (size_t)MPAD * DFF * 2 <= WS_END, "ws map");
static_assert(WS_GR - WS_XR == WS_Q - WS_GR, "xr/gr/q equally spaced");
static_assert(WS_XN + (size_t)MPAD * DM * 2 <= WS_XR && WS_XR + (size_t)MPAD * 512 * 2 <= WS_GR && WS_GR + (size_t)MPAD * 512 * 2 <= WS_Q && WS_Q + (size_t)MPAD * 512 * 2 <= WS_KB && WS_KB + (size_t)MPAD * 128 * 2 <= WS_VT, "ws map 2");
constexpr int LDS_BYTES = 132096;

struct Params {
    const float* in[24];
    float* out; unsigned char* ws;
};
typedef const __attribute__((address_space(4))) Params* KP;
__device__ __forceinline__ KP kargs() { KP q = (KP)__builtin_amdgcn_kernarg_segment_ptr(); asm volatile("" : "+s"(q)); return q; }
enum { I_XP = 0, I_XS, I_CK, I_CV, I_SCONV, I_SH, I_N1G, I_WIN, I_CONVW, I_CONVB, I_GAW, I_GAB, I_GXW, I_GXB, I_LAM, I_SINK, I_RNG, I_ANG, I_WOUT, I_N2G, I_WG, I_WU, I_WD, I_FNG };

__device__ __forceinline__ unsigned pk2(float lo, float hi) { f32x2_t v = {lo, hi}; bf16x2_t b = __builtin_convertvector(v, bf16x2_t); return __builtin_bit_cast(unsigned, b); }
__device__ __forceinline__ float bflo(unsigned w) { return __uint_as_float(w << 16); }
__device__ __forceinline__ float bfhi(unsigned w) { return __uint_as_float(w & 0xffff0000u); }
__device__ __forceinline__ float bf1(bf16 u) { return __uint_as_float((unsigned)u << 16); }
__device__ __forceinline__ float shx(float v, int o, int lane) { return __int_as_float(__builtin_amdgcn_ds_bpermute((lane ^ o) << 2, __float_as_int(v))); }
__device__ __forceinline__ float shl(float v, int src) { return __int_as_float(__builtin_amdgcn_ds_bpermute(src << 2, __float_as_int(v))); }
__device__ __forceinline__ float wave_sum(float v, int lane) {
#pragma unroll
    for (int o = 1; o < 64; o <<= 1) v += shx(v, o, lane);
    return v;
}
__device__ __forceinline__ float wave_max(float v, int lane) {
#pragma unroll
    for (int o = 1; o < 64; o <<= 1) v = fmaxf(v, shx(v, o, lane));
    return v;
}
__device__ __forceinline__ float frcp(float x) { return __builtin_amdgcn_rcpf(x); }
__device__ __forceinline__ float fsqrt(float x) { return __builtin_amdgcn_sqrtf(x); }
__device__ __forceinline__ float frsq(float x) { return __builtin_amdgcn_rsqf(x); }
__device__ __forceinline__ float fexp(float x) { return __builtin_amdgcn_exp2f(x * 1.4426950408889634f); }
__device__ __forceinline__ float sigmoidf_(float x) { return frcp(1.0f + fexp(-x)); }
__device__ __forceinline__ float gelu_tanh(float x) { const float z = 0.7978845608028654f * (x + 0.044715f * x * x * x); const float e = fexp(2.0f * z); return x * (1.0f - frcp(e + 1.0f)); }

using pg8::Unit;
struct EpiIn {
    static constexpr bool PERM = true, AFTER_DRAIN = false;
    unsigned char* ws; float* out;
    __device__ __forceinline__ void operator()(const f32x4 (&acc)[2][2][4][2], const Unit& u, int wr, int wc, int fr, int fq) const {
        const int pn = u.pn;
        bf16* const KB = (bf16*)(ws + WS_KB); bf16* const VT = (bf16*)(ws + WS_VT);
#pragma unroll
        for (int ai = 0; ai < 2; ++ai)
#pragma unroll
            for (int m = 0; m < 4; ++m) {
                const int row = u.pm * 256 + ai * 128 + wr * 64 + m * 16 + fr;
                const bool isp = row < MP, iss = (row >= MP) && (row < MR);
                const int b = isp ? (row >> 11) : (row - MP), t = row & (TSEQ - 1);
#pragma unroll
                for (int bj = 0; bj < 2; ++bj) {
                    const int c = bj * 128 + wc * 32 + 8 * fq;
                    f32x4 v0 = acc[ai][bj][m][0], v1 = acc[ai][bj][m][1];
                    if (pn < 6) {
                        bf16* dst = (bf16*)(ws + WS_XR + (size_t)(pn >> 1) * (WS_GR - WS_XR));
                        const int col = (pn & 1) * 256 + c;
                        if (pn >= 4) { v0 = v0 * 0.125f; v1 = v1 * 0.125f; }
                        u32x4 w; w.x = pk2(v0[0], v0[1]); w.y = pk2(v0[2], v0[3]); w.z = pk2(v1[0], v1[1]); w.w = pk2(v1[2], v1[3]);
                        *(u32x4*)(dst + (size_t)row * 512 + col) = w;
                        if (pn < 2) {
                            float* o = nullptr;
                            if (isp && t >= TSEQ - 3) o = out + OFF_PCONV + (size_t)(b * 3 + (t - (TSEQ - 3))) * 512 + col;
                            if (iss) o = out + OFF_SCONV + (size_t)(b * 3 + 2) * 512 + col;
                            if (o) { *(f32x4*)o = v0; *(f32x4*)(o + 4) = v1; }
                        }
                    } else {
                        const int cc = wc * 32 + 8 * fq;
                        if (bj == 0) {
                            u32x4 w; w.x = pk2(v0[0], v0[1]); w.y = pk2(v0[2], v0[3]); w.z = pk2(v1[0], v1[1]); w.w = pk2(v1[2], v1[3]);
                            *(u32x4*)(KB + (size_t)row * 128 + cc) = w;
                        } else if (isp) {
                            const int kvh = cc >> 6, d0 = cc & 63;
                            bf16* vt = VT + ((size_t)(b * 2 + kvh) * 64 + d0) * TSEQ + t;
                            const unsigned w0 = pk2(v0[0], v0[1]), w1 = pk2(v0[2], v0[3]), w2 = pk2(v1[0], v1[1]), w3 = pk2(v1[2], v1[3]);
                            vt[0 * TSEQ] = (bf16)(w0 & 0xffff); vt[1 * TSEQ] = (bf16)(w0 >> 16); vt[2 * TSEQ] = (bf16)(w1 & 0xffff); vt[3 * TSEQ] = (bf16)(w1 >> 16);
                            vt[4 * TSEQ] = (bf16)(w2 & 0xffff); vt[5 * TSEQ] = (bf16)(w2 >> 16); vt[6 * TSEQ] = (bf16)(w3 & 0xffff); vt[7 * TSEQ] = (bf16)(w3 >> 16);
                        }
                        float* o = nullptr;
                        if (isp && t >= TSEQ - 128) o = out + (bj == 0 ? OFF_PK : OFF_PV) + (size_t)(b * 128 + (t - (TSEQ - 128))) * 128 + cc;
                        if (iss) o = out + (bj == 0 ? OFF_SK : OFF_SV) + (size_t)(b * 128 + 127) * 128 + cc;
                        if (o) { *(f32x4*)o = v0; *(f32x4*)(o + 4) = v1; }
                    }
                }
            }
    }
};
struct EpiOut {
    static constexpr bool PERM = false, AFTER_DRAIN = false;
    const float *xp, *xs; float* H; unsigned char* ws;
    __device__ __forceinline__ void operator()(const f32x4 (&acc)[2][2][4][2], const Unit& u, int wr, int wc, int fr, int fq) const {
        const int col0 = u.pn * 256 + wc * 32 + 4 * fq, lane = fr + 16 * fq;
        bf16* const HB = (bf16*)(ws + WS_HB); float* const rsq = (float*)(ws + WS_RSQH);
        const bf16* const XN = (const bf16*)(ws + WS_XN); const float* const rsi = (const float*)(ws + WS_RSI);
        f32x4 ig[2][2];
#pragma unroll
        for (int bj = 0; bj < 2; ++bj)
#pragma unroll
            for (int n = 0; n < 2; ++n) { const f32x4 g = *(const f32x4*)(xp + col0 + bj * 128 + n * 16); ig[bj][n] = (f32x4){frcp(g[0]), frcp(g[1]), frcp(g[2]), frcp(g[3])}; }
#pragma unroll
        for (int ai = 0; ai < 2; ++ai)
#pragma unroll
            for (int m = 0; m < 4; ++m) {
                const int row = u.pm * 256 + ai * 128 + wr * 64 + m * 16 + fr;
                const bool real = row < MR;
                const float ri = real ? rsi[row] : 0.f;
                float s = 0.f;
#pragma unroll
                for (int bj = 0; bj < 2; ++bj)
#pragma unroll
                    for (int n = 0; n < 2; ++n) {
                        const int c = col0 + bj * 128 + n * 16;
                        f32x4 v = acc[ai][bj][m][n];
                        if (real) { const u32x2 xb = __builtin_nontemporal_load((const u32x2*)(XN + (size_t)row * DM + c)); v = v + (f32x4){bflo(xb.x), bfhi(xb.x), bflo(xb.y), bfhi(xb.y)} * ig[bj][n] * ri; }
                        s += (v[0] * v[0] + v[1] * v[1]) + (v[2] * v[2] + v[3] * v[3]);
                        u32x2 w; w.x = pk2(v[0], v[1]); w.y = pk2(v[2], v[3]);
                        *(u32x2*)(HB + (size_t)row * DM + c) = w;
                    }
                s += shx(s, 16, lane); s += shx(s, 32, lane);
                if (fq == 0) atomicAdd(rsq + row, s);
            }
    }
};
struct EpiGU {
    static constexpr bool PERM = true, AFTER_DRAIN = false;
    unsigned char* ws;
    __device__ __forceinline__ void operator()(const f32x4 (&acc)[2][2][4][2], const Unit& u, int wr, int wc, int fr, int fq) const {
        const int col = u.pn * 128 + wc * 32 + 8 * fq;
        bf16* const FF = (bf16*)(ws + WS_FF); const float* const rsq = (const float*)(ws + WS_RSQH);
#pragma unroll
        for (int ai = 0; ai < 2; ++ai)
#pragma unroll
            for (int m = 0; m < 4; ++m) {
                const int row = u.pm * 256 + ai * 128 + wr * 64 + m * 16 + fr;
                const float r = frsq(rsq[row] * (1.0f / DM) + EPS);
                float o[8];
#pragma unroll
                for (int n = 0; n < 2; ++n)
#pragma unroll
                    for (int e = 0; e < 4; ++e) { const float g = acc[ai][0][m][n][e] * r, uu = acc[ai][1][m][n][e] * r; o[4 * n + e] = g * sigmoidf_(g) * uu; }
                u32x4 w; w.x = pk2(o[0], o[1]); w.y = pk2(o[2], o[3]); w.z = pk2(o[4], o[5]); w.w = pk2(o[6], o[7]);
                *(u32x4*)(FF + (size_t)row * DFF + col) = w;
            }
    }
};
struct EpiDown {
    static constexpr bool PERM = false, AFTER_DRAIN = false;
    float* H;
    __device__ __forceinline__ void operator()(const f32x4 (&acc)[2][2][4][2], const Unit& u, int wr, int wc, int fr, int fq) const {
        const int col0 = u.pn * 256 + wc * 32 + 4 * fq;
#pragma unroll
        for (int ai = 0; ai < 2; ++ai)
#pragma unroll
            for (int m = 0; m < 4; ++m) {
                const int row = u.pm * 256 + ai * 128 + wr * 64 + m * 16 + fr;
                if (row < MR) {
#pragma unroll
                    for (int bj = 0; bj < 2; ++bj)
#pragma unroll
                        for (int n = 0; n < 2; ++n) {
                            float* pp = H + (size_t)row * DM + col0 + bj * 128 + n * 16;
                            *(f32x4*)pp = *(const f32x4*)pp + acc[ai][bj][m][n];
                        }
                }
            }
    }
};

constexpr size_t WS_XBUF = 768 * 1024;
constexpr int CW_PANEL = 4096, CW_SAMPLE = 8192, CW_S1 = 8192 + 64, CW_SCAN = 8192 + 128;
struct EpiDownFused {
    static constexpr bool PERM = false, AFTER_DRAIN = true;
    unsigned char* ws; float* out; const float* gf;
    __device__ __forceinline__ void operator()(const f32x4 (&)[2][2][4][2], const Unit&, int, int, int, int) const {}
    __device__ __forceinline__ void fused(f32x4 (&acc)[2][2][4][2], const Unit& u, int wr, int wc, int fr, int fq, PG8_LAS unsigned char* lds, int wid, int lane) const {
        LAS float* P = (LAS float*)lds;
        LAS float* Sr = (LAS float*)(lds + 4096);
        const bf16* HB = (const bf16*)(ws + WS_HB);
        float* xbuf = (float*)(ws + WS_XBUF);
        unsigned* cnt = g_ctl + CW_PANEL + 64 * u.pm;
        const int col0 = u.pn * 256 + wc * 32 + 4 * fq;
#pragma unroll
        for (int ai = 0; ai < 2; ++ai)
#pragma unroll
            for (int m = 0; m < 4; ++m) {
                const int rl = ai * 128 + wr * 64 + m * 16 + fr; const size_t row = (size_t)u.pm * 256 + rl;
                float s = 0.f;
#pragma unroll
                for (int bj = 0; bj < 2; ++bj)
#pragma unroll
                    for (int n = 0; n < 2; ++n) {
                        const u32x2 hb = __builtin_nontemporal_load((const u32x2*)(HB + row * DM + col0 + bj * 128 + n * 16));
                        f32x4 v = acc[ai][bj][m][n];
                        v[0] += bflo(hb.x); v[1] += bfhi(hb.x); v[2] += bflo(hb.y); v[3] += bfhi(hb.y);
                        acc[ai][bj][m][n] = v;
                        s += (v[0] * v[0] + v[1] * v[1]) + (v[2] * v[2] + v[3] * v[3]);
                    }
                s += shx(s, 16, lane); s += shx(s, 32, lane);
                if (fq == 0) P[rl * 4 + wc] = s;
            }
        asm volatile("s_waitcnt lgkmcnt(0)" ::: "memory"); __builtin_amdgcn_s_barrier(); asm volatile("" ::: "memory");
        const int rr = wid * 32 + (lane & 31);
        if (lane < 32) {
            const float tot = (P[rr * 4 + 0] + P[rr * 4 + 1]) + (P[rr * 4 + 2] + P[rr * 4 + 3]);
            __hip_atomic_store(xbuf + ((size_t)u.pm * 256 + rr) * 4 + u.pn, tot, __ATOMIC_RELAXED, __HIP_MEMORY_SCOPE_AGENT);
        }
        asm volatile("s_waitcnt vmcnt(0)" ::: "memory");
        if (lane == 0) __hip_atomic_fetch_add(cnt, 1u, __ATOMIC_RELAXED, __HIP_MEMORY_SCOPE_AGENT);
        if (wid == 0) {
            unsigned sp = 0;
            while ((unsigned)__builtin_amdgcn_readfirstlane(__hip_atomic_load(cnt, __ATOMIC_RELAXED, __HIP_MEMORY_SCOPE_AGENT)) < 32u) { __builtin_amdgcn_s_sleep(2); if (++sp > (1u << 22)) break; }
            __builtin_amdgcn_fence(__ATOMIC_ACQUIRE, "agent");
        }
        asm volatile("s_waitcnt vmcnt(0) lgkmcnt(0)" ::: "memory"); __builtin_amdgcn_s_barrier(); asm volatile("" ::: "memory");
        if (lane < 32) {
            const float* sl = xbuf + ((size_t)u.pm * 256 + rr) * 4; float t = 0.f;
#pragma unroll
            for (int k = 0; k < 4; ++k) t += __hip_atomic_load(sl + k, __ATOMIC_RELAXED, __HIP_MEMORY_SCOPE_AGENT);
            Sr[rr] = frsq(t * (1.0f / DM) + EPS);
        }
        asm volatile("s_waitcnt vmcnt(0) lgkmcnt(0)" ::: "memory"); __builtin_amdgcn_s_barrier(); asm volatile("" ::: "memory");
        f32x4 gv[2][2];
#pragma unroll
        for (int bj = 0; bj < 2; ++bj)
#pragma unroll
            for (int n = 0; n < 2; ++n) gv[bj][n] = *(const f32x4*)(gf + col0 + bj * 128 + n * 16);
#pragma unroll
        for (int ai = 0; ai < 2; ++ai)
#pragma unroll
            for (int m = 0; m < 4; ++m) {
                const int rl = ai * 128 + wr * 64 + m * 16 + fr; const size_t row = (size_t)u.pm * 256 + rl;
                const float sc = Sr[rl];
#pragma unroll
                for (int bj = 0; bj < 2; ++bj)
#pragma unroll
                    for (int n = 0; n < 2; ++n) __builtin_nontemporal_store(acc[ai][bj][m][n] * sc * gv[bj][n], (f32x4*)(out + row * DM + col0 + bj * 128 + n * 16));
            }
    }
};

__device__ __forceinline__ void tr_item(const float* __restrict__ W, int N, bf16* WT, int ldt, int k0, int n0, int drow0, const float* __restrict__ kscale, LAS float* scr, int lane) {
    float wv[32];
#pragma unroll
    for (int i = 0; i < 32; ++i) wv[i] = __builtin_nontemporal_load(W + (size_t)(k0 + 2 * i + (lane >> 5)) * N + n0 + (lane & 31));
#pragma unroll
    for (int i = 0; i < 32; ++i) { const int kk = 2 * i + (lane >> 5); float v = wv[i]; if (kscale) v *= kscale[k0 + kk]; scr[kk * 33 + (lane & 31)] = v; }
    asm volatile("s_waitcnt lgkmcnt(0)" ::: "memory");
    const int c = lane & 7;
#pragma unroll
    for (int j = 0; j < 4; ++j) { const int n = (lane >> 3) + 8 * j; const LAS float* s = scr + (8 * c) * 33 + n;
        u32x4 o; o.x = pk2(s[0 * 33], s[1 * 33]); o.y = pk2(s[2 * 33], s[3 * 33]); o.z = pk2(s[4 * 33], s[5 * 33]); o.w = pk2(s[6 * 33], s[7 * 33]);
        *(u32x4*)(WT + (size_t)(drow0 + n) * ldt + k0 + 8 * c) = o; }
    asm volatile("s_waitcnt lgkmcnt(0)" ::: "memory");
}
constexpr int CI_WIN = 16 * 56, CI_G = CI_WIN + 32, CI_WOUT = CI_G + 16 * 32, CI_WU = CI_WOUT + 2 * 16 * 88, CI_WD = CI_WU + 44 * 32;
__device__ __forceinline__ void convert_items(KP p, LAS unsigned char* lds, int lo, int hi, int gw, int NGW, int wave, int lane) {
    unsigned char* ws = p->ws;
    LAS float* scr = (LAS float*)(lds + wave * 16384);
    for (int it = lo + gw; it < hi; it += NGW) {
        const float* W; const float* ks = nullptr; bf16* WT; int N, ldt, k0, n0, drow0; int r = it;
        if (r < CI_WIN) { const int kb = r / 56, nb = r % 56; W = p->in[I_WIN]; N = DIN; WT = (bf16*)(ws + WS_WIN); ldt = DM; k0 = 64 * kb; n0 = 32 * nb; drow0 = n0; }
        else if (r < CI_G) { r -= CI_WIN; const int gx = r >> 4, n = (r & 15) >> 1, nb = r & 1; W = p->in[gx ? I_GXW : I_GAW] + n * 4096; N = 64; WT = (bf16*)(ws + WS_GWT) + gx * 8 * 4096 + n * 4096; ldt = 64; k0 = 0; n0 = 32 * nb; drow0 = n0; }
        else if (r < CI_WOUT) { r -= CI_G; const int kb = r / 32, nb = r % 32; W = p->in[I_WOUT]; N = DM; WT = (bf16*)(ws + WS_WOUT); ldt = DM; k0 = 64 * kb; n0 = 32 * nb; drow0 = n0; }
        else if (r < CI_WU) { r -= CI_WOUT; const int up = r >= 16 * 88 ? 1 : 0; if (up) r -= 16 * 88; const int kb = r / 88, nb = r % 88; W = p->in[up ? I_WU : I_WG]; N = DFF; WT = (bf16*)(ws + WS_WGU); ldt = DM; k0 = 64 * kb; n0 = 32 * nb;
            drow0 = 256 * (n0 >> 7) + 128 * up + (n0 & 127); ks = p->in[I_N2G]; }
        else { r -= CI_WU; const int kb = r / 32, nb = r % 32; W = p->in[I_WD]; N = DM; WT = (bf16*)(ws + WS_WD); ldt = DFF; k0 = 64 * kb; n0 = 32 * nb; drow0 = n0; }
        tr_item(W, N, WT, ldt, k0, n0, drow0, ks, scr, lane);
    }
}
__device__ __forceinline__ void copy_windows(KP p, int gt, int NGT) {
    for (int i = gt; i < NS * 4064; i += NGT) { const int b = i / 4064, o = i % 4064;
        __builtin_nontemporal_store(__builtin_nontemporal_load((const f32x4*)(p->in[I_CK] + (size_t)b * 16384 + 128) + o), (f32x4*)(p->out + OFF_SK + (size_t)b * 16384) + o);
        __builtin_nontemporal_store(__builtin_nontemporal_load((const f32x4*)(p->in[I_CV] + (size_t)b * 16384 + 128) + o), (f32x4*)(p->out + OFF_SV + (size_t)b * 16384) + o); }
    for (int i = gt; i < NS * 256; i += NGT) { const int b = i >> 8, o = i & 255;
        ((f32x4*)(p->out + OFF_SCONV + (size_t)b * 1536))[o] = ((const f32x4*)(p->in[I_SCONV] + (size_t)b * 1536 + 512))[o]; }
}
__device__ __forceinline__ void slack_slot(int nwg, int G, int bx, int& slot, int& nslots) {
    const int mx = (nwg + G - 1) / G, first = nwg - (mx - 1) * G;
    if (first >= G) { slot = bx; nslots = G; } else { slot = bx - first; nslots = G - first; }
}
__device__ __forceinline__ void p0_prologue(KP p, LAS unsigned char* lds, int gw, int NGW, int wave, int lane) {
    unsigned char* ws = p->ws;
    convert_items(p, lds, 0, CI_G, gw, NGW, wave, lane);
    {
        const f32x4* g4 = (const f32x4*)p->in[I_N1G] + lane;
        f32x4 g[4];
#pragma unroll
        for (int j = 0; j < 4; ++j) g[j] = g4[64 * j];
        for (int m0 = gw; m0 < MR; m0 += 2 * NGW) {
            f32x4 v[2][4];
#pragma unroll
            for (int rr = 0; rr < 2; ++rr) { const int m = m0 + rr * NGW, mc = m < MR ? m : m0;
                const float* xrow = mc < MP ? p->in[I_XP] + (size_t)mc * DM : p->in[I_XS] + (size_t)(mc - MP) * DM;
                const f32x4* xr = (const f32x4*)xrow + lane;
#pragma unroll
                for (int j = 0; j < 4; ++j) v[rr][j] = __builtin_nontemporal_load(xr + 64 * j); }
#pragma unroll
            for (int rr = 0; rr < 2; ++rr) { const int m = m0 + rr * NGW;
                float s = 0.f;
#pragma unroll
                for (int j = 0; j < 4; ++j) s += (v[rr][j].x * v[rr][j].x + v[rr][j].y * v[rr][j].y) + (v[rr][j].z * v[rr][j].z + v[rr][j].w * v[rr][j].w);
                const float ms = wave_sum(s, lane) * (1.f / DM) + EPS, rs = frsq(ms);
                if (m < MR && lane == 0) ((float*)(ws + WS_RSI))[m] = fsqrt(ms);
                if (m < MR) { u32x2* o8 = (u32x2*)((bf16*)(ws + WS_XN) + (size_t)m * DM) + lane;
#pragma unroll
                    for (int j = 0; j < 4; ++j) { u32x2 w; w.x = pk2(v[rr][j].x * rs * g[j].x, v[rr][j].y * rs * g[j].y); w.y = pk2(v[rr][j].z * rs * g[j].z, v[rr][j].w * rs * g[j].w); o8[64 * j] = w; } }
            }
        }
    }
    const int gt = gw * 64 + lane, NGT = NGW * 64;
    for (int i = gt; i < MPAD; i += NGT) ((float*)(ws + WS_RSQH))[i] = 0.f;
}

__device__ __forceinline__ void row_scan4(float A, float H, float c0, int q, float& cin, float& At, float& Ht) {
    const auto ra = __builtin_amdgcn_permlane16_swap(__float_as_uint(A), __float_as_uint(A), false, false);
    const auto rh = __builtin_amdgcn_permlane16_swap(__float_as_uint(H), __float_as_uint(H), false, false);
    const float Ae = __uint_as_float(ra[0]), Ao = __uint_as_float(ra[1]), He = __uint_as_float(rh[0]), Ho = __uint_as_float(rh[1]);
    const float Ap = Ae * Ao, Hp = Ao * He + Ho;
    const auto pa = __builtin_amdgcn_permlane32_swap(__float_as_uint(Ap), __float_as_uint(Ap), false, false);
    const auto ph = __builtin_amdgcn_permlane32_swap(__float_as_uint(Hp), __float_as_uint(Hp), false, false);
    const float Alo = __uint_as_float(pa[0]), Ahi = __uint_as_float(pa[1]), Hlo = __uint_as_float(ph[0]), Hhi = __uint_as_float(ph[1]);
    const float c2 = Alo * c0 + Hlo, base = (q & 2) ? c2 : c0;
    cin = (q & 1) ? (Ae * base + He) : base;
    At = Alo * Ahi; Ht = Ahi * Hlo + Hhi;
}

constexpr int HS_OFF = 16384, HS_LD = 1032;
#define MFMA16(a, b, c) __builtin_amdgcn_mfma_f32_16x16x32_bf16((a), (b), (c), 0, 0, 0)
#define MFMA32(a, b, c) __builtin_amdgcn_mfma_f32_32x32x16_bf16((a), (b), (c), 0, 0, 0)
typedef float f32x2v __attribute__((ext_vector_type(2)));
constexpr size_t WS_AU = 186 * MiB;
template <bool FINAL>
__device__ __forceinline__ void scan_unit(KP p, int b, int chunk, LAS unsigned char* lds, int wave, int lane) {
    unsigned char* ws = p->ws;
    const bf16* XR = (const bf16*)(ws + WS_XR);
    const bf16* GWT = (const bf16*)(ws + WS_GWT);
    float* SA = (float*)(ws + WS_SUMA); float* SH = (float*)(ws + WS_SUMH);
    unsigned* AU = (unsigned*)(ws + WS_AU);
    const LAS float* cw = (const LAS float*)lds;
    const int n = wave, j = lane & 15, q = lane >> 4;
    float hprev[4] = {0.f, 0.f, 0.f, 0.f}, acum[4] = {1.f, 1.f, 1.f, 1.f};
    const size_t au0 = ((size_t)b * TSEQ + chunk * 64 + 4 * q) * 512 + 64 * n + j;
    if constexpr (FINAL) {
        unsigned pfg; { const int t_ = wave * 64 + lane; pfg = *(const unsigned*)((const bf16*)(ws + WS_GR) + ((size_t)b * TSEQ + chunk * 64 + (t_ >> 3)) * 512 + (t_ & 7) * 64); }
        unsigned au[4][4], aun[4][4];
#define SCAN_LOADAU(dst, sc_) do { _Pragma("unroll") for (int nt = 0; nt < 4; ++nt) _Pragma("unroll") for (int r = 0; r < 4; ++r) dst[nt][r] = __builtin_nontemporal_load(AU + au0 + (size_t)((sc_) * 16 + r) * 512 + 16 * nt); } while (0)
        SCAN_LOADAU(au, 0);
        {
            float As[4] = {1.f, 1.f, 1.f, 1.f}, Hs[4] = {0.f, 0.f, 0.f, 0.f};
            float la[8][4], lh[8][4];
#pragma unroll
            for (int cc = 0; cc < 8; ++cc) { const int c = 8 * q + cc, ce = c < chunk ? c : 0;
#pragma unroll
                for (int nt = 0; nt < 4; ++nt) { const size_t o = (size_t)(b * 32 + ce) * 512 + 64 * n + 16 * nt + j; la[cc][nt] = __hip_atomic_load(SA + o, __ATOMIC_RELAXED, __HIP_MEMORY_SCOPE_AGENT); lh[cc][nt] = __hip_atomic_load(SH + o, __ATOMIC_RELAXED, __HIP_MEMORY_SCOPE_AGENT); } }
#pragma unroll
            for (int cc = 0; cc < 8; ++cc) { const bool ok = (8 * q + cc) < chunk;
#pragma unroll
                for (int nt = 0; nt < 4; ++nt) { const float a = ok ? la[cc][nt] : 1.f, hh = ok ? lh[cc][nt] : 0.f; Hs[nt] = a * Hs[nt] + hh; As[nt] *= a; } }
#pragma unroll
            for (int nt = 0; nt < 4; ++nt) { float cin_, At_, Ht_; row_scan4(As[nt], Hs[nt], 0.f, q, cin_, At_, Ht_); hprev[nt] = Ht_; }
        }
#pragma unroll
        for (int sc = 0; sc < 4; ++sc) {
            if (sc < 3) SCAN_LOADAU(aun, sc + 1);
#pragma unroll
            for (int nt = 0; nt < 4; ++nt) {
                float a4[4], u4[4];
#pragma unroll
                for (int r = 0; r < 4; ++r) { a4[r] = 1.0f - bflo(au[nt][r]); u4[r] = bfhi(au[nt][r]); }
                const float A4 = (a4[0] * a4[1]) * (a4[2] * a4[3]);
                const float H4 = ((u4[0] * a4[1] + u4[1]) * a4[2] + u4[2]) * a4[3] + u4[3];
                float cin, At_, Ht_; row_scan4(A4, H4, hprev[nt], q, cin, At_, Ht_);
                hprev[nt] = At_ * hprev[nt] + Ht_;
                LAS bf16* hs = (LAS bf16*)(lds + HS_OFF + (sc * 16 + 4 * q) * HS_LD) + (64 * n + 16 * nt + j);
                float h = cin;
#pragma unroll
                for (int r = 0; r < 4; ++r) { h = a4[r] * h + u4[r]; hs[r * (HS_LD / 2)] = (bf16)(pk2(h, 0.f) & 0xffff); }
            }
#pragma unroll
            for (int nt = 0; nt < 4; ++nt)
#pragma unroll
                for (int r = 0; r < 4; ++r) au[nt][r] = aun[nt][r];
        }
#undef SCAN_LOADAU
        asm volatile("" :: "v"(pfg));
    } else {
    bf16x8 wf[2][4][2];
#pragma unroll
    for (int g = 0; g < 2; ++g)
#pragma unroll
        for (int nt = 0; nt < 4; ++nt)
#pragma unroll
            for (int s = 0; s < 2; ++s) wf[g][nt][s] = *(const bf16x8*)(GWT + ((size_t)(g * 8 + n) * 64 + 16 * nt + j) * 64 + 32 * s + 8 * q);
    bf16x8 idf[2];
#pragma unroll
    for (int e = 0; e < 2; ++e)
#pragma unroll
        for (int jj = 0; jj < 8; ++jj) idf[e][jj] = (16 * e + j - 8 * q == jj) ? (short)0x3F80 : (short)0;
    float ba[4], bx[4], sp[4];
#pragma unroll
    for (int nt = 0; nt < 4; ++nt) { const int ch = 64 * n + 16 * nt + j; ba[nt] = p->in[I_GAB][ch]; bx[nt] = p->in[I_GXB][ch]; sp[nt] = 8.0f * log1pf(__expf(-p->in[I_LAM][ch])) * 1.4426950408889634f; }
#define SCAN_LOADX(dst, sc_) do { const int tok_ = chunk * 64 + (sc_) * 16 + j; \
        _Pragma("unroll") for (int s = 0; s < 2; ++s) _Pragma("unroll") for (int w = 0; w < 4; ++w) { \
            const int tt = tok_ - 3 + w, ttc = tt < 0 ? 0 : tt; \
            u32x4 x = __builtin_nontemporal_load((const u32x4*)(XR + (size_t)(b * TSEQ + ttc) * 512 + 64 * n + 32 * s + 8 * q)); \
            if (tt < 0) x = (u32x4){0u, 0u, 0u, 0u}; dst[s][w] = x; } } while (0)
    u32x4 xcur[2][4], xnext[2][4];
    SCAN_LOADX(xcur, 0);
#pragma unroll
    for (int sc = 0; sc < 4; ++sc) {
        if (sc < 3) SCAN_LOADX(xnext, sc + 1);
        bf16x8 af[2];
#pragma unroll
        for (int s = 0; s < 2; ++s) {
            const int ch0 = 64 * n + 32 * s + 8 * q;
            float a8[8];
            { const f32x4 c0 = *(const LAS f32x4*)(cw + 2048 + ch0), c1 = *(const LAS f32x4*)(cw + 2048 + ch0 + 4);
              a8[0] = c0[0]; a8[1] = c0[1]; a8[2] = c0[2]; a8[3] = c0[3]; a8[4] = c1[0]; a8[5] = c1[1]; a8[6] = c1[2]; a8[7] = c1[3]; }
#pragma unroll
            for (int w = 0; w < 4; ++w) {
                const u32x4 x = xcur[s][w];
                const f32x4 w0 = *(const LAS f32x4*)(cw + w * 512 + ch0), w1 = *(const LAS f32x4*)(cw + w * 512 + ch0 + 4);
                a8[0] += w0[0] * bflo(x.x); a8[1] += w0[1] * bfhi(x.x); a8[2] += w0[2] * bflo(x.y); a8[3] += w0[3] * bfhi(x.y);
                a8[4] += w1[0] * bflo(x.z); a8[5] += w1[1] * bfhi(x.z); a8[6] += w1[2] * bflo(x.w); a8[7] += w1[3] * bfhi(x.w);
            }
            u32x4 pk; pk.x = pk2(a8[0], a8[1]); pk.y = pk2(a8[2], a8[3]); pk.z = pk2(a8[4], a8[5]); pk.w = pk2(a8[6], a8[7]);
            af[s] = __builtin_bit_cast(bf16x8, pk);
        }
#pragma unroll
        for (int nt = 0; nt < 4; ++nt) {
            f32x4 da = {0.f, 0.f, 0.f, 0.f}, dx = {0.f, 0.f, 0.f, 0.f}, xc = {0.f, 0.f, 0.f, 0.f};
            da = MFMA16(af[0], wf[0][nt][0], da); da = MFMA16(af[1], wf[0][nt][1], da);
            dx = MFMA16(af[0], wf[1][nt][0], dx); dx = MFMA16(af[1], wf[1][nt][1], dx);
            xc = MFMA16(af[nt >> 1], idf[nt & 1], xc);
            float a4[4], u4[4];
#pragma unroll
            for (int r = 0; r < 4; ++r) {
                const float ra = sigmoidf_(da[r] + ba[nt]), ix = sigmoidf_(dx[r] + bx[nt]);
                const float a = __builtin_amdgcn_exp2f(-ra * sp[nt]);
                a4[r] = a; u4[r] = fsqrt(fmaxf(1.0f - a * a, 0.f)) * ix * xc[r];
                AU[au0 + (size_t)(sc * 16 + r) * 512 + 16 * nt] = pk2(1.0f - a4[r], u4[r]);
            }
            const float A4 = (a4[0] * a4[1]) * (a4[2] * a4[3]);
            const float H4 = ((u4[0] * a4[1] + u4[1]) * a4[2] + u4[2]) * a4[3] + u4[3];
            float cin_, At_, Ht_; row_scan4(A4, H4, hprev[nt], q, cin_, At_, Ht_);
            hprev[nt] = At_ * hprev[nt] + Ht_; acum[nt] *= At_;
            asm volatile("" : "+v"(hprev[nt]), "+v"(acum[nt]));
        }
#pragma unroll
        for (int s = 0; s < 2; ++s)
#pragma unroll
            for (int w = 0; w < 4; ++w) xcur[s][w] = xnext[s][w];
    }
#undef SCAN_LOADX
    }
    if (!FINAL) {
        if (q == 0) {
#pragma unroll
            for (int nt = 0; nt < 4; ++nt) { const int ch = 64 * n + 16 * nt + j; const size_t o = (size_t)(b * 32 + chunk) * 512 + ch;
                __hip_atomic_store(SA + o, acum[nt], __ATOMIC_RELAXED, __HIP_MEMORY_SCOPE_AGENT); __hip_atomic_store(SH + o, hprev[nt], __ATOMIC_RELAXED, __HIP_MEMORY_SCOPE_AGENT); }
        }
    } else {
        if (chunk == 31 && q == 0) {
#pragma unroll
            for (int nt = 0; nt < 4; ++nt) p->out[OFF_PH + (size_t)b * 512 + 64 * n + 16 * nt + j] = hprev[nt];
        }
        __syncthreads();
        const bf16* GR = (const bf16*)(ws + WS_GR);
        bf16* MIX = (bf16*)(ws + WS_MIX);
        const f32x4 g0 = *(const f32x4*)(p->in[I_RNG] + 8 * lane), g1 = *(const f32x4*)(p->in[I_RNG] + 8 * lane + 4);
        u32x4 grv[8];
#pragma unroll
        for (int tt = 0; tt < 8; ++tt) grv[tt] = __builtin_nontemporal_load((const u32x4*)(GR + ((size_t)b * TSEQ + chunk * 64 + wave * 8 + tt) * 512 + 8 * lane));
#pragma unroll
        for (int tt = 0; tt < 8; ++tt) {
            const int tl = wave * 8 + tt;
            const size_t row = (size_t)b * TSEQ + chunk * 64 + tl;
            const LAS u32x2* hp = (const LAS u32x2*)(lds + HS_OFF + tl * HS_LD + 16 * lane);
            const u32x2 h0 = hp[0], h1 = hp[1];
            const u32x4 gr = grv[tt];
            float rc[8];
            rc[0] = bflo(h0.x) * gelu_tanh(bflo(gr.x)); rc[1] = bfhi(h0.x) * gelu_tanh(bfhi(gr.x)); rc[2] = bflo(h0.y) * gelu_tanh(bflo(gr.y)); rc[3] = bfhi(h0.y) * gelu_tanh(bfhi(gr.y));
            rc[4] = bflo(h1.x) * gelu_tanh(bflo(gr.z)); rc[5] = bfhi(h1.x) * gelu_tanh(bfhi(gr.z)); rc[6] = bflo(h1.y) * gelu_tanh(bflo(gr.w)); rc[7] = bfhi(h1.y) * gelu_tanh(bfhi(gr.w));
            float ss = 0.f;
#pragma unroll
            for (int e = 0; e < 8; ++e) ss += rc[e] * rc[e];
            const float rn = frsq(wave_sum(ss, lane) * (1.0f / DREC) + EPS);
            u32x4 w; w.x = pk2(rc[0] * rn * g0[0], rc[1] * rn * g0[1]); w.y = pk2(rc[2] * rn * g0[2], rc[3] * rn * g0[3]);
            w.z = pk2(rc[4] * rn * g1[0], rc[5] * rn * g1[1]); w.w = pk2(rc[6] * rn * g1[2], rc[7] * rn * g1[3]);
            *(u32x4*)(MIX + row * DM + 8 * lane) = w;
        }
        __syncthreads();
    }
}

constexpr int AT_KLD = 272, AT_VLD = 336, AT_OLD = 1040;
constexpr int AT_K = 0, AT_V = AT_K + 160 * AT_KLD, AT_RED = AT_V + 128 * AT_VLD, AT_END = AT_RED + 1024;
static_assert(32 * AT_OLD <= AT_V && 12288 + AT_END <= 131072, "attention LDS map");
__device__ __forceinline__ void attn_unit(KP p, int b, int qt, LAS unsigned char* lds, int wave, int lane) {
    unsigned char* ws = p->ws;
    const bf16* Q = (const bf16*)(ws + WS_Q); const bf16* KB = (const bf16*)(ws + WS_KB); const bf16* VT = (const bf16*)(ws + WS_VT);
    bf16* MIX = (bf16*)(ws + WS_MIX);
    LAS float* red = (LAS float*)(lds + AT_RED);
    const int r = lane & 31, h = lane >> 5, kvh = wave >> 2, q0 = qt * 32, tid = wave * 64 + lane;
    const size_t rowq = (size_t)b * TSEQ + q0 + r;
    __syncthreads();
    bf16x8 qf[4];
#pragma unroll
    for (int s = 0; s < 4; ++s) qf[s] = __builtin_nontemporal_load((const bf16x8*)(Q + rowq * 512 + wave * 64 + 16 * s + 8 * h));
    {
        u32x4 kv[5], vv[5];
#pragma unroll
        for (int i = 0; i < 5; ++i) { const int id = tid + 512 * i, row = id >> 4, c16 = id & 15; int g = q0 - 128 + row; g = g < 0 ? 0 : g;
            kv[i] = *(const u32x4*)(KB + ((size_t)b * TSEQ + g) * 128 + c16 * 8); }
#pragma unroll
        for (int i = 0; i < 5; ++i) { const int id = tid + 512 * i, row = id / 20, cc = id % 20; int k0 = q0 - 128 + 8 * cc; k0 = k0 < 0 ? 0 : k0;
            vv[i] = *(const u32x4*)(VT + ((size_t)b * 128 + row) * TSEQ + k0); }
#pragma unroll
        for (int i = 0; i < 5; ++i) { const int id = tid + 512 * i, row = id >> 4, c16 = id & 15; *(LAS u32x4*)(lds + AT_K + row * AT_KLD + c16 * 16) = kv[i]; }
#pragma unroll
        for (int i = 0; i < 5; ++i) { const int id = tid + 512 * i, row = id / 20, cc = id % 20; *(LAS u32x4*)(lds + AT_V + row * AT_VLD + cc * 16) = vv[i]; }
    }
    __syncthreads();
    const int pr = (r & ~12) | ((r & 4) << 1) | ((r & 8) >> 1);
    f32x16 S[5];
#pragma unroll
    for (int kt = 0; kt < 5; ++kt) {
#pragma unroll
        for (int i = 0; i < 16; ++i) S[kt][i] = 0.f;
#pragma unroll
        for (int s = 0; s < 4; ++s) {
            const bf16x8 kf = *(const LAS bf16x8*)(lds + AT_K + (32 * kt + pr) * AT_KLD + kvh * 128 + (16 * s + 8 * h) * 2);
            S[kt] = MFMA32(kf, qf[s], S[kt]);
        }
    }
    const float sink = p->in[I_SINK][wave];
    float m = sink;
#pragma unroll
    for (int kt = 0; kt < 5; ++kt) {
        const int kbase = q0 - 128 + 32 * kt;
#pragma unroll
        for (int i = 0; i < 16; ++i) {
            const int kl = 16 * (i >> 3) + 8 * h + (i & 7);
            bool valid = kbase >= 0;
            if (kt == 0) valid = valid && (kl >= r);
            if (kt == 4) valid = valid && (kl <= r);
            const float sv = valid ? S[kt][i] : -INFINITY;
            S[kt][i] = sv; m = fmaxf(m, sv);
        }
    }
    m = fmaxf(m, shx(m, 32, lane));
    float l = 0.f;
#pragma unroll
    for (int kt = 0; kt < 5; ++kt)
#pragma unroll
        for (int i = 0; i < 16; ++i) { const float pv = fexp(S[kt][i] - m); S[kt][i] = pv; l += pv; }
    l += shx(l, 32, lane);
    const float inv = frcp(l + fexp(sink - m));
    f32x16 O[2];
#pragma unroll
    for (int dt = 0; dt < 2; ++dt)
#pragma unroll
        for (int i = 0; i < 16; ++i) O[dt][i] = 0.f;
#pragma unroll
    for (int kt = 0; kt < 5; ++kt) {
#pragma unroll
        for (int s2 = 0; s2 < 2; ++s2) {
            u32x4 pk; pk.x = pk2(S[kt][8 * s2 + 0], S[kt][8 * s2 + 1]); pk.y = pk2(S[kt][8 * s2 + 2], S[kt][8 * s2 + 3]);
            pk.z = pk2(S[kt][8 * s2 + 4], S[kt][8 * s2 + 5]); pk.w = pk2(S[kt][8 * s2 + 6], S[kt][8 * s2 + 7]);
            const bf16x8 pb = __builtin_bit_cast(bf16x8, pk);
#pragma unroll
            for (int dt = 0; dt < 2; ++dt) {
                const bf16x8 vf = *(const LAS bf16x8*)(lds + AT_V + (kvh * 64 + 32 * dt + r) * AT_VLD + (32 * kt + 16 * s2 + 8 * h) * 2);
                O[dt] = MFMA32(vf, pb, O[dt]);
            }
        }
    }
    float ss = 0.f;
#pragma unroll
    for (int dt = 0; dt < 2; ++dt)
#pragma unroll
        for (int i = 0; i < 16; ++i) { O[dt][i] *= inv; ss += O[dt][i] * O[dt][i]; }
    ss += shx(ss, 32, lane);
    if (h == 0) red[wave * 32 + r] = ss;
    __syncthreads();
    float tot = 0.f;
#pragma unroll
    for (int w = 0; w < 8; ++w) tot += red[w * 32 + r];
    const float rn = frsq(tot * (1.0f / DATT) + EPS);
#pragma unroll
    for (int dt = 0; dt < 2; ++dt)
#pragma unroll
        for (int g4 = 0; g4 < 4; ++g4) {
            const int d = 32 * dt + 8 * g4 + 4 * h;
            const f32x4 gg = *(const f32x4*)(p->in[I_ANG] + wave * 64 + d);
            u32x2 w; w.x = pk2(O[dt][4 * g4 + 0] * rn * gg[0], O[dt][4 * g4 + 1] * rn * gg[1]); w.y = pk2(O[dt][4 * g4 + 2] * rn * gg[2], O[dt][4 * g4 + 3] * rn * gg[3]);
            *(LAS u32x2*)(lds + AT_K + r * AT_OLD + (wave * 64 + d) * 2) = w;
        }
    __syncthreads();
#pragma unroll
    for (int i = 0; i < 4; ++i) { const int id = tid + 512 * i, row = id >> 6, cc = id & 63;
        *(u32x4*)(MIX + ((size_t)b * TSEQ + q0 + row) * DM + 512 + cc * 8) = *(const LAS u32x4*)(lds + AT_K + row * AT_OLD + cc * 16); }
    __syncthreads();
}

__device__ __forceinline__ void sample_unit(KP p, int b, LAS unsigned char* lds, int tid, int wave, int lane) {
    unsigned char* ws = p->ws;
    const size_t row = (size_t)MP + b;
    bf16* MIX = (bf16*)(ws + WS_MIX);
    LAS float* xs = (LAS float*)(lds + 12288);
    LAS float* redw = (LAS float*)(lds + 12288 + 2048);
    LAS float* qs = (LAS float*)(lds + 12288 + 4096);
    LAS float* ps = (LAS float*)(lds + 12288 + 8192);
    __syncthreads();
    {
        const int c = tid;
        const float* sc = p->in[I_SCONV] + (size_t)b * 1536;
        const float* cwg = p->in[I_CONVW];
        const float xr = p->out[OFF_SCONV + (size_t)(b * 3 + 2) * 512 + c];
        const float xc = p->in[I_CONVB][c] + sc[c] * cwg[c] + sc[512 + c] * cwg[512 + c] + sc[1024 + c] * cwg[1024 + c] + xr * cwg[1536 + c];
        xs[c] = xc;
        __syncthreads();
        const int n = c >> 6, jj = c & 63;
        const float* wa = p->in[I_GAW] + n * 4096 + jj; const float* wx = p->in[I_GXW] + n * 4096 + jj;
        float ya = p->in[I_GAB][c], yx = p->in[I_GXB][c];
#pragma unroll
        for (int hb = 0; hb < 2; ++hb) {
            float wa_[32], wx_[32];
#pragma unroll
            for (int i = 0; i < 32; ++i) { wa_[i] = wa[(hb * 32 + i) * 64]; wx_[i] = wx[(hb * 32 + i) * 64]; }
#pragma unroll
            for (int i = 0; i < 32; ++i) { const float xv = xs[64 * n + hb * 32 + i]; ya += xv * wa_[i]; yx += xv * wx_[i]; }
        }
        const float ra = sigmoidf_(ya), ix = sigmoidf_(yx);
        const float la = -8.0f * ra * log1pf(__expf(-p->in[I_LAM][c]));
        const float a = __expf(la);
        const float u = fsqrt(fmaxf(1.0f - a * a, 0.f)) * ix * xc;
        const float hn = a * p->in[I_SH][(size_t)b * 512 + c] + u;
        p->out[OFF_SH + (size_t)b * 512 + c] = hn;
        const float gr = bf1(((const bf16*)(ws + WS_GR))[row * 512 + c]);
        const float rec = hn * gelu_tanh(gr);
        const float ssw = wave_sum(rec * rec, lane);
        if (lane == 0) redw[wave] = ssw;
        __syncthreads();
        float tot = 0.f;
#pragma unroll
        for (int w = 0; w < 8; ++w) tot += redw[w];
        const float rn = frsq(tot * (1.0f / DREC) + EPS);
        { const float mv = rec * rn * p->in[I_RNG][c], mo = shx(mv, 1, lane);
          if ((lane & 1) == 0) __hip_atomic_store((unsigned*)(MIX + row * DM + c), pk2(mv, mo), __ATOMIC_RELAXED, __HIP_MEMORY_SCOPE_AGENT); }
    }
    {
        const int kvh = wave >> 2;
        const float qd = bf1(((const bf16*)(ws + WS_Q))[row * 512 + wave * 64 + lane]);
        qs[wave * 64 + lane] = qd;
        const float* kself = p->out + OFF_SK + (size_t)(b * 128 + 127) * 128 + kvh * 64;
        const float* vself = p->out + OFF_SV + (size_t)(b * 128 + 127) * 128 + kvh * 64;
        const float sself = wave_sum(qd * kself[lane], lane);
        asm volatile("s_waitcnt lgkmcnt(0)" ::: "memory");
        const float* kc = p->in[I_CK] + (size_t)b * 16384 + kvh * 64;
        float s0 = 0.f, s1 = 0.f;
        const f32x4* k0 = (const f32x4*)(kc + (size_t)lane * 128);
        const f32x4* k1 = (const f32x4*)(kc + (size_t)(lane + 64) * 128);
        const LAS f32x4* q4 = (const LAS f32x4*)(qs + wave * 64);
        {
            f32x4 ka[16], kb2[16];
#pragma unroll
            for (int i = 0; i < 16; ++i) { ka[i] = k0[i]; kb2[i] = k1[i]; }
#pragma unroll
            for (int i = 0; i < 16; ++i) { const f32x4 qq = q4[i], a0 = ka[i], a1 = kb2[i];
                s0 += (qq[0] * a0[0] + qq[1] * a0[1]) + (qq[2] * a0[2] + qq[3] * a0[3]);
                s1 += (qq[0] * a1[0] + qq[1] * a1[1]) + (qq[2] * a1[2] + qq[3] * a1[3]); }
        }
        const float sink = p->in[I_SINK][wave];
        const float m = fmaxf(fmaxf(wave_max(fmaxf(s0, s1), lane), sself), sink);
        const float p0 = __expf(s0 - m), p1 = __expf(s1 - m), pself = __expf(sself - m);
        const float den = wave_sum(p0 + p1, lane) + pself + __expf(sink - m);
        ps[wave * 128 + lane] = p0; ps[wave * 128 + 64 + lane] = p1;
        asm volatile("s_waitcnt lgkmcnt(0)" ::: "memory");
        const int kg = lane >> 4, d4 = lane & 15;
        const float* vc = p->in[I_CV] + (size_t)b * 16384 + kvh * 64 + 4 * d4;
        f32x4 o4 = {0.f, 0.f, 0.f, 0.f};
#pragma unroll
        for (int hb = 0; hb < 2; ++hb) {
            f32x4 vv[16];
#pragma unroll
            for (int i = 0; i < 16; ++i) vv[i] = *(const f32x4*)(vc + (size_t)(kg + 4 * (hb * 16 + i)) * 128);
#pragma unroll
            for (int i = 0; i < 16; ++i) o4 = o4 + vv[i] * ps[wave * 128 + kg + 4 * (hb * 16 + i)];
        }
#pragma unroll
        for (int e = 0; e < 4; ++e) { o4[e] += shx(o4[e], 16, lane); o4[e] += shx(o4[e], 32, lane); }
        o4 = (o4 + *(const f32x4*)(vself + 4 * d4) * pself) * (1.0f / den);
        const float ssw = wave_sum((o4[0] * o4[0] + o4[1] * o4[1]) + (o4[2] * o4[2] + o4[3] * o4[3]), lane) * 0.25f;
        if (lane == 0) redw[8 + wave] = ssw;
        __syncthreads();
        float tot = 0.f;
#pragma unroll
        for (int w = 0; w < 8; ++w) tot += redw[8 + w];
        const float rn = frsq(tot * (1.0f / DATT) + EPS);
        if (kg == 0) { const f32x4 gg = *(const f32x4*)(p->in[I_ANG] + wave * 64 + 4 * d4);
            u32x2 w; w.x = pk2(o4[0] * rn * gg[0], o4[1] * rn * gg[1]); w.y = pk2(o4[2] * rn * gg[2], o4[3] * rn * gg[3]);
            unsigned* mp = (unsigned*)(MIX + row * DM + 512 + wave * 64 + 4 * d4);
            __hip_atomic_store(mp, w.x, __ATOMIC_RELAXED, __HIP_MEMORY_SCOPE_AGENT); __hip_atomic_store(mp + 1, w.y, __ATOMIC_RELAXED, __HIP_MEMORY_SCOPE_AGENT); }
    }
    __syncthreads();
}


template <int MODE>
__device__ __forceinline__ void small_gemm_task(KP p, const bf16* __restrict__ A, const bf16* __restrict__ Bt, int K, int n0, LAS unsigned char* lds, int wave, int lane) {
    const int r = lane & 31, h = lane >> 5, mt = wave & 3, kh = wave >> 2, Kh = K >> 1;
    const bf16* ap = A + (size_t)(32 * mt + r) * K + kh * Kh + 64 * h;
    const bf16* bp = Bt + (size_t)(n0 + r) * K + kh * Kh + 64 * h;
    f32x16 acc;
#pragma unroll
    for (int i = 0; i < 16; ++i) acc[i] = 0.f;
    bf16x8 a[8], b[8], an[8], bn[8];
#pragma unroll
    for (int i = 0; i < 8; ++i) { a[i] = *(const bf16x8*)(ap + 8 * i); b[i] = *(const bf16x8*)(bp + 8 * i); }
    for (int k = 0; k < Kh; k += 128) {
        const int kn = (k + 128 < Kh) ? k + 128 : k;
#pragma unroll
        for (int i = 0; i < 8; ++i) { an[i] = *(const bf16x8*)(ap + kn + 8 * i); bn[i] = *(const bf16x8*)(bp + kn + 8 * i); }
#pragma unroll
        for (int i = 0; i < 8; ++i) acc = MFMA32(a[i], b[i], acc);
#pragma unroll
        for (int i = 0; i < 8; ++i) { a[i] = an[i]; b[i] = bn[i]; }
    }
    LAS float* red = (LAS float*)lds;
    __syncthreads();
    if (kh == 1) {
#pragma unroll
        for (int i = 0; i < 16; ++i) red[(mt * 16 + i) * 64 + lane] = acc[i];
    }
    __syncthreads();
    if (kh == 0) {
        float* H = p->out; const int c = n0 + r;
#pragma unroll
        for (int i = 0; i < 16; ++i) {
            const int rs = 32 * mt + (i & 3) + 8 * (i >> 2) + 4 * h;
            float v = acc[i] + red[(mt * 16 + i) * 64 + lane];
            float* hp = H + (size_t)(MP + rs) * DM + c;
            if (MODE == 0) {
                v += p->in[I_XS][(size_t)rs * DM + c];
                *hp = v;
                ((bf16*)(p->ws + WS_HB))[(size_t)(MP + rs) * DM + c] = (bf16)(pk2(v, 0.f) & 0xffff);
                float s = v * v;
                s += shx(s, 1, lane); s += shx(s, 2, lane); s += shx(s, 4, lane); s += shx(s, 8, lane); s += shx(s, 16, lane);
                if (r == 0) atomicAdd((float*)(p->ws + WS_RSQH) + MP + rs, s);
            } else {
                *hp = *hp + v;
            }
        }
    }
    __syncthreads();
}

#define XB_TMO      128
#define XB_XCNT(j)  (256  + 64 * (j))
#define XB_XSUB(j)  (1280 + 64 * (j))
#define XB_XGEN(j)  (2304 + 64 * (j))
#define XB_TOP      3328
#define XB_TOPGEN   3392
#define XCD_BAR_WORDS 3456
#define XB_SPIN_CAP (1u << 18)

__device__ __forceinline__ unsigned xb_ld(unsigned* p)              { return __hip_atomic_load(p, __ATOMIC_RELAXED, __HIP_MEMORY_SCOPE_AGENT); }
__device__ __forceinline__ unsigned xb_add(unsigned* p, unsigned v) { return __hip_atomic_fetch_add(p, v, __ATOMIC_RELAXED, __HIP_MEMORY_SCOPE_AGENT); }
__device__ __forceinline__ unsigned xb_xcc_id() { return (unsigned)__builtin_amdgcn_s_getreg((3 << 11) | 20) & 0xFu; }
#define XB_SPIN(cond, bar) do { unsigned _sp = 0; while (cond) { __builtin_amdgcn_s_sleep(1); \
    if ((++_sp & 255u) == 0u) { if (xb_ld(&(bar)[XB_TMO])) break; if (_sp > XB_SPIN_CAP) { atomicAdd(&(bar)[XB_TMO], 1u); break; } } } } while (0)

struct XcdBarrier {
    unsigned* bar; unsigned x;
    volatile LAS unsigned* st;
};

__device__ __forceinline__ XcdBarrier xcd_barrier_post(unsigned* bar, volatile LAS unsigned* st) {
    XcdBarrier b; b.bar = bar; b.x = xb_xcc_id(); b.st = st;
    if (threadIdx.x == 0) (void)xb_add(&bar[XB_XCNT(b.x)], 1u);
    return b;
}
__device__ __forceinline__ void xcd_barrier_complete(unsigned* bar, unsigned x, unsigned& nloc, unsigned& nx) {
    const unsigned G = gridDim.x * gridDim.y * gridDim.z;
    unsigned sum, cnt, mine, sp = 0u;
    for (;;) {
        sum = 0u; cnt = 0u; mine = 0u;
#pragma unroll
        for (unsigned j = 0; j < 16; ++j) { const unsigned c = xb_ld(&bar[XB_XCNT(j)]); sum += c; cnt += (c > 0u) ? 1u : 0u; mine = (j == x) ? c : mine; }
        if (sum == G) break;
        __builtin_amdgcn_s_sleep(1);
        if ((++sp & 255u) == 0u) { if (xb_ld(&bar[XB_TMO])) break; if (sp > XB_SPIN_CAP) { atomicAdd(&bar[XB_TMO], 1u); break; } }
    }
    nloc = mine > 0u ? mine : 1u; nx = cnt > 0u ? cnt : 1u;
}

__device__ __forceinline__ void xcd_barrier(const XcdBarrier& b) {
    asm volatile("s_waitcnt vmcnt(0)" ::: "memory");
    __syncthreads();
    if (threadIdx.x == 0) {
        unsigned* bar = b.bar;
        __builtin_amdgcn_s_waitcnt(0);
        unsigned nloc = b.st[0], nx = b.st[1];
        if (nloc == 0u) { xcd_barrier_complete(bar, b.x, nloc, nx); b.st[0] = nloc; b.st[1] = nx; }
        const unsigned old = xb_add(&bar[XB_XSUB(b.x)], 1u);
        const unsigned gen = old / nloc;
        if (old + 1u == (gen + 1u) * nloc) {
            __builtin_amdgcn_fence(__ATOMIC_RELEASE, "agent");
            asm volatile("s_waitcnt vmcnt(0)" ::: "memory");
            const unsigned og = xb_add(&bar[XB_TOP], 1u);
            const unsigned tg = og / nx;
            if (og + 1u == (tg + 1u) * nx) xb_add(&bar[XB_TOPGEN], 1u);
            else XB_SPIN(xb_ld(&bar[XB_TOPGEN]) == tg, bar);
            __builtin_amdgcn_fence(__ATOMIC_ACQUIRE, "agent");
            xb_add(&bar[XB_XGEN(b.x)], 1u);
            asm volatile("s_waitcnt vmcnt(0)" ::: "memory");
        } else {
            XB_SPIN(xb_ld(&bar[XB_XGEN(b.x)]) == gen, bar);
            __builtin_amdgcn_fence(__ATOMIC_ACQUIRE, "agent");
            asm volatile("s_waitcnt vmcnt(0)" ::: "memory");
        }
    }
    __syncthreads();
}

#ifndef REP_P0
#define REP_P0 1
#endif
#ifndef REP_P1
#define REP_P1 1
#endif
#ifndef REP_P4
#define REP_P4 1
#endif
#ifndef REP_SYNC
#define REP_SYNC 0
#endif
#ifndef PROBE_P3
#define PROBE_P3 0
#endif
#ifndef PROBE_P5
#define PROBE_P5 0
#endif
#ifndef PROBE_P6
#define PROBE_P6 0
#endif
#ifndef STAMP_A
#define STAMP_A -1
#define STAMP_B -1
#endif
#ifndef STAMP_MULT
#define STAMP_MULT 4
#endif
#ifndef REP_ALL
#define REP_ALL 1
#endif
#ifndef REP_P2
#define REP_P2 1
#endif
#ifndef REP_P2B
#define REP_P2B 1
#endif
__device__ __forceinline__ void fwd_body(LAS unsigned char* lds, const XcdBarrier& bar);
__global__ void __launch_bounds__(NTHR, 2) fwd_megakernel(Params p_unused) {
    extern __shared__ __attribute__((aligned(16))) unsigned char lds_[];
    cg::grid_group grid = cg::this_grid();
    LAS unsigned char* lds = (LAS unsigned char*)lds_;
    if (threadIdx.x < 2) ((LAS unsigned*)(lds + 131072))[threadIdx.x] = 0u;
    __syncthreads();
    XcdBarrier bar;
    { KP p = kargs(); unsigned char* ws = p->ws;
      if (ws == nullptr) grid.sync();
      bar = xcd_barrier_post(g_ctl, (volatile LAS unsigned*)(lds + 131072)); }
#define GRID_SYNC() xcd_barrier(bar)
    fwd_body(lds, bar);
    asm volatile("s_waitcnt vmcnt(0)" ::: "memory");
    __syncthreads();
    LAS unsigned* lf = (LAS unsigned*)(lds + 131072 + 16);
    if (threadIdx.x == 0) { const unsigned old = atomicAdd(&g_ctl[CW_DONE], 1u); *lf = (old + 1u == gridDim.x) ? 1u : 0u; }
    __syncthreads();
    if (*lf) { for (int i = threadIdx.x; i < CTL_WORDS; i += NTHR) g_ctl[i] = 0u; }
}
__device__ __forceinline__ void fwd_body(LAS unsigned char* lds, const XcdBarrier& bar) {
    const int G = gridDim.x, bx = blockIdx.x;
#define STAMP(i) do { if (STAMP_A >= 0 && blockIdx.x == 0 && threadIdx.x == 0) ((LAS unsigned long long*)(lds + 131072 + 64))[i] = __builtin_amdgcn_s_memrealtime(); } while (0)
    STAMP(0);
#define PHASE_IDS int tid_ = threadIdx.x; asm volatile("" : "+v"(tid_)); const int tid = tid_, lane = tid & 63, wave = __builtin_amdgcn_readfirstlane(tid >> 6); (void)tid; (void)lane; (void)wave;

    for (int rep = 0; rep < REP_P0; ++rep) { PHASE_IDS KP p = kargs(); p0_prologue(p, lds, bx * NWAVES + wave, G * NWAVES, wave, lane); }
    GRID_SYNC();
    STAMP(1);

    for (int rep = 0; rep < REP_SYNC; ++rep) GRID_SYNC();
    for (int rep = 0; rep < REP_P1; ++rep) {
        KP p = kargs(); unsigned char* ws = p->ws;
        pg8::Gemm g{(const bf16*)(ws + WS_XN), (const bf16*)(ws + WS_WIN), MPAD, DIN, DM}; pg8::StaticOrder S; S.init(MPAD, DIN, G, bx);
        EpiIn E{ws, p->out};
        pg8::gemm_phase<EpiIn, pg8::StaticOrder, true, true>(lds, g, S, E);
        { PHASE_IDS int slot, ns; slack_slot((MPAD / 256) * (DIN / 256), G, bx, slot, ns);
          if (slot >= 0) convert_items(p, lds, CI_G, CI_WU, slot * NWAVES + wave, ns * NWAVES, wave, lane); }
    }
    GRID_SYNC();
    STAMP(2);

    {
        PHASE_IDS KP p = kargs();
        for (int i = tid; i < 2560; i += NTHR) ((LAS float*)lds)[i] = i < 2048 ? p->in[I_CONVW][i] : p->in[I_CONVB][i - 2048];
        __syncthreads();
        unsigned* cw = g_ctl;
        for (int u = bx; u < 1184; u += G) {
            int tl_ = threadIdx.x; asm volatile("" : "+v"(tl_)); const int tid = tl_, lane = tl_ & 63;
            if (u < 128) { sample_unit(p, u, lds, tid, wave, lane); asm volatile("s_waitcnt vmcnt(0)" ::: "memory"); __syncthreads(); if (tid == 0) atomicAdd(cw + CW_S1, 1u); }
            else if (u < 384) { const int k = u - 128; scan_unit<false>(p, k >> 5, k & 31, lds, wave, lane); asm volatile("s_waitcnt vmcnt(0)" ::: "memory"); __syncthreads(); if (tid == 0) atomicAdd(cw + CW_SCAN + 64 * (k >> 5), 1u); }
            else if (u < 896) { const int a = u - 384; attn_unit(p, a >> 6, a & 63, lds + 12288, wave, lane); }
            else if (u < 1152) { const int k = u - 896;
                if (tid == 0) { unsigned sp = 0; while (__hip_atomic_load(cw + CW_SCAN + 64 * (k >> 5), __ATOMIC_RELAXED, __HIP_MEMORY_SCOPE_AGENT) < 32u) { __builtin_amdgcn_s_sleep(4); if (++sp > (1u << 22)) break; } }
                __syncthreads(); __builtin_amdgcn_fence(__ATOMIC_ACQUIRE, "agent");
                scan_unit<true>(p, k >> 5, k & 31, lds, wave, lane); }
            else {
                if (tid == 0) { unsigned sp = 0; while (__hip_atomic_load(cw + CW_S1, __ATOMIC_RELAXED, __HIP_MEMORY_SCOPE_AGENT) < 128u) { __builtin_amdgcn_s_sleep(4); if (++sp > (1u << 22)) break; } }
                __syncthreads(); __builtin_amdgcn_fence(__ATOMIC_ACQUIRE, "agent");
                small_gemm_task<0>(p, (const bf16*)(p->ws + WS_MIX) + (size_t)MP * DM, (const bf16*)(p->ws + WS_WOUT), DM, 32 * (u - 1152), lds, wave, lane);
            }
        }
    }
    GRID_SYNC();
    STAMP(4);

    {
        KP p = kargs(); unsigned char* ws = p->ws;
        pg8::Gemm g{(const bf16*)(ws + WS_MIX), (const bf16*)(ws + WS_WOUT), MP, DM, DM}; pg8::StaticOrder S; S.init(MP, DM, G, bx);
        if (PROBE_P3) { EpiOut E0{p->in[I_XP], p->in[I_XS], (float*)(ws + 92 * MiB), ws + 128 * MiB}; pg8::gemm_phase<EpiOut, pg8::StaticOrder, true, true>(lds, g, S, E0); }
        EpiOut E{p->in[I_N1G], p->in[I_XS], p->out, ws};
        pg8::gemm_phase<EpiOut, pg8::StaticOrder, true, true>(lds, g, S, E);
    }
    GRID_SYNC();
    STAMP(5);

    for (int rep = 0; rep < REP_P4; ++rep) {
        KP p = kargs(); unsigned char* ws = p->ws;
        pg8::Gemm g{(const bf16*)(ws + WS_HB), (const bf16*)(ws + WS_WGU), MPAD, 2 * DFF, DM}; pg8::StaticOrder S; S.init(MPAD, 2 * DFF, G, bx);
        EpiGU E{ws};
        pg8::gemm_phase<EpiGU, pg8::StaticOrder, true, true>(lds, g, S, E);
        { PHASE_IDS int slot, ns; slack_slot((MPAD / 256) * (2 * DFF / 256), G, bx, slot, ns);
          if (slot >= 0) { convert_items(p, lds, CI_WU, CI_WD, slot * NWAVES + wave, ns * NWAVES, wave, lane);
                           copy_windows(p, (slot * NWAVES + wave) * 64 + lane, ns * NWAVES * 64); } }
    }
    GRID_SYNC();
    STAMP(6);

    {
        KP p = kargs(); unsigned char* ws = p->ws;
        pg8::Gemm g{(const bf16*)(ws + WS_FF), (const bf16*)(ws + WS_WD), MP, DM, DFF}; pg8::StaticOrder S; S.init(MP, DM, G, bx);
        EpiDownFused E{ws, p->out, p->in[I_FNG]};
        pg8::gemm_phase<EpiDownFused, pg8::StaticOrder, false, true>(lds, g, S, E);
        { PHASE_IDS
          int ndone = 0;
          for (int u = bx; u < 32; u += G) { small_gemm_task<1>(p, (const bf16*)(ws + WS_FF) + (size_t)MP * DFF, (const bf16*)(ws + WS_WD), DFF, 32 * u, lds, wave, lane); ++ndone; }
          if (ndone) {
              __threadfence(); __syncthreads();
              LAS unsigned* flag = (LAS unsigned*)(lds + 8192);
              if (tid == 0) { const unsigned old = atomicAdd(g_ctl + CW_SAMPLE, (unsigned)ndone); *flag = (old + (unsigned)ndone == 32u) ? 1u : 0u; }
              __syncthreads();
              if (*flag) {
                  __builtin_amdgcn_fence(__ATOMIC_ACQUIRE, "agent");
                  const f32x4* g4 = (const f32x4*)p->in[I_FNG] + lane;
                  f32x4 gq[4];
#pragma unroll
                  for (int j = 0; j < 4; ++j) gq[j] = g4[64 * j];
                  for (int m0 = MP + wave; m0 < MR; m0 += 4 * NWAVES) {
                      f32x4 v[4][4];
#pragma unroll
                      for (int q = 0; q < 4; ++q) { const f32x4* yr = (const f32x4*)(p->out + (size_t)(m0 + q * NWAVES) * DM) + lane;
#pragma unroll
                          for (int j = 0; j < 4; ++j) v[q][j] = yr[64 * j]; }
#pragma unroll
                      for (int q = 0; q < 4; ++q) { float s = 0.f;
#pragma unroll
                          for (int j = 0; j < 4; ++j) s += (v[q][j].x * v[q][j].x + v[q][j].y * v[q][j].y) + (v[q][j].z * v[q][j].z + v[q][j].w * v[q][j].w);
                          const float rs = frsq(wave_sum(s, lane) * (1.f / DM) + EPS);
                          f32x4* yw = (f32x4*)(p->out + (size_t)(m0 + q * NWAVES) * DM) + lane;
#pragma unroll
                          for (int j = 0; j < 4; ++j) yw[64 * j] = v[q][j] * rs * gq[j]; }
                  }
              }
          }
        }
    }
    STAMP(7);
    STAMP(8);
    if (STAMP_A >= 0 && blockIdx.x == 0 && threadIdx.x == 0) {
        const LAS unsigned long long* ts = (const LAS unsigned long long*)(lds + 131072 + 64);
        const unsigned long long d = (ts[STAMP_B < 0 ? 0 : STAMP_B] - ts[STAMP_A < 0 ? 0 : STAMP_A]) * STAMP_MULT, t0 = __builtin_amdgcn_s_memrealtime();
        while (__builtin_amdgcn_s_memrealtime() - t0 < d) __builtin_amdgcn_s_sleep(16);
    }
}

extern "C" void kernel_launch(void* const* d_in, const int* in_sizes, int n_in, void* d_out, int out_size, void* d_ws, size_t ws_size, hipStream_t stream) {
    static int grid = 0;
    if (grid == 0) {
        int dev = 0, cus = 0, per_cu = 0;
        hipGetDevice(&dev);
        hipDeviceGetAttribute(&cus, hipDeviceAttributeMultiprocessorCount, dev);
        hipFuncSetAttribute((const void*)fwd_megakernel, hipFuncAttributeMaxDynamicSharedMemorySize, LDS_BYTES);
        hipOccupancyMaxActiveBlocksPerMultiprocessor(&per_cu, (const void*)fwd_megakernel, NTHR, LDS_BYTES);
        if (per_cu < 1) { fprintf(stderr, "kernel_launch: occupancy query says %d blocks/CU\n", per_cu); per_cu = 1; }
        (void)hipGetLastError();
        grid = cus;
        if (n_in != 24 || ws_size < WS_END || (size_t)out_size != OUT_END) fprintf(stderr, "kernel_launch: unexpected sizes n_in %d ws %zu out %d\n", n_in, ws_size, out_size);
    }
    Params p{};
    for (int i = 0; i < 24; ++i) p.in[i] = (const float*)d_in[i];
    p.out = (float*)d_out; p.ws = (unsigned char*)d_ws;
    void* args[] = {&p};
    hipError_t e = hipLaunchCooperativeKernel((const void*)fwd_megakernel, dim3(grid), dim3(NTHR), args, LDS_BYTES, stream);
    if (e != hipSuccess) fprintf(stderr, "cooperative launch failed: %s (grid %d)\n", hipGetErrorString(e), grid);
}
```
